# Optimizing an MI355X kernel written in HIP

```python
import jax, jax.numpy as jnp
from jax import lax
import numpy as np

D_MODEL = 2048
BATCH = 4
SEQ = 2048
DEPTH = 4

RMS_EPS = 1e-6
SSM_WIDTH = D_MODEL // 2
SSM_GROUP_SIZE = 16
SSM_GROUPS = SSM_WIDTH // SSM_GROUP_SIZE
SSM_STATE = 64
SSM_DT_MIN = 0.001
SSM_DT_MAX = 0.1
GLA_HEADS = 4
GLA_KEY_WIDTH = D_MODEL // 4
GLA_VALUE_WIDTH = D_MODEL // 2
GLA_DK = GLA_KEY_WIDTH // GLA_HEADS
GLA_DV = GLA_VALUE_WIDTH // GLA_HEADS
GLA_GATE_RANK = 16
GLA_GATE_NORM = 16.0
GLA_CHUNK = 64
MOBA_WIDTH = D_MODEL // 2
MOBA_HEAD_DIM = 128
MOBA_HEADS = MOBA_WIDTH // MOBA_HEAD_DIM
MOBA_BLOCK = 256
MOBA_TOPK = 3
MOBA_Q_CHUNK = 32
FFN_HIDDEN = -(-8 * D_MODEL // (3 * 256)) * 256
IN_SPLIT_SIZES = (SSM_WIDTH, GLA_KEY_WIDTH, GLA_KEY_WIDTH, GLA_VALUE_WIDTH, GLA_VALUE_WIDTH,
                  GLA_GATE_RANK, MOBA_WIDTH, MOBA_WIDTH, MOBA_WIDTH, D_MODEL, D_MODEL, D_MODEL)
IN_WIDTH = sum(IN_SPLIT_SIZES)

kernel_name = "hybrid_s5_gla_moba_gated_trunk"


def rms_norm(x, g):
    xf = x.astype(jnp.float32)
    y = xf * lax.rsqrt(jnp.mean(xf * xf, axis=-1, keepdims=True) + RMS_EPS)
    return (y * g.astype(jnp.float32)).astype(x.dtype)


def s5_mixer(u, lam_re, lam_im, log_dt, b_re, b_im, c_re, c_im, d_skip, w_glu, b_glu):
    bsz, L, _ = u.shape
    ug = u.reshape(bsz, L, SSM_GROUPS, SSM_GROUP_SIZE)
    dt = jnp.exp(log_dt)[:, None]
    mag = jnp.exp(lam_re * dt)
    ang = lam_im * dt
    a_re = mag * jnp.cos(ang)
    a_im = mag * jnp.sin(ang)
    den = lam_re * lam_re + lam_im * lam_im
    n_re = a_re - 1.0
    n_im = a_im
    z_re = (n_re * lam_re + n_im * lam_im) / den
    z_im = (n_im * lam_re - n_re * lam_im) / den
    bb_re = z_re[..., None] * b_re - z_im[..., None] * b_im
    bb_im = z_re[..., None] * b_im + z_im[..., None] * b_re
    bu_re = jnp.einsum('blgc,gpc->blgp', ug, bb_re)
    bu_im = jnp.einsum('blgc,gpc->blgp', ug, bb_im)
    ar = jnp.broadcast_to(a_re, bu_re.shape)
    ai = jnp.broadcast_to(a_im, bu_im.shape)

    def combine(e1, e2):
        ar1, ai1, br1, bi1 = e1
        ar2, ai2, br2, bi2 = e2
        return (ar1 * ar2 - ai1 * ai2,
                ar1 * ai2 + ai1 * ar2,
                ar2 * br1 - ai2 * bi1 + br2,
                ar2 * bi1 + ai2 * br1 + bi2)

    _, _, x_re, x_im = lax.associative_scan(combine, (ar, ai, bu_re, bu_im), axis=1)
    y = (jnp.einsum('blgp,gcp->blgc', x_re, c_re)
         - jnp.einsum('blgp,gcp->blgc', x_im, c_im))
    y = y.reshape(bsz, L, SSM_WIDTH) + d_skip * u
    z = jax.nn.gelu(y)
    return z * jax.nn.sigmoid(z @ w_glu + b_glu)


def gla_mixer(q, k, v, r, gate_lr, w_gate2, b_gate2, norm_g):
    bsz, L, _ = q.shape
    H, C = GLA_HEADS, GLA_CHUNK
    N = L // C
    f32 = jnp.float32

    def heads(t, dh):
        return t.astype(f32).reshape(bsz, N, C, H, dh).transpose(0, 3, 1, 2, 4)

    g = jax.nn.log_sigmoid((gate_lr @ w_gate2 + b_gate2).astype(f32)) / GLA_GATE_NORM
    qh = heads(q, GLA_DK) * (GLA_DK ** -0.5)
    kh = heads(k, GLA_DK)
    vh = heads(v, GLA_DV)
    gh = heads(g, GLA_DK)
    bcum = jnp.cumsum(gh, axis=3)
    b_last = bcum[:, :, :, -1:, :]
    q_dec = qh * jnp.exp(bcum)
    k_inv = kh * jnp.exp(-bcum)
    causal = jnp.tril(jnp.ones((C, C), dtype=bool))
    attn = jnp.einsum('bhncd,bhnjd->bhncj', q_dec, k_inv)
    attn = jnp.where(causal, attn, 0.0)
    o_intra = jnp.einsum('bhncj,bhnje->bhnce', attn, vh)
    k_dec = kh * jnp.exp(b_last - bcum)
    kv = jnp.einsum('bhncd,bhnce->bhnde', k_dec, vh)
    decay = jnp.exp(b_last[:, :, :, 0, :])

    def step(s, inp):
        dec, kv_n = inp
        return dec[..., None] * s + kv_n, s

    s0 = jnp.zeros((bsz, H, GLA_DK, GLA_DV), f32)
    _, s_prev = lax.scan(step, s0, (jnp.moveaxis(decay, 2, 0), jnp.moveaxis(kv, 2, 0)))
    s_prev = jnp.moveaxis(s_prev, 0, 2)
    o = o_intra + jnp.einsum('bhncd,bhnde->bhnce', q_dec, s_prev)
    o = rms_norm(o, norm_g)
    o = o.transpose(0, 2, 3, 1, 4).reshape(bsz, L, GLA_VALUE_WIDTH).astype(q.dtype)
    return o * jax.nn.silu(r)


def moba_mixer(q, k, v, q_g, k_g):
    bsz, L, _ = q.shape
    H, hd, BS, QC = MOBA_HEADS, MOBA_HEAD_DIM, MOBA_BLOCK, MOBA_Q_CHUNK
    Lp = -(-L // BS) * BS
    nb = Lp // BS
    topk = min(MOBA_TOPK, nb)
    pad = Lp - L

    def heads(t):
        t = jnp.pad(t, ((0, 0), (0, pad), (0, 0), (0, 0)))
        return t.transpose(0, 2, 1, 3)

    qh = heads(rms_norm(q.reshape(bsz, L, H, hd), q_g) * (hd ** -0.5))
    kh = heads(rms_norm(k.reshape(bsz, L, H, hd), k_g))
    vh = heads(v.reshape(bsz, L, H, hd))
    k_blocks = kh.reshape(bsz, H, nb, BS, hd)
    v_blocks = vh.reshape(bsz, H, nb, BS, hd)
    k_mean = jnp.mean(k_blocks, axis=3)

    blk_scores = jnp.einsum('bhqd,bhnd->bhqn', qh, k_mean).astype(jnp.float32)
    q_blk = jnp.arange(Lp) // BS
    past = jnp.arange(nb)[None, :] < q_blk[:, None]
    blk_scores = jnp.where(past, blk_scores, -jnp.inf)
    _, sel = lax.top_k(blk_scores, topk)
    sel_valid = jnp.arange(topk)[None, :] < q_blk[:, None]
    gather = jax.vmap(jax.vmap(lambda blocks, idx: blocks[idx]))

    def chunk(c):
        start = c * QC
        blk = start // BS
        q_c = lax.dynamic_slice_in_dim(qh, start, QC, axis=2)
        sel_c = lax.dynamic_slice_in_dim(sel, start, QC, axis=2)
        valid_c = lax.dynamic_slice_in_dim(sel_valid, start, QC, axis=0)
        k_sel = gather(k_blocks, sel_c)
        v_sel = gather(v_blocks, sel_c)
        s_past = jnp.einsum('bhqd,bhqkjd->bhqkj', q_c, k_sel).astype(jnp.float32)
        s_past = jnp.where(valid_c[None, None, :, :, None], s_past, -jnp.inf)
        s_past = s_past.reshape(bsz, H, QC, topk * BS)
        k_own = lax.dynamic_slice_in_dim(kh, blk * BS, BS, axis=2)
        v_own = lax.dynamic_slice_in_dim(vh, blk * BS, BS, axis=2)
        s_own = jnp.einsum('bhqd,bhjd->bhqj', q_c, k_own).astype(jnp.float32)
        q_pos = start + jnp.arange(QC)
        k_pos = blk * BS + jnp.arange(BS)
        s_own = jnp.where(k_pos[None, :] <= q_pos[:, None], s_own, -jnp.inf)
        p = jax.nn.softmax(jnp.concatenate([s_past, s_own], axis=-1), axis=-1).astype(v.dtype)
        p_past = p[..., :topk * BS].reshape(bsz, H, QC, topk, BS)
        p_own = p[..., topk * BS:]
        return (jnp.einsum('bhqkj,bhqkjd->bhqd', p_past, v_sel)
                + jnp.einsum('bhqj,bhjd->bhqd', p_own, v_own))

    o = lax.map(chunk, jnp.arange(Lp // QC))
    o = o.transpose(1, 0, 3, 2, 4).reshape(bsz, Lp, H * hd)
    return o[:, :L]


def setup_inputs(seed: int = 0) -> dict:
    key = jax.random.key(seed)
    ks = jax.random.split(key, 26)
    f32 = jnp.float32

    def nrm(k, shape, scale):
        return jax.random.normal(k, shape, f32) * scale

    G, P, S = SSM_GROUPS, SSM_STATE, SSM_GROUP_SIZE
    lam_im0 = jnp.pi * jnp.arange(P, dtype=f32)
    return {
        "x": nrm(ks[0], (BATCH, SEQ, D_MODEL), 1.0),
        "norm1_g": 1.0 + nrm(ks[1], (DEPTH, D_MODEL), 0.01),
        "w_in": nrm(ks[2], (DEPTH, D_MODEL, IN_WIDTH), D_MODEL ** -0.5),
        "ssm_lambda_re": -0.5 + nrm(ks[3], (DEPTH, G, P), 0.01),
        "ssm_lambda_im": lam_im0 + nrm(ks[4], (DEPTH, G, P), 0.01),
        "ssm_log_dt": jax.random.uniform(ks[5], (DEPTH, G), f32, np.log(SSM_DT_MIN), np.log(SSM_DT_MAX)),
        "ssm_b_re": nrm(ks[6], (DEPTH, G, P, S), (2.0 * S) ** -0.5),
        "ssm_b_im": nrm(ks[7], (DEPTH, G, P, S), (2.0 * S) ** -0.5),
        "ssm_c_re": nrm(ks[8], (DEPTH, G, S, P), (2.0 * P) ** -0.5),
        "ssm_c_im": nrm(ks[9], (DEPTH, G, S, P), (2.0 * P) ** -0.5),
        "ssm_d": nrm(ks[10], (DEPTH, SSM_WIDTH), 1.0),
        "ssm_w_glu": nrm(ks[11], (DEPTH, SSM_WIDTH, SSM_WIDTH), SSM_WIDTH ** -0.5),
        "ssm_b_glu": nrm(ks[12], (DEPTH, SSM_WIDTH), 0.01),
        "gla_w_gate2": nrm(ks[13], (DEPTH, GLA_GATE_RANK, GLA_KEY_WIDTH), GLA_GATE_RANK ** -0.5),
        "gla_b_gate2": nrm(ks[14], (DEPTH, GLA_KEY_WIDTH), 0.01),
        "gla_norm_g": 1.0 + nrm(ks[15], (DEPTH, GLA_DV), 0.01),
        "moba_q_norm_g": 1.0 + nrm(ks[16], (DEPTH, MOBA_HEAD_DIM), 0.01),
        "moba_k_norm_g": 1.0 + nrm(ks[17], (DEPTH, MOBA_HEAD_DIM), 0.01),
        "w_branch_ssm": nrm(ks[18], (DEPTH, SSM_WIDTH, D_MODEL), SSM_WIDTH ** -0.5),
        "w_branch_gla": nrm(ks[19], (DEPTH, GLA_VALUE_WIDTH, D_MODEL), GLA_VALUE_WIDTH ** -0.5),
        "w_branch_moba": nrm(ks[20], (DEPTH, MOBA_WIDTH, D_MODEL), MOBA_WIDTH ** -0.5),
        "w_out": nrm(ks[21], (DEPTH, D_MODEL, D_MODEL), D_MODEL ** -0.5),
        "norm2_g": 1.0 + nrm(ks[22], (DEPTH, D_MODEL), 0.01),
        "ffn_w_gate": nrm(ks[23], (DEPTH, D_MODEL, FFN_HIDDEN), D_MODEL ** -0.5),
        "ffn_w_up": nrm(ks[24], (DEPTH, D_MODEL, FFN_HIDDEN), D_MODEL ** -0.5),
        "ffn_w_down": nrm(ks[25], (DEPTH, FFN_HIDDEN, D_MODEL), FFN_HIDDEN ** -0.5),
    }


def reference(x, norm1_g, w_in, ssm_lambda_re, ssm_lambda_im, ssm_log_dt, ssm_b_re, ssm_b_im,
              ssm_c_re, ssm_c_im, ssm_d, ssm_w_glu, ssm_b_glu, gla_w_gate2, gla_b_gate2, gla_norm_g,
              moba_q_norm_g, moba_k_norm_g, w_branch_ssm, w_branch_gla, w_branch_moba, w_out,
              norm2_g, ffn_w_gate, ffn_w_up, ffn_w_down):
    split_points = np.cumsum(IN_SPLIT_SIZES)[:-1].tolist()
    for l in range(DEPTH):
        xn = rms_norm(x, norm1_g[l])
        proj = xn @ w_in[l]
        (ssm_u, gla_q, gla_k, gla_v, gla_r, gla_glr, moba_q, moba_k, moba_v,
         gate_ssm, gate_gla, gate_moba) = jnp.split(proj, split_points, axis=-1)
        y_ssm = s5_mixer(ssm_u, ssm_lambda_re[l], ssm_lambda_im[l], ssm_log_dt[l], ssm_b_re[l],
                         ssm_b_im[l], ssm_c_re[l], ssm_c_im[l], ssm_d[l], ssm_w_glu[l], ssm_b_glu[l])
        y_gla = gla_mixer(gla_q, gla_k, gla_v, gla_r, gla_glr, gla_w_gate2[l], gla_b_gate2[l],
                          gla_norm_g[l])
        y_moba = moba_mixer(moba_q, moba_k, moba_v, moba_q_norm_g[l], moba_k_norm_g[l])
        merged = (jax.nn.sigmoid(gate_ssm) * (y_ssm @ w_branch_ssm[l])
                  + jax.nn.sigmoid(gate_gla) * (y_gla @ w_branch_gla[l])
                  + jax.nn.sigmoid(gate_moba) * (y_moba @ w_branch_moba[l]))
        x = x + merged @ w_out[l]
        h = rms_norm(x, norm2_g[l])
        x = x + (jax.nn.silu(h @ ffn_w_gate[l]) * (h @ ffn_w_up[l])) @ ffn_w_down[l]
    return x
```

```cpp
#include <hip/hip_runtime.h>
#include <cstdio>
#include <cstdint>

#ifndef MK_FUSED
#define MK_FUSED 0
#endif

__device__ __forceinline__ unsigned char* opaque_ptr(unsigned char* p) { asm volatile("" : "+s"(p)); return p; }
__device__ __forceinline__ int opaque_tid() { int t = threadIdx.x; asm volatile("" : "+v"(t)); return t; }

namespace pg8 {
#define PG8_LAS __attribute__((address_space(3)))
typedef unsigned short bf16_t;
typedef short bf16x8 __attribute__((ext_vector_type(8)));
typedef float f32x4 __attribute__((ext_vector_type(4)));
typedef unsigned u32x4 __attribute__((ext_vector_type(4)));
typedef unsigned u32x2 __attribute__((ext_vector_type(2)));
constexpr int BM = 256, BK = 64, HALF = 128, HTB = HALF * BK * 2, STAGE_BYTES = 8 * HTB, NXCD = 8, WGM = 8;

__host__ __device__ __forceinline__ int lds_byte(int r, int c) { const int st = (r >> 4) * 2 + (c >> 5), rr = r & 15, cc = c & 31, ob = rr * 64 + cc * 2; return st * 1024 + (ob ^ (((ob >> 9) & 1) << 5)); }
__host__ __device__ __forceinline__ void stage_rc(int b, int& R, int& C) { const int st = b / 1024, sb = b % 1024, swz = sb ^ (((sb >> 9) & 1) << 5); R = (st >> 1) * 16 + swz / 64; C = (st & 1) * 32 + (swz % 64) / 2; }
__host__ __device__ __forceinline__ int perm32(int rho) { const int n = rho >> 4, i = rho & 15; return 8 * (i >> 2) + 4 * n + (i & 3); }

struct Unit { int pm, pn, br; };
struct Gemm { const bf16_t* A; int lda; const bf16_t* Bt; int ldb; int K; int abr, bbr; };

struct TileOrder {
    int nM, nN, nwg, G, c, nbr;
    __device__ __forceinline__ void init(int M, int N, int G_, int c_, int nbr_) { asm volatile("" : "+s"(G_), "+s"(c_)); nM = M / BM; nN = N / BM; nwg = nM * nN; G = G_; c = c_; nbr = nbr_; }
    __device__ __forceinline__ bool next(int i, Unit& u) const {
        const int it = i / nbr; u.br = i - it * nbr;
        const long L = (long)it * G + c; if (L >= nwg) return false;
        int wgid = (int)L; { const int q = nwg / NXCD, r = nwg % NXCD, xcd = wgid % NXCD, off = wgid / NXCD; wgid = (xcd < r ? xcd * (q + 1) : r * (q + 1) + (xcd - r) * q) + off; }
        const int nig = WGM * nN, gid = wgid / nig, fm = gid * WGM, gsz = (nM - fm) < WGM ? (nM - fm) : WGM;
        u.pm = __builtin_amdgcn_readfirstlane(fm + ((wgid % nig) % gsz)); u.pn = __builtin_amdgcn_readfirstlane((wgid % nig) / gsz); return true;
    }
};

__device__ __forceinline__ unsigned cvt_pk_bf16(float lo, float hi) { unsigned r; asm volatile("v_cvt_pk_bf16_f32 %0, %1, %2" : "=v"(r) : "v"(lo), "v"(hi)); return r; }

template <class Epi, class Sched>
__device__ __forceinline__ void gemm_phase(PG8_LAS unsigned char* lds, const Gemm g, const Sched& S, const Epi& E) {
    const int tid = opaque_tid(), wid = __builtin_amdgcn_readfirstlane(tid >> 6), lane = tid & 63, wr = wid >> 2, wc = wid & 3, fr = lane & 15, fq = lane >> 4;
    const int K = g.K, nt = K / BK;
    unsigned voffA[2], voffB[2];
#pragma unroll
    for (int i = 0; i < 2; ++i) { int R, C; stage_rc(tid * 16 + i * 8192, R, C); const int Rb = (R & ~31) + perm32(R & 31);
        voffA[i] = (unsigned)(R * g.lda + C) * 2u; voffB[i] = (unsigned)(Rb * g.ldb + C) * 2u; }
    const size_t kstep = (size_t)(BK * 2);
    const size_t hstepA = (size_t)HALF * g.lda * 2, hstepB = (size_t)HALF * g.ldb * 2;
    const size_t tstepA = 2 * hstepA, tstepB = 2 * hstepB;
    const unsigned ldsw = (unsigned)wid * 1024u;
    const int aoff = lds_byte(wr * 64 + fr, fq * 8), boff = lds_byte(wc * 32 + fr, fq * 8);
#define PG8_SA(b, h) (((b) * 2 + (h)) * HTB)
#define PG8_SB(b, h) ((4 + (b) * 2 + (h)) * HTB)
#define PG8_STAGE(bufoff, gbase, voff) do { _Pragma("unroll") for (int _i = 0; _i < 2; ++_i) \
        __builtin_amdgcn_global_load_lds((const unsigned*)((const char*)(gbase) + (voff)[_i]), (PG8_LAS unsigned*)(lds + (bufoff) + ldsw + _i * 8192), 16, 0, 0); } while (0)
#define PG8_LDA(dst, b, h) do { _Pragma("unroll") for (int m = 0; m < 4; ++m) _Pragma("unroll") for (int k = 0; k < 2; ++k) dst[m][k] = *(const PG8_LAS bf16x8*)(lds + PG8_SA(b, h) + aoff + m * 2048 + k * 1024); } while (0)
#define PG8_LDB(dst, b, h) do { _Pragma("unroll") for (int n = 0; n < 2; ++n) _Pragma("unroll") for (int k = 0; k < 2; ++k) dst[n][k] = *(const PG8_LAS bf16x8*)(lds + PG8_SB(b, h) + boff + n * 2048 + k * 1024); } while (0)
#define PG8_MMA(ai, bj, At, Bt) do { __builtin_amdgcn_s_setprio(1); _Pragma("unroll") for (int m = 0; m < 4; ++m) _Pragma("unroll") for (int n = 0; n < 2; ++n) _Pragma("unroll") for (int k = 0; k < 2; ++k) \
        acc[ai][bj][m][n] = __builtin_amdgcn_mfma_f32_16x16x32_bf16(Bt[n][k], At[m][k], acc[ai][bj][m][n], 0, 0, 0); __builtin_amdgcn_s_setprio(0); } while (0)
#define PG8_WAIT_V(n) asm volatile("s_waitcnt vmcnt(" #n ")" ::: "memory")
#define PG8_WAIT_L(n) asm volatile("s_waitcnt lgkmcnt(" #n ")" ::: "memory")
#define PG8_BAR __builtin_amdgcn_s_barrier()
#define PG8_SCHED __builtin_amdgcn_sched_barrier(0)
    Unit cur, nxt; int ui = 0;
    if (!S.next(0, cur)) return;
    f32x4 acc[2][2][4][2];
#pragma unroll
    for (int a = 0; a < 2; ++a)
#pragma unroll
        for (int b = 0; b < 2; ++b)
#pragma unroll
            for (int m = 0; m < 4; ++m)
#pragma unroll
                for (int n = 0; n < 2; ++n) acc[a][b][m][n] = (f32x4){0.f, 0.f, 0.f, 0.f};
    bf16x8 At[4][2], B0[2][2], B1[2][2];
    const char* cA = (const char*)g.A + (size_t)cur.pm * tstepA + (size_t)cur.br * g.abr * 2; const char* cB = (const char*)g.Bt + (size_t)cur.pn * tstepB + (size_t)cur.br * g.bbr * 2;
    PG8_STAGE(PG8_SB(0, 0), cB, voffB); PG8_STAGE(PG8_SB(0, 1), cB + hstepB, voffB); PG8_STAGE(PG8_SA(0, 0), cA, voffA); PG8_STAGE(PG8_SA(0, 1), cA + hstepA, voffA);
    if (wr == 1) PG8_BAR;
    PG8_WAIT_V(2); PG8_BAR;
    PG8_STAGE(PG8_SB(1, 0), cB + kstep, voffB); PG8_STAGE(PG8_SA(1, 0), cA + kstep, voffA); PG8_STAGE(PG8_SB(1, 1), cB + hstepB + kstep, voffB);
    PG8_WAIT_V(6); PG8_BAR;
    for (;;) {
        const bool has_next = S.next(ui + 1, nxt);
        const char* nA = has_next ? (const char*)g.A + (size_t)nxt.pm * tstepA + (size_t)nxt.br * g.abr * 2 : cA; const char* nB = has_next ? (const char*)g.Bt + (size_t)nxt.pn * tstepB + (size_t)nxt.br * g.bbr * 2 : cB;
        for (int t = 0; t < nt; t += 2) {
            const bool last = (t == nt - 2);
            const char* a1 = cA + (size_t)(t + 1) * kstep;
            const char* a2 = last ? nA : cA + (size_t)(t + 2) * kstep; const char* b2 = last ? nB : cB + (size_t)(t + 2) * kstep;
            const char* a3 = a2 + kstep; const char* b3 = b2 + kstep;
            PG8_LDB(B0, 0, 0); PG8_LDB(B1, 0, 1); PG8_SCHED; PG8_LDA(At, 0, 0); PG8_STAGE(PG8_SA(1, 1), a1 + hstepA, voffA);
            PG8_WAIT_V(8); PG8_WAIT_L(0); PG8_BAR; PG8_MMA(0, 0, At, B0); PG8_MMA(0, 1, At, B1); PG8_BAR; PG8_SCHED;
            PG8_LDA(At, 0, 1); PG8_STAGE(PG8_SB(0, 0), b2, voffB); PG8_STAGE(PG8_SB(0, 1), b2 + hstepB, voffB); PG8_STAGE(PG8_SA(0, 0), a2, voffA);
            PG8_WAIT_V(8); PG8_WAIT_L(0); PG8_BAR; PG8_MMA(1, 0, At, B0); PG8_MMA(1, 1, At, B1); PG8_BAR; PG8_SCHED;
            PG8_LDB(B0, 1, 0); PG8_LDB(B1, 1, 1); PG8_SCHED; PG8_LDA(At, 1, 0); PG8_STAGE(PG8_SA(0, 1), a2 + hstepA, voffA);
            PG8_WAIT_V(8); PG8_WAIT_L(0); PG8_BAR; PG8_MMA(0, 0, At, B0); PG8_MMA(0, 1, At, B1); PG8_BAR; PG8_SCHED;
            PG8_LDA(At, 1, 1); PG8_STAGE(PG8_SB(1, 0), b3, voffB); PG8_STAGE(PG8_SB(1, 1), b3 + hstepB, voffB); PG8_STAGE(PG8_SA(1, 0), a3, voffA);
            PG8_WAIT_V(8); PG8_WAIT_L(0); PG8_BAR; PG8_MMA(1, 0, At, B0); PG8_MMA(1, 1, At, B1); PG8_BAR; PG8_SCHED;
        }
        if (wr == 0) PG8_BAR;
        E(acc, cur, wr, wc, fr, fq, lds);
        if (!has_next) break;
#pragma unroll
        for (int a = 0; a < 2; ++a)
#pragma unroll
            for (int b = 0; b < 2; ++b)
#pragma unroll
                for (int m = 0; m < 4; ++m)
#pragma unroll
                    for (int n = 0; n < 2; ++n) acc[a][b][m][n] = (f32x4){0.f, 0.f, 0.f, 0.f};
        cur = nxt; cA = nA; cB = nB; ++ui;
        if (wr == 1) PG8_BAR;
    }
    PG8_WAIT_V(0);
    PG8_BAR;
#undef PG8_SA
#undef PG8_SB
#undef PG8_STAGE
#undef PG8_LDA
#undef PG8_LDB
#undef PG8_MMA
#undef PG8_WAIT_V
#undef PG8_WAIT_L
#undef PG8_BAR
#undef PG8_SCHED
}
}

constexpr int NWAVES = 8;
constexpr int DM = 2048, NBATCH = 4, SEQ = 2048, DEPTH = 4, MTOK = NBATCH * SEQ;
constexpr int INW = 13328;
constexpr int NP = 13568;
constexpr int PC_SSM = 0, PC_GQ = 1024, PC_GK = 1536, PC_GV = 2048, PC_GR = 3072, PC_MQ = 4096, PC_MK = 5120, PC_MV = 6144, PC_GS = 7168, PC_GLR = 13312;
constexpr int FFN = 5632, NGU = 2 * FFN;
constexpr int YW = 3072;
constexpr float RMS_EPS = 1e-6f;

constexpr size_t MiB = 1u << 20;
constexpr size_t WS_CTL = 0, CTL_ZERO_BYTES = 1 * MiB;
constexpr size_t SZ_WIN = (size_t)NP * DM * 2, SZ_WGLU = (size_t)1024 * 1024 * 2, SZ_WBR = (size_t)DM * 3072 * 2, SZ_WOUT = (size_t)DM * DM * 2, SZ_WGU = (size_t)NGU * DM * 2, SZ_WDN = (size_t)DM * FFN * 2;
constexpr size_t OFF_WIN = 0, OFF_WGLU = OFF_WIN + SZ_WIN, OFF_WBR = OFF_WGLU + SZ_WGLU, OFF_WOUT = OFF_WBR + SZ_WBR, OFF_WGU = OFF_WOUT + SZ_WOUT, OFF_WDN = OFF_WGU + SZ_WGU, SZ_WLAYER = OFF_WDN + SZ_WDN;
constexpr size_t WS_W = 2 * MiB;
constexpr size_t WS_P = WS_W + ((DEPTH * SZ_WLAYER + MiB - 1) / MiB) * MiB;
constexpr size_t WS_Z = WS_P + (size_t)MTOK * NP * 2;
constexpr size_t WS_Y = WS_Z + (size_t)MTOK * 1024 * 2;
constexpr size_t WS_MG = WS_Y + (size_t)MTOK * YW * 2;
constexpr size_t WS_MB = WS_MG + (size_t)MTOK * DM * 4;
constexpr size_t WS_XR = WS_MB + (size_t)MTOK * DM * 2;
constexpr size_t WS_XB = WS_XR + (size_t)MTOK * DM * 4;
constexpr size_t WS_H = WS_XB + (size_t)MTOK * DM * 2;
constexpr size_t WS_SSQ = WS_H + (size_t)MTOK * FFN * 2;
constexpr size_t WS_EG = WS_SSQ + (size_t)MTOK * 8 * 4;
constexpr size_t WS_OT = WS_EG + (size_t)MTOK * 512 * 4;
constexpr size_t WS_QN = WS_OT + (size_t)4 * MTOK * 1024 * 4;
constexpr size_t WS_KN = WS_QN + (size_t)MTOK * 1024 * 2;
constexpr size_t WS_KM = WS_KN + (size_t)MTOK * 1024 * 2;
constexpr size_t WS_END = WS_KM + (size_t)4 * 8 * 8 * 128 * 4;
constexpr int CW_BAR = 4096;
constexpr int CW_QUEUE = 16384;

constexpr int RING_BYTES = 131072;
constexpr int LDSCTL_OFF = RING_BYTES, MISC_OFF = LDSCTL_OFF + 320;
constexpr int TAB_OFF = RING_BYTES + 1024;
constexpr int LDS_BYTES = 147456;

#define GAS __attribute__((address_space(1)))
#define LAS __attribute__((address_space(3)))
typedef unsigned short bf16;
typedef unsigned v4u __attribute__((ext_vector_type(4)));
typedef unsigned v2u __attribute__((ext_vector_type(2)));
typedef float f32x4 __attribute__((ext_vector_type(4)));
typedef float f32x2 __attribute__((ext_vector_type(2)));
#define LDS_WAIT() asm volatile("s_waitcnt lgkmcnt(0)" ::: "memory")
#define VM_WAIT() asm volatile("s_waitcnt vmcnt(0)" ::: "memory")
__device__ __forceinline__ unsigned f2bf(float f) { unsigned u = __builtin_bit_cast(unsigned, f); return (u + 0x7fffu + ((u >> 16) & 1u)) >> 16; }
__device__ __forceinline__ unsigned pk2(float lo, float hi) { return f2bf(lo) | (f2bf(hi) << 16); }
__device__ __forceinline__ float bflo(unsigned u) { return __builtin_bit_cast(float, u << 16); }
__device__ __forceinline__ float bfhi(unsigned u) { return __builtin_bit_cast(float, u & 0xffff0000u); }
__device__ __forceinline__ float bf1(bf16 b) { return __builtin_bit_cast(float, ((unsigned)b) << 16); }
__device__ __forceinline__ float sigmoidf_(float x) { return __builtin_amdgcn_rcpf(1.0f + __expf(-x)); }
__device__ __forceinline__ float gelu_tanh(float x) { const float u = 0.7978845608028654f * (x + 0.044715f * x * x * x); return x * sigmoidf_(2.0f * u); }
__device__ __forceinline__ float wave_sum(float v) {
#pragma unroll
    for (int o = 1; o < 64; o <<= 1) v += __shfl_xor(v, o);
    return v;
}
__device__ __forceinline__ float wave_max(float v) {
#pragma unroll
    for (int o = 1; o < 64; o <<= 1) v = fmaxf(v, __shfl_xor(v, o));
    return v;
}

#define XB_TMO      128
#define XB_XCNT(j)  (256  + 64 * (j))
#define XB_XSUB(j)  (1280 + 64 * (j))
#define XB_XGEN(j)  (2304 + 64 * (j))
#define XB_TOP      3328
#define XB_TOPGEN   3392
#define XCD_BAR_WORDS 3456
#define XB_SPIN_CAP (1u << 18)
__device__ __forceinline__ unsigned xb_ld(unsigned* p)              { return __hip_atomic_load(p, __ATOMIC_RELAXED, __HIP_MEMORY_SCOPE_AGENT); }
__device__ __forceinline__ unsigned xb_add(unsigned* p, unsigned v) { return __hip_atomic_fetch_add(p, v, __ATOMIC_RELAXED, __HIP_MEMORY_SCOPE_AGENT); }
__device__ __forceinline__ unsigned xb_xcc_id() { return (unsigned)__builtin_amdgcn_s_getreg((3 << 11) | 20) & 0xFu; }
#define XB_SPIN(cond, bar) do { unsigned _sp = 0; while (cond) { __builtin_amdgcn_s_sleep(1); \
    if ((++_sp & 255u) == 0u) { if (xb_ld(&(bar)[XB_TMO])) break; if (_sp > XB_SPIN_CAP) { atomicAdd(&(bar)[XB_TMO], 1u); break; } } } } while (0)
struct XcdBarrier { unsigned* bar; unsigned x; volatile LAS unsigned* st; };
__device__ __forceinline__ XcdBarrier xcd_barrier_post(unsigned* bar, volatile LAS unsigned* st) {
    XcdBarrier b; b.bar = bar; b.x = xb_xcc_id(); b.st = st;
    if (threadIdx.x == 0) (void)xb_add(&bar[XB_XCNT(b.x)], 1u);
    return b;
}
__device__ __forceinline__ void xcd_barrier_complete(unsigned* bar, unsigned x, unsigned& nloc, unsigned& nx) {
    const unsigned G = gridDim.x * gridDim.y * gridDim.z;
    unsigned sum, cnt, mine, sp = 0u;
    for (;;) {
        sum = 0u; cnt = 0u; mine = 0u;
#pragma unroll
        for (unsigned j = 0; j < 16; ++j) { const unsigned c = xb_ld(&bar[XB_XCNT(j)]); sum += c; cnt += (c > 0u) ? 1u : 0u; mine = (j == x) ? c : mine; }
        if (sum == G) break;
        __builtin_amdgcn_s_sleep(1);
        if ((++sp & 255u) == 0u) { if (xb_ld(&bar[XB_TMO])) break; if (sp > XB_SPIN_CAP) { atomicAdd(&bar[XB_TMO], 1u); break; } }
    }
    nloc = mine > 0u ? mine : 1u; nx = cnt > 0u ? cnt : 1u;
}
__device__ __forceinline__ void xcd_barrier(const XcdBarrier& b) {
    asm volatile("s_waitcnt vmcnt(0)" ::: "memory");
    __syncthreads();
    if (threadIdx.x == 0) {
        unsigned* bar = b.bar;
        __builtin_amdgcn_s_waitcnt(0);
        unsigned nloc = b.st[0], nx = b.st[1];
        if (nloc == 0u) { xcd_barrier_complete(bar, b.x, nloc, nx); b.st[0] = nloc; b.st[1] = nx; }
        const unsigned old = xb_add(&bar[XB_XSUB(b.x)], 1u);
        const unsigned gen = old / nloc;
        if (old + 1u == (gen + 1u) * nloc) {
            __builtin_amdgcn_fence(__ATOMIC_RELEASE, "agent");
            asm volatile("s_waitcnt vmcnt(0)" ::: "memory");
            const unsigned og = xb_add(&bar[XB_TOP], 1u);
            const unsigned tg = og / nx;
            if (og + 1u == (tg + 1u) * nx) xb_add(&bar[XB_TOPGEN], 1u);
            else XB_SPIN(xb_ld(&bar[XB_TOPGEN]) == tg, bar);
            __builtin_amdgcn_fence(__ATOMIC_ACQUIRE, "agent");
            xb_add(&bar[XB_XGEN(b.x)], 1u);
            asm volatile("s_waitcnt vmcnt(0)" ::: "memory");
        } else {
            XB_SPIN(xb_ld(&bar[XB_XGEN(b.x)]) == gen, bar);
            __builtin_amdgcn_fence(__ATOMIC_ACQUIRE, "agent");
            asm volatile("s_waitcnt vmcnt(0)" ::: "memory");
        }
    }
    __syncthreads();
}

struct Args {
    const float* in[26];
    float* out; unsigned char* ws;
    int l_lo, l_hi, ph_lo, ph_hi;
    int fused, pad;
};
enum { I_X = 0, I_N1G, I_WIN, I_LRE, I_LIM, I_LDT, I_BRE, I_BIM, I_CRE, I_CIM, I_SD, I_WGLU, I_BGLU, I_GW2, I_GB2, I_GNG, I_MQG, I_MKG, I_WBS, I_WBG, I_WBM, I_WOUT, I_N2G, I_FWG, I_FWU, I_FWD };

namespace pg8 {
#define EPI_FENCE() asm volatile("" ::: "memory")
__device__ __forceinline__ void load_rstd(const float* ssq, int pm, int wr, int fr, int fq, float (&rs)[2][4]) {
    f32x2 p[2][4];
#pragma unroll
    for (int ai = 0; ai < 2; ++ai)
#pragma unroll
        for (int m = 0; m < 4; ++m) { const int row = pm * BM + ai * HALF + wr * 64 + m * 16 + fr; p[ai][m] = *(const f32x2*)(ssq + (size_t)row * 8 + 2 * fq); }
#pragma unroll
    for (int ai = 0; ai < 2; ++ai)
#pragma unroll
        for (int m = 0; m < 4; ++m) { float s = p[ai][m][0] + p[ai][m][1]; s += __shfl_xor(s, 16); s += __shfl_xor(s, 32); rs[ai][m] = 1.0f / sqrtf(s * (1.0f / DM) + RMS_EPS); }
    EPI_FENCE();
}
struct EpiInProj {
    bf16_t* P; const float* ssq;
    __device__ __forceinline__ void operator()(const f32x4 (&acc)[2][2][4][2], const Unit& u, int wr, int wc, int fr, int fq, PG8_LAS unsigned char*) const {
        float rs[2][4]; load_rstd(ssq, u.pm, wr, fr, fq, rs);
        const int row0 = u.pm * BM + wr * 64 + fr, col0 = u.pn * BM + wc * 32 + 8 * fq;
#pragma unroll
        for (int ai = 0; ai < 2; ++ai)
#pragma unroll
            for (int m = 0; m < 4; ++m) { bf16_t* rowp = P + (size_t)(row0 + ai * HALF + m * 16) * NP + col0; const float r = rs[ai][m];
#pragma unroll
                for (int bj = 0; bj < 2; ++bj) { const f32x4 v0 = acc[ai][bj][m][0] * r, v1 = acc[ai][bj][m][1] * r;
                    u32x4 w; w.x = cvt_pk_bf16(v0[0], v0[1]); w.y = cvt_pk_bf16(v0[2], v0[3]); w.z = cvt_pk_bf16(v1[0], v1[1]); w.w = cvt_pk_bf16(v1[2], v1[3]);
                    *(u32x4*)(rowp + bj * HALF) = w; } }
    }
};
struct EpiGLU {
    const bf16_t* Z; bf16_t* Y; const float* bias;
    __device__ __forceinline__ void operator()(const f32x4 (&acc)[2][2][4][2], const Unit& u, int wr, int wc, int fr, int fq, PG8_LAS unsigned char*) const {
        const int row0 = u.pm * BM + wr * 64 + fr, col0 = u.pn * BM + wc * 32 + 8 * fq;
        f32x4 bv[2][2];
#pragma unroll
        for (int bj = 0; bj < 2; ++bj)
#pragma unroll
            for (int n = 0; n < 2; ++n) bv[bj][n] = *(const f32x4*)(bias + col0 + bj * HALF + 4 * n);
        u32x4 zb[2][2];
#pragma unroll
        for (int idx = 0; idx <= 8; ++idx) {
            if (idx < 8) { const size_t row = (size_t)(row0 + (idx >> 2) * HALF + (idx & 3) * 16);
#pragma unroll
                for (int bj = 0; bj < 2; ++bj) zb[idx & 1][bj] = *(const u32x4*)(Z + row * 1024 + col0 + bj * HALF); }
            if (idx > 0) { const int ai = (idx - 1) >> 2, m = (idx - 1) & 3; const size_t row = (size_t)(row0 + ai * HALF + m * 16);
#pragma unroll
                for (int bj = 0; bj < 2; ++bj) { const u32x4 zz = zb[(idx - 1) & 1][bj];
                    const f32x4 g0 = acc[ai][bj][m][0] + bv[bj][0], g1 = acc[ai][bj][m][1] + bv[bj][1];
                    u32x4 w;
                    w.x = cvt_pk_bf16(bflo(zz.x) * sigmoidf_(g0[0]), bfhi(zz.x) * sigmoidf_(g0[1])); w.y = cvt_pk_bf16(bflo(zz.y) * sigmoidf_(g0[2]), bfhi(zz.y) * sigmoidf_(g0[3]));
                    w.z = cvt_pk_bf16(bflo(zz.z) * sigmoidf_(g1[0]), bfhi(zz.z) * sigmoidf_(g1[1])); w.w = cvt_pk_bf16(bflo(zz.w) * sigmoidf_(g1[2]), bfhi(zz.w) * sigmoidf_(g1[3]));
                    *(u32x4*)(Y + row * YW + col0 + bj * HALF) = w; } }
            EPI_FENCE();
        }
    }
};
struct EpiBranch {
    const bf16_t* P; float* MG; bf16_t* MB;
    __device__ __forceinline__ void operator()(const f32x4 (&acc)[2][2][4][2], const Unit& u, int wr, int wc, int fr, int fq, PG8_LAS unsigned char*) const {
        const int row0 = u.pm * BM + wr * 64 + fr, col0 = u.pn * BM + wc * 32 + 8 * fq;
        const int br = u.br;
        u32x4 gb[2][2]; f32x4 mb[2][2][2];
#pragma unroll
        for (int idx = 0; idx <= 8; ++idx) {
            if (idx < 8) { const size_t row = (size_t)(row0 + (idx >> 2) * HALF + (idx & 3) * 16);
#pragma unroll
                for (int bj = 0; bj < 2; ++bj) { const int col = col0 + bj * HALF; gb[idx & 1][bj] = *(const u32x4*)(P + row * NP + PC_GS + br * DM + col);
                    if (br != 0) { mb[idx & 1][bj][0] = *(const f32x4*)(MG + row * DM + col); mb[idx & 1][bj][1] = *(const f32x4*)(MG + row * DM + col + 4); } } }
            if (idx > 0) { const int ai = (idx - 1) >> 2, m = (idx - 1) & 3; const size_t row = (size_t)(row0 + ai * HALF + m * 16);
#pragma unroll
                for (int bj = 0; bj < 2; ++bj) { const int col = col0 + bj * HALF; const u32x4 gg = gb[(idx - 1) & 1][bj];
                    f32x4 v0 = acc[ai][bj][m][0], v1 = acc[ai][bj][m][1];
                    v0[0] *= sigmoidf_(bflo(gg.x)); v0[1] *= sigmoidf_(bfhi(gg.x)); v0[2] *= sigmoidf_(bflo(gg.y)); v0[3] *= sigmoidf_(bfhi(gg.y));
                    v1[0] *= sigmoidf_(bflo(gg.z)); v1[1] *= sigmoidf_(bfhi(gg.z)); v1[2] *= sigmoidf_(bflo(gg.w)); v1[3] *= sigmoidf_(bfhi(gg.w));
                    if (br != 0) { v0 = v0 + mb[(idx - 1) & 1][bj][0]; v1 = v1 + mb[(idx - 1) & 1][bj][1]; }
                    if (br != 2) { *(f32x4*)(MG + row * DM + col) = v0; *(f32x4*)(MG + row * DM + col + 4) = v1; }
                    else { u32x4 w; w.x = cvt_pk_bf16(v0[0], v0[1]); w.y = cvt_pk_bf16(v0[2], v0[3]); w.z = cvt_pk_bf16(v1[0], v1[1]); w.w = cvt_pk_bf16(v1[2], v1[3]); *(u32x4*)(MB + row * DM + col) = w; } } }
            EPI_FENCE();
        }
    }
};
struct EpiResid {
    const float* xin; float* xout; bf16_t* XB; float* ssq;
    __device__ __forceinline__ void operator()(const f32x4 (&acc)[2][2][4][2], const Unit& u, int wr, int wc, int fr, int fq, PG8_LAS unsigned char* lds) const {
        const int row0 = u.pm * BM + wr * 64 + fr, col0 = u.pn * BM + wc * 32 + 8 * fq;
        PG8_LAS float* T = (PG8_LAS float*)(lds + TAB_OFF);
        f32x4 xb[2][2][2];
#pragma unroll
        for (int idx = 0; idx <= 8; ++idx) {
            if (idx < 8) { const size_t row = (size_t)(row0 + (idx >> 2) * HALF + (idx & 3) * 16);
#pragma unroll
                for (int bj = 0; bj < 2; ++bj) { const size_t o = row * DM + col0 + bj * HALF; xb[idx & 1][bj][0] = *(const f32x4*)(xin + o); xb[idx & 1][bj][1] = *(const f32x4*)(xin + o + 4); } }
            if (idx > 0) { const int ai = (idx - 1) >> 2, m = (idx - 1) & 3; const size_t row = (size_t)(row0 + ai * HALF + m * 16); float s = 0.f;
#pragma unroll
                for (int bj = 0; bj < 2; ++bj) { const size_t o = row * DM + col0 + bj * HALF;
                    const f32x4 v0 = acc[ai][bj][m][0] + xb[(idx - 1) & 1][bj][0], v1 = acc[ai][bj][m][1] + xb[(idx - 1) & 1][bj][1];
                    *(f32x4*)(xout + o) = v0; *(f32x4*)(xout + o + 4) = v1;
                    u32x4 w; w.x = cvt_pk_bf16(v0[0], v0[1]); w.y = cvt_pk_bf16(v0[2], v0[3]); w.z = cvt_pk_bf16(v1[0], v1[1]); w.w = cvt_pk_bf16(v1[2], v1[3]); *(u32x4*)(XB + o) = w;
                    s += (v0[0] * v0[0] + v0[1] * v0[1]) + (v0[2] * v0[2] + v0[3] * v0[3]) + (v1[0] * v1[0] + v1[1] * v1[1]) + (v1[2] * v1[2] + v1[3] * v1[3]); }
                s += __shfl_xor(s, 16); s += __shfl_xor(s, 32);
                if (fq == 0) T[(ai * HALF + wr * 64 + m * 16 + fr) * 4 + wc] = s; }
            EPI_FENCE();
        }
        asm volatile("s_waitcnt lgkmcnt(0)" ::: "memory"); __builtin_amdgcn_s_barrier(); asm volatile("" ::: "memory");
        const int t = (wr * 4 + wc) * 64 + fq * 16 + fr;
        if (t < 256) { const f32x4 p = *(const PG8_LAS f32x4*)(T + t * 4); ssq[(size_t)(u.pm * BM + t) * 8 + u.pn] = (p[0] + p[1]) + (p[2] + p[3]); }
    }
};
struct EpiFFNUp {
    bf16_t* H; const float* ssq;
    __device__ __forceinline__ void operator()(const f32x4 (&acc)[2][2][4][2], const Unit& u, int wr, int wc, int fr, int fq, PG8_LAS unsigned char*) const {
        float rs[2][4]; load_rstd(ssq, u.pm, wr, fr, fq, rs);
        const int row0 = u.pm * BM + wr * 64 + fr, col0 = u.pn * HALF + wc * 32 + 8 * fq;
#pragma unroll
        for (int ai = 0; ai < 2; ++ai)
#pragma unroll
            for (int m = 0; m < 4; ++m) { const float r = rs[ai][m]; float h[8];
#pragma unroll
                for (int n = 0; n < 2; ++n)
#pragma unroll
                    for (int e = 0; e < 4; ++e) { const float gv = acc[ai][0][m][n][e] * r, uv = acc[ai][1][m][n][e] * r; h[n * 4 + e] = gv * sigmoidf_(gv) * uv; }
                u32x4 w; w.x = cvt_pk_bf16(h[0], h[1]); w.y = cvt_pk_bf16(h[2], h[3]); w.z = cvt_pk_bf16(h[4], h[5]); w.w = cvt_pk_bf16(h[6], h[7]);
                *(u32x4*)(H + (size_t)(row0 + ai * HALF + m * 16) * FFN + col0) = w; }
    }
};
}

struct Frame {
    __device__ __forceinline__ void refresh() { ws = opaque_ptr(ws0); tid = opaque_tid(); lane = tid & 63; wave = __builtin_amdgcn_readfirstlane(tid >> 6); }
    LAS unsigned char* lds;
    volatile LAS unsigned* MISC;
    unsigned* ctl;
    int tid, lane, wave, G;
    const float* const* in;
    unsigned char* ws; unsigned char* ws0;
};

__device__ __forceinline__ void conv_item(const float* W, int ldw, int k0, int src_c0, int nvalid, const float* gk, bf16* WT, int ldt, int dst_r0, int dst_k, LAS float* scr, int lane) {
    const int c = lane & 31;
#pragma unroll 8
    for (int i = 0; i < 32; ++i) { const int kk = 2 * i + (lane >> 5); float v = 0.f;
        if (c < nvalid) { v = W[(size_t)(k0 + kk) * ldw + src_c0 + c]; if (gk) v *= gk[k0 + kk]; }
        scr[kk * 33 + c] = v; }
    LDS_WAIT(); asm volatile("" ::: "memory");
    const int c8 = lane & 7;
#pragma unroll
    for (int j = 0; j < 4; ++j) { const int n = (lane >> 3) + 8 * j; const LAS float* s = scr + (8 * c8) * 33 + n;
        v4u o; o.x = pk2(s[0 * 33], s[1 * 33]); o.y = pk2(s[2 * 33], s[3 * 33]); o.z = pk2(s[4 * 33], s[5 * 33]); o.w = pk2(s[6 * 33], s[7 * 33]);
        *(GAS v4u*)(WT + (size_t)(dst_r0 + n) * ldt + dst_k + 8 * c8) = o; }
    LDS_WAIT(); asm volatile("" ::: "memory");
}
__device__ __forceinline__ void p0_prologue(Frame& F) {
    LAS float* scr = (LAS float*)(F.lds + F.wave * 16384);
    const int gw = blockIdx.x * NWAVES + F.wave, NGW = F.G * NWAVES, lane = F.lane;
    constexpr int I_IN = 32 * (NP / 32), I_GLU = 16 * 32, I_BR = 3 * 16 * 64, I_OUT = 32 * 64, I_GU = 2 * 32 * (FFN / 32), I_DN = (FFN / 64) * 64;
    constexpr int I_LAYER = I_IN + I_GLU + I_BR + I_OUT + I_GU + I_DN;
    for (int it = gw; it < DEPTH * I_LAYER; it += NGW) {
        const int l = it / I_LAYER; int r = it - l * I_LAYER;
        unsigned char* wl = F.ws + WS_W + (size_t)l * SZ_WLAYER;
        if (r < I_IN) { const int nb = r % (NP / 32), kb = r / (NP / 32), n0 = 32 * nb; int src, nv;
            if (n0 < 4096) { src = n0; nv = 32; } else if (n0 < PC_GLR) { src = n0 + 16; nv = 32; } else if (n0 == PC_GLR) { src = 4096; nv = 16; } else { src = 0; nv = 0; }
            conv_item(F.in[I_WIN] + (size_t)l * DM * INW, INW, 64 * kb, src, nv, F.in[I_N1G] + l * DM, (bf16*)(wl + OFF_WIN), DM, n0, 64 * kb, scr, lane); continue; } r -= I_IN;
        if (r < I_GLU) { const int nb = r % 32, kb = r / 32;
            conv_item(F.in[I_WGLU] + (size_t)l * 1024 * 1024, 1024, 64 * kb, 32 * nb, 32, nullptr, (bf16*)(wl + OFF_WGLU), 1024, 32 * nb, 64 * kb, scr, lane); continue; } r -= I_GLU;
        if (r < I_BR) { const int br = r / (16 * 64), rr = r % (16 * 64), nb = rr % 64, kb = rr / 64;
            conv_item(F.in[I_WBS + br] + (size_t)l * 1024 * DM, DM, 64 * kb, 32 * nb, 32, nullptr, (bf16*)(wl + OFF_WBR), 3072, 32 * nb, br * 1024 + 64 * kb, scr, lane); continue; } r -= I_BR;
        if (r < I_OUT) { const int nb = r % 64, kb = r / 64;
            conv_item(F.in[I_WOUT] + (size_t)l * DM * DM, DM, 64 * kb, 32 * nb, 32, nullptr, (bf16*)(wl + OFF_WOUT), DM, 32 * nb, 64 * kb, scr, lane); continue; } r -= I_OUT;
        if (r < I_GU) { const int sel = r / (32 * (FFN / 32)), rr = r % (32 * (FFN / 32)), nb = rr % (FFN / 32), kb = rr / (FFN / 32), j0 = 32 * nb;
            conv_item(F.in[I_FWG + sel] + (size_t)l * DM * FFN, FFN, 64 * kb, j0, 32, F.in[I_N2G] + l * DM, (bf16*)(wl + OFF_WGU), DM, (j0 / 128) * 256 + sel * 128 + (j0 % 128), 64 * kb, scr, lane); continue; } r -= I_GU;
        { const int nb = r % 64, kb = r / 64;
            conv_item(F.in[I_FWD] + (size_t)l * FFN * DM, DM, 64 * kb, 32 * nb, 32, nullptr, (bf16*)(wl + OFF_WDN), FFN, 32 * nb, 64 * kb, scr, lane); }
    }
    const float* x = F.in[I_X]; bf16* XB = (bf16*)(F.ws + WS_XB); float* ssq = (float*)(F.ws + WS_SSQ);
    for (int m = gw; m < MTOK; m += NGW) {
        const GAS f32x4* xr = (const GAS f32x4*)(x + (size_t)m * DM) + lane; float s = 0.f;
        GAS v2u* o8 = (GAS v2u*)(XB + (size_t)m * DM) + lane;
#pragma unroll
        for (int j = 0; j < 8; ++j) { const f32x4 v = xr[64 * j]; s += (v[0] * v[0] + v[1] * v[1]) + (v[2] * v[2] + v[3] * v[3]); v2u w; w.x = pk2(v[0], v[1]); w.y = pk2(v[2], v[3]); o8[64 * j] = w; }
        s = wave_sum(s);
        if (lane < 8) ssq[(size_t)m * 8 + lane] = (lane == 0) ? s : 0.f;
    }
}

__device__ __forceinline__ void p2a_naive(Frame& F, int l) {
    const bf16* P = (const bf16*)(F.ws + WS_P);
    const int lane = F.lane;
    { float* EG = (float*)(F.ws + WS_EG); const float* w2 = F.in[I_GW2] + (size_t)l * 16 * 512; const float* b2 = F.in[I_GB2] + l * 512;
      for (int idx = blockIdx.x * 512 + F.tid; idx < MTOK * 512; idx += F.G * 512) { const int tok = idx >> 9, dk = idx & 511;
          const v4u g0 = *(const v4u*)(P + (size_t)tok * NP + PC_GLR), g1 = *(const v4u*)(P + (size_t)tok * NP + PC_GLR + 8);
          const unsigned gw_[8] = {g0.x, g0.y, g0.z, g0.w, g1.x, g1.y, g1.z, g1.w}; float a = b2[dk];
#pragma unroll
          for (int r = 0; r < 8; ++r) { a += bflo(gw_[r]) * w2[(2 * r) * 512 + dk]; a += bfhi(gw_[r]) * w2[(2 * r + 1) * 512 + dk]; }
          const float ls = fminf(a, 0.f) - log1pf(__expf(-fabsf(a)));
          EG[idx] = __expf(ls * (1.0f / 16.0f)); } }
    { bf16* QN = (bf16*)(F.ws + WS_QN); bf16* KN = (bf16*)(F.ws + WS_KN); const float* qg = F.in[I_MQG] + l * 128; const float* kg = F.in[I_MKG] + l * 128;
      const int gw = blockIdx.x * NWAVES + F.wave, NGW = F.G * NWAVES;
      const float g0q = qg[2 * lane] * 0.08838834764831845f, g1q = qg[2 * lane + 1] * 0.08838834764831845f, g0k = kg[2 * lane], g1k = kg[2 * lane + 1];
      for (int it = gw; it < MTOK * 8 * 2; it += NGW) { const int which = it & 1, th = it >> 1, tok = th >> 3, h = th & 7;
          const unsigned w = *(const unsigned*)(P + (size_t)tok * NP + (which ? PC_MK : PC_MQ) + h * 128 + 2 * lane);
          const float x0 = bflo(w), x1 = bfhi(w); const float ss = wave_sum(x0 * x0 + x1 * x1); const float r = 1.0f / sqrtf(ss * (1.0f / 128.0f) + RMS_EPS);
          *(unsigned*)((which ? KN : QN) + (size_t)tok * 1024 + h * 128 + 2 * lane) = which ? pk2(x0 * r * g0k, x1 * r * g1k) : pk2(x0 * r * g0q, x1 * r * g1q); }
      float* KM = (float*)(F.ws + WS_KM);
      for (int it = gw; it < 4 * 8 * 8; it += NGW) { const int kb = it & 7, h = (it >> 3) & 7, b = it >> 6; float a0 = 0.f, a1 = 0.f;
          for (int j = 0; j < 256; ++j) { const int tok = b * SEQ + kb * 256 + j; const unsigned w = *(const unsigned*)(P + (size_t)tok * NP + PC_MK + h * 128 + 2 * lane);
              const float x0 = bflo(w), x1 = bfhi(w); const float ss = wave_sum(x0 * x0 + x1 * x1); const float r = 1.0f / sqrtf(ss * (1.0f / 128.0f) + RMS_EPS); a0 += x0 * r * g0k; a1 += x1 * r * g1k; }
          *(f32x2*)(KM + (size_t)it * 128 + 2 * lane) = (f32x2){a0 * (1.0f / 256.0f), a1 * (1.0f / 256.0f)}; } }
}

__device__ __forceinline__ void s5_naive_item(Frame& F, int l, int item, LAS float* scr) {
    const int lane = F.lane, b = item >> 6, g = item & 63, lg = l * 64 + g;
    const bf16* P = (const bf16*)(F.ws + WS_P); bf16* Z = (bf16*)(F.ws + WS_Z);
    const float lre = F.in[I_LRE][lg * 64 + lane], lim = F.in[I_LIM][lg * 64 + lane], dt = expf(F.in[I_LDT][lg]);
    const float mag = expf(lre * dt), ang = lim * dt, ar = mag * cosf(ang), ai = mag * sinf(ang);
    const float den = lre * lre + lim * lim, nre = ar - 1.0f, nim = ai;
    const float zre = (nre * lre + nim * lim) / den, zim = (nim * lre - nre * lim) / den;
    float bbr[16], bbi[16], cr[16], ci[16];
#pragma unroll
    for (int c = 0; c < 16; ++c) { const float br_ = F.in[I_BRE][(size_t)(lg * 64 + lane) * 16 + c], bi_ = F.in[I_BIM][(size_t)(lg * 64 + lane) * 16 + c];
        bbr[c] = zre * br_ - zim * bi_; bbi[c] = zre * bi_ + zim * br_;
        cr[c] = F.in[I_CRE][(size_t)(lg * 16 + c) * 64 + lane]; ci[c] = F.in[I_CIM][(size_t)(lg * 16 + c) * 64 + lane]; }
    const float dsk = F.in[I_SD][l * 1024 + g * 16 + (lane & 15)];
    float xr = 0.f, xi = 0.f;
    const int cc = lane & 15, qq = lane >> 4;
    for (int t0 = 0; t0 < SEQ; t0 += 4) {
        v4u ub[4][2];
#pragma unroll
        for (int s = 0; s < 4; ++s) { const bf16* up = P + (size_t)(b * SEQ + t0 + s) * NP + PC_SSM + g * 16; ub[s][0] = *(const v4u*)up; ub[s][1] = *(const v4u*)(up + 8); }
#pragma unroll
        for (int s = 0; s < 4; ++s) {
            const unsigned uw[8] = {ub[s][0].x, ub[s][0].y, ub[s][0].z, ub[s][0].w, ub[s][1].x, ub[s][1].y, ub[s][1].z, ub[s][1].w};
            float bur = 0.f, bui = 0.f;
#pragma unroll
            for (int c = 0; c < 8; ++c) { const float u0 = bflo(uw[c]), u1 = bfhi(uw[c]); bur += bbr[2 * c] * u0 + bbr[2 * c + 1] * u1; bui += bbi[2 * c] * u0 + bbi[2 * c + 1] * u1; }
            const float nxr = ar * xr - ai * xi + bur, nxi = ar * xi + ai * xr + bui; xr = nxr; xi = nxi;
#pragma unroll
            for (int c = 0; c < 16; ++c) scr[c * 65 + lane] = cr[c] * xr - ci[c] * xi;
            LDS_WAIT();
            float sum = 0.f;
#pragma unroll
            for (int j = 0; j < 16; ++j) sum += scr[cc * 65 + qq * 16 + j];
            LDS_WAIT();
            sum += __shfl_xor(sum, 16); sum += __shfl_xor(sum, 32);
            const size_t row = (size_t)(b * SEQ + t0 + s);
            if (lane < 16) { const float uv = bf1(P[row * NP + PC_SSM + g * 16 + lane]); const float y = sum + dsk * uv; Z[row * 1024 + g * 16 + lane] = (bf16)f2bf(gelu_tanh(y)); }
        }
    }
}
__device__ __forceinline__ void gla_naive_item(Frame& F, int item, LAS float* scr) {
    const int lane = F.lane, hf = item & 3, qt = (item >> 2) & 3, h = (item >> 4) & 3, b = item >> 6;
    const bf16* P = (const bf16*)(F.ws + WS_P); const float* EG = (const float*)(F.ws + WS_EG); float* OT = (float*)(F.ws + WS_OT) + (size_t)hf * MTOK * 1024;
    float S[32];
#pragma unroll
    for (int i = 0; i < 32; ++i) S[i] = 0.f;
    const int l32 = lane & 31;
    const bf16* pq = P + (size_t)(b * SEQ) * NP + PC_GQ + h * 128 + hf * 32 + l32; const bf16* pv = P + (size_t)(b * SEQ) * NP + PC_GV + h * 256 + qt * 64 + lane;
    const float* pe = EG + (size_t)(b * SEQ) * 512 + h * 128 + hf * 32 + l32; float* po = OT + (size_t)(b * SEQ) * 1024 + h * 256 + qt * 64 + lane;
    for (int t0 = 0; t0 < SEQ; t0 += 2) {
        float qw[2], kw[2], ew[2]; bf16 vw[2];
#pragma unroll
        for (int s = 0; s < 2; ++s) { qw[s] = bf1(pq[(size_t)s * NP]); kw[s] = bf1(pq[(size_t)s * NP + (PC_GK - PC_GQ)]); ew[s] = pe[s * 512]; vw[s] = pv[(size_t)s * NP]; }
#pragma unroll
        for (int s = 0; s < 2; ++s) {
            if (lane < 32) { scr[lane] = qw[s]; scr[32 + lane] = kw[s]; scr[64 + lane] = ew[s]; }
            LDS_WAIT();
            const float v = bf1(vw[s]); float o = 0.f;
#pragma unroll
            for (int d = 0; d < 32; d += 4) { const f32x4 q4 = *(const LAS f32x4*)(scr + d), k4 = *(const LAS f32x4*)(scr + 32 + d), e4 = *(const LAS f32x4*)(scr + 64 + d);
#pragma unroll
                for (int e = 0; e < 4; ++e) { S[d + e] = e4[e] * S[d + e] + k4[e] * v; o += q4[e] * S[d + e]; }
                if ((d & 4) != 0) asm volatile("" ::: "memory"); }
            LDS_WAIT();
            po[s * 1024] = o * 0.08838834764831845f;
        }
        pq += 2 * (size_t)NP; pv += 2 * (size_t)NP; pe += 2 * 512; po += 2 * 1024;
    }
}
__device__ __forceinline__ void moba_naive_query(Frame& F, int qi, LAS float* scr) {
    const int lane = F.lane, t = qi & (SEQ - 1), h = (qi >> 11) & 7, b = qi >> 14, qb = t >> 8;
    const bf16* P = (const bf16*)(F.ws + WS_P); const bf16* QN = (const bf16*)(F.ws + WS_QN); const bf16* KN = (const bf16*)(F.ws + WS_KN); const float* KM = (const float*)(F.ws + WS_KM);
    bf16* Y = (bf16*)(F.ws + WS_Y);
    const unsigned qw = *(const unsigned*)(QN + (size_t)(b * SEQ + t) * 1024 + h * 128 + 2 * lane);
    const float q0 = bflo(qw), q1 = bfhi(qw);
    *(LAS f32x2*)(scr + 2 * lane) = (f32x2){q0, q1};
    LDS_WAIT();
    float sc[8]; unsigned selmask = 0u;
#pragma unroll
    for (int kb = 0; kb < 8; ++kb) { const f32x2 km = *(const f32x2*)(KM + (size_t)(((b * 8 + h) * 8 + kb) * 128) + 2 * lane); const float d = wave_sum(q0 * km[0] + q1 * km[1]); sc[kb] = (kb < qb) ? d : -__builtin_inff(); }
#pragma unroll
    for (int kb = 0; kb < 8; ++kb) { int rank = 0;
#pragma unroll
        for (int j = 0; j < 8; ++j) if (j != kb) rank += ((j < qb) && (sc[j] > sc[kb] || (sc[j] == sc[kb] && j < kb))) ? 1 : 0;
        if (kb < qb && rank < 3) selmask |= 1u << kb; }
    selmask |= 1u << qb;
    float m = -__builtin_inff(), lsum = 0.f, o0 = 0.f, o1 = 0.f;
    for (int kb = 0; kb <= qb; ++kb) {
        if (!((selmask >> kb) & 1u)) continue;
        for (int tile = 0; tile < 4; ++tile) {
            const int key0 = kb * 256 + tile * 64; if (key0 > t) break;
            const int key = key0 + lane;
            const v4u* kp = (const v4u*)(KN + (size_t)(b * SEQ + key) * 1024 + h * 128);
            float s = 0.f;
#pragma unroll
            for (int c = 0; c < 16; ++c) { if (c == 8) asm volatile("" ::: "memory"); const v4u kk = kp[c]; const f32x4 qa = *(const LAS f32x4*)(scr + 8 * c), qb4 = *(const LAS f32x4*)(scr + 8 * c + 4);
                s += qa[0] * bflo(kk.x) + qa[1] * bfhi(kk.x) + qa[2] * bflo(kk.y) + qa[3] * bfhi(kk.y) + qb4[0] * bflo(kk.z) + qb4[1] * bfhi(kk.z) + qb4[2] * bflo(kk.w) + qb4[3] * bfhi(kk.w); }
            if (key > t) s = -__builtin_inff();
            const float mnew = fmaxf(m, wave_max(s)); const float p = __expf(s - mnew), corr = __expf(m - mnew);
            lsum = lsum * corr + wave_sum(p); o0 *= corr; o1 *= corr; m = mnew;
            const bf16* vp = P + (size_t)(b * SEQ + key0) * NP + PC_MV + h * 128 + 2 * lane;
#pragma unroll 16
            for (int j = 0; j < 64; ++j) { const float pj = __shfl(p, j); const unsigned vw = *(const unsigned*)(vp + (size_t)j * NP); o0 += pj * bflo(vw); o1 += pj * bfhi(vw); }
        }
    }
    LDS_WAIT();
    const float inv = 1.0f / lsum;
    *(unsigned*)(Y + (size_t)(b * SEQ + t) * YW + 2048 + h * 128 + 2 * lane) = pk2(o0 * inv, o1 * inv);
}
__device__ __forceinline__ void p2b_naive(Frame& F, int l) {
    { F.refresh(); LAS float* scr = (LAS float*)(F.lds + F.wave * 16384);
      if (F.wave == 0) for (int it = blockIdx.x; it < 256; it += F.G) s5_naive_item(F, l, it, scr); }
    { F.refresh(); LAS float* scr = (LAS float*)(F.lds + F.wave * 16384);
      if (F.wave == 1) for (int it = blockIdx.x; it < 256; it += F.G) gla_naive_item(F, it, scr); }
    { F.refresh(); LAS float* scr = (LAS float*)(F.lds + F.wave * 16384);
      unsigned* head = F.ctl + CW_QUEUE + 64 * l;
      for (;;) {
          unsigned qi = 0; if (F.lane == 0) qi = __hip_atomic_fetch_add(head, 1u, __ATOMIC_RELAXED, __HIP_MEMORY_SCOPE_AGENT);
          qi = __builtin_amdgcn_readfirstlane(qi);
          if (qi >= (unsigned)(NBATCH * 8 * SEQ)) break;
          moba_naive_query(F, (int)qi, scr);
      } }
}
__device__ __forceinline__ void p2c_gla_finish(Frame& F, int l) {
    const bf16* P = (const bf16*)(F.ws + WS_P); const float* OT = (const float*)(F.ws + WS_OT); bf16* Y = (bf16*)(F.ws + WS_Y);
    const int lane = F.lane, gw = blockIdx.x * NWAVES + F.wave, NGW = F.G * NWAVES;
    const f32x4 gn = *(const f32x4*)(F.in[I_GNG] + l * 256 + 4 * lane);
    for (int it = gw; it < MTOK * 4; it += NGW) { const int tok = it >> 2, h = it & 3;
        const f32x4 o = (*(const f32x4*)(OT + (size_t)tok * 1024 + h * 256 + 4 * lane) + *(const f32x4*)(OT + (size_t)(MTOK + tok) * 1024 + h * 256 + 4 * lane)) + (*(const f32x4*)(OT + (size_t)(2 * MTOK + tok) * 1024 + h * 256 + 4 * lane) + *(const f32x4*)(OT + (size_t)(3 * MTOK + tok) * 1024 + h * 256 + 4 * lane));
        const float ss = wave_sum((o[0] * o[0] + o[1] * o[1]) + (o[2] * o[2] + o[3] * o[3])); const float rn = 1.0f / sqrtf(ss * (1.0f / 256.0f) + RMS_EPS);
        const v2u rw = *(const v2u*)(P + (size_t)tok * NP + PC_GR + h * 256 + 4 * lane);
        const float r0 = bflo(rw.x), r1 = bfhi(rw.x), r2 = bflo(rw.y), r3 = bfhi(rw.y);
        v2u w; w.x = pk2(o[0] * rn * gn[0] * r0 * sigmoidf_(r0), o[1] * rn * gn[1] * r1 * sigmoidf_(r1)); w.y = pk2(o[2] * rn * gn[2] * r2 * sigmoidf_(r2), o[3] * rn * gn[3] * r3 * sigmoidf_(r3));
        *(v2u*)(Y + (size_t)tok * YW + 1024 + h * 256 + 4 * lane) = w; }
}

constexpr int NPH = 9;
__global__ void __launch_bounds__(NWAVES * 64, 2) fwd_kernel(Args args) {
    extern __shared__ __attribute__((aligned(16))) unsigned char lds[];
    Frame F;
    F.lds = (LAS unsigned char*)lds;
    F.MISC = (volatile LAS unsigned*)(F.lds + MISC_OFF);
    F.tid = threadIdx.x; F.lane = F.tid & 63; F.wave = __builtin_amdgcn_readfirstlane(F.tid >> 6);
    F.G = gridDim.x; F.in = args.in; F.ws = args.ws; F.ws0 = args.ws; F.ctl = (unsigned*)(args.ws + WS_CTL);
    for (int u = F.tid; u < (LDS_BYTES - LDSCTL_OFF) / 4; u += NWAVES * 64) ((LAS unsigned*)(F.lds + LDSCTL_OFF))[u] = 0u;
    __syncthreads();
    XcdBarrier bar; bar.bar = F.ctl + CW_BAR; bar.x = 0; bar.st = nullptr;
    if (args.fused) bar = xcd_barrier_post(F.ctl + CW_BAR, F.MISC + 8);
#define GRID_BAR() do { if (args.fused) xcd_barrier(bar); } while (0)
    const int lo = args.ph_lo, hi = args.ph_hi;
#ifndef PH_MASK
#define PH_MASK 0x1ff
#endif
#define IN(k) (((PH_MASK >> (k)) & 1) && lo <= (k) && (k) < hi)
#define WSP(T, off) ((T*)(ws + (off)))

    if (args.l_lo == 0 && IN(0)) { F.refresh(); p0_prologue(F); GRID_BAR(); }

    for (int l = args.l_lo; l < args.l_hi; ++l) {
        if (IN(1)) {
            unsigned char* ws = opaque_ptr(args.ws); const unsigned char* wl = ws + WS_W + (size_t)l * SZ_WLAYER;
            pg8::Gemm g{WSP(pg8::bf16_t, WS_XB), DM, (const pg8::bf16_t*)(wl + OFF_WIN), DM, DM, 0, 0}; pg8::TileOrder S; S.init(MTOK, NP, F.G, (int)blockIdx.x, 1);
            pg8::EpiInProj E{WSP(pg8::bf16_t, WS_P), WSP(float, WS_SSQ)};
            pg8::gemm_phase(F.lds, g, S, E);
            GRID_BAR();
        }
        if (IN(2)) { F.refresh(); p2a_naive(F, l); GRID_BAR(); }
        if (IN(3)) { F.refresh(); p2b_naive(F, l); GRID_BAR(); }
        if (IN(4)) {
            F.refresh(); p2c_gla_finish(F, l);
            VM_WAIT(); __syncthreads();
            unsigned char* ws = opaque_ptr(args.ws); const unsigned char* wl = ws + WS_W + (size_t)l * SZ_WLAYER;
            pg8::Gemm g{WSP(pg8::bf16_t, WS_Z), 1024, (const pg8::bf16_t*)(wl + OFF_WGLU), 1024, 1024, 0, 0}; pg8::TileOrder S; S.init(MTOK, 1024, F.G, (int)blockIdx.x, 1);
            pg8::EpiGLU E{WSP(pg8::bf16_t, WS_Z), WSP(pg8::bf16_t, WS_Y), args.in[I_BGLU] + l * 1024};
            pg8::gemm_phase(F.lds, g, S, E);
            GRID_BAR();
        }
        if (IN(5)) {
            unsigned char* ws = opaque_ptr(args.ws); const unsigned char* wl = ws + WS_W + (size_t)l * SZ_WLAYER;
            pg8::Gemm g{WSP(pg8::bf16_t, WS_Y), YW, (const pg8::bf16_t*)(wl + OFF_WBR), 3072, 1024, 1024, 1024}; pg8::TileOrder S; S.init(MTOK, DM, F.G, (int)blockIdx.x, 3);
            pg8::EpiBranch E{WSP(pg8::bf16_t, WS_P), WSP(float, WS_MG), WSP(pg8::bf16_t, WS_MB)};
            pg8::gemm_phase(F.lds, g, S, E);
            GRID_BAR();
        }
        if (IN(6)) {
            unsigned char* ws = opaque_ptr(args.ws); const unsigned char* wl = ws + WS_W + (size_t)l * SZ_WLAYER;
            pg8::Gemm g{WSP(pg8::bf16_t, WS_MB), DM, (const pg8::bf16_t*)(wl + OFF_WOUT), DM, DM, 0, 0}; pg8::TileOrder S; S.init(MTOK, DM, F.G, (int)blockIdx.x, 1);
            pg8::EpiResid E{l == 0 ? args.in[I_X] : WSP(float, WS_XR), WSP(float, WS_XR), WSP(pg8::bf16_t, WS_XB), WSP(float, WS_SSQ)};
            pg8::gemm_phase(F.lds, g, S, E);
            GRID_BAR();
        }
        if (IN(7)) {
            unsigned char* ws = opaque_ptr(args.ws); const unsigned char* wl = ws + WS_W + (size_t)l * SZ_WLAYER;
            pg8::Gemm g{WSP(pg8::bf16_t, WS_XB), DM, (const pg8::bf16_t*)(wl + OFF_WGU), DM, DM, 0, 0}; pg8::TileOrder S; S.init(MTOK, NGU, F.G, (int)blockIdx.x, 1);
            pg8::EpiFFNUp E{WSP(pg8::bf16_t, WS_H), WSP(float, WS_SSQ)};
            pg8::gemm_phase(F.lds, g, S, E);
            GRID_BAR();
        }
        if (IN(8)) {
            unsigned char* ws = opaque_ptr(args.ws); const unsigned char* wl = ws + WS_W + (size_t)l * SZ_WLAYER;
            pg8::Gemm g{WSP(pg8::bf16_t, WS_H), FFN, (const pg8::bf16_t*)(wl + OFF_WDN), FFN, FFN, 0, 0}; pg8::TileOrder S; S.init(MTOK, DM, F.G, (int)blockIdx.x, 1);
            pg8::EpiResid E{WSP(float, WS_XR), l == DEPTH - 1 ? args.out : WSP(float, WS_XR), WSP(pg8::bf16_t, WS_XB), WSP(float, WS_SSQ)};
            pg8::gemm_phase(F.lds, g, S, E);
            if (l + 1 < DEPTH) GRID_BAR();
        }
    }
#undef IN
#undef GRID_BAR
}

extern "C" void kernel_launch(void* const* d_in, const int* in_sizes, int n_in, void* d_out, int out_size, void* d_ws, size_t ws_size, hipStream_t stream) {
    static int grid = 0;
    if (grid == 0) {
        if (n_in != 26 || out_size != MTOK * DM || ws_size < WS_END) { fprintf(stderr, "kernel_launch: unexpected problem (n_in %d out %d ws %zu need %zu)\n", n_in, out_size, ws_size, (size_t)WS_END); grid = -1; return; }
        int dev = 0, cus = 0, per_cu = 0;
        if (hipGetDevice(&dev) != hipSuccess || hipDeviceGetAttribute(&cus, hipDeviceAttributeMultiprocessorCount, dev) != hipSuccess) { grid = -1; return; }
        if (hipFuncSetAttribute((const void*)fwd_kernel, hipFuncAttributeMaxDynamicSharedMemorySize, LDS_BYTES) != hipSuccess) { fprintf(stderr, "kernel_launch: hipFuncSetAttribute failed\n"); grid = -1; return; }
        if (hipOccupancyMaxActiveBlocksPerMultiprocessor(&per_cu, (const void*)fwd_kernel, NWAVES * 64, LDS_BYTES) != hipSuccess || per_cu < 1) { fprintf(stderr, "kernel_launch: occupancy query says %d\n", per_cu); }
        (void)hipGetLastError();
        grid = cus;
    }
    if (grid < 0) return;
    if (hipMemsetAsync((char*)d_ws + WS_CTL, 0, CTL_ZERO_BYTES, stream) != hipSuccess) return;
    Args a{};
    for (int i = 0; i < 26; ++i) a.in[i] = (const float*)d_in[i];
    a.out = (float*)d_out; a.ws = (unsigned char*)d_ws; a.pad = 0;
#if MK_FUSED
    a.l_lo = 0; a.l_hi = DEPTH; a.ph_lo = 0; a.ph_hi = NPH; a.fused = 1;
    hipLaunchKernelGGL(fwd_kernel, dim3(grid), dim3(NWAVES * 64), LDS_BYTES, stream, a);
#else
    a.fused = 0;
    for (int l = 0; l < DEPTH; ++l)
        for (int ph = (l == 0 ? 0 : 1); ph < NPH; ++ph) { a.l_lo = l; a.l_hi = l + 1; a.ph_lo = ph; a.ph_hi = ph + 1; hipLaunchKernelGGL(fwd_kernel, dim3(grid), dim3(NWAVES * 64), LDS_BYTES, stream, a); }
#endif
}
```

```cpp
#include <hip/hip_runtime.h>
#include <cstdio>
#include <cstdint>

#ifndef MK_FUSED
#define MK_FUSED 1
#endif

__device__ __forceinline__ unsigned char* opaque_ptr(unsigned char* p) { asm volatile("" : "+s"(p)); return p; }
__device__ __forceinline__ int opaque_tid() { int t = threadIdx.x; asm volatile("" : "+v"(t)); return t; }

namespace pg8 {
#define PG8_LAS __attribute__((address_space(3)))
typedef unsigned short bf16_t;
typedef short bf16x8 __attribute__((ext_vector_type(8)));
typedef float f32x4 __attribute__((ext_vector_type(4)));
typedef unsigned u32x4 __attribute__((ext_vector_type(4)));
typedef unsigned u32x2 __attribute__((ext_vector_type(2)));
constexpr int BM = 256, BK = 64, HALF = 128, HTB = HALF * BK * 2, STAGE_BYTES = 8 * HTB, NXCD = 8, WGM = 8;

__host__ __device__ __forceinline__ int lds_byte(int r, int c) { const int st = (r >> 4) * 2 + (c >> 5), rr = r & 15, cc = c & 31, ob = rr * 64 + cc * 2; return st * 1024 + (ob ^ (((ob >> 9) & 1) << 5)); }
__host__ __device__ __forceinline__ void stage_rc(int b, int& R, int& C) { const int st = b / 1024, sb = b % 1024, swz = sb ^ (((sb >> 9) & 1) << 5); R = (st >> 1) * 16 + swz / 64; C = (st & 1) * 32 + (swz % 64) / 2; }
__host__ __device__ __forceinline__ int perm32(int rho) { const int n = rho >> 4, i = rho & 15; return 8 * (i >> 2) + 4 * n + (i & 3); }

struct Unit { int pm, pn, br; };
struct Gemm { const bf16_t* A; int lda; const bf16_t* Bt; int ldb; int K; int abr, bbr; };

struct TileOrder {
    int nM, nN, nwg, G, c, nbr;
    __device__ __forceinline__ void init(int M, int N, int G_, int c_, int nbr_) { asm volatile("" : "+s"(G_), "+s"(c_)); nM = M / BM; nN = N / BM; nwg = nM * nN; G = G_; c = c_; nbr = nbr_; }
    __device__ __forceinline__ bool next(int i, Unit& u) const {
        const int it = i / nbr; u.br = i - it * nbr;
        const long L = (long)it * G + c; if (L >= nwg) return false;
        int wgid = (int)L; { const int q = nwg / NXCD, r = nwg % NXCD, xcd = wgid % NXCD, off = wgid / NXCD; wgid = (xcd < r ? xcd * (q + 1) : r * (q + 1) + (xcd - r) * q) + off; }
        const int nig = WGM * nN, gid = wgid / nig, fm = gid * WGM, gsz = (nM - fm) < WGM ? (nM - fm) : WGM;
        u.pm = __builtin_amdgcn_readfirstlane(fm + ((wgid % nig) % gsz)); u.pn = __builtin_amdgcn_readfirstlane((wgid % nig) / gsz); return true;
    }
};

__device__ __forceinline__ unsigned cvt_pk_bf16(float lo, float hi) { unsigned r; asm volatile("v_cvt_pk_bf16_f32 %0, %1, %2" : "=v"(r) : "v"(lo), "v"(hi)); return r; }

template <class Epi, class Sched>
__device__ __forceinline__ void gemm_phase(PG8_LAS unsigned char* lds, const Gemm g, const Sched& S, const Epi& E) {
    const int tid = opaque_tid(), wid = __builtin_amdgcn_readfirstlane(tid >> 6), lane = tid & 63, wr = wid >> 2, wc = wid & 3, fr = lane & 15, fq = lane >> 4;
    const int K = g.K, nt = K / BK;
    unsigned voffA[2], voffB[2];
#pragma unroll
    for (int i = 0; i < 2; ++i) { int R, C; stage_rc(tid * 16 + i * 8192, R, C); const int Rb = (R & ~31) + perm32(R & 31);
        voffA[i] = (unsigned)(R * g.lda + C) * 2u; voffB[i] = (unsigned)(Rb * g.ldb + C) * 2u; }
    const size_t kstep = (size_t)(BK * 2);
    const size_t hstepA = (size_t)HALF * g.lda * 2, hstepB = (size_t)HALF * g.ldb * 2;
    const size_t tstepA = 2 * hstepA, tstepB = 2 * hstepB;
    const unsigned ldsw = (unsigned)wid * 1024u;
    const int aoff = lds_byte(wr * 64 + fr, fq * 8), boff = lds_byte(wc * 32 + fr, fq * 8);
#define PG8_SA(b, h) (((b) * 2 + (h)) * HTB)
#define PG8_SB(b, h) ((4 + (b) * 2 + (h)) * HTB)
#define PG8_STAGE(bufoff, gbase, voff) do { _Pragma("unroll") for (int _i = 0; _i < 2; ++_i) \
        __builtin_amdgcn_global_load_lds((const unsigned*)((const char*)(gbase) + (voff)[_i]), (PG8_LAS unsigned*)(lds + (bufoff) + ldsw + _i * 8192), 16, 0, 0); } while (0)
#define PG8_LDA(dst, b, h) do { _Pragma("unroll") for (int m = 0; m < 4; ++m) _Pragma("unroll") for (int k = 0; k < 2; ++k) dst[m][k] = *(const PG8_LAS bf16x8*)(lds + PG8_SA(b, h) + aoff + m * 2048 + k * 1024); } while (0)
#define PG8_LDB(dst, b, h) do { _Pragma("unroll") for (int n = 0; n < 2; ++n) _Pragma("unroll") for (int k = 0; k < 2; ++k) dst[n][k] = *(const PG8_LAS bf16x8*)(lds + PG8_SB(b, h) + boff + n * 2048 + k * 1024); } while (0)
#define PG8_MMA(ai, bj, At, Bt) do { __builtin_amdgcn_s_setprio(1); _Pragma("unroll") for (int m = 0; m < 4; ++m) _Pragma("unroll") for (int n = 0; n < 2; ++n) _Pragma("unroll") for (int k = 0; k < 2; ++k) \
        acc[ai][bj][m][n] = __builtin_amdgcn_mfma_f32_16x16x32_bf16(Bt[n][k], At[m][k], acc[ai][bj][m][n], 0, 0, 0); __builtin_amdgcn_s_setprio(0); } while (0)
#define PG8_WAIT_V(n) asm volatile("s_waitcnt vmcnt(" #n ")" ::: "memory")
#define PG8_WAIT_L(n) asm volatile("s_waitcnt lgkmcnt(" #n ")" ::: "memory")
#define PG8_BAR __builtin_amdgcn_s_barrier()
#define PG8_SCHED __builtin_amdgcn_sched_barrier(0)
    Unit cur, nxt; int ui = 0;
    if (!S.next(0, cur)) return;
    f32x4 acc[2][2][4][2];
#pragma unroll
    for (int a = 0; a < 2; ++a)
#pragma unroll
        for (int b = 0; b < 2; ++b)
#pragma unroll
            for (int m = 0; m < 4; ++m)
#pragma unroll
                for (int n = 0; n < 2; ++n) acc[a][b][m][n] = (f32x4){0.f, 0.f, 0.f, 0.f};
    bf16x8 At[4][2], B0[2][2], B1[2][2];
    const char* cA = (const char*)g.A + (size_t)cur.pm * tstepA + (size_t)cur.br * g.abr * 2; const char* cB = (const char*)g.Bt + (size_t)cur.pn * tstepB + (size_t)cur.br * g.bbr * 2;
    PG8_STAGE(PG8_SB(0, 0), cB, voffB); PG8_STAGE(PG8_SB(0, 1), cB + hstepB, voffB); PG8_STAGE(PG8_SA(0, 0), cA, voffA); PG8_STAGE(PG8_SA(0, 1), cA + hstepA, voffA);
    if (wr == 1) PG8_BAR;
    PG8_WAIT_V(2); PG8_BAR;
    PG8_STAGE(PG8_SB(1, 0), cB + kstep, voffB); PG8_STAGE(PG8_SA(1, 0), cA + kstep, voffA); PG8_STAGE(PG8_SB(1, 1), cB + hstepB + kstep, voffB);
    PG8_WAIT_V(6); PG8_BAR;
    for (;;) {
        const bool has_next = S.next(ui + 1, nxt);
        const char* nA = has_next ? (const char*)g.A + (size_t)nxt.pm * tstepA + (size_t)nxt.br * g.abr * 2 : cA; const char* nB = has_next ? (const char*)g.Bt + (size_t)nxt.pn * tstepB + (size_t)nxt.br * g.bbr * 2 : cB;
        for (int t = 0; t < nt; t += 2) {
            const bool last = (t == nt - 2);
            const char* a1 = cA + (size_t)(t + 1) * kstep;
            const char* a2 = last ? nA : cA + (size_t)(t + 2) * kstep; const char* b2 = last ? nB : cB + (size_t)(t + 2) * kstep;
            const char* a3 = a2 + kstep; const char* b3 = b2 + kstep;
            PG8_LDB(B0, 0, 0); PG8_LDB(B1, 0, 1); PG8_SCHED; PG8_LDA(At, 0, 0); PG8_STAGE(PG8_SA(1, 1), a1 + hstepA, voffA);
            PG8_WAIT_V(8); PG8_WAIT_L(0); PG8_BAR; PG8_MMA(0, 0, At, B0); PG8_MMA(0, 1, At, B1); PG8_BAR; PG8_SCHED;
            PG8_LDA(At, 0, 1); PG8_STAGE(PG8_SB(0, 0), b2, voffB); PG8_STAGE(PG8_SB(0, 1), b2 + hstepB, voffB); PG8_STAGE(PG8_SA(0, 0), a2, voffA);
            PG8_WAIT_V(8); PG8_WAIT_L(0); PG8_BAR; PG8_MMA(1, 0, At, B0); PG8_MMA(1, 1, At, B1); PG8_BAR; PG8_SCHED;
            PG8_LDB(B0, 1, 0); PG8_LDB(B1, 1, 1); PG8_SCHED; PG8_LDA(At, 1, 0); PG8_STAGE(PG8_SA(0, 1), a2 + hstepA, voffA);
            PG8_WAIT_V(8); PG8_WAIT_L(0); PG8_BAR; PG8_MMA(0, 0, At, B0); PG8_MMA(0, 1, At, B1); PG8_BAR; PG8_SCHED;
            PG8_LDA(At, 1, 1); PG8_STAGE(PG8_SB(1, 0), b3, voffB); PG8_STAGE(PG8_SB(1, 1), b3 + hstepB, voffB); PG8_STAGE(PG8_SA(1, 0), a3, voffA);
            PG8_WAIT_V(8); PG8_WAIT_L(0); PG8_BAR; PG8_MMA(1, 0, At, B0); PG8_MMA(1, 1, At, B1); PG8_BAR; PG8_SCHED;
        }
        if (wr == 0) PG8_BAR;
        E(acc, cur, wr, wc, fr, fq, lds);
        if (!has_next) break;
#pragma unroll
        for (int a = 0; a < 2; ++a)
#pragma unroll
            for (int b = 0; b < 2; ++b)
#pragma unroll
                for (int m = 0; m < 4; ++m)
#pragma unroll
                    for (int n = 0; n < 2; ++n) acc[a][b][m][n] = (f32x4){0.f, 0.f, 0.f, 0.f};
        cur = nxt; cA = nA; cB = nB; ++ui;
        if (wr == 1) PG8_BAR;
    }
    PG8_WAIT_V(0);
    PG8_BAR;
#undef PG8_SA
#undef PG8_SB
#undef PG8_STAGE
#undef PG8_LDA
#undef PG8_LDB
#undef PG8_MMA
#undef PG8_WAIT_V
#undef PG8_WAIT_L
#undef PG8_BAR
#undef PG8_SCHED
}
}

constexpr int NWAVES = 8;
constexpr int DM = 2048, NBATCH = 4, SEQ = 2048, DEPTH = 4, MTOK = NBATCH * SEQ;
constexpr int INW = 13328;
constexpr int NP = 13568;
constexpr int PC_SSM = 0, PC_GQ = 1024, PC_GK = 1536, PC_GV = 2048, PC_GR = 3072, PC_MQ = 4096, PC_MK = 5120, PC_MV = 6144, PC_GS = 7168, PC_GLR = 13312;
constexpr int FFN = 5632, NGU = 2 * FFN;
constexpr int YW = 3072;
constexpr float RMS_EPS = 1e-6f;

constexpr size_t MiB = 1u << 20;
constexpr size_t WS_CTL = 0, CTL_ZERO_BYTES = 1 * MiB;
constexpr size_t SZ_WIN = (size_t)NP * DM * 2, SZ_WGLU = (size_t)1024 * 1024 * 2, SZ_WBR = (size_t)DM * 3072 * 2, SZ_WOUT = (size_t)DM * DM * 2, SZ_WGU = (size_t)NGU * DM * 2, SZ_WDN = (size_t)DM * FFN * 2;
constexpr size_t OFF_WIN = 0, OFF_WGLU = OFF_WIN + SZ_WIN, OFF_WBR = OFF_WGLU + SZ_WGLU, OFF_WOUT = OFF_WBR + SZ_WBR, OFF_WGU = OFF_WOUT + SZ_WOUT, OFF_WDN = OFF_WGU + SZ_WGU, SZ_WLAYER = OFF_WDN + SZ_WDN;
constexpr size_t WS_W = 2 * MiB;
constexpr size_t WS_P = WS_W + ((DEPTH * SZ_WLAYER + MiB - 1) / MiB) * MiB;
constexpr size_t WS_Z = WS_P + (size_t)MTOK * NP * 2;
constexpr size_t WS_Y = WS_Z + (size_t)MTOK * 1024 * 2;
constexpr size_t WS_MG = WS_Y + (size_t)MTOK * YW * 2;
constexpr size_t WS_MB = WS_MG + (size_t)MTOK * DM * 4;
constexpr size_t WS_XR = WS_MB + (size_t)MTOK * DM * 2;
constexpr size_t WS_XB = WS_XR + (size_t)MTOK * DM * 4;
constexpr size_t WS_H = WS_XB + (size_t)MTOK * DM * 2;
constexpr size_t WS_SSQ = WS_H + (size_t)MTOK * FFN * 2;
constexpr size_t WS_EG = WS_SSQ + (size_t)MTOK * 8 * 4;
constexpr size_t WS_OT = WS_EG + (size_t)MTOK * 512 * 4;
constexpr size_t WS_QN = WS_OT + (size_t)4 * MTOK * 1024 * 4;
constexpr size_t WS_KN = WS_QN + (size_t)MTOK * 1024 * 2;
constexpr size_t WS_KM = WS_KN + (size_t)MTOK * 1024 * 2;
constexpr size_t WS_END = WS_KM + (size_t)4 * 8 * 8 * 128 * 4;
constexpr int CW_BAR = 4096;
constexpr int CW_QUEUE = 16384;

constexpr int RING_BYTES = 131072;
constexpr int LDSCTL_OFF = RING_BYTES, MISC_OFF = LDSCTL_OFF + 320;
constexpr int TAB_OFF = RING_BYTES + 1024;
constexpr int LDS_BYTES = 147456;

#define GAS __attribute__((address_space(1)))
#define LAS __attribute__((address_space(3)))
typedef unsigned short bf16;
typedef unsigned v4u __attribute__((ext_vector_type(4)));
typedef unsigned v2u __attribute__((ext_vector_type(2)));
typedef float f32x4 __attribute__((ext_vector_type(4)));
typedef float f32x2 __attribute__((ext_vector_type(2)));
#define LDS_WAIT() asm volatile("s_waitcnt lgkmcnt(0)" ::: "memory")
#define VM_WAIT() asm volatile("s_waitcnt vmcnt(0)" ::: "memory")
__device__ __forceinline__ unsigned f2bf(float f) { unsigned u = __builtin_bit_cast(unsigned, f); return (u + 0x7fffu + ((u >> 16) & 1u)) >> 16; }
__device__ __forceinline__ unsigned pk2(float lo, float hi) { return f2bf(lo) | (f2bf(hi) << 16); }
__device__ __forceinline__ float bflo(unsigned u) { return __builtin_bit_cast(float, u << 16); }
__device__ __forceinline__ float bfhi(unsigned u) { return __builtin_bit_cast(float, u & 0xffff0000u); }
__device__ __forceinline__ float bf1(bf16 b) { return __builtin_bit_cast(float, ((unsigned)b) << 16); }
__device__ __forceinline__ float sigmoidf_(float x) { return __builtin_amdgcn_rcpf(1.0f + __expf(-x)); }
__device__ __forceinline__ float gelu_tanh(float x) { const float u = 0.7978845608028654f * (x + 0.044715f * x * x * x); return x * sigmoidf_(2.0f * u); }
__device__ __forceinline__ float wave_sum(float v) {
#pragma unroll
    for (int o = 1; o < 64; o <<= 1) v += __shfl_xor(v, o);
    return v;
}
__device__ __forceinline__ float wave_max(float v) {
#pragma unroll
    for (int o = 1; o < 64; o <<= 1) v = fmaxf(v, __shfl_xor(v, o));
    return v;
}

#define XB_TMO      128
#define XB_XCNT(j)  (256  + 64 * (j))
#define XB_XSUB(j)  (1280 + 64 * (j))
#define XB_XGEN(j)  (2304 + 64 * (j))
#define XB_TOP      3328
#define XB_TOPGEN   3392
#define XCD_BAR_WORDS 3456
#define XB_SPIN_CAP (1u << 18)
__device__ __forceinline__ unsigned xb_ld(unsigned* p)              { return __hip_atomic_load(p, __ATOMIC_RELAXED, __HIP_MEMORY_SCOPE_AGENT); }
__device__ __forceinline__ unsigned xb_add(unsigned* p, unsigned v) { return __hip_atomic_fetch_add(p, v, __ATOMIC_RELAXED, __HIP_MEMORY_SCOPE_AGENT); }
__device__ __forceinline__ unsigned xb_xcc_id() { return (unsigned)__builtin_amdgcn_s_getreg((3 << 11) | 20) & 0xFu; }
#define XB_SPIN(cond, bar) do { unsigned _sp = 0; while (cond) { __builtin_amdgcn_s_sleep(1); \
    if ((++_sp & 255u) == 0u) { if (xb_ld(&(bar)[XB_TMO])) break; if (_sp > XB_SPIN_CAP) { atomicAdd(&(bar)[XB_TMO], 1u); break; } } } } while (0)
struct XcdBarrier { unsigned* bar; unsigned x; volatile LAS unsigned* st; };
__device__ __forceinline__ XcdBarrier xcd_barrier_post(unsigned* bar, volatile LAS unsigned* st) {
    XcdBarrier b; b.bar = bar; b.x = xb_xcc_id(); b.st = st;
    if (threadIdx.x == 0) (void)xb_add(&bar[XB_XCNT(b.x)], 1u);
    return b;
}
__device__ __forceinline__ void xcd_barrier_complete(unsigned* bar, unsigned x, unsigned& nloc, unsigned& nx) {
    const unsigned G = gridDim.x * gridDim.y * gridDim.z;
    unsigned sum, cnt, mine, sp = 0u;
    for (;;) {
        sum = 0u; cnt = 0u; mine = 0u;
#pragma unroll
        for (unsigned j = 0; j < 16; ++j) { const unsigned c = xb_ld(&bar[XB_XCNT(j)]); sum += c; cnt += (c > 0u) ? 1u : 0u; mine = (j == x) ? c : mine; }
        if (sum == G) break;
        __builtin_amdgcn_s_sleep(1);
        if ((++sp & 255u) == 0u) { if (xb_ld(&bar[XB_TMO])) break; if (sp > XB_SPIN_CAP) { atomicAdd(&bar[XB_TMO], 1u); break; } }
    }
    nloc = mine > 0u ? mine : 1u; nx = cnt > 0u ? cnt : 1u;
}
__device__ __forceinline__ void xcd_barrier(const XcdBarrier& b) {
    asm volatile("s_waitcnt vmcnt(0)" ::: "memory");
    __syncthreads();
    if (threadIdx.x == 0) {
        unsigned* bar = b.bar;
        __builtin_amdgcn_s_waitcnt(0);
        unsigned nloc = b.st[0], nx = b.st[1];
        if (nloc == 0u) { xcd_barrier_complete(bar, b.x, nloc, nx); b.st[0] = nloc; b.st[1] = nx; }
        const unsigned old = xb_add(&bar[XB_XSUB(b.x)], 1u);
        const unsigned gen = old / nloc;
        if (old + 1u == (gen + 1u) * nloc) {
            __builtin_amdgcn_fence(__ATOMIC_RELEASE, "agent");
            asm volatile("s_waitcnt vmcnt(0)" ::: "memory");
            const unsigned og = xb_add(&bar[XB_TOP], 1u);
            const unsigned tg = og / nx;
            if (og + 1u == (tg + 1u) * nx) xb_add(&bar[XB_TOPGEN], 1u);
            else XB_SPIN(xb_ld(&bar[XB_TOPGEN]) == tg, bar);
            __builtin_amdgcn_fence(__ATOMIC_ACQUIRE, "agent");
            xb_add(&bar[XB_XGEN(b.x)], 1u);
            asm volatile("s_waitcnt vmcnt(0)" ::: "memory");
        } else {
            XB_SPIN(xb_ld(&bar[XB_XGEN(b.x)]) == gen, bar);
            __builtin_amdgcn_fence(__ATOMIC_ACQUIRE, "agent");
            asm volatile("s_waitcnt vmcnt(0)" ::: "memory");
        }
    }
    __syncthreads();
}

struct Args {
    const float* in[26];
    float* out; unsigned char* ws;
    int l_lo, l_hi, ph_lo, ph_hi;
    int fused, pad;
};
enum { I_X = 0, I_N1G, I_WIN, I_LRE, I_LIM, I_LDT, I_BRE, I_BIM, I_CRE, I_CIM, I_SD, I_WGLU, I_BGLU, I_GW2, I_GB2, I_GNG, I_MQG, I_MKG, I_WBS, I_WBG, I_WBM, I_WOUT, I_N2G, I_FWG, I_FWU, I_FWD };

namespace pg8 {
#define EPI_FENCE() asm volatile("" ::: "memory")
__device__ __forceinline__ void load_rstd(const float* ssq, int pm, int wr, int fr, int fq, float (&rs)[2][4]) {
    f32x2 p[2][4];
#pragma unroll
    for (int ai = 0; ai < 2; ++ai)
#pragma unroll
        for (int m = 0; m < 4; ++m) { const int row = pm * BM + ai * HALF + wr * 64 + m * 16 + fr; p[ai][m] = *(const f32x2*)(ssq + (size_t)row * 8 + 2 * fq); }
#pragma unroll
    for (int ai = 0; ai < 2; ++ai)
#pragma unroll
        for (int m = 0; m < 4; ++m) { float s = p[ai][m][0] + p[ai][m][1]; s += __shfl_xor(s, 16); s += __shfl_xor(s, 32); rs[ai][m] = 1.0f / sqrtf(s * (1.0f / DM) + RMS_EPS); }
    EPI_FENCE();
}
struct EpiInProj {
    bf16_t* P; const float* ssq;
    __device__ __forceinline__ void operator()(const f32x4 (&acc)[2][2][4][2], const Unit& u, int wr, int wc, int fr, int fq, PG8_LAS unsigned char*) const {
        float rs[2][4]; load_rstd(ssq, u.pm, wr, fr, fq, rs);
        const int row0 = u.pm * BM + wr * 64 + fr, col0 = u.pn * BM + wc * 32 + 8 * fq;
#pragma unroll
        for (int ai = 0; ai < 2; ++ai)
#pragma unroll
            for (int m = 0; m < 4; ++m) { bf16_t* rowp = P + (size_t)(row0 + ai * HALF + m * 16) * NP + col0; const float r = rs[ai][m];
#pragma unroll
                for (int bj = 0; bj < 2; ++bj) { const f32x4 v0 = acc[ai][bj][m][0] * r, v1 = acc[ai][bj][m][1] * r;
                    u32x4 w; w.x = cvt_pk_bf16(v0[0], v0[1]); w.y = cvt_pk_bf16(v0[2], v0[3]); w.z = cvt_pk_bf16(v1[0], v1[1]); w.w = cvt_pk_bf16(v1[2], v1[3]);
                    *(u32x4*)(rowp + bj * HALF) = w; } }
    }
};
struct EpiGLU {
    const bf16_t* Z; bf16_t* Y; const float* bias;
    __device__ __forceinline__ void operator()(const f32x4 (&acc)[2][2][4][2], const Unit& u, int wr, int wc, int fr, int fq, PG8_LAS unsigned char*) const {
        const int row0 = u.pm * BM + wr * 64 + fr, col0 = u.pn * BM + wc * 32 + 8 * fq;
        f32x4 bv[2][2];
#pragma unroll
        for (int bj = 0; bj < 2; ++bj)
#pragma unroll
            for (int n = 0; n < 2; ++n) bv[bj][n] = *(const f32x4*)(bias + col0 + bj * HALF + 4 * n);
        u32x4 zb[2][2];
#pragma unroll
        for (int idx = 0; idx <= 8; ++idx) {
            if (idx < 8) { const size_t row = (size_t)(row0 + (idx >> 2) * HALF + (idx & 3) * 16);
#pragma unroll
                for (int bj = 0; bj < 2; ++bj) zb[idx & 1][bj] = *(const u32x4*)(Z + row * 1024 + col0 + bj * HALF); }
            if (idx > 0) { const int ai = (idx - 1) >> 2, m = (idx - 1) & 3; const size_t row = (size_t)(row0 + ai * HALF + m * 16);
#pragma unroll
                for (int bj = 0; bj < 2; ++bj) { const u32x4 zz = zb[(idx - 1) & 1][bj];
                    const f32x4 g0 = acc[ai][bj][m][0] + bv[bj][0], g1 = acc[ai][bj][m][1] + bv[bj][1];
                    u32x4 w;
                    w.x = cvt_pk_bf16(bflo(zz.x) * sigmoidf_(g0[0]), bfhi(zz.x) * sigmoidf_(g0[1])); w.y = cvt_pk_bf16(bflo(zz.y) * sigmoidf_(g0[2]), bfhi(zz.y) * sigmoidf_(g0[3]));
                    w.z = cvt_pk_bf16(bflo(zz.z) * sigmoidf_(g1[0]), bfhi(zz.z) * sigmoidf_(g1[1])); w.w = cvt_pk_bf16(bflo(zz.w) * sigmoidf_(g1[2]), bfhi(zz.w) * sigmoidf_(g1[3]));
                    *(u32x4*)(Y + row * YW + col0 + bj * HALF) = w; } }
            EPI_FENCE();
        }
    }
};
struct EpiBranch {
    const bf16_t* P; float* MG; bf16_t* MB;
    __device__ __forceinline__ void operator()(const f32x4 (&acc)[2][2][4][2], const Unit& u, int wr, int wc, int fr, int fq, PG8_LAS unsigned char*) const {
        const int row0 = u.pm * BM + wr * 64 + fr, col0 = u.pn * BM + wc * 32 + 8 * fq;
        const int br = u.br;
        u32x4 gb[2][2]; f32x4 mb[2][2][2];
#pragma unroll
        for (int idx = 0; idx <= 8; ++idx) {
            if (idx < 8) { const size_t row = (size_t)(row0 + (idx >> 2) * HALF + (idx & 3) * 16);
#pragma unroll
                for (int bj = 0; bj < 2; ++bj) { const int col = col0 + bj * HALF; gb[idx & 1][bj] = *(const u32x4*)(P + row * NP + PC_GS + br * DM + col);
                    if (br != 0) { mb[idx & 1][bj][0] = *(const f32x4*)(MG + row * DM + col); mb[idx & 1][bj][1] = *(const f32x4*)(MG + row * DM + col + 4); } } }
            if (idx > 0) { const int ai = (idx - 1) >> 2, m = (idx - 1) & 3; const size_t row = (size_t)(row0 + ai * HALF + m * 16);
#pragma unroll
                for (int bj = 0; bj < 2; ++bj) { const int col = col0 + bj * HALF; const u32x4 gg = gb[(idx - 1) & 1][bj];
                    f32x4 v0 = acc[ai][bj][m][0], v1 = acc[ai][bj][m][1];
                    v0[0] *= sigmoidf_(bflo(gg.x)); v0[1] *= sigmoidf_(bfhi(gg.x)); v0[2] *= sigmoidf_(bflo(gg.y)); v0[3] *= sigmoidf_(bfhi(gg.y));
                    v1[0] *= sigmoidf_(bflo(gg.z)); v1[1] *= sigmoidf_(bfhi(gg.z)); v1[2] *= sigmoidf_(bflo(gg.w)); v1[3] *= sigmoidf_(bfhi(gg.w));
                    if (br != 0) { v0 = v0 + mb[(idx - 1) & 1][bj][0]; v1 = v1 + mb[(idx - 1) & 1][bj][1]; }
                    if (br != 2) { *(f32x4*)(MG + row * DM + col) = v0; *(f32x4*)(MG + row * DM + col + 4) = v1; }
                    else { u32x4 w; w.x = cvt_pk_bf16(v0[0], v0[1]); w.y = cvt_pk_bf16(v0[2], v0[3]); w.z = cvt_pk_bf16(v1[0], v1[1]); w.w = cvt_pk_bf16(v1[2], v1[3]); *(u32x4*)(MB + row * DM + col) = w; } } }
            EPI_FENCE();
        }
    }
};
struct EpiResid {
    const float* xin; float* xout; bf16_t* XB; float* ssq;
    __device__ __forceinline__ void operator()(const f32x4 (&acc)[2][2][4][2], const Unit& u, int wr, int wc, int fr, int fq, PG8_LAS unsigned char* lds) const {
        const int row0 = u.pm * BM + wr * 64 + fr, col0 = u.pn * BM + wc * 32 + 8 * fq;
        PG8_LAS float* T = (PG8_LAS float*)(lds + TAB_OFF);
        f32x4 xb[2][2][2];
#pragma unroll
        for (int idx = 0; idx <= 8; ++idx) {
            if (idx < 8) { const size_t row = (size_t)(row0 + (idx >> 2) * HALF + (idx & 3) * 16);
#pragma unroll
                for (int bj = 0; bj < 2; ++bj) { const size_t o = row * DM + col0 + bj * HALF; xb[idx & 1][bj][0] = *(const f32x4*)(xin + o); xb[idx & 1][bj][1] = *(const f32x4*)(xin + o + 4); } }
            if (idx > 0) { const int ai = (idx - 1) >> 2, m = (idx - 1) & 3; const size_t row = (size_t)(row0 + ai * HALF + m * 16); float s = 0.f;
#pragma unroll
                for (int bj = 0; bj < 2; ++bj) { const size_t o = row * DM + col0 + bj * HALF;
                    const f32x4 v0 = acc[ai][bj][m][0] + xb[(idx - 1) & 1][bj][0], v1 = acc[ai][bj][m][1] + xb[(idx - 1) & 1][bj][1];
                    *(f32x4*)(xout + o) = v0; *(f32x4*)(xout + o + 4) = v1;
                    u32x4 w; w.x = cvt_pk_bf16(v0[0], v0[1]); w.y = cvt_pk_bf16(v0[2], v0[3]); w.z = cvt_pk_bf16(v1[0], v1[1]); w.w = cvt_pk_bf16(v1[2], v1[3]); *(u32x4*)(XB + o) = w;
                    s += (v0[0] * v0[0] + v0[1] * v0[1]) + (v0[2] * v0[2] + v0[3] * v0[3]) + (v1[0] * v1[0] + v1[1] * v1[1]) + (v1[2] * v1[2] + v1[3] * v1[3]); }
                s += __shfl_xor(s, 16); s += __shfl_xor(s, 32);
                if (fq == 0) T[(ai * HALF + wr * 64 + m * 16 + fr) * 4 + wc] = s; }
            EPI_FENCE();
        }
        asm volatile("s_waitcnt lgkmcnt(0)" ::: "memory"); __builtin_amdgcn_s_barrier(); asm volatile("" ::: "memory");
        const int t = (wr * 4 + wc) * 64 + fq * 16 + fr;
        if (t < 256) { const f32x4 p = *(const PG8_LAS f32x4*)(T + t * 4); ssq[(size_t)(u.pm * BM + t) * 8 + u.pn] = (p[0] + p[1]) + (p[2] + p[3]); }
    }
};
struct EpiFFNUp {
    bf16_t* H; const float* ssq;
    __device__ __forceinline__ void operator()(const f32x4 (&acc)[2][2][4][2], const Unit& u, int wr, int wc, int fr, int fq, PG8_LAS unsigned char*) const {
        float rs[2][4]; load_rstd(ssq, u.pm, wr, fr, fq, rs);
        const int row0 = u.pm * BM + wr * 64 + fr, col0 = u.pn * HALF + wc * 32 + 8 * fq;
#pragma unroll
        for (int ai = 0; ai < 2; ++ai)
#pragma unroll
            for (int m = 0; m < 4; ++m) { const float r = rs[ai][m]; float h[8];
#pragma unroll
                for (int n = 0; n < 2; ++n)
#pragma unroll
                    for (int e = 0; e < 4; ++e) { const float gv = acc[ai][0][m][n][e] * r, uv = acc[ai][1][m][n][e] * r; h[n * 4 + e] = gv * sigmoidf_(gv) * uv; }
                u32x4 w; w.x = cvt_pk_bf16(h[0], h[1]); w.y = cvt_pk_bf16(h[2], h[3]); w.z = cvt_pk_bf16(h[4], h[5]); w.w = cvt_pk_bf16(h[6], h[7]);
                *(u32x4*)(H + (size_t)(row0 + ai * HALF + m * 16) * FFN + col0) = w; }
    }
};
}

struct Frame {
    __device__ __forceinline__ void refresh() { ws = opaque_ptr(ws0); tid = opaque_tid(); lane = tid & 63; wave = __builtin_amdgcn_readfirstlane(tid >> 6); }
    LAS unsigned char* lds;
    volatile LAS unsigned* MISC;
    unsigned* ctl;
    int tid, lane, wave, G;
    const float* const* in;
    unsigned char* ws; unsigned char* ws0;
};

__device__ __forceinline__ void conv_item(const float* W, int ldw, int k0, int src_c0, int nvalid, const float* gk, bf16* WT, int ldt, int dst_r0, int dst_k, LAS float* scr, int lane) {
    const int c = lane & 31;
#pragma unroll 8
    for (int i = 0; i < 32; ++i) { const int kk = 2 * i + (lane >> 5); float v = 0.f;
        if (c < nvalid) { v = W[(size_t)(k0 + kk) * ldw + src_c0 + c]; if (gk) v *= gk[k0 + kk]; }
        scr[kk * 33 + c] = v; }
    LDS_WAIT(); asm volatile("" ::: "memory");
    const int c8 = lane & 7;
#pragma unroll
    for (int j = 0; j < 4; ++j) { const int n = (lane >> 3) + 8 * j; const LAS float* s = scr + (8 * c8) * 33 + n;
        v4u o; o.x = pk2(s[0 * 33], s[1 * 33]); o.y = pk2(s[2 * 33], s[3 * 33]); o.z = pk2(s[4 * 33], s[5 * 33]); o.w = pk2(s[6 * 33], s[7 * 33]);
        *(GAS v4u*)(WT + (size_t)(dst_r0 + n) * ldt + dst_k + 8 * c8) = o; }
    LDS_WAIT(); asm volatile("" ::: "memory");
}
__device__ __forceinline__ void p0_prologue(Frame& F) {
    LAS float* scr = (LAS float*)(F.lds + F.wave * 16384);
    const int gw = blockIdx.x * NWAVES + F.wave, NGW = F.G * NWAVES, lane = F.lane;
    constexpr int I_IN = 32 * (NP / 32), I_GLU = 16 * 32, I_BR = 3 * 16 * 64, I_OUT = 32 * 64, I_GU = 2 * 32 * (FFN / 32), I_DN = (FFN / 64) * 64;
    constexpr int I_LAYER = I_IN + I_GLU + I_BR + I_OUT + I_GU + I_DN;
    for (int it = gw; it < DEPTH * I_LAYER; it += NGW) {
        const int l = it / I_LAYER; int r = it - l * I_LAYER;
        unsigned char* wl = F.ws + WS_W + (size_t)l * SZ_WLAYER;
        if (r < I_IN) { const int nb = r % (NP / 32), kb = r / (NP / 32), n0 = 32 * nb; int src, nv;
            if (n0 < 4096) { src = n0; nv = 32; } else if (n0 < PC_GLR) { src = n0 + 16; nv = 32; } else if (n0 == PC_GLR) { src = 4096; nv = 16; } else { src = 0; nv = 0; }
            conv_item(F.in[I_WIN] + (size_t)l * DM * INW, INW, 64 * kb, src, nv, F.in[I_N1G] + l * DM, (bf16*)(wl + OFF_WIN), DM, n0, 64 * kb, scr, lane); continue; } r -= I_IN;
        if (r < I_GLU) { const int nb = r % 32, kb = r / 32;
            conv_item(F.in[I_WGLU] + (size_t)l * 1024 * 1024, 1024, 64 * kb, 32 * nb, 32, nullptr, (bf16*)(wl + OFF_WGLU), 1024, 32 * nb, 64 * kb, scr, lane); continue; } r -= I_GLU;
        if (r < I_BR) { const int br = r / (16 * 64), rr = r % (16 * 64), nb = rr % 64, kb = rr / 64;
            conv_item(F.in[I_WBS + br] + (size_t)l * 1024 * DM, DM, 64 * kb, 32 * nb, 32, nullptr, (bf16*)(wl + OFF_WBR), 3072, 32 * nb, br * 1024 + 64 * kb, scr, lane); continue; } r -= I_BR;
        if (r < I_OUT) { const int nb = r % 64, kb = r / 64;
            conv_item(F.in[I_WOUT] + (size_t)l * DM * DM, DM, 64 * kb, 32 * nb, 32, nullptr, (bf16*)(wl + OFF_WOUT), DM, 32 * nb, 64 * kb, scr, lane); continue; } r -= I_OUT;
        if (r < I_GU) { const int sel = r / (32 * (FFN / 32)), rr = r % (32 * (FFN / 32)), nb = rr % (FFN / 32), kb = rr / (FFN / 32), j0 = 32 * nb;
            conv_item(F.in[I_FWG + sel] + (size_t)l * DM * FFN, FFN, 64 * kb, j0, 32, F.in[I_N2G] + l * DM, (bf16*)(wl + OFF_WGU), DM, (j0 / 128) * 256 + sel * 128 + (j0 % 128), 64 * kb, scr, lane); continue; } r -= I_GU;
        { const int nb = r % 64, kb = r / 64;
            conv_item(F.in[I_FWD] + (size_t)l * FFN * DM, DM, 64 * kb, 32 * nb, 32, nullptr, (bf16*)(wl + OFF_WDN), FFN, 32 * nb, 64 * kb, scr, lane); }
    }
    const float* x = F.in[I_X]; bf16* XB = (bf16*)(F.ws + WS_XB); float* ssq = (float*)(F.ws + WS_SSQ);
    for (int m = gw; m < MTOK; m += NGW) {
        const GAS f32x4* xr = (const GAS f32x4*)(x + (size_t)m * DM) + lane; float s = 0.f;
        GAS v2u* o8 = (GAS v2u*)(XB + (size_t)m * DM) + lane;
#pragma unroll
        for (int j = 0; j < 8; ++j) { const f32x4 v = xr[64 * j]; s += (v[0] * v[0] + v[1] * v[1]) + (v[2] * v[2] + v[3] * v[3]); v2u w; w.x = pk2(v[0], v[1]); w.y = pk2(v[2], v[3]); o8[64 * j] = w; }
        s = wave_sum(s);
        if (lane < 8) ssq[(size_t)m * 8 + lane] = (lane == 0) ? s : 0.f;
    }
}

__device__ __forceinline__ void p2a_naive(Frame& F, int l) {
    const bf16* P = (const bf16*)(F.ws + WS_P);
    const int lane = F.lane;
    { float* EG = (float*)(F.ws + WS_EG); const float* w2 = F.in[I_GW2] + (size_t)l * 16 * 512; const float* b2 = F.in[I_GB2] + l * 512;
      for (int idx = blockIdx.x * 512 + F.tid; idx < MTOK * 512; idx += F.G * 512) { const int tok = idx >> 9, dk = idx & 511;
          const v4u g0 = *(const v4u*)(P + (size_t)tok * NP + PC_GLR), g1 = *(const v4u*)(P + (size_t)tok * NP + PC_GLR + 8);
          const unsigned gw_[8] = {g0.x, g0.y, g0.z, g0.w, g1.x, g1.y, g1.z, g1.w}; float a = b2[dk];
#pragma unroll
          for (int r = 0; r < 8; ++r) { a += bflo(gw_[r]) * w2[(2 * r) * 512 + dk]; a += bfhi(gw_[r]) * w2[(2 * r + 1) * 512 + dk]; }
          const float ls = fminf(a, 0.f) - log1pf(__expf(-fabsf(a)));
          EG[idx] = __expf(ls * (1.0f / 16.0f)); } }
    { bf16* QN = (bf16*)(F.ws + WS_QN); bf16* KN = (bf16*)(F.ws + WS_KN); const float* qg = F.in[I_MQG] + l * 128; const float* kg = F.in[I_MKG] + l * 128;
      const int gw = blockIdx.x * NWAVES + F.wave, NGW = F.G * NWAVES;
      const float g0q = qg[2 * lane] * 0.08838834764831845f, g1q = qg[2 * lane + 1] * 0.08838834764831845f, g0k = kg[2 * lane], g1k = kg[2 * lane + 1];
      for (int it = gw; it < MTOK * 8 * 2; it += NGW) { const int which = it & 1, th = it >> 1, tok = th >> 3, h = th & 7;
          const unsigned w = *(const unsigned*)(P + (size_t)tok * NP + (which ? PC_MK : PC_MQ) + h * 128 + 2 * lane);
          const float x0 = bflo(w), x1 = bfhi(w); const float ss = wave_sum(x0 * x0 + x1 * x1); const float r = 1.0f / sqrtf(ss * (1.0f / 128.0f) + RMS_EPS);
          *(unsigned*)((which ? KN : QN) + (size_t)tok * 1024 + h * 128 + 2 * lane) = which ? pk2(x0 * r * g0k, x1 * r * g1k) : pk2(x0 * r * g0q, x1 * r * g1q); }
      float* KM = (float*)(F.ws + WS_KM);
      for (int it = gw; it < 4 * 8 * 8; it += NGW) { const int kb = it & 7, h = (it >> 3) & 7, b = it >> 6; float a0 = 0.f, a1 = 0.f;
          for (int j = 0; j < 256; ++j) { const int tok = b * SEQ + kb * 256 + j; const unsigned w = *(const unsigned*)(P + (size_t)tok * NP + PC_MK + h * 128 + 2 * lane);
              const float x0 = bflo(w), x1 = bfhi(w); const float ss = wave_sum(x0 * x0 + x1 * x1); const float r = 1.0f / sqrtf(ss * (1.0f / 128.0f) + RMS_EPS); a0 += x0 * r * g0k; a1 += x1 * r * g1k; }
          *(f32x2*)(KM + (size_t)it * 128 + 2 * lane) = (f32x2){a0 * (1.0f / 256.0f), a1 * (1.0f / 256.0f)}; } }
}

__device__ __forceinline__ void s5_naive_item(Frame& F, int l, int item, LAS float* scr) {
    const int lane = F.lane, b = item >> 6, g = item & 63, lg = l * 64 + g;
    const bf16* P = (const bf16*)(F.ws + WS_P); bf16* Z = (bf16*)(F.ws + WS_Z);
    const float lre = F.in[I_LRE][lg * 64 + lane], lim = F.in[I_LIM][lg * 64 + lane], dt = expf(F.in[I_LDT][lg]);
    const float mag = expf(lre * dt), ang = lim * dt, ar = mag * cosf(ang), ai = mag * sinf(ang);
    const float den = lre * lre + lim * lim, nre = ar - 1.0f, nim = ai;
    const float zre = (nre * lre + nim * lim) / den, zim = (nim * lre - nre * lim) / den;
    float bbr[16], bbi[16], cr[16], ci[16];
#pragma unroll
    for (int c = 0; c < 16; ++c) { const float br_ = F.in[I_BRE][(size_t)(lg * 64 + lane) * 16 + c], bi_ = F.in[I_BIM][(size_t)(lg * 64 + lane) * 16 + c];
        bbr[c] = zre * br_ - zim * bi_; bbi[c] = zre * bi_ + zim * br_;
        cr[c] = F.in[I_CRE][(size_t)(lg * 16 + c) * 64 + lane]; ci[c] = F.in[I_CIM][(size_t)(lg * 16 + c) * 64 + lane]; }
    const float dsk = F.in[I_SD][l * 1024 + g * 16 + (lane & 15)];
    float xr = 0.f, xi = 0.f;
    const int cc = lane & 15, qq = lane >> 4;
    for (int t0 = 0; t0 < SEQ; t0 += 4) {
        v4u ub[4][2];
#pragma unroll
        for (int s = 0; s < 4; ++s) { const bf16* up = P + (size_t)(b * SEQ + t0 + s) * NP + PC_SSM + g * 16; ub[s][0] = *(const v4u*)up; ub[s][1] = *(const v4u*)(up + 8); }
#pragma unroll
        for (int s = 0; s < 4; ++s) {
            const unsigned uw[8] = {ub[s][0].x, ub[s][0].y, ub[s][0].z, ub[s][0].w, ub[s][1].x, ub[s][1].y, ub[s][1].z, ub[s][1].w};
            float bur = 0.f, bui = 0.f;
#pragma unroll
            for (int c = 0; c < 8; ++c) { const float u0 = bflo(uw[c]), u1 = bfhi(uw[c]); bur += bbr[2 * c] * u0 + bbr[2 * c + 1] * u1; bui += bbi[2 * c] * u0 + bbi[2 * c + 1] * u1; }
            const float nxr = ar * xr - ai * xi + bur, nxi = ar * xi + ai * xr + bui; xr = nxr; xi = nxi;
#pragma unroll
            for (int c = 0; c < 16; ++c) scr[c * 65 + lane] = cr[c] * xr - ci[c] * xi;
            LDS_WAIT();
            float sum = 0.f;
#pragma unroll
            for (int j = 0; j < 16; ++j) sum += scr[cc * 65 + qq * 16 + j];
            LDS_WAIT();
            sum += __shfl_xor(sum, 16); sum += __shfl_xor(sum, 32);
            const size_t row = (size_t)(b * SEQ + t0 + s);
            if (lane < 16) { const float uv = bf1(P[row * NP + PC_SSM + g * 16 + lane]); const float y = sum + dsk * uv; Z[row * 1024 + g * 16 + lane] = (bf16)f2bf(gelu_tanh(y)); }
        }
    }
}
__device__ __forceinline__ void gla_naive_item(Frame& F, int item, LAS float* scr) {
    const int lane = F.lane, hf = item & 3, qt = (item >> 2) & 3, h = (item >> 4) & 3, b = item >> 6;
    const bf16* P = (const bf16*)(F.ws + WS_P); const float* EG = (const float*)(F.ws + WS_EG); float* OT = (float*)(F.ws + WS_OT) + (size_t)hf * MTOK * 1024;
    float S[32];
#pragma unroll
    for (int i = 0; i < 32; ++i) S[i] = 0.f;
    const int l32 = lane & 31;
    const bf16* pq = P + (size_t)(b * SEQ) * NP + PC_GQ + h * 128 + hf * 32 + l32; const bf16* pv = P + (size_t)(b * SEQ) * NP + PC_GV + h * 256 + qt * 64 + lane;
    const float* pe = EG + (size_t)(b * SEQ) * 512 + h * 128 + hf * 32 + l32; float* po = OT + (size_t)(b * SEQ) * 1024 + h * 256 + qt * 64 + lane;
    for (int t0 = 0; t0 < SEQ; t0 += 2) {
        float qw[2], kw[2], ew[2]; bf16 vw[2];
#pragma unroll
        for (int s = 0; s < 2; ++s) { qw[s] = bf1(pq[(size_t)s * NP]); kw[s] = bf1(pq[(size_t)s * NP + (PC_GK - PC_GQ)]); ew[s] = pe[s * 512]; vw[s] = pv[(size_t)s * NP]; }
#pragma unroll
        for (int s = 0; s < 2; ++s) {
            if (lane < 32) { scr[lane] = qw[s]; scr[32 + lane] = kw[s]; scr[64 + lane] = ew[s]; }
            LDS_WAIT();
            const float v = bf1(vw[s]); float o = 0.f;
#pragma unroll
            for (int d = 0; d < 32; d += 4) { const f32x4 q4 = *(const LAS f32x4*)(scr + d), k4 = *(const LAS f32x4*)(scr + 32 + d), e4 = *(const LAS f32x4*)(scr + 64 + d);
#pragma unroll
                for (int e = 0; e < 4; ++e) { S[d + e] = e4[e] * S[d + e] + k4[e] * v; o += q4[e] * S[d + e]; }
                if ((d & 4) != 0) asm volatile("" ::: "memory"); }
            LDS_WAIT();
            po[s * 1024] = o * 0.08838834764831845f;
        }
        pq += 2 * (size_t)NP; pv += 2 * (size_t)NP; pe += 2 * 512; po += 2 * 1024;
    }
}
__device__ __forceinline__ void moba_naive_query(Frame& F, int qi, LAS float* scr) {
    const int lane = F.lane, t = qi & (SEQ - 1), h = (qi >> 11) & 7, b = qi >> 14, qb = t >> 8;
    const bf16* P = (const bf16*)(F.ws + WS_P); const bf16* QN = (const bf16*)(F.ws + WS_QN); const bf16* KN = (const bf16*)(F.ws + WS_KN); const float* KM = (const float*)(F.ws + WS_KM);
    bf16* Y = (bf16*)(F.ws + WS_Y);
    const unsigned qw = *(const unsigned*)(QN + (size_t)(b * SEQ + t) * 1024 + h * 128 + 2 * lane);
    const float q0 = bflo(qw), q1 = bfhi(qw);
    *(LAS f32x2*)(scr + 2 * lane) = (f32x2){q0, q1};
    LDS_WAIT();
    float sc[8]; unsigned selmask = 0u;
#pragma unroll
    for (int kb = 0; kb < 8; ++kb) { const f32x2 km = *(const f32x2*)(KM + (size_t)(((b * 8 + h) * 8 + kb) * 128) + 2 * lane); const float d = wave_sum(q0 * km[0] + q1 * km[1]); sc[kb] = (kb < qb) ? d : -__builtin_inff(); }
#pragma unroll
    for (int kb = 0; kb < 8; ++kb) { int rank = 0;
#pragma unroll
        for (int j = 0; j < 8; ++j) if (j != kb) rank += ((j < qb) && (sc[j] > sc[kb] || (sc[j] == sc[kb] && j < kb))) ? 1 : 0;
        if (kb < qb && rank < 3) selmask |= 1u << kb; }
    selmask |= 1u << qb;
    float m = -__builtin_inff(), lsum = 0.f, o0 = 0.f, o1 = 0.f;
    for (int kb = 0; kb <= qb; ++kb) {
        if (!((selmask >> kb) & 1u)) continue;
        for (int tile = 0; tile < 4; ++tile) {
            const int key0 = kb * 256 + tile * 64; if (key0 > t) break;
            const int key = key0 + lane;
            const v4u* kp = (const v4u*)(KN + (size_t)(b * SEQ + key) * 1024 + h * 128);
            float s = 0.f;
#pragma unroll
            for (int c = 0; c < 16; ++c) { if (c == 8) asm volatile("" ::: "memory"); const v4u kk = kp[c]; const f32x4 qa = *(const LAS f32x4*)(scr + 8 * c), qb4 = *(const LAS f32x4*)(scr + 8 * c + 4);
                s += qa[0] * bflo(kk.x) + qa[1] * bfhi(kk.x) + qa[2] * bflo(kk.y) + qa[3] * bfhi(kk.y) + qb4[0] * bflo(kk.z) + qb4[1] * bfhi(kk.z) + qb4[2] * bflo(kk.w) + qb4[3] * bfhi(kk.w); }
            if (key > t) s = -__builtin_inff();
            const float mnew = fmaxf(m, wave_max(s)); const float p = __expf(s - mnew), corr = __expf(m - mnew);
            lsum = lsum * corr + wave_sum(p); o0 *= corr; o1 *= corr; m = mnew;
            const bf16* vp = P + (size_t)(b * SEQ + key0) * NP + PC_MV + h * 128 + 2 * lane;
#pragma unroll 16
            for (int j = 0; j < 64; ++j) { const float pj = __shfl(p, j); const unsigned vw = *(const unsigned*)(vp + (size_t)j * NP); o0 += pj * bflo(vw); o1 += pj * bfhi(vw); }
        }
    }
    LDS_WAIT();
    const float inv = 1.0f / lsum;
    *(unsigned*)(Y + (size_t)(b * SEQ + t) * YW + 2048 + h * 128 + 2 * lane) = pk2(o0 * inv, o1 * inv);
}
__device__ __forceinline__ void p2b_naive(Frame& F, int l) {
    { F.refresh(); LAS float* scr = (LAS float*)(F.lds + F.wave * 16384);
      if (F.wave == 0) for (int it = blockIdx.x; it < 256; it += F.G) s5_naive_item(F, l, it, scr); }
    { F.refresh(); LAS float* scr = (LAS float*)(F.lds + F.wave * 16384);
      if (F.wave == 1) for (int it = blockIdx.x; it < 256; it += F.G) gla_naive_item(F, it, scr); }
    { F.refresh(); LAS float* scr = (LAS float*)(F.lds + F.wave * 16384);
      unsigned* head = F.ctl + CW_QUEUE + 64 * l;
      for (;;) {
          unsigned qi = 0; if (F.lane == 0) qi = __hip_atomic_fetch_add(head, 1u, __ATOMIC_RELAXED, __HIP_MEMORY_SCOPE_AGENT);
          qi = __builtin_amdgcn_readfirstlane(qi);
          if (qi >= (unsigned)(NBATCH * 8 * SEQ)) break;
          moba_naive_query(F, (int)qi, scr);
      } }
}
__device__ __forceinline__ void p2c_gla_finish(Frame& F, int l) {
    const bf16* P = (const bf16*)(F.ws + WS_P); const float* OT = (const float*)(F.ws + WS_OT); bf16* Y = (bf16*)(F.ws + WS_Y);
    const int lane = F.lane, gw = blockIdx.x * NWAVES + F.wave, NGW = F.G * NWAVES;
    const f32x4 gn = *(const f32x4*)(F.in[I_GNG] + l * 256 + 4 * lane);
    for (int it = gw; it < MTOK * 4; it += NGW) { const int tok = it >> 2, h = it & 3;
        const f32x4 o = (*(const f32x4*)(OT + (size_t)tok * 1024 + h * 256 + 4 * lane) + *(const f32x4*)(OT + (size_t)(MTOK + tok) * 1024 + h * 256 + 4 * lane)) + (*(const f32x4*)(OT + (size_t)(2 * MTOK + tok) * 1024 + h * 256 + 4 * lane) + *(const f32x4*)(OT + (size_t)(3 * MTOK + tok) * 1024 + h * 256 + 4 * lane));
        const float ss = wave_sum((o[0] * o[0] + o[1] * o[1]) + (o[2] * o[2] + o[3] * o[3])); const float rn = 1.0f / sqrtf(ss * (1.0f / 256.0f) + RMS_EPS);
        const v2u rw = *(const v2u*)(P + (size_t)tok * NP + PC_GR + h * 256 + 4 * lane);
        const float r0 = bflo(rw.x), r1 = bfhi(rw.x), r2 = bflo(rw.y), r3 = bfhi(rw.y);
        v2u w; w.x = pk2(o[0] * rn * gn[0] * r0 * sigmoidf_(r0), o[1] * rn * gn[1] * r1 * sigmoidf_(r1)); w.y = pk2(o[2] * rn * gn[2] * r2 * sigmoidf_(r2), o[3] * rn * gn[3] * r3 * sigmoidf_(r3));
        *(v2u*)(Y + (size_t)tok * YW + 1024 + h * 256 + 4 * lane) = w; }
}

constexpr int NPH = 9;
__global__ void __launch_bounds__(NWAVES * 64, 2) fwd_kernel(Args args) {
    extern __shared__ __attribute__((aligned(16))) unsigned char lds[];
    Frame F;
    F.lds = (LAS unsigned char*)lds;
    F.MISC = (volatile LAS unsigned*)(F.lds + MISC_OFF);
    F.tid = threadIdx.x; F.lane = F.tid & 63; F.wave = __builtin_amdgcn_readfirstlane(F.tid >> 6);
    F.G = gridDim.x; F.in = args.in; F.ws = args.ws; F.ws0 = args.ws; F.ctl = (unsigned*)(args.ws + WS_CTL);
    for (int u = F.tid; u < (LDS_BYTES - LDSCTL_OFF) / 4; u += NWAVES * 64) ((LAS unsigned*)(F.lds + LDSCTL_OFF))[u] = 0u;
    __syncthreads();
    XcdBarrier bar; bar.bar = F.ctl + CW_BAR; bar.x = 0; bar.st = nullptr;
    if (args.fused) bar = xcd_barrier_post(F.ctl + CW_BAR, F.MISC + 8);
#define GRID_BAR() do { if (args.fused) xcd_barrier(bar); } while (0)
    const int lo = args.ph_lo, hi = args.ph_hi;
#ifndef PH_MASK
#define PH_MASK 0x1ff
#endif
#define IN(k) (((PH_MASK >> (k)) & 1) && lo <= (k) && (k) < hi)
#define WSP(T, off) ((T*)(ws + (off)))

    if (args.l_lo == 0 && IN(0)) { F.refresh(); p0_prologue(F); GRID_BAR(); }

    for (int l = args.l_lo; l < args.l_hi; ++l) {
        if (IN(1)) {
            unsigned char* ws = opaque_ptr(args.ws); const unsigned char* wl = ws + WS_W + (size_t)l * SZ_WLAYER;
            pg8::Gemm g{WSP(pg8::bf16_t, WS_XB), DM, (const pg8::bf16_t*)(wl + OFF_WIN), DM, DM, 0, 0}; pg8::TileOrder S; S.init(MTOK, NP, F.G, (int)blockIdx.x, 1);
            pg8::EpiInProj E{WSP(pg8::bf16_t, WS_P), WSP(float, WS_SSQ)};
            pg8::gemm_phase(F.lds, g, S, E);
            GRID_BAR();
        }
        if (IN(2)) { F.refresh(); p2a_naive(F, l); GRID_BAR(); }
        if (IN(3)) { F.refresh(); p2b_naive(F, l); GRID_BAR(); }
        if (IN(4)) {
            F.refresh(); p2c_gla_finish(F, l);
            VM_WAIT(); __syncthreads();
            unsigned char* ws = opaque_ptr(args.ws); const unsigned char* wl = ws + WS_W + (size_t)l * SZ_WLAYER;
            pg8::Gemm g{WSP(pg8::bf16_t, WS_Z), 1024, (const pg8::bf16_t*)(wl + OFF_WGLU), 1024, 1024, 0, 0}; pg8::TileOrder S; S.init(MTOK, 1024, F.G, (int)blockIdx.x, 1);
            pg8::EpiGLU E{WSP(pg8::bf16_t, WS_Z), WSP(pg8::bf16_t, WS_Y), args.in[I_BGLU] + l * 1024};
            pg8::gemm_phase(F.lds, g, S, E);
            GRID_BAR();
        }
        if (IN(5)) {
            unsigned char* ws = opaque_ptr(args.ws); const unsigned char* wl = ws + WS_W + (size_t)l * SZ_WLAYER;
            pg8::Gemm g{WSP(pg8::bf16_t, WS_Y), YW, (const pg8::bf16_t*)(wl + OFF_WBR), 3072, 1024, 1024, 1024}; pg8::TileOrder S; S.init(MTOK, DM, F.G, (int)blockIdx.x, 3);
            pg8::EpiBranch E{WSP(pg8::bf16_t, WS_P), WSP(float, WS_MG), WSP(pg8::bf16_t, WS_MB)};
            pg8::gemm_phase(F.lds, g, S, E);
            GRID_BAR();
        }
        if (IN(6)) {
            unsigned char* ws = opaque_ptr(args.ws); const unsigned char* wl = ws + WS_W + (size_t)l * SZ_WLAYER;
            pg8::Gemm g{WSP(pg8::bf16_t, WS_MB), DM, (const pg8::bf16_t*)(wl + OFF_WOUT), DM, DM, 0, 0}; pg8::TileOrder S; S.init(MTOK, DM, F.G, (int)blockIdx.x, 1);
            pg8::EpiResid E{l == 0 ? args.in[I_X] : WSP(float, WS_XR), WSP(float, WS_XR), WSP(pg8::bf16_t, WS_XB), WSP(float, WS_SSQ)};
            pg8::gemm_phase(F.lds, g, S, E);
            GRID_BAR();
        }
        if (IN(7)) {
            unsigned char* ws = opaque_ptr(args.ws); const unsigned char* wl = ws + WS_W + (size_t)l * SZ_WLAYER;
            pg8::Gemm g{WSP(pg8::bf16_t, WS_XB), DM, (const pg8::bf16_t*)(wl + OFF_WGU), DM, DM, 0, 0}; pg8::TileOrder S; S.init(MTOK, NGU, F.G, (int)blockIdx.x, 1);
            pg8::EpiFFNUp E{WSP(pg8::bf16_t, WS_H), WSP(float, WS_SSQ)};
            pg8::gemm_phase(F.lds, g, S, E);
            GRID_BAR();
        }
        if (IN(8)) {
            unsigned char* ws = opaque_ptr(args.ws); const unsigned char* wl = ws + WS_W + (size_t)l * SZ_WLAYER;
            pg8::Gemm g{WSP(pg8::bf16_t, WS_H), FFN, (const pg8::bf16_t*)(wl + OFF_WDN), FFN, FFN, 0, 0}; pg8::TileOrder S; S.init(MTOK, DM, F.G, (int)blockIdx.x, 1);
            pg8::EpiResid E{WSP(float, WS_XR), l == DEPTH - 1 ? args.out : WSP(float, WS_XR), WSP(pg8::bf16_t, WS_XB), WSP(float, WS_SSQ)};
            pg8::gemm_phase(F.lds, g, S, E);
            if (l + 1 < DEPTH) GRID_BAR();
        }
    }
#undef IN
#undef GRID_BAR
}

extern "C" void kernel_launch(void* const* d_in, const int* in_sizes, int n_in, void* d_out, int out_size, void* d_ws, size_t ws_size, hipStream_t stream) {
    static int grid = 0;
    if (grid == 0) {
        if (n_in != 26 || out_size != MTOK * DM || ws_size < WS_END) { fprintf(stderr, "kernel_launch: unexpected problem (n_in %d out %d ws %zu need %zu)\n", n_in, out_size, ws_size, (size_t)WS_END); grid = -1; return; }
        int dev = 0, cus = 0, per_cu = 0;
        if (hipGetDevice(&dev) != hipSuccess || hipDeviceGetAttribute(&cus, hipDeviceAttributeMultiprocessorCount, dev) != hipSuccess) { grid = -1; return; }
        if (hipFuncSetAttribute((const void*)fwd_kernel, hipFuncAttributeMaxDynamicSharedMemorySize, LDS_BYTES) != hipSuccess) { fprintf(stderr, "kernel_launch: hipFuncSetAttribute failed\n"); grid = -1; return; }
        if (hipOccupancyMaxActiveBlocksPerMultiprocessor(&per_cu, (const void*)fwd_kernel, NWAVES * 64, LDS_BYTES) != hipSuccess || per_cu < 1) { fprintf(stderr, "kernel_launch: occupancy query says %d\n", per_cu); }
        (void)hipGetLastError();
        grid = cus;
    }
    if (grid < 0) return;
    if (hipMemsetAsync((char*)d_ws + WS_CTL, 0, CTL_ZERO_BYTES, stream) != hipSuccess) return;
    Args a{};
    for (int i = 0; i < 26; ++i) a.in[i] = (const float*)d_in[i];
    a.out = (float*)d_out; a.ws = (unsigned char*)d_ws; a.pad = 0;
#if MK_FUSED
    a.l_lo = 0; a.l_hi = DEPTH; a.ph_lo = 0; a.ph_hi = NPH; a.fused = 1;
    hipLaunchKernelGGL(fwd_kernel, dim3(grid), dim3(NWAVES * 64), LDS_BYTES, stream, a);
#else
    a.fused = 0;
    for (int l = 0; l < DEPTH; ++l)
        for (int ph = (l == 0 ? 0 : 1); ph < NPH; ++ph) { a.l_lo = l; a.l_hi = l + 1; a.ph_lo = ph; a.ph_hi = ph + 1; hipLaunchKernelGGL(fwd_kernel, dim3(grid), dim3(NWAVES * 64), LDS_BYTES, stream, a); }
#endif
}
```

```cpp
#include <hip/hip_runtime.h>
#include <cstdio>
#include <cstdint>

#ifndef S5_MFMA
#define S5_MFMA 1
#endif
#ifndef GLA_MFMA
#define GLA_MFMA 1
#endif
#ifndef MOBA_MFMA
#define MOBA_MFMA 1
#endif
#ifndef MK_FUSED
#define MK_FUSED 1
#endif

__device__ __forceinline__ unsigned char* opaque_ptr(unsigned char* p) { asm volatile("" : "+s"(p)); return p; }
__device__ __forceinline__ int opaque_tid() { int t = threadIdx.x; asm volatile("" : "+v"(t)); return t; }

namespace pg8 {
#define PG8_LAS __attribute__((address_space(3)))
typedef unsigned short bf16_t;
typedef short bf16x8 __attribute__((ext_vector_type(8)));
typedef float f32x4 __attribute__((ext_vector_type(4)));
typedef unsigned u32x4 __attribute__((ext_vector_type(4)));
typedef unsigned u32x2 __attribute__((ext_vector_type(2)));
constexpr int BM = 256, BK = 64, HALF = 128, HTB = HALF * BK * 2, STAGE_BYTES = 8 * HTB, NXCD = 8, WGM = 8;

__host__ __device__ __forceinline__ int lds_byte(int r, int c) { const int st = (r >> 4) * 2 + (c >> 5), rr = r & 15, cc = c & 31, ob = rr * 64 + cc * 2; return st * 1024 + (ob ^ (((ob >> 9) & 1) << 5)); }
__host__ __device__ __forceinline__ void stage_rc(int b, int& R, int& C) { const int st = b / 1024, sb = b % 1024, swz = sb ^ (((sb >> 9) & 1) << 5); R = (st >> 1) * 16 + swz / 64; C = (st & 1) * 32 + (swz % 64) / 2; }
__host__ __device__ __forceinline__ int perm32(int rho) { const int n = rho >> 4, i = rho & 15; return 8 * (i >> 2) + 4 * n + (i & 3); }

struct Unit { int pm, pn, br; };
struct Gemm { const bf16_t* A; int lda; const bf16_t* Bt; int ldb; int K; int abr, bbr; };

struct TileOrder {
    int nM, nN, nwg, G, c, nbr;
    __device__ __forceinline__ void init(int M, int N, int G_, int c_, int nbr_) { asm volatile("" : "+s"(G_), "+s"(c_)); nM = M / BM; nN = N / BM; nwg = nM * nN; G = G_; c = c_; nbr = nbr_; }
    __device__ __forceinline__ bool next(int i, Unit& u) const {
        const int it = i / nbr; u.br = i - it * nbr;
        const long L = (long)it * G + c; if (L >= nwg) return false;
        int wgid = (int)L; { const int q = nwg / NXCD, r = nwg % NXCD, xcd = wgid % NXCD, off = wgid / NXCD; wgid = (xcd < r ? xcd * (q + 1) : r * (q + 1) + (xcd - r) * q) + off; }
        const int nig = WGM * nN, gid = wgid / nig, fm = gid * WGM, gsz = (nM - fm) < WGM ? (nM - fm) : WGM;
        u.pm = __builtin_amdgcn_readfirstlane(fm + ((wgid % nig) % gsz)); u.pn = __builtin_amdgcn_readfirstlane((wgid % nig) / gsz); return true;
    }
};

__device__ __forceinline__ unsigned cvt_pk_bf16(float lo, float hi) { unsigned r; asm volatile("v_cvt_pk_bf16_f32 %0, %1, %2" : "=v"(r) : "v"(lo), "v"(hi)); return r; }

template <class Epi, class Sched>
__device__ __forceinline__ void gemm_phase(PG8_LAS unsigned char* lds, const Gemm g, const Sched& S, const Epi& E) {
    const int tid = opaque_tid(), wid = __builtin_amdgcn_readfirstlane(tid >> 6), lane = tid & 63, wr = wid >> 2, wc = wid & 3, fr = lane & 15, fq = lane >> 4;
    const int K = g.K, nt = K / BK;
    unsigned voffA[2], voffB[2];
#pragma unroll
    for (int i = 0; i < 2; ++i) { int R, C; stage_rc(tid * 16 + i * 8192, R, C); const int Rb = (R & ~31) + perm32(R & 31);
        voffA[i] = (unsigned)(R * g.lda + C) * 2u; voffB[i] = (unsigned)(Rb * g.ldb + C) * 2u; }
    const size_t kstep = (size_t)(BK * 2);
    const size_t hstepA = (size_t)HALF * g.lda * 2, hstepB = (size_t)HALF * g.ldb * 2;
    const size_t tstepA = 2 * hstepA, tstepB = 2 * hstepB;
    const unsigned ldsw = (unsigned)wid * 1024u;
    const int aoff = lds_byte(wr * 64 + fr, fq * 8), boff = lds_byte(wc * 32 + fr, fq * 8);
#define PG8_SA(b, h) (((b) * 2 + (h)) * HTB)
#define PG8_SB(b, h) ((4 + (b) * 2 + (h)) * HTB)
#define PG8_STAGE(bufoff, gbase, voff) do { _Pragma("unroll") for (int _i = 0; _i < 2; ++_i) \
        __builtin_amdgcn_global_load_lds((const unsigned*)((const char*)(gbase) + (voff)[_i]), (PG8_LAS unsigned*)(lds + (bufoff) + ldsw + _i * 8192), 16, 0, 0); } while (0)
#define PG8_LDA(dst, b, h) do { _Pragma("unroll") for (int m = 0; m < 4; ++m) _Pragma("unroll") for (int k = 0; k < 2; ++k) dst[m][k] = *(const PG8_LAS bf16x8*)(lds + PG8_SA(b, h) + aoff + m * 2048 + k * 1024); } while (0)
#define PG8_LDB(dst, b, h) do { _Pragma("unroll") for (int n = 0; n < 2; ++n) _Pragma("unroll") for (int k = 0; k < 2; ++k) dst[n][k] = *(const PG8_LAS bf16x8*)(lds + PG8_SB(b, h) + boff + n * 2048 + k * 1024); } while (0)
#define PG8_MMA(ai, bj, At, Bt) do { __builtin_amdgcn_s_setprio(1); _Pragma("unroll") for (int m = 0; m < 4; ++m) _Pragma("unroll") for (int n = 0; n < 2; ++n) _Pragma("unroll") for (int k = 0; k < 2; ++k) \
        acc[ai][bj][m][n] = __builtin_amdgcn_mfma_f32_16x16x32_bf16(Bt[n][k], At[m][k], acc[ai][bj][m][n], 0, 0, 0); __builtin_amdgcn_s_setprio(0); } while (0)
#define PG8_WAIT_V(n) asm volatile("s_waitcnt vmcnt(" #n ")" ::: "memory")
#define PG8_WAIT_L(n) asm volatile("s_waitcnt lgkmcnt(" #n ")" ::: "memory")
#define PG8_BAR __builtin_amdgcn_s_barrier()
#define PG8_SCHED __builtin_amdgcn_sched_barrier(0)
    Unit cur, nxt; int ui = 0;
    if (!S.next(0, cur)) return;
    f32x4 acc[2][2][4][2];
#pragma unroll
    for (int a = 0; a < 2; ++a)
#pragma unroll
        for (int b = 0; b < 2; ++b)
#pragma unroll
            for (int m = 0; m < 4; ++m)
#pragma unroll
                for (int n = 0; n < 2; ++n) acc[a][b][m][n] = (f32x4){0.f, 0.f, 0.f, 0.f};
    bf16x8 At[4][2], B0[2][2], B1[2][2];
    const char* cA = (const char*)g.A + (size_t)cur.pm * tstepA + (size_t)cur.br * g.abr * 2; const char* cB = (const char*)g.Bt + (size_t)cur.pn * tstepB + (size_t)cur.br * g.bbr * 2;
    PG8_STAGE(PG8_SB(0, 0), cB, voffB); PG8_STAGE(PG8_SB(0, 1), cB + hstepB, voffB); PG8_STAGE(PG8_SA(0, 0), cA, voffA); PG8_STAGE(PG8_SA(0, 1), cA + hstepA, voffA);
    if (wr == 1) PG8_BAR;
    PG8_WAIT_V(2); PG8_BAR;
    PG8_STAGE(PG8_SB(1, 0), cB + kstep, voffB); PG8_STAGE(PG8_SA(1, 0), cA + kstep, voffA); PG8_STAGE(PG8_SB(1, 1), cB + hstepB + kstep, voffB);
    PG8_WAIT_V(6); PG8_BAR;
    for (;;) {
        const bool has_next = S.next(ui + 1, nxt);
        const char* nA = has_next ? (const char*)g.A + (size_t)nxt.pm * tstepA + (size_t)nxt.br * g.abr * 2 : cA; const char* nB = has_next ? (const char*)g.Bt + (size_t)nxt.pn * tstepB + (size_t)nxt.br * g.bbr * 2 : cB;
        for (int t = 0; t < nt; t += 2) {
            const bool last = (t == nt - 2);
            const char* a1 = cA + (size_t)(t + 1) * kstep;
            const char* a2 = last ? nA : cA + (size_t)(t + 2) * kstep; const char* b2 = last ? nB : cB + (size_t)(t + 2) * kstep;
            const char* a3 = a2 + kstep; const char* b3 = b2 + kstep;
            PG8_LDB(B0, 0, 0); PG8_LDB(B1, 0, 1); PG8_SCHED; PG8_LDA(At, 0, 0); PG8_STAGE(PG8_SA(1, 1), a1 + hstepA, voffA);
            PG8_WAIT_V(8); PG8_WAIT_L(0); PG8_BAR; PG8_MMA(0, 0, At, B0); PG8_MMA(0, 1, At, B1); PG8_BAR; PG8_SCHED;
            PG8_LDA(At, 0, 1); PG8_STAGE(PG8_SB(0, 0), b2, voffB); PG8_STAGE(PG8_SB(0, 1), b2 + hstepB, voffB); PG8_STAGE(PG8_SA(0, 0), a2, voffA);
            PG8_WAIT_V(8); PG8_WAIT_L(0); PG8_BAR; PG8_MMA(1, 0, At, B0); PG8_MMA(1, 1, At, B1); PG8_BAR; PG8_SCHED;
            PG8_LDB(B0, 1, 0); PG8_LDB(B1, 1, 1); PG8_SCHED; PG8_LDA(At, 1, 0); PG8_STAGE(PG8_SA(0, 1), a2 + hstepA, voffA);
            PG8_WAIT_V(8); PG8_WAIT_L(0); PG8_BAR; PG8_MMA(0, 0, At, B0); PG8_MMA(0, 1, At, B1); PG8_BAR; PG8_SCHED;
            PG8_LDA(At, 1, 1); PG8_STAGE(PG8_SB(1, 0), b3, voffB); PG8_STAGE(PG8_SB(1, 1), b3 + hstepB, voffB); PG8_STAGE(PG8_SA(1, 0), a3, voffA);
            PG8_WAIT_V(8); PG8_WAIT_L(0); PG8_BAR; PG8_MMA(1, 0, At, B0); PG8_MMA(1, 1, At, B1); PG8_BAR; PG8_SCHED;
        }
        if (wr == 0) PG8_BAR;
        E(acc, cur, wr, wc, fr, fq, lds);
        if (!has_next) break;
#pragma unroll
        for (int a = 0; a < 2; ++a)
#pragma unroll
            for (int b = 0; b < 2; ++b)
#pragma unroll
                for (int m = 0; m < 4; ++m)
#pragma unroll
                    for (int n = 0; n < 2; ++n) acc[a][b][m][n] = (f32x4){0.f, 0.f, 0.f, 0.f};
        cur = nxt; cA = nA; cB = nB; ++ui;
        if (wr == 1) PG8_BAR;
    }
    PG8_WAIT_V(0);
    PG8_BAR;
#undef PG8_SA
#undef PG8_SB
#undef PG8_STAGE
#undef PG8_LDA
#undef PG8_LDB
#undef PG8_MMA
#undef PG8_WAIT_V
#undef PG8_WAIT_L
#undef PG8_BAR
#undef PG8_SCHED
}
}

constexpr int NWAVES = 8;
constexpr int DM = 2048, NBATCH = 4, SEQ = 2048, DEPTH = 4, MTOK = NBATCH * SEQ;
constexpr int INW = 13328;
constexpr int NP = 13568;
constexpr int PC_SSM = 0, PC_GQ = 1024, PC_GK = 1536, PC_GV = 2048, PC_GR = 3072, PC_MQ = 4096, PC_MK = 5120, PC_MV = 6144, PC_GS = 7168, PC_GLR = 13312;
constexpr int FFN = 5632, NGU = 2 * FFN;
constexpr int YW = 3072;
constexpr float RMS_EPS = 1e-6f;

constexpr size_t MiB = 1u << 20;
constexpr size_t WS_CTL = 0, CTL_ZERO_BYTES = 1 * MiB;
constexpr size_t SZ_WIN = (size_t)NP * DM * 2, SZ_WGLU = (size_t)1024 * 1024 * 2, SZ_WBR = (size_t)DM * 3072 * 2, SZ_WOUT = (size_t)DM * DM * 2, SZ_WGU = (size_t)NGU * DM * 2, SZ_WDN = (size_t)DM * FFN * 2;
constexpr size_t OFF_WIN = 0, OFF_WGLU = OFF_WIN + SZ_WIN, OFF_WBR = OFF_WGLU + SZ_WGLU, OFF_WOUT = OFF_WBR + SZ_WBR, OFF_WGU = OFF_WOUT + SZ_WOUT, OFF_WDN = OFF_WGU + SZ_WGU, SZ_WLAYER = OFF_WDN + SZ_WDN;
constexpr size_t WS_W = 2 * MiB;
constexpr size_t WS_P = WS_W + ((DEPTH * SZ_WLAYER + MiB - 1) / MiB) * MiB;
constexpr size_t WS_Z = WS_P + (size_t)MTOK * NP * 2;
constexpr size_t WS_Y = WS_Z + (size_t)MTOK * 1024 * 2;
constexpr size_t WS_MG = WS_Y + (size_t)MTOK * YW * 2;
constexpr size_t WS_MB = WS_MG + (size_t)MTOK * DM * 4;
constexpr size_t WS_XR = WS_MB + (size_t)MTOK * DM * 2;
constexpr size_t WS_XB = WS_XR + (size_t)MTOK * DM * 4;
constexpr size_t WS_H = WS_XB + (size_t)MTOK * DM * 2;
constexpr size_t WS_SSQ = WS_H + (size_t)MTOK * FFN * 2;
constexpr size_t WS_EG = WS_SSQ + (size_t)MTOK * 8 * 4;
constexpr size_t WS_OT = WS_EG + (size_t)MTOK * 512 * 4;
constexpr size_t WS_QN = WS_OT + (size_t)4 * MTOK * 1024 * 4;
constexpr size_t WS_KN = WS_QN + (size_t)MTOK * 1024 * 2;
constexpr size_t WS_KM = WS_KN + (size_t)MTOK * 1024 * 2;
constexpr size_t WS_TK = WS_KM + (size_t)4 * 8 * 8 * 128 * 4;
constexpr size_t WS_TW = WS_TK + (size_t)DEPTH * 64 * 64 * 256 * 2;
constexpr size_t WS_TC = WS_TW + (size_t)DEPTH * 64 * 128 * 1024 * 2;
constexpr size_t WS_A64 = WS_TC + (size_t)DEPTH * 64 * 1024 * 128 * 2;
constexpr size_t WS_SL = WS_A64 + (size_t)DEPTH * 64 * 128 * 4;
constexpr size_t WS_QD = WS_SL + (size_t)NBATCH * 32 * 64 * 128 * 4;
constexpr size_t WS_KI = WS_QD + (size_t)512 * 64 * 128 * 2;
constexpr size_t WS_GVT = WS_KI + (size_t)512 * 64 * 128 * 2;
constexpr size_t WS_KV = WS_GVT + (size_t)512 * 256 * 64 * 2;
constexpr size_t WS_DEC = WS_KV + (size_t)512 * 256 * 128 * 4;
constexpr size_t WS_ST = WS_DEC + (size_t)512 * 128 * 4;
constexpr size_t WS_VT = WS_ST + (size_t)512 * 256 * 128 * 2;
constexpr size_t WS_END = WS_VT + (size_t)NBATCH * 8 * 128 * SEQ * 2;
constexpr int CW_BAR = 4096;
constexpr int CW_QUEUE = 16384;

constexpr int RING_BYTES = 131072;
constexpr int LDSCTL_OFF = RING_BYTES, MISC_OFF = LDSCTL_OFF + 320;
constexpr int TAB_OFF = RING_BYTES + 1024;
constexpr int LDS_BYTES = 147456;

#define GAS __attribute__((address_space(1)))
#define LAS __attribute__((address_space(3)))
typedef unsigned short bf16;
typedef unsigned v4u __attribute__((ext_vector_type(4)));
typedef unsigned v2u __attribute__((ext_vector_type(2)));
typedef float f32x4 __attribute__((ext_vector_type(4)));
typedef float f32x2 __attribute__((ext_vector_type(2)));
#define LDS_WAIT() asm volatile("s_waitcnt lgkmcnt(0)" ::: "memory")
#define VM_WAIT() asm volatile("s_waitcnt vmcnt(0)" ::: "memory")
__device__ __forceinline__ unsigned f2bf(float f) { unsigned u = __builtin_bit_cast(unsigned, f); return (u + 0x7fffu + ((u >> 16) & 1u)) >> 16; }
__device__ __forceinline__ unsigned pk2(float lo, float hi) { return f2bf(lo) | (f2bf(hi) << 16); }
__device__ __forceinline__ float bflo(unsigned u) { return __builtin_bit_cast(float, u << 16); }
__device__ __forceinline__ float bfhi(unsigned u) { return __builtin_bit_cast(float, u & 0xffff0000u); }
__device__ __forceinline__ float bf1(bf16 b) { return __builtin_bit_cast(float, ((unsigned)b) << 16); }
__device__ __forceinline__ float sigmoidf_(float x) { return __builtin_amdgcn_rcpf(1.0f + __expf(-x)); }
__device__ __forceinline__ float gelu_tanh(float x) { const float u = 0.7978845608028654f * (x + 0.044715f * x * x * x); return x * sigmoidf_(2.0f * u); }
__device__ __forceinline__ float wave_sum(float v) {
#pragma unroll
    for (int o = 1; o < 64; o <<= 1) v += __shfl_xor(v, o);
    return v;
}
__device__ __forceinline__ float wave_max(float v) {
#pragma unroll
    for (int o = 1; o < 64; o <<= 1) v = fmaxf(v, __shfl_xor(v, o));
    return v;
}

#define XB_TMO      128
#define XB_XCNT(j)  (256  + 64 * (j))
#define XB_XSUB(j)  (1280 + 64 * (j))
#define XB_XGEN(j)  (2304 + 64 * (j))
#define XB_TOP      3328
#define XB_TOPGEN   3392
#define XCD_BAR_WORDS 3456
#define XB_SPIN_CAP (1u << 18)
__device__ __forceinline__ unsigned xb_ld(unsigned* p)              { return __hip_atomic_load(p, __ATOMIC_RELAXED, __HIP_MEMORY_SCOPE_AGENT); }
__device__ __forceinline__ unsigned xb_add(unsigned* p, unsigned v) { return __hip_atomic_fetch_add(p, v, __ATOMIC_RELAXED, __HIP_MEMORY_SCOPE_AGENT); }
__device__ __forceinline__ unsigned xb_xcc_id() { return (unsigned)__builtin_amdgcn_s_getreg((3 << 11) | 20) & 0xFu; }
#define XB_SPIN(cond, bar) do { unsigned _sp = 0; while (cond) { __builtin_amdgcn_s_sleep(1); \
    if ((++_sp & 255u) == 0u) { if (xb_ld(&(bar)[XB_TMO])) break; if (_sp > XB_SPIN_CAP) { atomicAdd(&(bar)[XB_TMO], 1u); break; } } } } while (0)
struct XcdBarrier { unsigned* bar; unsigned x; volatile LAS unsigned* st; };
__device__ __forceinline__ XcdBarrier xcd_barrier_post(unsigned* bar, volatile LAS unsigned* st) {
    XcdBarrier b; b.bar = bar; b.x = xb_xcc_id(); b.st = st;
    if (threadIdx.x == 0) (void)xb_add(&bar[XB_XCNT(b.x)], 1u);
    return b;
}
__device__ __forceinline__ void xcd_barrier_complete(unsigned* bar, unsigned x, unsigned& nloc, unsigned& nx) {
    const unsigned G = gridDim.x * gridDim.y * gridDim.z;
    unsigned sum, cnt, mine, sp = 0u;
    for (;;) {
        sum = 0u; cnt = 0u; mine = 0u;
#pragma unroll
        for (unsigned j = 0; j < 16; ++j) { const unsigned c = xb_ld(&bar[XB_XCNT(j)]); sum += c; cnt += (c > 0u) ? 1u : 0u; mine = (j == x) ? c : mine; }
        if (sum == G) break;
        __builtin_amdgcn_s_sleep(1);
        if ((++sp & 255u) == 0u) { if (xb_ld(&bar[XB_TMO])) break; if (sp > XB_SPIN_CAP) { atomicAdd(&bar[XB_TMO], 1u); break; } }
    }
    nloc = mine > 0u ? mine : 1u; nx = cnt > 0u ? cnt : 1u;
}
__device__ __forceinline__ void xcd_barrier(const XcdBarrier& b) {
    asm volatile("s_waitcnt vmcnt(0)" ::: "memory");
    __syncthreads();
    if (threadIdx.x == 0) {
        unsigned* bar = b.bar;
        __builtin_amdgcn_s_waitcnt(0);
        unsigned nloc = b.st[0], nx = b.st[1];
        if (nloc == 0u) { xcd_barrier_complete(bar, b.x, nloc, nx); b.st[0] = nloc; b.st[1] = nx; }
        const unsigned old = xb_add(&bar[XB_XSUB(b.x)], 1u);
        const unsigned gen = old / nloc;
        if (old + 1u == (gen + 1u) * nloc) {
            __builtin_amdgcn_fence(__ATOMIC_RELEASE, "agent");
            asm volatile("s_waitcnt vmcnt(0)" ::: "memory");
            const unsigned og = xb_add(&bar[XB_TOP], 1u);
            const unsigned tg = og / nx;
            if (og + 1u == (tg + 1u) * nx) xb_add(&bar[XB_TOPGEN], 1u);
            else XB_SPIN(xb_ld(&bar[XB_TOPGEN]) == tg, bar);
            __builtin_amdgcn_fence(__ATOMIC_ACQUIRE, "agent");
            xb_add(&bar[XB_XGEN(b.x)], 1u);
            asm volatile("s_waitcnt vmcnt(0)" ::: "memory");
        } else {
            XB_SPIN(xb_ld(&bar[XB_XGEN(b.x)]) == gen, bar);
            __builtin_amdgcn_fence(__ATOMIC_ACQUIRE, "agent");
            asm volatile("s_waitcnt vmcnt(0)" ::: "memory");
        }
    }
    __syncthreads();
}

struct Args {
    const float* in[26];
    float* out; unsigned char* ws;
    int l_lo, l_hi, ph_lo, ph_hi;
    int fused, pad;
};
enum { I_X = 0, I_N1G, I_WIN, I_LRE, I_LIM, I_LDT, I_BRE, I_BIM, I_CRE, I_CIM, I_SD, I_WGLU, I_BGLU, I_GW2, I_GB2, I_GNG, I_MQG, I_MKG, I_WBS, I_WBG, I_WBM, I_WOUT, I_N2G, I_FWG, I_FWU, I_FWD };

namespace pg8 {
#define EPI_FENCE() asm volatile("" ::: "memory")
__device__ __forceinline__ void load_rstd(const float* ssq, int pm, int wr, int fr, int fq, float (&rs)[2][4]) {
    f32x2 p[2][4];
#pragma unroll
    for (int ai = 0; ai < 2; ++ai)
#pragma unroll
        for (int m = 0; m < 4; ++m) { const int row = pm * BM + ai * HALF + wr * 64 + m * 16 + fr; p[ai][m] = *(const f32x2*)(ssq + (size_t)row * 8 + 2 * fq); }
#pragma unroll
    for (int ai = 0; ai < 2; ++ai)
#pragma unroll
        for (int m = 0; m < 4; ++m) { float s = p[ai][m][0] + p[ai][m][1]; s += __shfl_xor(s, 16); s += __shfl_xor(s, 32); rs[ai][m] = 1.0f / sqrtf(s * (1.0f / DM) + RMS_EPS); }
    EPI_FENCE();
}
struct EpiInProj {
    bf16_t* P; const float* ssq;
    __device__ __forceinline__ void operator()(const f32x4 (&acc)[2][2][4][2], const Unit& u, int wr, int wc, int fr, int fq, PG8_LAS unsigned char*) const {
        float rs[2][4]; load_rstd(ssq, u.pm, wr, fr, fq, rs);
        const int row0 = u.pm * BM + wr * 64 + fr, col0 = u.pn * BM + wc * 32 + 8 * fq;
#pragma unroll
        for (int ai = 0; ai < 2; ++ai)
#pragma unroll
            for (int m = 0; m < 4; ++m) { bf16_t* rowp = P + (size_t)(row0 + ai * HALF + m * 16) * NP + col0; const float r = rs[ai][m];
#pragma unroll
                for (int bj = 0; bj < 2; ++bj) { const f32x4 v0 = acc[ai][bj][m][0] * r, v1 = acc[ai][bj][m][1] * r;
                    u32x4 w; w.x = cvt_pk_bf16(v0[0], v0[1]); w.y = cvt_pk_bf16(v0[2], v0[3]); w.z = cvt_pk_bf16(v1[0], v1[1]); w.w = cvt_pk_bf16(v1[2], v1[3]);
                    *(u32x4*)(rowp + bj * HALF) = w; } }
    }
};
struct EpiGLU {
    const bf16_t* Z; bf16_t* Y; const float* bias;
    __device__ __forceinline__ void operator()(const f32x4 (&acc)[2][2][4][2], const Unit& u, int wr, int wc, int fr, int fq, PG8_LAS unsigned char*) const {
        const int row0 = u.pm * BM + wr * 64 + fr, col0 = u.pn * BM + wc * 32 + 8 * fq;
        f32x4 bv[2][2];
#pragma unroll
        for (int bj = 0; bj < 2; ++bj)
#pragma unroll
            for (int n = 0; n < 2; ++n) bv[bj][n] = *(const f32x4*)(bias + col0 + bj * HALF + 4 * n);
        u32x4 zb[2][2];
#pragma unroll
        for (int idx = 0; idx <= 8; ++idx) {
            if (idx < 8) { const size_t row = (size_t)(row0 + (idx >> 2) * HALF + (idx & 3) * 16);
#pragma unroll
                for (int bj = 0; bj < 2; ++bj) zb[idx & 1][bj] = *(const u32x4*)(Z + row * 1024 + col0 + bj * HALF); }
            if (idx > 0) { const int ai = (idx - 1) >> 2, m = (idx - 1) & 3; const size_t row = (size_t)(row0 + ai * HALF + m * 16);
#pragma unroll
                for (int bj = 0; bj < 2; ++bj) { const u32x4 zz = zb[(idx - 1) & 1][bj];
                    const f32x4 g0 = acc[ai][bj][m][0] + bv[bj][0], g1 = acc[ai][bj][m][1] + bv[bj][1];
                    u32x4 w;
                    w.x = cvt_pk_bf16(bflo(zz.x) * sigmoidf_(g0[0]), bfhi(zz.x) * sigmoidf_(g0[1])); w.y = cvt_pk_bf16(bflo(zz.y) * sigmoidf_(g0[2]), bfhi(zz.y) * sigmoidf_(g0[3]));
                    w.z = cvt_pk_bf16(bflo(zz.z) * sigmoidf_(g1[0]), bfhi(zz.z) * sigmoidf_(g1[1])); w.w = cvt_pk_bf16(bflo(zz.w) * sigmoidf_(g1[2]), bfhi(zz.w) * sigmoidf_(g1[3]));
                    *(u32x4*)(Y + row * YW + col0 + bj * HALF) = w; } }
            EPI_FENCE();
        }
    }
};
struct EpiBranch {
    const bf16_t* P; float* MG; bf16_t* MB;
    __device__ __forceinline__ void operator()(const f32x4 (&acc)[2][2][4][2], const Unit& u, int wr, int wc, int fr, int fq, PG8_LAS unsigned char*) const {
        const int row0 = u.pm * BM + wr * 64 + fr, col0 = u.pn * BM + wc * 32 + 8 * fq;
        const int br = u.br;
        u32x4 gb[2][2]; f32x4 mb[2][2][2];
#pragma unroll
        for (int idx = 0; idx <= 8; ++idx) {
            if (idx < 8) { const size_t row = (size_t)(row0 + (idx >> 2) * HALF + (idx & 3) * 16);
#pragma unroll
                for (int bj = 0; bj < 2; ++bj) { const int col = col0 + bj * HALF; gb[idx & 1][bj] = *(const u32x4*)(P + row * NP + PC_GS + br * DM + col);
                    if (br != 0) { mb[idx & 1][bj][0] = *(const f32x4*)(MG + row * DM + col); mb[idx & 1][bj][1] = *(const f32x4*)(MG + row * DM + col + 4); } } }
            if (idx > 0) { const int ai = (idx - 1) >> 2, m = (idx - 1) & 3; const size_t row = (size_t)(row0 + ai * HALF + m * 16);
#pragma unroll
                for (int bj = 0; bj < 2; ++bj) { const int col = col0 + bj * HALF; const u32x4 gg = gb[(idx - 1) & 1][bj];
                    f32x4 v0 = acc[ai][bj][m][0], v1 = acc[ai][bj][m][1];
                    v0[0] *= sigmoidf_(bflo(gg.x)); v0[1] *= sigmoidf_(bfhi(gg.x)); v0[2] *= sigmoidf_(bflo(gg.y)); v0[3] *= sigmoidf_(bfhi(gg.y));
                    v1[0] *= sigmoidf_(bflo(gg.z)); v1[1] *= sigmoidf_(bfhi(gg.z)); v1[2] *= sigmoidf_(bflo(gg.w)); v1[3] *= sigmoidf_(bfhi(gg.w));
                    if (br != 0) { v0 = v0 + mb[(idx - 1) & 1][bj][0]; v1 = v1 + mb[(idx - 1) & 1][bj][1]; }
                    if (br != 2) { *(f32x4*)(MG + row * DM + col) = v0; *(f32x4*)(MG + row * DM + col + 4) = v1; }
                    else { u32x4 w; w.x = cvt_pk_bf16(v0[0], v0[1]); w.y = cvt_pk_bf16(v0[2], v0[3]); w.z = cvt_pk_bf16(v1[0], v1[1]); w.w = cvt_pk_bf16(v1[2], v1[3]); *(u32x4*)(MB + row * DM + col) = w; } } }
            EPI_FENCE();
        }
    }
};
struct EpiResid {
    const float* xin; float* xout; bf16_t* XB; float* ssq;
    __device__ __forceinline__ void operator()(const f32x4 (&acc)[2][2][4][2], const Unit& u, int wr, int wc, int fr, int fq, PG8_LAS unsigned char* lds) const {
        const int row0 = u.pm * BM + wr * 64 + fr, col0 = u.pn * BM + wc * 32 + 8 * fq;
        PG8_LAS float* T = (PG8_LAS float*)(lds + TAB_OFF);
        f32x4 xb[2][2][2];
#pragma unroll
        for (int idx = 0; idx <= 8; ++idx) {
            if (idx < 8) { const size_t row = (size_t)(row0 + (idx >> 2) * HALF + (idx & 3) * 16);
#pragma unroll
                for (int bj = 0; bj < 2; ++bj) { const size_t o = row * DM + col0 + bj * HALF; xb[idx & 1][bj][0] = *(const f32x4*)(xin + o); xb[idx & 1][bj][1] = *(const f32x4*)(xin + o + 4); } }
            if (idx > 0) { const int ai = (idx - 1) >> 2, m = (idx - 1) & 3; const size_t row = (size_t)(row0 + ai * HALF + m * 16); float s = 0.f;
#pragma unroll
                for (int bj = 0; bj < 2; ++bj) { const size_t o = row * DM + col0 + bj * HALF;
                    const f32x4 v0 = acc[ai][bj][m][0] + xb[(idx - 1) & 1][bj][0], v1 = acc[ai][bj][m][1] + xb[(idx - 1) & 1][bj][1];
                    *(f32x4*)(xout + o) = v0; *(f32x4*)(xout + o + 4) = v1;
                    u32x4 w; w.x = cvt_pk_bf16(v0[0], v0[1]); w.y = cvt_pk_bf16(v0[2], v0[3]); w.z = cvt_pk_bf16(v1[0], v1[1]); w.w = cvt_pk_bf16(v1[2], v1[3]); *(u32x4*)(XB + o) = w;
                    s += (v0[0] * v0[0] + v0[1] * v0[1]) + (v0[2] * v0[2] + v0[3] * v0[3]) + (v1[0] * v1[0] + v1[1] * v1[1]) + (v1[2] * v1[2] + v1[3] * v1[3]); }
                s += __shfl_xor(s, 16); s += __shfl_xor(s, 32);
                if (fq == 0) T[(ai * HALF + wr * 64 + m * 16 + fr) * 4 + wc] = s; }
            EPI_FENCE();
        }
        asm volatile("s_waitcnt lgkmcnt(0)" ::: "memory"); __builtin_amdgcn_s_barrier(); asm volatile("" ::: "memory");
        const int t = (wr * 4 + wc) * 64 + fq * 16 + fr;
        if (t < 256) { const f32x4 p = *(const PG8_LAS f32x4*)(T + t * 4); ssq[(size_t)(u.pm * BM + t) * 8 + u.pn] = (p[0] + p[1]) + (p[2] + p[3]); }
    }
};
struct EpiFFNUp {
    bf16_t* H; const float* ssq;
    __device__ __forceinline__ void operator()(const f32x4 (&acc)[2][2][4][2], const Unit& u, int wr, int wc, int fr, int fq, PG8_LAS unsigned char*) const {
        float rs[2][4]; load_rstd(ssq, u.pm, wr, fr, fq, rs);
        const int row0 = u.pm * BM + wr * 64 + fr, col0 = u.pn * HALF + wc * 32 + 8 * fq;
#pragma unroll
        for (int ai = 0; ai < 2; ++ai)
#pragma unroll
            for (int m = 0; m < 4; ++m) { const float r = rs[ai][m]; float h[8];
#pragma unroll
                for (int n = 0; n < 2; ++n)
#pragma unroll
                    for (int e = 0; e < 4; ++e) { const float gv = acc[ai][0][m][n][e] * r, uv = acc[ai][1][m][n][e] * r; h[n * 4 + e] = gv * sigmoidf_(gv) * uv; }
                u32x4 w; w.x = cvt_pk_bf16(h[0], h[1]); w.y = cvt_pk_bf16(h[2], h[3]); w.z = cvt_pk_bf16(h[4], h[5]); w.w = cvt_pk_bf16(h[6], h[7]);
                *(u32x4*)(H + (size_t)(row0 + ai * HALF + m * 16) * FFN + col0) = w; }
    }
};
}

struct Frame {
    __device__ __forceinline__ void refresh() { ws = opaque_ptr(ws0); tid = opaque_tid(); lane = tid & 63; wave = __builtin_amdgcn_readfirstlane(tid >> 6); }
    LAS unsigned char* lds;
    volatile LAS unsigned* MISC;
    unsigned* ctl;
    int tid, lane, wave, G;
    const float* const* in;
    unsigned char* ws; unsigned char* ws0;
};

__device__ __forceinline__ void conv_item(const float* W, int ldw, int k0, int src_c0, int nvalid, const float* gk, bf16* WT, int ldt, int dst_r0, int dst_k, LAS float* scr, int lane) {
    const int c = lane & 31;
#pragma unroll 8
    for (int i = 0; i < 32; ++i) { const int kk = 2 * i + (lane >> 5); float v = 0.f;
        if (c < nvalid) { v = W[(size_t)(k0 + kk) * ldw + src_c0 + c]; if (gk) v *= gk[k0 + kk]; }
        scr[kk * 33 + c] = v; }
    LDS_WAIT(); asm volatile("" ::: "memory");
    const int c8 = lane & 7;
#pragma unroll
    for (int j = 0; j < 4; ++j) { const int n = (lane >> 3) + 8 * j; const LAS float* s = scr + (8 * c8) * 33 + n;
        v4u o; o.x = pk2(s[0 * 33], s[1 * 33]); o.y = pk2(s[2 * 33], s[3 * 33]); o.z = pk2(s[4 * 33], s[5 * 33]); o.w = pk2(s[6 * 33], s[7 * 33]);
        *(GAS v4u*)(WT + (size_t)(dst_r0 + n) * ldt + dst_k + 8 * c8) = o; }
    LDS_WAIT(); asm volatile("" ::: "memory");
}
__device__ __forceinline__ void s5_tables_unit(Frame& F, int lg);
__device__ __forceinline__ void p0_prologue(Frame& F) {
    LAS float* scr = (LAS float*)(F.lds + F.wave * 16384);
    const int gw = blockIdx.x * NWAVES + F.wave, NGW = F.G * NWAVES, lane = F.lane;
    constexpr int I_IN = 32 * (NP / 32), I_GLU = 16 * 32, I_BR = 3 * 16 * 64, I_OUT = 32 * 64, I_GU = 2 * 32 * (FFN / 32), I_DN = (FFN / 64) * 64;
    constexpr int I_LAYER = I_IN + I_GLU + I_BR + I_OUT + I_GU + I_DN;
#if S5_MFMA
    for (int lg = blockIdx.x; lg < DEPTH * 64; lg += F.G) s5_tables_unit(F, lg);
#endif
    for (int it = gw; it < DEPTH * I_LAYER; it += NGW) {
        const int l = it / I_LAYER; int r = it - l * I_LAYER;
        unsigned char* wl = F.ws + WS_W + (size_t)l * SZ_WLAYER;
        if (r < I_IN) { const int nb = r % (NP / 32), kb = r / (NP / 32), n0 = 32 * nb; int src, nv;
            if (n0 < 4096) { src = n0; nv = 32; } else if (n0 < PC_GLR) { src = n0 + 16; nv = 32; } else if (n0 == PC_GLR) { src = 4096; nv = 16; } else { src = 0; nv = 0; }
            conv_item(F.in[I_WIN] + (size_t)l * DM * INW, INW, 64 * kb, src, nv, F.in[I_N1G] + l * DM, (bf16*)(wl + OFF_WIN), DM, n0, 64 * kb, scr, lane); continue; } r -= I_IN;
        if (r < I_GLU) { const int nb = r % 32, kb = r / 32;
            conv_item(F.in[I_WGLU] + (size_t)l * 1024 * 1024, 1024, 64 * kb, 32 * nb, 32, nullptr, (bf16*)(wl + OFF_WGLU), 1024, 32 * nb, 64 * kb, scr, lane); continue; } r -= I_GLU;
        if (r < I_BR) { const int br = r / (16 * 64), rr = r % (16 * 64), nb = rr % 64, kb = rr / 64;
            conv_item(F.in[I_WBS + br] + (size_t)l * 1024 * DM, DM, 64 * kb, 32 * nb, 32, nullptr, (bf16*)(wl + OFF_WBR), 3072, 32 * nb, br * 1024 + 64 * kb, scr, lane); continue; } r -= I_BR;
        if (r < I_OUT) { const int nb = r % 64, kb = r / 64;
            conv_item(F.in[I_WOUT] + (size_t)l * DM * DM, DM, 64 * kb, 32 * nb, 32, nullptr, (bf16*)(wl + OFF_WOUT), DM, 32 * nb, 64 * kb, scr, lane); continue; } r -= I_OUT;
        if (r < I_GU) { const int sel = r / (32 * (FFN / 32)), rr = r % (32 * (FFN / 32)), nb = rr % (FFN / 32), kb = rr / (FFN / 32), j0 = 32 * nb;
            conv_item(F.in[I_FWG + sel] + (size_t)l * DM * FFN, FFN, 64 * kb, j0, 32, F.in[I_N2G] + l * DM, (bf16*)(wl + OFF_WGU), DM, (j0 / 128) * 256 + sel * 128 + (j0 % 128), 64 * kb, scr, lane); continue; } r -= I_GU;
        { const int nb = r % 64, kb = r / 64;
            conv_item(F.in[I_FWD] + (size_t)l * FFN * DM, DM, 64 * kb, 32 * nb, 32, nullptr, (bf16*)(wl + OFF_WDN), FFN, 32 * nb, 64 * kb, scr, lane); }
    }
    const float* x = F.in[I_X]; bf16* XB = (bf16*)(F.ws + WS_XB); float* ssq = (float*)(F.ws + WS_SSQ);
    for (int m = gw; m < MTOK; m += NGW) {
        const GAS f32x4* xr = (const GAS f32x4*)(x + (size_t)m * DM) + lane; float s = 0.f;
        GAS v2u* o8 = (GAS v2u*)(XB + (size_t)m * DM) + lane;
#pragma unroll
        for (int j = 0; j < 8; ++j) { const f32x4 v = xr[64 * j]; s += (v[0] * v[0] + v[1] * v[1]) + (v[2] * v[2] + v[3] * v[3]); v2u w; w.x = pk2(v[0], v[1]); w.y = pk2(v[2], v[3]); o8[64 * j] = w; }
        s = wave_sum(s);
        if (lane < 8) ssq[(size_t)m * 8 + lane] = (lane == 0) ? s : 0.f;
    }
}

__device__ __forceinline__ void p2a_naive(Frame& F, int l) {
    const bf16* P = (const bf16*)(F.ws + WS_P);
    const int lane = F.lane;
    if (!GLA_MFMA) { float* EG = (float*)(F.ws + WS_EG); const float* w2 = F.in[I_GW2] + (size_t)l * 16 * 512; const float* b2 = F.in[I_GB2] + l * 512;
      for (int idx = blockIdx.x * 512 + F.tid; idx < MTOK * 512; idx += F.G * 512) { const int tok = idx >> 9, dk = idx & 511;
          const v4u g0 = *(const v4u*)(P + (size_t)tok * NP + PC_GLR), g1 = *(const v4u*)(P + (size_t)tok * NP + PC_GLR + 8);
          const unsigned gw_[8] = {g0.x, g0.y, g0.z, g0.w, g1.x, g1.y, g1.z, g1.w}; float a = b2[dk];
#pragma unroll
          for (int r = 0; r < 8; ++r) { a += bflo(gw_[r]) * w2[(2 * r) * 512 + dk]; a += bfhi(gw_[r]) * w2[(2 * r + 1) * 512 + dk]; }
          const float ls = fminf(a, 0.f) - log1pf(__expf(-fabsf(a)));
          EG[idx] = __expf(ls * (1.0f / 16.0f)); } }
    if (!MOBA_MFMA) { bf16* QN = (bf16*)(F.ws + WS_QN); bf16* KN = (bf16*)(F.ws + WS_KN); const float* qg = F.in[I_MQG] + l * 128; const float* kg = F.in[I_MKG] + l * 128;
      const int gw = blockIdx.x * NWAVES + F.wave, NGW = F.G * NWAVES;
      const float g0q = qg[2 * lane] * 0.08838834764831845f, g1q = qg[2 * lane + 1] * 0.08838834764831845f, g0k = kg[2 * lane], g1k = kg[2 * lane + 1];
      for (int it = gw; it < MTOK * 8 * 2; it += NGW) { const int which = it & 1, th = it >> 1, tok = th >> 3, h = th & 7;
          const unsigned w = *(const unsigned*)(P + (size_t)tok * NP + (which ? PC_MK : PC_MQ) + h * 128 + 2 * lane);
          const float x0 = bflo(w), x1 = bfhi(w); const float ss = wave_sum(x0 * x0 + x1 * x1); const float r = 1.0f / sqrtf(ss * (1.0f / 128.0f) + RMS_EPS);
          *(unsigned*)((which ? KN : QN) + (size_t)tok * 1024 + h * 128 + 2 * lane) = which ? pk2(x0 * r * g0k, x1 * r * g1k) : pk2(x0 * r * g0q, x1 * r * g1q); }
      float* KM = (float*)(F.ws + WS_KM);
      for (int it = gw; it < 4 * 8 * 8; it += NGW) { const int kb = it & 7, h = (it >> 3) & 7, b = it >> 6; float a0 = 0.f, a1 = 0.f;
          for (int j = 0; j < 256; ++j) { const int tok = b * SEQ + kb * 256 + j; const unsigned w = *(const unsigned*)(P + (size_t)tok * NP + PC_MK + h * 128 + 2 * lane);
              const float x0 = bflo(w), x1 = bfhi(w); const float ss = wave_sum(x0 * x0 + x1 * x1); const float r = 1.0f / sqrtf(ss * (1.0f / 128.0f) + RMS_EPS); a0 += x0 * r * g0k; a1 += x1 * r * g1k; }
          *(f32x2*)(KM + (size_t)it * 128 + 2 * lane) = (f32x2){a0 * (1.0f / 256.0f), a1 * (1.0f / 256.0f)}; } }
}

__device__ __forceinline__ void s5_naive_item(Frame& F, int l, int item, LAS float* scr) {
    const int lane = F.lane, b = item >> 6, g = item & 63, lg = l * 64 + g;
    const bf16* P = (const bf16*)(F.ws + WS_P); bf16* Z = (bf16*)(F.ws + WS_Z);
    const float lre = F.in[I_LRE][lg * 64 + lane], lim = F.in[I_LIM][lg * 64 + lane], dt = expf(F.in[I_LDT][lg]);
    const float mag = expf(lre * dt), ang = lim * dt, ar = mag * cosf(ang), ai = mag * sinf(ang);
    const float den = lre * lre + lim * lim, nre = ar - 1.0f, nim = ai;
    const float zre = (nre * lre + nim * lim) / den, zim = (nim * lre - nre * lim) / den;
    float bbr[16], bbi[16], cr[16], ci[16];
#pragma unroll
    for (int c = 0; c < 16; ++c) { const float br_ = F.in[I_BRE][(size_t)(lg * 64 + lane) * 16 + c], bi_ = F.in[I_BIM][(size_t)(lg * 64 + lane) * 16 + c];
        bbr[c] = zre * br_ - zim * bi_; bbi[c] = zre * bi_ + zim * br_;
        cr[c] = F.in[I_CRE][(size_t)(lg * 16 + c) * 64 + lane]; ci[c] = F.in[I_CIM][(size_t)(lg * 16 + c) * 64 + lane]; }
    const float dsk = F.in[I_SD][l * 1024 + g * 16 + (lane & 15)];
    float xr = 0.f, xi = 0.f;
    const int cc = lane & 15, qq = lane >> 4;
    for (int t0 = 0; t0 < SEQ; t0 += 4) {
        v4u ub[4][2];
#pragma unroll
        for (int s = 0; s < 4; ++s) { const bf16* up = P + (size_t)(b * SEQ + t0 + s) * NP + PC_SSM + g * 16; ub[s][0] = *(const v4u*)up; ub[s][1] = *(const v4u*)(up + 8); }
#pragma unroll
        for (int s = 0; s < 4; ++s) {
            const unsigned uw[8] = {ub[s][0].x, ub[s][0].y, ub[s][0].z, ub[s][0].w, ub[s][1].x, ub[s][1].y, ub[s][1].z, ub[s][1].w};
            float bur = 0.f, bui = 0.f;
#pragma unroll
            for (int c = 0; c < 8; ++c) { const float u0 = bflo(uw[c]), u1 = bfhi(uw[c]); bur += bbr[2 * c] * u0 + bbr[2 * c + 1] * u1; bui += bbi[2 * c] * u0 + bbi[2 * c + 1] * u1; }
            const float nxr = ar * xr - ai * xi + bur, nxi = ar * xi + ai * xr + bui; xr = nxr; xi = nxi;
#pragma unroll
            for (int c = 0; c < 16; ++c) scr[c * 65 + lane] = cr[c] * xr - ci[c] * xi;
            LDS_WAIT();
            float sum = 0.f;
#pragma unroll
            for (int j = 0; j < 16; ++j) sum += scr[cc * 65 + qq * 16 + j];
            LDS_WAIT();
            sum += __shfl_xor(sum, 16); sum += __shfl_xor(sum, 32);
            const size_t row = (size_t)(b * SEQ + t0 + s);
            if (lane < 16) { const float uv = bf1(P[row * NP + PC_SSM + g * 16 + lane]); const float y = sum + dsk * uv; Z[row * 1024 + g * 16 + lane] = (bf16)f2bf(gelu_tanh(y)); }
        }
    }
}
__device__ __forceinline__ void gla_naive_item(Frame& F, int item, LAS float* scr) {
    const int lane = F.lane, hf = item & 3, qt = (item >> 2) & 3, h = (item >> 4) & 3, b = item >> 6;
    const bf16* P = (const bf16*)(F.ws + WS_P); const float* EG = (const float*)(F.ws + WS_EG); float* OT = (float*)(F.ws + WS_OT) + (size_t)hf * MTOK * 1024;
    float S[32];
#pragma unroll
    for (int i = 0; i < 32; ++i) S[i] = 0.f;
    const int l32 = lane & 31;
    const bf16* pq = P + (size_t)(b * SEQ) * NP + PC_GQ + h * 128 + hf * 32 + l32; const bf16* pv = P + (size_t)(b * SEQ) * NP + PC_GV + h * 256 + qt * 64 + lane;
    const float* pe = EG + (size_t)(b * SEQ) * 512 + h * 128 + hf * 32 + l32; float* po = OT + (size_t)(b * SEQ) * 1024 + h * 256 + qt * 64 + lane;
    for (int t0 = 0; t0 < SEQ; t0 += 2) {
        float qw[2], kw[2], ew[2]; bf16 vw[2];
#pragma unroll
        for (int s = 0; s < 2; ++s) { qw[s] = bf1(pq[(size_t)s * NP]); kw[s] = bf1(pq[(size_t)s * NP + (PC_GK - PC_GQ)]); ew[s] = pe[s * 512]; vw[s] = pv[(size_t)s * NP]; }
#pragma unroll
        for (int s = 0; s < 2; ++s) {
            if (lane < 32) { scr[lane] = qw[s]; scr[32 + lane] = kw[s]; scr[64 + lane] = ew[s]; }
            LDS_WAIT();
            const float v = bf1(vw[s]); float o = 0.f;
#pragma unroll
            for (int d = 0; d < 32; d += 4) { const f32x4 q4 = *(const LAS f32x4*)(scr + d), k4 = *(const LAS f32x4*)(scr + 32 + d), e4 = *(const LAS f32x4*)(scr + 64 + d);
#pragma unroll
                for (int e = 0; e < 4; ++e) { S[d + e] = e4[e] * S[d + e] + k4[e] * v; o += q4[e] * S[d + e]; }
                if ((d & 4) != 0) asm volatile("" ::: "memory"); }
            LDS_WAIT();
            po[s * 1024] = o * 0.08838834764831845f;
        }
        pq += 2 * (size_t)NP; pv += 2 * (size_t)NP; pe += 2 * 512; po += 2 * 1024;
    }
}
__device__ __forceinline__ void moba_naive_query(Frame& F, int qi, LAS float* scr) {
    const int lane = F.lane, t = qi & (SEQ - 1), h = (qi >> 11) & 7, b = qi >> 14, qb = t >> 8;
    const bf16* P = (const bf16*)(F.ws + WS_P); const bf16* QN = (const bf16*)(F.ws + WS_QN); const bf16* KN = (const bf16*)(F.ws + WS_KN); const float* KM = (const float*)(F.ws + WS_KM);
    bf16* Y = (bf16*)(F.ws + WS_Y);
    const unsigned qw = *(const unsigned*)(QN + (size_t)(b * SEQ + t) * 1024 + h * 128 + 2 * lane);
    const float q0 = bflo(qw), q1 = bfhi(qw);
    *(LAS f32x2*)(scr + 2 * lane) = (f32x2){q0, q1};
    LDS_WAIT();
    float sc[8]; unsigned selmask = 0u;
#pragma unroll
    for (int kb = 0; kb < 8; ++kb) { const f32x2 km = *(const f32x2*)(KM + (size_t)(((b * 8 + h) * 8 + kb) * 128) + 2 * lane); const float d = wave_sum(q0 * km[0] + q1 * km[1]); sc[kb] = (kb < qb) ? d : -__builtin_inff(); }
#pragma unroll
    for (int kb = 0; kb < 8; ++kb) { int rank = 0;
#pragma unroll
        for (int j = 0; j < 8; ++j) if (j != kb) rank += ((j < qb) && (sc[j] > sc[kb] || (sc[j] == sc[kb] && j < kb))) ? 1 : 0;
        if (kb < qb && rank < 3) selmask |= 1u << kb; }
    selmask |= 1u << qb;
    float m = -__builtin_inff(), lsum = 0.f, o0 = 0.f, o1 = 0.f;
    for (int kb = 0; kb <= qb; ++kb) {
        if (!((selmask >> kb) & 1u)) continue;
        for (int tile = 0; tile < 4; ++tile) {
            const int key0 = kb * 256 + tile * 64; if (key0 > t) break;
            const int key = key0 + lane;
            const v4u* kp = (const v4u*)(KN + (size_t)(b * SEQ + key) * 1024 + h * 128);
            float s = 0.f;
#pragma unroll
            for (int c = 0; c < 16; ++c) { if (c == 8) asm volatile("" ::: "memory"); const v4u kk = kp[c]; const f32x4 qa = *(const LAS f32x4*)(scr + 8 * c), qb4 = *(const LAS f32x4*)(scr + 8 * c + 4);
                s += qa[0] * bflo(kk.x) + qa[1] * bfhi(kk.x) + qa[2] * bflo(kk.y) + qa[3] * bfhi(kk.y) + qb4[0] * bflo(kk.z) + qb4[1] * bfhi(kk.z) + qb4[2] * bflo(kk.w) + qb4[3] * bfhi(kk.w); }
            if (key > t) s = -__builtin_inff();
            const float mnew = fmaxf(m, wave_max(s)); const float p = __expf(s - mnew), corr = __expf(m - mnew);
            lsum = lsum * corr + wave_sum(p); o0 *= corr; o1 *= corr; m = mnew;
            const bf16* vp = P + (size_t)(b * SEQ + key0) * NP + PC_MV + h * 128 + 2 * lane;
#pragma unroll 16
            for (int j = 0; j < 64; ++j) { const float pj = __shfl(p, j); const unsigned vw = *(const unsigned*)(vp + (size_t)j * NP); o0 += pj * bflo(vw); o1 += pj * bfhi(vw); }
        }
    }
    LDS_WAIT();
    const float inv = 1.0f / lsum;
    *(unsigned*)(Y + (size_t)(b * SEQ + t) * YW + 2048 + h * 128 + 2 * lane) = pk2(o0 * inv, o1 * inv);
}
__device__ __forceinline__ void p2b_naive(Frame& F, int l) {
    { F.refresh(); LAS float* scr = (LAS float*)(F.lds + F.wave * 16384);
#if !S5_MFMA
      if (F.wave == 0) for (int it = blockIdx.x; it < 256; it += F.G) s5_naive_item(F, l, it, scr);
#endif
      (void)scr; }
    { F.refresh(); LAS float* scr = (LAS float*)(F.lds + F.wave * 16384);
#if !GLA_MFMA
      if (F.wave == 1) for (int it = blockIdx.x; it < 256; it += F.G) gla_naive_item(F, it, scr);
#endif
      (void)scr; }
    { F.refresh(); LAS float* scr = (LAS float*)(F.lds + F.wave * 16384);
      unsigned* head = F.ctl + CW_QUEUE + 64 * l;
      for (;;) {
          unsigned qi = 0; if (F.lane == 0) qi = __hip_atomic_fetch_add(head, 1u, __ATOMIC_RELAXED, __HIP_MEMORY_SCOPE_AGENT);
          qi = __builtin_amdgcn_readfirstlane(qi);
          if (qi >= (unsigned)(NBATCH * 8 * SEQ)) break;
          moba_naive_query(F, (int)qi, scr);
      } }
}

typedef short bf16x8_t __attribute__((ext_vector_type(8)));
__device__ __forceinline__ f32x4 mma16(bf16x8_t a, bf16x8_t b, f32x4 c) { return __builtin_amdgcn_mfma_f32_16x16x32_bf16(a, b, c, 0, 0, 0); }
constexpr int S5_USTR = 2064;
constexpr int S5_XSTR = 272;
__device__ __forceinline__ void s5_tables_unit(Frame& F, int lg) {
    LAS float* APr = (LAS float*)F.lds; LAS float* APi = APr + 65 * 64; LAS float* BBr = APi + 65 * 64; LAS float* BBi = BBr + 1024; LAS float* CCr = BBi + 1024; LAS float* CCi = CCr + 1024;
    const int tid = F.tid;
    const float* lre_ = F.in[I_LRE] + lg * 64; const float* lim_ = F.in[I_LIM] + lg * 64; const double dt = exp((double)F.in[I_LDT][lg]);
    for (int idx = tid; idx < 65 * 64; idx += 512) { const int t = idx >> 6, p = idx & 63;
        const double lr = (double)lre_[p], li = (double)lim_[p]; const double mag = exp(lr * dt * (double)t); double ang = li * dt * (double)t;
        ang -= 6.283185307179586476925 * rint(ang * 0.15915494309189533577);
        APr[idx] = (float)(mag * (double)cosf((float)ang)); APi[idx] = (float)(mag * (double)sinf((float)ang)); }
    for (int idx = tid; idx < 1024; idx += 512) { const int p = idx >> 4, c = idx & 15;
        const double lr = (double)lre_[p], li = (double)lim_[p]; const double mag = exp(lr * dt); double ang = li * dt; ang -= 6.283185307179586476925 * rint(ang * 0.15915494309189533577);
        const double ar = mag * (double)cosf((float)ang), ai = mag * (double)sinf((float)ang), den = lr * lr + li * li, nr = ar - 1.0, ni = ai;
        const double zr = (nr * lr + ni * li) / den, zi = (ni * lr - nr * li) / den;
        const double br = (double)F.in[I_BRE][(size_t)(lg * 64 + p) * 16 + c], bi = (double)F.in[I_BIM][(size_t)(lg * 64 + p) * 16 + c];
        BBr[idx] = (float)(zr * br - zi * bi); BBi[idx] = (float)(zr * bi + zi * br);
        CCr[idx] = F.in[I_CRE][(size_t)lg * 1024 + idx]; CCi[idx] = F.in[I_CIM][(size_t)lg * 1024 + idx]; }
    LDS_WAIT(); __syncthreads();
    { const int t = tid >> 3, co0 = 2 * (tid & 7); float acc0[16], acc1[16];
#pragma unroll
      for (int i = 0; i < 16; ++i) { acc0[i] = 0.f; acc1[i] = 0.f; }
      for (int p = 0; p < 64; ++p) { const float ar = APr[t * 64 + p], ai = APi[t * 64 + p];
          const float c0r = CCr[co0 * 64 + p], c0i = CCi[co0 * 64 + p], c1r = CCr[(co0 + 1) * 64 + p], c1i = CCi[(co0 + 1) * 64 + p];
          const float w0r = c0r * ar - c0i * ai, w0i = c0r * ai + c0i * ar, w1r = c1r * ar - c1i * ai, w1i = c1r * ai + c1i * ar;
#pragma unroll
          for (int ci = 0; ci < 16; ++ci) { const float br = BBr[p * 16 + ci], bi = BBi[p * 16 + ci]; acc0[ci] += w0r * br - w0i * bi; acc1[ci] += w1r * br - w1i * bi; } }
      bf16* TK = (bf16*)(F.ws + WS_TK) + (size_t)lg * 64 * 256 + (size_t)(t * 16 + co0) * 16;
      v4u o0, o1, o2, o3; o0.x = pk2(acc0[0], acc0[1]); o0.y = pk2(acc0[2], acc0[3]); o0.z = pk2(acc0[4], acc0[5]); o0.w = pk2(acc0[6], acc0[7]);
      o1.x = pk2(acc0[8], acc0[9]); o1.y = pk2(acc0[10], acc0[11]); o1.z = pk2(acc0[12], acc0[13]); o1.w = pk2(acc0[14], acc0[15]);
      o2.x = pk2(acc1[0], acc1[1]); o2.y = pk2(acc1[2], acc1[3]); o2.z = pk2(acc1[4], acc1[5]); o2.w = pk2(acc1[6], acc1[7]);
      o3.x = pk2(acc1[8], acc1[9]); o3.y = pk2(acc1[10], acc1[11]); o3.z = pk2(acc1[12], acc1[13]); o3.w = pk2(acc1[14], acc1[15]);
      *(v4u*)(TK) = o0; *(v4u*)(TK + 8) = o1; *(v4u*)(TK + 16) = o2; *(v4u*)(TK + 24) = o3; }
    { bf16* TW = (bf16*)(F.ws + WS_TW) + (size_t)lg * 128 * 1024;
      for (int ch = tid; ch < 16384; ch += 512) { const int col = ch >> 7, kc = ch & 127, ri = col >> 6, p = col & 63, j = kc >> 1, c0 = 8 * (kc & 1);
          const float ar = APr[(63 - j) * 64 + p], ai = APi[(63 - j) * 64 + p]; float v[8];
#pragma unroll
          for (int e = 0; e < 8; ++e) { const float br = BBr[p * 16 + c0 + e], bi = BBi[p * 16 + c0 + e]; v[e] = ri ? (ar * bi + ai * br) : (ar * br - ai * bi); }
          v4u o; o.x = pk2(v[0], v[1]); o.y = pk2(v[2], v[3]); o.z = pk2(v[4], v[5]); o.w = pk2(v[6], v[7]);
          *(v4u*)(TW + (size_t)col * 1024 + kc * 8) = o; } }
    { bf16* TC = (bf16*)(F.ws + WS_TC) + (size_t)lg * 1024 * 128;
      for (int ch = tid; ch < 16384; ch += 512) { const int row = ch >> 4, kc = ch & 15, i = row >> 4, co = row & 15, ri = kc >> 3, p0 = 8 * (kc & 7); float v[8];
#pragma unroll
          for (int e = 0; e < 8; ++e) { const int p = p0 + e; const float ar = APr[(i + 1) * 64 + p], ai = APi[(i + 1) * 64 + p], cr = CCr[co * 64 + p], ci = CCi[co * 64 + p];
              v[e] = ri ? -(cr * ai + ci * ar) : (cr * ar - ci * ai); }
          v4u o; o.x = pk2(v[0], v[1]); o.y = pk2(v[2], v[3]); o.z = pk2(v[4], v[5]); o.w = pk2(v[6], v[7]);
          *(v4u*)(TC + (size_t)row * 128 + kc * 8) = o; } }
    if (tid < 128) ((float*)(F.ws + WS_A64))[(size_t)lg * 128 + tid] = (tid < 64) ? APr[64 * 64 + tid] : APi[64 * 64 + tid - 64];
    LDS_WAIT(); __syncthreads();
}
__device__ __forceinline__ void s5_stage_u(Frame& F, int g, int b, LAS unsigned char* U) {
    const bf16* P = (const bf16*)(F.ws + WS_P);
#pragma unroll
    for (int it = 0; it < 8; ++it) { const int ch = F.tid + 512 * it, t = ch >> 1, hf = ch & 1, n = t >> 6, j = t & 63;
        const v4u v = *(const v4u*)(P + (size_t)(b * SEQ + t) * NP + PC_SSM + 16 * g + 8 * hf);
        *(LAS v4u*)(U + n * S5_USTR + (j * 16 + 8 * hf) * 2) = v; }
}
__device__ __forceinline__ void s5_s1_unit(Frame& F, int l, int unit) {
    const int g = unit & 63, b = unit >> 6, lg = l * 64 + g, lane = F.lane, w = F.wave, fr = lane & 15, fq = lane >> 4;
    LAS unsigned char* U = F.lds;
    s5_stage_u(F, g, b, U);
    LDS_WAIT(); __syncthreads();
    const bf16* TW = (const bf16*)(F.ws + WS_TW) + (size_t)lg * 128 * 1024 + (size_t)(16 * w + fr) * 1024 + 8 * fq;
    f32x4 acc[2] = {(f32x4){0.f, 0.f, 0.f, 0.f}, (f32x4){0.f, 0.f, 0.f, 0.f}};
#pragma unroll 4
    for (int ks = 0; ks < 32; ++ks) {
        const bf16x8_t bfr = *(const bf16x8_t*)(TW + 32 * ks);
        const bf16x8_t a0 = *(const LAS bf16x8_t*)(U + fr * S5_USTR + (32 * ks + 8 * fq) * 2), a1 = *(const LAS bf16x8_t*)(U + (16 + fr) * S5_USTR + (32 * ks + 8 * fq) * 2);
        acc[0] = mma16(a0, bfr, acc[0]); acc[1] = mma16(a1, bfr, acc[1]); }
    float* SL = (float*)(F.ws + WS_SL);
#pragma unroll
    for (int mt = 0; mt < 2; ++mt)
#pragma unroll
        for (int r = 0; r < 4; ++r) { const int n = 16 * mt + 4 * fq + r; SL[((size_t)(b * 32 + n) * 64 + g) * 128 + 16 * w + fr] = acc[mt][r]; }
    __syncthreads();
}
__device__ __forceinline__ void s5_s3_unit(Frame& F, int l, int unit) {
    const int g = unit & 63, b = unit >> 6, lg = l * 64 + g, lane = F.lane, w = F.wave, fr = lane & 15, fq = lane >> 4;
    LAS unsigned char* U = F.lds; LAS unsigned char* TKL = F.lds + 32 * S5_USTR; LAS unsigned char* XP = TKL + 32768;
    s5_stage_u(F, g, b, U);
    { const v4u* src = (const v4u*)((const bf16*)(F.ws + WS_TK) + (size_t)lg * 64 * 256);
#pragma unroll
      for (int it = 0; it < 4; ++it) *(LAS v4u*)(TKL + (F.tid + 512 * it) * 16) = src[F.tid + 512 * it]; }
    if (w == 0) {
        const float* SL = (const float*)(F.ws + WS_SL); const float* A64 = (const float*)(F.ws + WS_A64) + (size_t)lg * 128;
        const float ar = A64[lane], ai = A64[64 + lane]; float xr = 0.f, xi = 0.f;
        for (int n0 = 0; n0 < 32; n0 += 8) { float sr[8], si[8];
#pragma unroll
            for (int e = 0; e < 8; ++e) { const float* sp = SL + ((size_t)(b * 32 + n0 + e) * 64 + g) * 128; sr[e] = sp[lane]; si[e] = sp[64 + lane]; }
#pragma unroll
            for (int e = 0; e < 8; ++e) { *(LAS bf16*)(XP + (n0 + e) * S5_XSTR + lane * 2) = (bf16)f2bf(xr); *(LAS bf16*)(XP + (n0 + e) * S5_XSTR + (64 + lane) * 2) = (bf16)f2bf(xi);
                const float nr = ar * xr - ai * xi + sr[e], ni = ar * xi + ai * xr + si[e]; xr = nr; xi = ni; } }
    }
    LDS_WAIT(); __syncthreads();
    f32x4 acc[2][8];
#pragma unroll
    for (int mt = 0; mt < 2; ++mt)
#pragma unroll
        for (int it = 0; it < 8; ++it) acc[mt][it] = (f32x4){0.f, 0.f, 0.f, 0.f};
    for (int ks = 0; ks < 32; ++ks) {
        const bf16x8_t a0 = *(const LAS bf16x8_t*)(U + fr * S5_USTR + (32 * ks + 8 * fq) * 2), a1 = *(const LAS bf16x8_t*)(U + (16 + fr) * S5_USTR + (32 * ks + 8 * fq) * 2);
        const int jl = 2 * ks + (fq >> 1);
#pragma unroll
        for (int it = 0; it < 8; ++it) { const int i = w + 8 * it;
            if (i >= 2 * ks) { const int lag = i - jl; bf16x8_t bfr = *(const LAS bf16x8_t*)(TKL + ((lag < 0 ? 0 : lag) * 16 + fr) * 32 + 16 * (fq & 1));
                if (lag < 0) bfr = (bf16x8_t){0, 0, 0, 0, 0, 0, 0, 0};
                acc[0][it] = mma16(a0, bfr, acc[0][it]); acc[1][it] = mma16(a1, bfr, acc[1][it]); } }
    }
    { const bf16* TC = (const bf16*)(F.ws + WS_TC) + (size_t)lg * 1024 * 128;
#pragma unroll
      for (int ks = 0; ks < 4; ++ks) {
          const bf16x8_t a0 = *(const LAS bf16x8_t*)(XP + fr * S5_XSTR + (32 * ks + 8 * fq) * 2), a1 = *(const LAS bf16x8_t*)(XP + (16 + fr) * S5_XSTR + (32 * ks + 8 * fq) * 2);
#pragma unroll
          for (int it = 0; it < 8; ++it) { const int i = w + 8 * it; const bf16x8_t bfr = *(const bf16x8_t*)(TC + (size_t)(i * 16 + fr) * 128 + 32 * ks + 8 * fq);
              acc[0][it] = mma16(a0, bfr, acc[0][it]); acc[1][it] = mma16(a1, bfr, acc[1][it]); } } }
    { const float dsk = F.in[I_SD][l * 1024 + 16 * g + fr]; bf16* Z = (bf16*)(F.ws + WS_Z);
#pragma unroll
      for (int mt = 0; mt < 2; ++mt)
#pragma unroll
          for (int it = 0; it < 8; ++it)
#pragma unroll
              for (int r = 0; r < 4; ++r) { const int n = 16 * mt + 4 * fq + r, i = w + 8 * it;
                  const float uv = bf1(*(const LAS bf16*)(U + n * S5_USTR + (i * 16 + fr) * 2)); const float y = acc[mt][it][r] + dsk * uv;
                  Z[(size_t)(b * SEQ + 64 * n + i) * 1024 + 16 * g + fr] = (bf16)f2bf(gelu_tanh(y)); } }
    __syncthreads();
}


constexpr int GL_TSTR = 144;
constexpr int GL_DSTR = 272;
__device__ __forceinline__ void gla_g1_unit(Frame& F, int l, int u) {
    const int n = u & 31, h = (u >> 5) & 3, b = u >> 7, tid = F.tid, lane = F.lane, w = F.wave, fr = lane & 15, fq = lane >> 4;
    const size_t tok0 = (size_t)b * SEQ + 64 * n;
    const bf16* P = (const bf16*)(F.ws + WS_P);
    LAS float* GL = (LAS float*)F.lds; LAS float* W2L = (LAS float*)(F.lds + 32768); LAS float* GLR = (LAS float*)(F.lds + 40960);
    LAS unsigned char* KDt = F.lds + 45056; LAS unsigned char* VTt = F.lds + 63488;
    { const float* w2 = F.in[I_GW2] + (size_t)l * 16 * 512;
#pragma unroll
      for (int it = 0; it < 4; ++it) { const int idx = tid + 512 * it, r = idx >> 7, dk = idx & 127; W2L[idx] = w2[r * 512 + h * 128 + dk]; }
#pragma unroll
      for (int it = 0; it < 2; ++it) { const int idx = tid + 512 * it, i = idx >> 4, r = idx & 15; GLR[idx] = bf1(P[(tok0 + i) * NP + PC_GLR + r]); } }
    LDS_WAIT(); __syncthreads();
    const int ti = tid >> 3, dq = tid & 7;
    { const float* b2 = F.in[I_GB2] + l * 512 + h * 128 + 16 * dq; float a[16];
#pragma unroll
      for (int e = 0; e < 16; ++e) a[e] = b2[e];
#pragma unroll
      for (int r = 0; r < 16; ++r) { const float gv = GLR[ti * 16 + r];
#pragma unroll
          for (int e = 0; e < 16; ++e) a[e] += gv * W2L[r * 128 + 16 * dq + e]; }
#pragma unroll
      for (int e = 0; e < 16; ++e) { const float x = a[e]; GL[ti * 128 + 16 * dq + e] = (fminf(x, 0.f) - log1pf(__expf(-fabsf(x)))) * (1.0f / 16.0f); } }
    LDS_WAIT(); __syncthreads();
    if (tid < 128) { float run = 0.f;
        for (int i = 0; i < 64; ++i) { run += GL[i * 128 + tid]; GL[i * 128 + tid] = run; }
        GLR[tid] = run; ((float*)(F.ws + WS_DEC))[(size_t)u * 128 + tid] = __expf(run); }
    LDS_WAIT(); __syncthreads();
    {
      const bf16* qp = P + (tok0 + ti) * NP + PC_GQ + h * 128 + 16 * dq; const bf16* kp = P + (tok0 + ti) * NP + PC_GK + h * 128 + 16 * dq;
      const v4u q0 = *(const v4u*)qp, q1 = *(const v4u*)(qp + 8), k0 = *(const v4u*)kp, k1 = *(const v4u*)(kp + 8);
      const unsigned qw[8] = {q0.x, q0.y, q0.z, q0.w, q1.x, q1.y, q1.z, q1.w}, kw[8] = {k0.x, k0.y, k0.z, k0.w, k1.x, k1.y, k1.z, k1.w};
      float qd[16], ki[16];
#pragma unroll
      for (int e = 0; e < 16; ++e) { const int dk = 16 * dq + e; const float bc = GL[ti * 128 + dk], bl = GLR[dk];
          const float qv = (e & 1) ? bfhi(qw[e >> 1]) : bflo(qw[e >> 1]), kv = (e & 1) ? bfhi(kw[e >> 1]) : bflo(kw[e >> 1]);
          qd[e] = qv * 0.08838834764831845f * __expf(bc); ki[e] = kv * __expf(-bc);
          *(LAS bf16*)(KDt + dk * GL_TSTR + ti * 2) = (bf16)f2bf(kv * __expf(bl - bc)); }
      bf16* QD = (bf16*)(F.ws + WS_QD) + ((size_t)u * 64 + ti) * 128 + 16 * dq; bf16* KI = (bf16*)(F.ws + WS_KI) + ((size_t)u * 64 + ti) * 128 + 16 * dq;
      v4u o; o.x = pk2(qd[0], qd[1]); o.y = pk2(qd[2], qd[3]); o.z = pk2(qd[4], qd[5]); o.w = pk2(qd[6], qd[7]); *(v4u*)QD = o;
      o.x = pk2(qd[8], qd[9]); o.y = pk2(qd[10], qd[11]); o.z = pk2(qd[12], qd[13]); o.w = pk2(qd[14], qd[15]); *(v4u*)(QD + 8) = o;
      o.x = pk2(ki[0], ki[1]); o.y = pk2(ki[2], ki[3]); o.z = pk2(ki[4], ki[5]); o.w = pk2(ki[6], ki[7]); *(v4u*)KI = o;
      o.x = pk2(ki[8], ki[9]); o.y = pk2(ki[10], ki[11]); o.z = pk2(ki[12], ki[13]); o.w = pk2(ki[14], ki[15]); *(v4u*)(KI + 8) = o;
      const bf16* vp = P + (tok0 + ti) * NP + PC_GV + h * 256 + 32 * dq;
#pragma unroll
      for (int c = 0; c < 4; ++c) { const v4u vv = *(const v4u*)(vp + 8 * c); const unsigned vw[4] = {vv.x, vv.y, vv.z, vv.w};
#pragma unroll
          for (int e = 0; e < 4; ++e) { const int dv = 32 * dq + 8 * c + 2 * e;
              *(LAS bf16*)(VTt + dv * GL_TSTR + ti * 2) = (bf16)(vw[e] & 0xffffu); *(LAS bf16*)(VTt + (dv + 1) * GL_TSTR + ti * 2) = (bf16)(vw[e] >> 16); } } }
    LDS_WAIT(); __syncthreads();
    {
      bf16* GVT = (bf16*)(F.ws + WS_GVT) + (size_t)u * 256 * 64; const int row = tid >> 1, hf = tid & 1;
#pragma unroll
      for (int c = 0; c < 4; ++c) *(v4u*)(GVT + row * 64 + 32 * hf + 8 * c) = *(const LAS v4u*)(VTt + row * GL_TSTR + 64 * hf + 16 * c); }
    {
      f32x4 acc[2][8];
#pragma unroll
      for (int mt = 0; mt < 2; ++mt)
#pragma unroll
          for (int nt = 0; nt < 8; ++nt) acc[mt][nt] = (f32x4){0.f, 0.f, 0.f, 0.f};
#pragma unroll
      for (int ks = 0; ks < 2; ++ks) { bf16x8_t a[2];
#pragma unroll
          for (int mt = 0; mt < 2; ++mt) a[mt] = *(const LAS bf16x8_t*)(VTt + (16 * (2 * w + mt) + fr) * GL_TSTR + (32 * ks + 8 * fq) * 2);
#pragma unroll
          for (int nt = 0; nt < 8; ++nt) { const bf16x8_t bb = *(const LAS bf16x8_t*)(KDt + (16 * nt + fr) * GL_TSTR + (32 * ks + 8 * fq) * 2);
              acc[0][nt] = mma16(a[0], bb, acc[0][nt]); acc[1][nt] = mma16(a[1], bb, acc[1][nt]); } }
      float* KV = (float*)(F.ws + WS_KV) + (size_t)u * 256 * 128;
#pragma unroll
      for (int mt = 0; mt < 2; ++mt)
#pragma unroll
          for (int nt = 0; nt < 8; ++nt)
#pragma unroll
              for (int r = 0; r < 4; ++r) KV[(size_t)(16 * (2 * w + mt) + 4 * fq + r) * 128 + 16 * nt + fr] = acc[mt][nt][r]; }
    __syncthreads();
}
__device__ __forceinline__ void gla_g2_scan(Frame& F) {
    const float* KV = (const float*)(F.ws + WS_KV); const float* DEC = (const float*)(F.ws + WS_DEC); bf16* ST = (bf16*)(F.ws + WS_ST);
    for (int e4 = blockIdx.x * 512 + F.tid; e4 < 16 * 256 * 32; e4 += F.G * 512) { const int bh = e4 >> 13, dv = (e4 >> 5) & 255, d4 = e4 & 31;
        f32x4 s = (f32x4){0.f, 0.f, 0.f, 0.f};
        for (int n0 = 0; n0 < 32; n0 += 4) { f32x4 kv[4], dc[4];
#pragma unroll
            for (int e = 0; e < 4; ++e) { const size_t u = (size_t)bh * 32 + n0 + e; kv[e] = *(const f32x4*)(KV + (u * 256 + dv) * 128 + 4 * d4); dc[e] = *(const f32x4*)(DEC + u * 128 + 4 * d4); }
#pragma unroll
            for (int e = 0; e < 4; ++e) { const size_t u = (size_t)bh * 32 + n0 + e; v2u o; o.x = pk2(s[0], s[1]); o.y = pk2(s[2], s[3]); *(v2u*)(ST + (u * 256 + dv) * 128 + 4 * d4) = o; s = dc[e] * s + kv[e]; } } }
}
__device__ __forceinline__ void gla_g3_unit(Frame& F, int l, int u) {
    const int n = u & 31, h = (u >> 5) & 3, b = u >> 7, tid = F.tid, lane = F.lane, w = F.wave, fr = lane & 15, fq = lane >> 4;
    const size_t tok0 = (size_t)b * SEQ + 64 * n;
    LAS unsigned char* QDL = F.lds; LAS unsigned char* KIL = F.lds + 17408; LAS unsigned char* ATL = F.lds + 34816; LAS float* SSQL = (LAS float*)(F.lds + 44032); LAS float* RSL = (LAS float*)(F.lds + 46080);
    { const v4u* qs = (const v4u*)((const bf16*)(F.ws + WS_QD) + (size_t)u * 64 * 128); const v4u* ks_ = (const v4u*)((const bf16*)(F.ws + WS_KI) + (size_t)u * 64 * 128);
#pragma unroll
      for (int it = 0; it < 2; ++it) { const int c = tid + 512 * it, row = c >> 4, c16 = c & 15; *(LAS v4u*)(QDL + row * GL_DSTR + c16 * 16) = qs[c]; *(LAS v4u*)(KIL + row * GL_DSTR + c16 * 16) = ks_[c]; } }
    LDS_WAIT(); __syncthreads();
#pragma unroll
    for (int tt = 0; tt < 2; ++tt) { const int tile = 2 * w + tt, mi = tile >> 2, nj = tile & 3; f32x4 acc = (f32x4){0.f, 0.f, 0.f, 0.f};
        if (nj <= mi) {
#pragma unroll
            for (int ks = 0; ks < 4; ++ks) { const bf16x8_t a = *(const LAS bf16x8_t*)(QDL + (16 * mi + fr) * GL_DSTR + (32 * ks + 8 * fq) * 2), bb = *(const LAS bf16x8_t*)(KIL + (16 * nj + fr) * GL_DSTR + (32 * ks + 8 * fq) * 2);
                acc = mma16(a, bb, acc); } }
#pragma unroll
        for (int r = 0; r < 4; ++r) { const int i = 16 * mi + 4 * fq + r, j = 16 * nj + fr; *(LAS bf16*)(ATL + i * GL_TSTR + j * 2) = (bf16)f2bf(j <= i ? acc[r] : 0.f); } }
    LDS_WAIT(); __syncthreads();
    f32x4 acc[4][2];
#pragma unroll
    for (int mi = 0; mi < 4; ++mi) { acc[mi][0] = (f32x4){0.f, 0.f, 0.f, 0.f}; acc[mi][1] = (f32x4){0.f, 0.f, 0.f, 0.f}; }
    { const bf16* GVT = (const bf16*)(F.ws + WS_GVT) + (size_t)u * 256 * 64;
#pragma unroll
      for (int ks = 0; ks < 2; ++ks) { bf16x8_t bb[2];
#pragma unroll
          for (int nt = 0; nt < 2; ++nt) bb[nt] = *(const bf16x8_t*)(GVT + (size_t)(16 * (2 * w + nt) + fr) * 64 + 32 * ks + 8 * fq);
#pragma unroll
          for (int mi = 0; mi < 4; ++mi) { const bf16x8_t a = *(const LAS bf16x8_t*)(ATL + (16 * mi + fr) * GL_TSTR + (32 * ks + 8 * fq) * 2);
              acc[mi][0] = mma16(a, bb[0], acc[mi][0]); acc[mi][1] = mma16(a, bb[1], acc[mi][1]); } }
      const bf16* ST = (const bf16*)(F.ws + WS_ST) + (size_t)u * 256 * 128;
#pragma unroll
      for (int ks = 0; ks < 4; ++ks) { bf16x8_t bb[2];
#pragma unroll
          for (int nt = 0; nt < 2; ++nt) bb[nt] = *(const bf16x8_t*)(ST + (size_t)(16 * (2 * w + nt) + fr) * 128 + 32 * ks + 8 * fq);
#pragma unroll
          for (int mi = 0; mi < 4; ++mi) { const bf16x8_t a = *(const LAS bf16x8_t*)(QDL + (16 * mi + fr) * GL_DSTR + (32 * ks + 8 * fq) * 2);
              acc[mi][0] = mma16(a, bb[0], acc[mi][0]); acc[mi][1] = mma16(a, bb[1], acc[mi][1]); } } }
#pragma unroll
    for (int mi = 0; mi < 4; ++mi)
#pragma unroll
        for (int r = 0; r < 4; ++r) { float v = acc[mi][0][r] * acc[mi][0][r] + acc[mi][1][r] * acc[mi][1][r];
            v += __shfl_xor(v, 1); v += __shfl_xor(v, 2); v += __shfl_xor(v, 4); v += __shfl_xor(v, 8);
            if (fr == 0) SSQL[w * 64 + 16 * mi + 4 * fq + r] = v; }
    LDS_WAIT(); __syncthreads();
    if (tid < 64) { float s = 0.f;
#pragma unroll
        for (int ww = 0; ww < 8; ++ww) s += SSQL[ww * 64 + tid];
        RSL[tid] = 1.0f / sqrtf(s * (1.0f / 256.0f) + RMS_EPS); }
    LDS_WAIT(); __syncthreads();
    { const bf16* P = (const bf16*)(F.ws + WS_P); bf16* Y = (bf16*)(F.ws + WS_Y); const float* gn = F.in[I_GNG] + l * 256;
#pragma unroll
      for (int nt = 0; nt < 2; ++nt) { const int dv = 32 * w + 16 * nt + fr; const float gv = gn[dv];
#pragma unroll
          for (int mi = 0; mi < 4; ++mi)
#pragma unroll
              for (int r = 0; r < 4; ++r) { const int i = 16 * mi + 4 * fq + r; const float rr = bf1(P[(tok0 + i) * NP + PC_GR + h * 256 + dv]);
                  Y[(tok0 + i) * YW + 1024 + h * 256 + dv] = (bf16)f2bf(acc[mi][nt][r] * RSL[i] * gv * rr * sigmoidf_(rr)); } } }
    __syncthreads();
}


constexpr int MB_KSTR = 272, MB_VSTR = 144, MB_KBYTES = 64 * MB_KSTR, MB_BUF = MB_KBYTES + 128 * MB_VSTR;
__device__ __forceinline__ void moba_prep_unit(Frame& F, int l, int unit) {
    const int kb = unit & 7, h = (unit >> 3) & 7, b = unit >> 6, tid = F.tid;
    const size_t tok0 = (size_t)b * SEQ + 256 * kb;
    const bf16* P = (const bf16*)(F.ws + WS_P);
    LAS unsigned char* TL = F.lds; LAS float* PART = (LAS float*)(F.lds + 69632);
    const int tok = tid >> 1, hf = tid & 1;
#pragma unroll
    for (int which = 0; which < 2; ++which) {
        const bf16* src = P + (tok0 + tok) * NP + (which ? PC_MK : PC_MQ) + h * 128 + 64 * hf; const float* gp = F.in[which ? I_MKG : I_MQG] + l * 128 + 64 * hf;
        v4u x[8]; float ss = 0.f;
#pragma unroll
        for (int c = 0; c < 8; ++c) { x[c] = *(const v4u*)(src + 8 * c); const unsigned xw[4] = {x[c].x, x[c].y, x[c].z, x[c].w};
#pragma unroll
            for (int e = 0; e < 4; ++e) { const float a = bflo(xw[e]), bb = bfhi(xw[e]); ss += a * a + bb * bb; } }
        ss += __shfl_xor(ss, 1);
        const float r = (1.0f / sqrtf(ss * (1.0f / 128.0f) + RMS_EPS)) * (which ? 1.0f : 0.08838834764831845f);
        bf16* dst = (bf16*)(F.ws + (which ? WS_KN : WS_QN)) + (tok0 + tok) * 1024 + h * 128 + 64 * hf;
#pragma unroll
        for (int c = 0; c < 8; ++c) { const unsigned xw[4] = {x[c].x, x[c].y, x[c].z, x[c].w}; const f32x4 g0 = *(const f32x4*)(gp + 8 * c), g1 = *(const f32x4*)(gp + 8 * c + 4);
            v4u o; o.x = pk2(bflo(xw[0]) * r * g0[0], bfhi(xw[0]) * r * g0[1]); o.y = pk2(bflo(xw[1]) * r * g0[2], bfhi(xw[1]) * r * g0[3]);
            o.z = pk2(bflo(xw[2]) * r * g1[0], bfhi(xw[2]) * r * g1[1]); o.w = pk2(bflo(xw[3]) * r * g1[2], bfhi(xw[3]) * r * g1[3]);
            *(v4u*)(dst + 8 * c) = o; if (which) *(LAS v4u*)(TL + tok * MB_KSTR + (64 * hf + 8 * c) * 2) = o; }
    }
    LDS_WAIT(); __syncthreads();
    { const int d = tid & 127, part = tid >> 7; float a = 0.f;
      for (int j = 0; j < 64; ++j) a += bf1(*(const LAS bf16*)(TL + (64 * part + j) * MB_KSTR + d * 2));
      PART[part * 128 + d] = a; }
    LDS_WAIT(); __syncthreads();
    if (tid < 128) ((float*)(F.ws + WS_KM))[(size_t)unit * 128 + tid] = ((PART[tid] + PART[128 + tid]) + (PART[256 + tid] + PART[384 + tid])) * (1.0f / 256.0f);
    { const bf16* src = P + (tok0 + tok) * NP + PC_MV + h * 128 + 64 * hf;
#pragma unroll
      for (int c = 0; c < 8; ++c) *(LAS v4u*)(TL + tok * MB_KSTR + (64 * hf + 8 * c) * 2) = *(const v4u*)(src + 8 * c); }
    LDS_WAIT(); __syncthreads();
    { const int d = tid >> 2, tq = tid & 3; bf16* dst = (bf16*)(F.ws + WS_VT) + ((size_t)(b * 8 + h) * 128 + d) * SEQ + 256 * kb + 64 * tq;
#pragma unroll
      for (int c = 0; c < 8; ++c) { unsigned wv[4];
#pragma unroll
          for (int e = 0; e < 4; ++e) { const unsigned lo = *(const LAS bf16*)(TL + (64 * tq + 8 * c + 2 * e) * MB_KSTR + d * 2), hi = *(const LAS bf16*)(TL + (64 * tq + 8 * c + 2 * e + 1) * MB_KSTR + d * 2); wv[e] = lo | (hi << 16); }
          v4u o; o.x = wv[0]; o.y = wv[1]; o.z = wv[2]; o.w = wv[3]; *(v4u*)(dst + 8 * c) = o; } }
    __syncthreads();
}
__device__ __forceinline__ void moba_attn_unit(Frame& F, int bh, int qt) {
    const int b = bh >> 3, h = bh & 7, tid = F.tid, lane = F.lane, w = F.wave, fr = lane & 15, fq = lane >> 4;
    const int qb = qt >> 1, nt = 2 * (qt + 1), qpos = 128 * qt + 16 * w + fr;
    const bf16* KN = (const bf16*)(F.ws + WS_KN) + (size_t)b * SEQ * 1024 + h * 128; const bf16* VT = (const bf16*)(F.ws + WS_VT) + (size_t)bh * 128 * SEQ;
    LAS float* KML = (LAS float*)(F.lds + 2 * MB_BUF);
    { const float* km = (const float*)(F.ws + WS_KM) + (size_t)bh * 1024; KML[tid] = km[tid]; KML[512 + tid] = km[512 + tid]; }
    bf16x8_t bq[4];
    { const bf16* qp = (const bf16*)(F.ws + WS_QN) + ((size_t)b * SEQ + qpos) * 1024 + h * 128 + 8 * fq;
#pragma unroll
      for (int ks = 0; ks < 4; ++ks) bq[ks] = *(const bf16x8_t*)(qp + 32 * ks); }
    v4u sk[2], sv[2];
#define MB_LOAD(it_) do { _Pragma("unroll") for (int p_ = 0; p_ < 2; ++p_) { const int cc_ = tid + 512 * p_; \
        sk[p_] = *(const v4u*)(KN + (size_t)(64 * (it_) + (cc_ >> 4)) * 1024 + 8 * (cc_ & 15)); sv[p_] = *(const v4u*)(VT + (size_t)(cc_ >> 3) * SEQ + 64 * (it_) + 8 * (cc_ & 7)); } } while (0)
#define MB_STORE(buf_) do { _Pragma("unroll") for (int p_ = 0; p_ < 2; ++p_) { const int cc_ = tid + 512 * p_; \
        *(LAS v4u*)((buf_) + (cc_ >> 4) * MB_KSTR + (cc_ & 15) * 16) = sk[p_]; *(LAS v4u*)((buf_) + MB_KBYTES + (cc_ >> 3) * MB_VSTR + (cc_ & 7) * 16) = sv[p_]; } } while (0)
    MB_LOAD(0);
    LDS_WAIT(); __syncthreads();
    unsigned selmask = 0u;
    { float sc[8];
#pragma unroll
      for (int kb = 0; kb < 8; ++kb) { float a = 0.f;
#pragma unroll
          for (int ks = 0; ks < 4; ++ks) { const LAS float* kp = KML + kb * 128 + 32 * ks + 8 * fq; const f32x4 k0 = *(const LAS f32x4*)kp, k1 = *(const LAS f32x4*)(kp + 4);
              const unsigned q01 = (unsigned)(unsigned short)bq[ks][0] | ((unsigned)(unsigned short)bq[ks][1] << 16), q23 = (unsigned)(unsigned short)bq[ks][2] | ((unsigned)(unsigned short)bq[ks][3] << 16);
              const unsigned q45 = (unsigned)(unsigned short)bq[ks][4] | ((unsigned)(unsigned short)bq[ks][5] << 16), q67 = (unsigned)(unsigned short)bq[ks][6] | ((unsigned)(unsigned short)bq[ks][7] << 16);
              a += bflo(q01) * k0[0] + bfhi(q01) * k0[1] + bflo(q23) * k0[2] + bfhi(q23) * k0[3] + bflo(q45) * k1[0] + bfhi(q45) * k1[1] + bflo(q67) * k1[2] + bfhi(q67) * k1[3]; }
          a += __shfl_xor(a, 16); a += __shfl_xor(a, 32); sc[kb] = (kb < qb) ? a : -__builtin_inff(); }
#pragma unroll
      for (int kb = 0; kb < 8; ++kb) { int rank = 0;
#pragma unroll
          for (int j = 0; j < 8; ++j) if (j != kb) rank += ((j < qb) && (sc[j] > sc[kb] || (sc[j] == sc[kb] && j < kb))) ? 1 : 0;
          if (kb < qb && rank < 3) selmask |= 1u << kb; } }
    MB_STORE(F.lds);
    LDS_WAIT(); __syncthreads();
    f32x4 ao[8];
#pragma unroll
    for (int dt = 0; dt < 8; ++dt) ao[dt] = (f32x4){0.f, 0.f, 0.f, 0.f};
    float m = -__builtin_inff(), lsum = 0.f;
#pragma unroll 1
    for (int it = 0; it < nt; ++it) {
        LAS unsigned char* KB = F.lds + (it & 1) * MB_BUF; LAS unsigned char* VB = KB + MB_KBYTES;
        if (it + 1 < nt) MB_LOAD(it + 1);
        const int kb = it >> 2; const bool past = kb < qb; const bool mine = past ? (((selmask >> kb) & 1u) != 0u) : true;
        if (__any(mine)) {
            f32x4 as[4];
#pragma unroll
            for (int mt = 0; mt < 4; ++mt) { as[mt] = (f32x4){0.f, 0.f, 0.f, 0.f};
#pragma unroll
                for (int ks = 0; ks < 4; ++ks) { const bf16x8_t a = *(const LAS bf16x8_t*)(KB + (16 * mt + fr) * MB_KSTR + (32 * ks + 8 * fq) * 2); as[mt] = mma16(a, bq[ks], as[mt]); } }
            float mx = -__builtin_inff();
#pragma unroll
            for (int mt = 0; mt < 4; ++mt)
#pragma unroll
                for (int r = 0; r < 4; ++r) { const int key = 64 * it + 16 * mt + 4 * fq + r; const bool ok = past ? mine : (key <= qpos); const float sv_ = ok ? as[mt][r] : -__builtin_inff(); as[mt][r] = sv_; mx = fmaxf(mx, sv_); }
            mx = fmaxf(mx, __shfl_xor(mx, 16)); mx = fmaxf(mx, __shfl_xor(mx, 32));
            const float mnew = fmaxf(m, mx), msafe = (mnew == -__builtin_inff()) ? 0.f : mnew, corr = __expf(m - msafe);
            float ps = 0.f;
#pragma unroll
            for (int mt = 0; mt < 4; ++mt)
#pragma unroll
                for (int r = 0; r < 4; ++r) { const float p = __expf(as[mt][r] - msafe); as[mt][r] = p; ps += p; }
            lsum = lsum * corr + ps; m = mnew;
            bf16x8_t pf[2];
#pragma unroll
            for (int k2 = 0; k2 < 2; ++k2) { const unsigned w0 = pk2(as[2 * k2][0], as[2 * k2][1]), w1 = pk2(as[2 * k2][2], as[2 * k2][3]), w2 = pk2(as[2 * k2 + 1][0], as[2 * k2 + 1][1]), w3 = pk2(as[2 * k2 + 1][2], as[2 * k2 + 1][3]);
                v4u t; t.x = w0; t.y = w1; t.z = w2; t.w = w3; pf[k2] = __builtin_bit_cast(bf16x8_t, t); }
#pragma unroll
            for (int dt = 0; dt < 8; ++dt) { ao[dt] = ao[dt] * corr;
#pragma unroll
                for (int k2 = 0; k2 < 2; ++k2) { const LAS unsigned char* vp = VB + (16 * dt + fr) * MB_VSTR + (32 * k2 + 4 * fq) * 2; const v2u lo = *(const LAS v2u*)vp, hi = *(const LAS v2u*)(vp + 32);
                    v4u t; t.x = lo.x; t.y = lo.y; t.z = hi.x; t.w = hi.y; ao[dt] = mma16(__builtin_bit_cast(bf16x8_t, t), pf[k2], ao[dt]); } }
        }
        if (it + 1 < nt) MB_STORE(F.lds + ((it + 1) & 1) * MB_BUF);
        LDS_WAIT(); __syncthreads();
    }
#undef MB_LOAD
#undef MB_STORE
    lsum += __shfl_xor(lsum, 16); lsum += __shfl_xor(lsum, 32);
    const float inv = 1.0f / lsum;
    bf16* yp = (bf16*)(F.ws + WS_Y) + ((size_t)b * SEQ + qpos) * YW + 2048 + h * 128 + 4 * fq;
#pragma unroll
    for (int dt = 0; dt < 8; ++dt) { v2u o; o.x = pk2(ao[dt][0] * inv, ao[dt][1] * inv); o.y = pk2(ao[dt][2] * inv, ao[dt][3] * inv); *(v2u*)(yp + 16 * dt) = o; }
}

__device__ __forceinline__ void p2c_gla_finish(Frame& F, int l) {
    const bf16* P = (const bf16*)(F.ws + WS_P); const float* OT = (const float*)(F.ws + WS_OT); bf16* Y = (bf16*)(F.ws + WS_Y);
    const int lane = F.lane, gw = blockIdx.x * NWAVES + F.wave, NGW = F.G * NWAVES;
    const f32x4 gn = *(const f32x4*)(F.in[I_GNG] + l * 256 + 4 * lane);
    for (int it = gw; it < MTOK * 4; it += NGW) { const int tok = it >> 2, h = it & 3;
        const f32x4 o = (*(const f32x4*)(OT + (size_t)tok * 1024 + h * 256 + 4 * lane) + *(const f32x4*)(OT + (size_t)(MTOK + tok) * 1024 + h * 256 + 4 * lane)) + (*(const f32x4*)(OT + (size_t)(2 * MTOK + tok) * 1024 + h * 256 + 4 * lane) + *(const f32x4*)(OT + (size_t)(3 * MTOK + tok) * 1024 + h * 256 + 4 * lane));
        const float ss = wave_sum((o[0] * o[0] + o[1] * o[1]) + (o[2] * o[2] + o[3] * o[3])); const float rn = 1.0f / sqrtf(ss * (1.0f / 256.0f) + RMS_EPS);
        const v2u rw = *(const v2u*)(P + (size_t)tok * NP + PC_GR + h * 256 + 4 * lane);
        const float r0 = bflo(rw.x), r1 = bfhi(rw.x), r2 = bflo(rw.y), r3 = bfhi(rw.y);
        v2u w; w.x = pk2(o[0] * rn * gn[0] * r0 * sigmoidf_(r0), o[1] * rn * gn[1] * r1 * sigmoidf_(r1)); w.y = pk2(o[2] * rn * gn[2] * r2 * sigmoidf_(r2), o[3] * rn * gn[3] * r3 * sigmoidf_(r3));
        *(v2u*)(Y + (size_t)tok * YW + 1024 + h * 256 + 4 * lane) = w; }
}

constexpr int NPH = 9;
__global__ void __launch_bounds__(NWAVES * 64, 2) fwd_kernel(Args args) {
    extern __shared__ __attribute__((aligned(16))) unsigned char lds[];
    Frame F;
    F.lds = (LAS unsigned char*)lds;
    F.MISC = (volatile LAS unsigned*)(F.lds + MISC_OFF);
    F.tid = threadIdx.x; F.lane = F.tid & 63; F.wave = __builtin_amdgcn_readfirstlane(F.tid >> 6);
    F.G = gridDim.x; F.in = args.in; F.ws = args.ws; F.ws0 = args.ws; F.ctl = (unsigned*)(args.ws + WS_CTL);
    for (int u = F.tid; u < (LDS_BYTES - LDSCTL_OFF) / 4; u += NWAVES * 64) ((LAS unsigned*)(F.lds + LDSCTL_OFF))[u] = 0u;
    __syncthreads();
    XcdBarrier bar; bar.bar = F.ctl + CW_BAR; bar.x = 0; bar.st = nullptr;
    if (args.fused) bar = xcd_barrier_post(F.ctl + CW_BAR, F.MISC + 8);
#define GRID_BAR() do { if (args.fused) xcd_barrier(bar); } while (0)
    const int lo = args.ph_lo, hi = args.ph_hi;
#ifndef PH_MASK
#define PH_MASK 0x1ff
#endif
#define IN(k) (((PH_MASK >> (k)) & 1) && lo <= (k) && (k) < hi)
#define WSP(T, off) ((T*)(ws + (off)))

    if (args.l_lo == 0 && IN(0)) { F.refresh(); p0_prologue(F); GRID_BAR(); }

    for (int l = args.l_lo; l < args.l_hi; ++l) {
        if (IN(1)) {
            unsigned char* ws = opaque_ptr(args.ws); const unsigned char* wl = ws + WS_W + (size_t)l * SZ_WLAYER;
            pg8::Gemm g{WSP(pg8::bf16_t, WS_XB), DM, (const pg8::bf16_t*)(wl + OFF_WIN), DM, DM, 0, 0}; pg8::TileOrder S; S.init(MTOK, NP, F.G, (int)blockIdx.x, 1);
            pg8::EpiInProj E{WSP(pg8::bf16_t, WS_P), WSP(float, WS_SSQ)};
            pg8::gemm_phase(F.lds, g, S, E);
            GRID_BAR();
        }
        if (IN(2)) { F.refresh(); p2a_naive(F, l);
#if S5_MFMA
            VM_WAIT(); __syncthreads(); F.refresh(); for (int u = blockIdx.x; u < 256; u += F.G) s5_s1_unit(F, l, u);
#endif
#if GLA_MFMA
            VM_WAIT(); __syncthreads(); F.refresh(); for (int u = blockIdx.x; u < 512; u += F.G) gla_g1_unit(F, l, u);
#endif
#if MOBA_MFMA
            VM_WAIT(); __syncthreads(); F.refresh(); for (int u = blockIdx.x; u < 256; u += F.G) moba_prep_unit(F, l, u);
#endif
            GRID_BAR(); }
        if (IN(3)) {
#if S5_MFMA
            F.refresh(); for (int u = blockIdx.x; u < 256; u += F.G) s5_s3_unit(F, l, u);
            VM_WAIT(); __syncthreads();
#endif
#if GLA_MFMA
            F.refresh(); gla_g2_scan(F);
#endif
#if MOBA_MFMA
            VM_WAIT(); __syncthreads(); F.refresh();
            for (int pi2 = 2 * blockIdx.x; pi2 < 512; pi2 += 2 * F.G) {
#pragma unroll 1
                for (int hh = 0; hh < 2; ++hh) { const int pi = pi2 >> 1; moba_attn_unit(F, pi >> 3, hh ? (pi & 7) : 15 - (pi & 7)); } }
#else
            F.refresh(); p2b_naive(F, l);
#endif
            GRID_BAR(); }
        if (IN(4)) {
#if GLA_MFMA
            const int gh = F.G >= 2 ? F.G / 2 : 1;
            if ((int)blockIdx.x < gh) {
                unsigned char* ws = opaque_ptr(args.ws); const unsigned char* wl = ws + WS_W + (size_t)l * SZ_WLAYER;
                pg8::Gemm g{WSP(pg8::bf16_t, WS_Z), 1024, (const pg8::bf16_t*)(wl + OFF_WGLU), 1024, 1024, 0, 0}; pg8::TileOrder S; S.init(MTOK, 1024, gh, (int)blockIdx.x, 1);
                pg8::EpiGLU E{WSP(pg8::bf16_t, WS_Z), WSP(pg8::bf16_t, WS_Y), args.in[I_BGLU] + l * 1024};
                pg8::gemm_phase(F.lds, g, S, E);
            }
            if ((int)blockIdx.x >= gh || F.G < 2) { F.refresh(); const int nb3 = F.G < 2 ? 1 : F.G - gh; for (int u = F.G < 2 ? 0 : (int)blockIdx.x - gh; u < 512; u += nb3) gla_g3_unit(F, l, u); }
#else
            F.refresh(); p2c_gla_finish(F, l);
            VM_WAIT(); __syncthreads();
            unsigned char* ws = opaque_ptr(args.ws); const unsigned char* wl = ws + WS_W + (size_t)l * SZ_WLAYER;
            pg8::Gemm g{WSP(pg8::bf16_t, WS_Z), 1024, (const pg8::bf16_t*)(wl + OFF_WGLU), 1024, 1024, 0, 0}; pg8::TileOrder S; S.init(MTOK, 1024, F.G, (int)blockIdx.x, 1);
            pg8::EpiGLU E{WSP(pg8::bf16_t, WS_Z), WSP(pg8::bf16_t, WS_Y), args.in[I_BGLU] + l * 1024};
            pg8::gemm_phase(F.lds, g, S, E);
#endif
            GRID_BAR();
        }
        if (IN(5)) {
            unsigned char* ws = opaque_ptr(args.ws); const unsigned char* wl = ws + WS_W + (size_t)l * SZ_WLAYER;
            pg8::Gemm g{WSP(pg8::bf16_t, WS_Y), YW, (const pg8::bf16_t*)(wl + OFF_WBR), 3072, 1024, 1024, 1024}; pg8::TileOrder S; S.init(MTOK, DM, F.G, (int)blockIdx.x, 3);
            pg8::EpiBranch E{WSP(pg8::bf16_t, WS_P), WSP(float, WS_MG), WSP(pg8::bf16_t, WS_MB)};
            pg8::gemm_phase(F.lds, g, S, E);
            GRID_BAR();
        }
        if (IN(6)) {
            unsigned char* ws = opaque_ptr(args.ws); const unsigned char* wl = ws + WS_W + (size_t)l * SZ_WLAYER;
            pg8::Gemm g{WSP(pg8::bf16_t, WS_MB), DM, (const pg8::bf16_t*)(wl + OFF_WOUT), DM, DM, 0, 0}; pg8::TileOrder S; S.init(MTOK, DM, F.G, (int)blockIdx.x, 1);
            pg8::EpiResid E{l == 0 ? args.in[I_X] : WSP(float, WS_XR), WSP(float, WS_XR), WSP(pg8::bf16_t, WS_XB), WSP(float, WS_SSQ)};
            pg8::gemm_phase(F.lds, g, S, E);
            GRID_BAR();
        }
        if (IN(7)) {
            unsigned char* ws = opaque_ptr(args.ws); const unsigned char* wl = ws + WS_W + (size_t)l * SZ_WLAYER;
            pg8::Gemm g{WSP(pg8::bf16_t, WS_XB), DM, (const pg8::bf16_t*)(wl + OFF_WGU), DM, DM, 0, 0}; pg8::TileOrder S; S.init(MTOK, NGU, F.G, (int)blockIdx.x, 1);
            pg8::EpiFFNUp E{WSP(pg8::bf16_t, WS_H), WSP(float, WS_SSQ)};
            pg8::gemm_phase(F.lds, g, S, E);
            GRID_BAR();
        }
        if (IN(8)) {
            unsigned char* ws = opaque_ptr(args.ws); const unsigned char* wl = ws + WS_W + (size_t)l * SZ_WLAYER;
            pg8::Gemm g{WSP(pg8::bf16_t, WS_H), FFN, (const pg8::bf16_t*)(wl + OFF_WDN), FFN, FFN, 0, 0}; pg8::TileOrder S; S.init(MTOK, DM, F.G, (int)blockIdx.x, 1);
            pg8::EpiResid E{WSP(float, WS_XR), l == DEPTH - 1 ? args.out : WSP(float, WS_XR), WSP(pg8::bf16_t, WS_XB), WSP(float, WS_SSQ)};
            pg8::gemm_phase(F.lds, g, S, E);
            if (l + 1 < DEPTH) GRID_BAR();
        }
    }
#undef IN
#undef GRID_BAR
}

extern "C" void kernel_launch(void* const* d_in, const int* in_sizes, int n_in, void* d_out, int out_size, void* d_ws, size_t ws_size, hipStream_t stream) {
    static int grid = 0;
    if (grid == 0) {
        if (n_in != 26 || out_size != MTOK * DM || ws_size < WS_END) { fprintf(stderr, "kernel_launch: unexpected problem (n_in %d out %d ws %zu need %zu)\n", n_in, out_size, ws_size, (size_t)WS_END); grid = -1; return; }
        int dev = 0, cus = 0, per_cu = 0;
        if (hipGetDevice(&dev) != hipSuccess || hipDeviceGetAttribute(&cus, hipDeviceAttributeMultiprocessorCount, dev) != hipSuccess) { grid = -1; return; }
        if (hipFuncSetAttribute((const void*)fwd_kernel, hipFuncAttributeMaxDynamicSharedMemorySize, LDS_BYTES) != hipSuccess) { fprintf(stderr, "kernel_launch: hipFuncSetAttribute failed\n"); grid = -1; return; }
        if (hipOccupancyMaxActiveBlocksPerMultiprocessor(&per_cu, (const void*)fwd_kernel, NWAVES * 64, LDS_BYTES) != hipSuccess || per_cu < 1) { fprintf(stderr, "kernel_launch: occupancy query says %d\n", per_cu); }
        (void)hipGetLastError();
        grid = cus;
    }
    if (grid < 0) return;
    if (hipMemsetAsync((char*)d_ws + WS_CTL, 0, CTL_ZERO_BYTES, stream) != hipSuccess) return;
    Args a{};
    for (int i = 0; i < 26; ++i) a.in[i] = (const float*)d_in[i];
    a.out = (float*)d_out; a.ws = (unsigned char*)d_ws; a.pad = 0;
#if MK_FUSED
    a.l_lo = 0; a.l_hi = DEPTH; a.ph_lo = 0; a.ph_hi = NPH; a.fused = 1;
    hipLaunchKernelGGL(fwd_kernel, dim3(grid), dim3(NWAVES * 64), LDS_BYTES, stream, a);
#else
    a.fused = 0;
    for (int l = 0; l < DEPTH; ++l)
        for (int ph = (l == 0 ? 0 : 1); ph < NPH; ++ph) { a.l_lo = l; a.l_hi = l + 1; a.ph_lo = ph; a.ph_hi = ph + 1; hipLaunchKernelGGL(fwd_kernel, dim3(grid), dim3(NWAVES * 64), LDS_BYTES, stream, a); }
#endif
}
```

```cpp
#include <hip/hip_runtime.h>
#include <cstdio>
#include <cstdint>

#ifndef S5_MFMA
#define S5_MFMA 1
#endif
#ifndef GLA_MFMA
#define GLA_MFMA 1
#endif
#ifndef REPEAT_MASK
#define REPEAT_MASK 0
#endif
#define NREP(k) (1 + ((REPEAT_MASK >> (k)) & 1))
#ifndef MOBA_MFMA
#define MOBA_MFMA 1
#endif
#ifndef MK_FUSED
#define MK_FUSED 1
#endif

__device__ __forceinline__ unsigned char* opaque_ptr(unsigned char* p) { asm volatile("" : "+s"(p)); return p; }
__device__ __forceinline__ int opaque_tid(int wv) { int ln; asm volatile("v_mbcnt_lo_u32_b32 %0, -1, 0\n\tv_mbcnt_hi_u32_b32 %0, -1, %0" : "=v"(ln)); return (wv << 6) | ln; }

namespace pg8 {
#define PG8_LAS __attribute__((address_space(3)))
typedef unsigned short bf16_t;
typedef short bf16x8 __attribute__((ext_vector_type(8)));
typedef float f32x4 __attribute__((ext_vector_type(4)));
typedef unsigned u32x4 __attribute__((ext_vector_type(4)));
typedef unsigned u32x2 __attribute__((ext_vector_type(2)));
constexpr int BM = 256, BK = 64, HALF = 128, HTB = HALF * BK * 2, STAGE_BYTES = 8 * HTB, NXCD = 8, WGM = 8;

__host__ __device__ __forceinline__ int lds_byte(int r, int c) { const int st = (r >> 4) * 2 + (c >> 5), rr = r & 15, cc = c & 31, ob = rr * 64 + cc * 2; return st * 1024 + (ob ^ (((ob >> 9) & 1) << 5)); }
__host__ __device__ __forceinline__ void stage_rc(int b, int& R, int& C) { const int st = b / 1024, sb = b % 1024, swz = sb ^ (((sb >> 9) & 1) << 5); R = (st >> 1) * 16 + swz / 64; C = (st & 1) * 32 + (swz % 64) / 2; }
__host__ __device__ __forceinline__ int perm32(int rho) { const int n = rho >> 4, i = rho & 15; return 8 * (i >> 2) + 4 * n + (i & 3); }

struct Unit { int pm, pn, br; };
struct Gemm { const bf16_t* A; int lda; const bf16_t* Bt; int ldb; int K; int abr, bbr; };

struct TileOrder {
    int nM, nN, nwg, G, c, nbr;
    __device__ __forceinline__ void init(int M, int N, int G_, int c_, int nbr_) { asm volatile("" : "+s"(G_), "+s"(c_)); nM = M / BM; nN = N / BM; nwg = nM * nN; G = G_; c = c_; nbr = nbr_; }
    __device__ __forceinline__ bool next(int i, Unit& u) const {
        const int it = i / nbr; u.br = i - it * nbr;
        const long L = (long)it * G + c; if (L >= nwg) return false;
        int wgid = (int)L; { const int q = nwg / NXCD, r = nwg % NXCD, xcd = wgid % NXCD, off = wgid / NXCD; wgid = (xcd < r ? xcd * (q + 1) : r * (q + 1) + (xcd - r) * q) + off; }
        const int nig = WGM * nN, gid = wgid / nig, fm = gid * WGM, gsz = (nM - fm) < WGM ? (nM - fm) : WGM;
        u.pm = __builtin_amdgcn_readfirstlane(fm + ((wgid % nig) % gsz)); u.pn = __builtin_amdgcn_readfirstlane((wgid % nig) / gsz); return true;
    }
};

__device__ __forceinline__ unsigned cvt_pk_bf16(float lo, float hi) { unsigned r; asm volatile("v_cvt_pk_bf16_f32 %0, %1, %2" : "=v"(r) : "v"(lo), "v"(hi)); return r; }

template <class Epi, class Sched>
__device__ __forceinline__ void gemm_phase(PG8_LAS unsigned char* lds, const Gemm g, const Sched& S, const Epi& E, int wv) {
    const int tid = opaque_tid(wv), wid = __builtin_amdgcn_readfirstlane(tid >> 6), lane = tid & 63, wr = wid >> 2, wc = wid & 3, fr = lane & 15, fq = lane >> 4;
    const int K = g.K, nt = K / BK;
    unsigned voffA[2], voffB[2];
#pragma unroll
    for (int i = 0; i < 2; ++i) { int R, C; stage_rc(tid * 16 + i * 8192, R, C); const int Rb = (R & ~31) + perm32(R & 31);
        voffA[i] = (unsigned)(R * g.lda + C) * 2u; voffB[i] = (unsigned)(Rb * g.ldb + C) * 2u; }
    const size_t kstep = (size_t)(BK * 2);
    const size_t hstepA = (size_t)HALF * g.lda * 2, hstepB = (size_t)HALF * g.ldb * 2;
    const size_t tstepA = 2 * hstepA, tstepB = 2 * hstepB;
    const unsigned ldsw = (unsigned)wid * 1024u;
    const int aoff = lds_byte(wr * 64 + fr, fq * 8), boff = lds_byte(wc * 32 + fr, fq * 8);
#define PG8_SA(b, h) (((b) * 2 + (h)) * HTB)
#define PG8_SB(b, h) ((4 + (b) * 2 + (h)) * HTB)
#define PG8_STAGE(bufoff, gbase, voff) do { _Pragma("unroll") for (int _i = 0; _i < 2; ++_i) \
        __builtin_amdgcn_global_load_lds((const unsigned*)((const char*)(gbase) + (voff)[_i]), (PG8_LAS unsigned*)(lds + (bufoff) + ldsw + _i * 8192), 16, 0, 0); } while (0)
#define PG8_LDA(dst, b, h) do { _Pragma("unroll") for (int m = 0; m < 4; ++m) _Pragma("unroll") for (int k = 0; k < 2; ++k) dst[m][k] = *(const PG8_LAS bf16x8*)(lds + PG8_SA(b, h) + aoff + m * 2048 + k * 1024); } while (0)
#define PG8_LDB(dst, b, h) do { _Pragma("unroll") for (int n = 0; n < 2; ++n) _Pragma("unroll") for (int k = 0; k < 2; ++k) dst[n][k] = *(const PG8_LAS bf16x8*)(lds + PG8_SB(b, h) + boff + n * 2048 + k * 1024); } while (0)
#define PG8_MMA(ai, bj, At, Bt) do { __builtin_amdgcn_s_setprio(1); _Pragma("unroll") for (int m = 0; m < 4; ++m) _Pragma("unroll") for (int n = 0; n < 2; ++n) _Pragma("unroll") for (int k = 0; k < 2; ++k) \
        acc[ai][bj][m][n] = __builtin_amdgcn_mfma_f32_16x16x32_bf16(Bt[n][k], At[m][k], acc[ai][bj][m][n], 0, 0, 0); __builtin_amdgcn_s_setprio(0); } while (0)
#define PG8_WAIT_V(n) asm volatile("s_waitcnt vmcnt(" #n ")" ::: "memory")
#define PG8_WAIT_L(n) asm volatile("s_waitcnt lgkmcnt(" #n ")" ::: "memory")
#define PG8_BAR __builtin_amdgcn_s_barrier()
#define PG8_SCHED __builtin_amdgcn_sched_barrier(0)
    Unit cur, nxt; int ui = 0;
    if (!S.next(0, cur)) return;
    f32x4 acc[2][2][4][2];
#pragma unroll
    for (int a = 0; a < 2; ++a)
#pragma unroll
        for (int b = 0; b < 2; ++b)
#pragma unroll
            for (int m = 0; m < 4; ++m)
#pragma unroll
                for (int n = 0; n < 2; ++n) acc[a][b][m][n] = (f32x4){0.f, 0.f, 0.f, 0.f};
    bf16x8 At[4][2], B0[2][2], B1[2][2];
    const char* cA = (const char*)g.A + (size_t)cur.pm * tstepA + (size_t)cur.br * g.abr * 2; const char* cB = (const char*)g.Bt + (size_t)cur.pn * tstepB + (size_t)cur.br * g.bbr * 2;
    PG8_STAGE(PG8_SB(0, 0), cB, voffB); PG8_STAGE(PG8_SB(0, 1), cB + hstepB, voffB); PG8_STAGE(PG8_SA(0, 0), cA, voffA); PG8_STAGE(PG8_SA(0, 1), cA + hstepA, voffA);
    if (wr == 1) PG8_BAR;
    PG8_WAIT_V(2); PG8_BAR;
    PG8_STAGE(PG8_SB(1, 0), cB + kstep, voffB); PG8_STAGE(PG8_SA(1, 0), cA + kstep, voffA); PG8_STAGE(PG8_SB(1, 1), cB + hstepB + kstep, voffB);
    PG8_WAIT_V(6); PG8_BAR;
    for (;;) {
        const bool has_next = S.next(ui + 1, nxt);
        const char* nA = has_next ? (const char*)g.A + (size_t)nxt.pm * tstepA + (size_t)nxt.br * g.abr * 2 : cA; const char* nB = has_next ? (const char*)g.Bt + (size_t)nxt.pn * tstepB + (size_t)nxt.br * g.bbr * 2 : cB;
        for (int t = 0; t < nt; t += 2) {
            const bool last = (t == nt - 2);
            const char* a1 = cA + (size_t)(t + 1) * kstep;
            const char* a2 = last ? nA : cA + (size_t)(t + 2) * kstep; const char* b2 = last ? nB : cB + (size_t)(t + 2) * kstep;
            const char* a3 = a2 + kstep; const char* b3 = b2 + kstep;
            PG8_LDB(B0, 0, 0); PG8_LDB(B1, 0, 1); PG8_SCHED; PG8_LDA(At, 0, 0); PG8_STAGE(PG8_SA(1, 1), a1 + hstepA, voffA);
            PG8_WAIT_V(8); PG8_WAIT_L(0); PG8_BAR; PG8_MMA(0, 0, At, B0); PG8_MMA(0, 1, At, B1); PG8_BAR; PG8_SCHED;
            PG8_LDA(At, 0, 1); PG8_STAGE(PG8_SB(0, 0), b2, voffB); PG8_STAGE(PG8_SB(0, 1), b2 + hstepB, voffB); PG8_STAGE(PG8_SA(0, 0), a2, voffA);
            PG8_WAIT_V(8); PG8_WAIT_L(0); PG8_BAR; PG8_MMA(1, 0, At, B0); PG8_MMA(1, 1, At, B1); PG8_BAR; PG8_SCHED;
            PG8_LDB(B0, 1, 0); PG8_LDB(B1, 1, 1); PG8_SCHED; PG8_LDA(At, 1, 0); PG8_STAGE(PG8_SA(0, 1), a2 + hstepA, voffA);
            PG8_WAIT_V(8); PG8_WAIT_L(0); PG8_BAR; PG8_MMA(0, 0, At, B0); PG8_MMA(0, 1, At, B1); PG8_BAR; PG8_SCHED;
            PG8_LDA(At, 1, 1); PG8_STAGE(PG8_SB(1, 0), b3, voffB); PG8_STAGE(PG8_SB(1, 1), b3 + hstepB, voffB); PG8_STAGE(PG8_SA(1, 0), a3, voffA);
            PG8_WAIT_V(8); PG8_WAIT_L(0); PG8_BAR; PG8_MMA(1, 0, At, B0); PG8_MMA(1, 1, At, B1); PG8_BAR; PG8_SCHED;
        }
        if (wr == 0) PG8_BAR;
        E(acc, cur, wr, wc, fr, fq, lds);
        if (!has_next) break;
        if (!Epi::CHAIN || cur.br == S.nbr - 1) {
#pragma unroll
        for (int a = 0; a < 2; ++a)
#pragma unroll
            for (int b = 0; b < 2; ++b)
#pragma unroll
                for (int m = 0; m < 4; ++m)
#pragma unroll
                    for (int n = 0; n < 2; ++n) acc[a][b][m][n] = (f32x4){0.f, 0.f, 0.f, 0.f};
        }
        cur = nxt; cA = nA; cB = nB; ++ui;
        if (wr == 1) PG8_BAR;
    }
    PG8_WAIT_V(0);
    PG8_BAR;
#undef PG8_SA
#undef PG8_SB
#undef PG8_STAGE
#undef PG8_LDA
#undef PG8_LDB
#undef PG8_MMA
#undef PG8_WAIT_V
#undef PG8_WAIT_L
#undef PG8_BAR
#undef PG8_SCHED
}
}

constexpr int NWAVES = 8;
constexpr int DM = 2048, NBATCH = 4, SEQ = 2048, DEPTH = 4, MTOK = NBATCH * SEQ;
constexpr int INW = 13328;
constexpr int NP = 13568;
constexpr int PC_SSM = 0, PC_GQ = 1024, PC_GK = 1536, PC_GV = 2048, PC_GR = 3072, PC_MQ = 4096, PC_MK = 5120, PC_MV = 6144, PC_GS = 7168, PC_GLR = 13312;
constexpr int FFN = 5632, NGU = 2 * FFN;
constexpr int YW = 3072;
constexpr float RMS_EPS = 1e-6f;

constexpr size_t MiB = 1u << 20;
constexpr size_t WS_CTL = 0, CTL_ZERO_BYTES = 1 * MiB;
constexpr size_t SZ_WIN = (size_t)NP * DM * 2, SZ_WGLU = (size_t)1024 * 1024 * 2, SZ_WBR = (size_t)DM * 3072 * 2, SZ_WOUT = (size_t)DM * DM * 2, SZ_WGU = (size_t)NGU * DM * 2, SZ_WDN = (size_t)DM * FFN * 2;
constexpr size_t OFF_WIN = 0, OFF_WGLU = OFF_WIN + SZ_WIN, OFF_WBR = OFF_WGLU + SZ_WGLU, OFF_WOUT = OFF_WBR + SZ_WBR, OFF_WGU = OFF_WOUT + SZ_WOUT, OFF_WDN = OFF_WGU + SZ_WGU, SZ_WLAYER = OFF_WDN + SZ_WDN;
constexpr size_t WS_W = 2 * MiB;
constexpr size_t WS_P = WS_W + ((DEPTH * SZ_WLAYER + MiB - 1) / MiB) * MiB;
constexpr size_t WS_Z = WS_P + (size_t)MTOK * NP * 2;
constexpr size_t WS_Y = WS_Z + (size_t)MTOK * 1024 * 2;
constexpr size_t WS_MG = WS_Y + (size_t)MTOK * YW * 2;
constexpr size_t WS_MB = WS_MG + (size_t)MTOK * DM * 4;
constexpr size_t WS_XR = WS_MB + (size_t)MTOK * DM * 2;
constexpr size_t WS_XB = WS_XR + (size_t)MTOK * DM * 4;
constexpr size_t WS_H = WS_XB + (size_t)MTOK * DM * 2;
constexpr size_t WS_SSQ = WS_H + (size_t)MTOK * FFN * 2;
constexpr size_t WS_EG = WS_SSQ + (size_t)MTOK * 8 * 4;
constexpr size_t WS_OT = WS_EG + (size_t)MTOK * 512 * 4;
constexpr size_t WS_QN = WS_OT + (size_t)4 * MTOK * 1024 * 4;
constexpr size_t WS_KN = WS_QN + (size_t)MTOK * 1024 * 2;
constexpr size_t WS_KM = WS_KN + (size_t)MTOK * 1024 * 2;
constexpr size_t WS_TK = WS_KM + (size_t)4 * 8 * 8 * 128 * 4;
constexpr size_t WS_TW = WS_TK + (size_t)DEPTH * 64 * 64 * 256 * 2;
constexpr size_t WS_TC = WS_TW + (size_t)DEPTH * 64 * 128 * 1024 * 2;
constexpr size_t WS_A64 = WS_TC + (size_t)DEPTH * 64 * 1024 * 128 * 2;
constexpr size_t WS_SL = WS_A64 + (size_t)DEPTH * 64 * 128 * 4;
constexpr size_t WS_QD = WS_SL + (size_t)NBATCH * 32 * 64 * 128 * 4;
constexpr size_t WS_KI = WS_QD + (size_t)512 * 64 * 128 * 2;
constexpr size_t WS_GVT = WS_KI + (size_t)512 * 64 * 128 * 2;
constexpr size_t WS_KV = WS_GVT + (size_t)512 * 256 * 64 * 2;
constexpr size_t WS_DEC = WS_KV + (size_t)512 * 256 * 128 * 4;
constexpr size_t WS_ST = WS_DEC + (size_t)512 * 128 * 4;
constexpr size_t WS_VT = WS_ST + (size_t)512 * 256 * 128 * 2;
constexpr size_t WS_END = WS_VT + (size_t)NBATCH * 8 * 128 * SEQ * 2;
constexpr int CW_BAR = 4096;
constexpr int CW_QUEUE = 16384;

constexpr int RING_BYTES = 135168;
constexpr int LDSCTL_OFF = RING_BYTES, MISC_OFF = LDSCTL_OFF + 320;
constexpr int TAB_OFF = RING_BYTES + 1024;
constexpr int LDS_BYTES = 147456;

#define GAS __attribute__((address_space(1)))
#define LAS __attribute__((address_space(3)))
typedef unsigned short bf16;
typedef unsigned v4u __attribute__((ext_vector_type(4)));
typedef unsigned v2u __attribute__((ext_vector_type(2)));
typedef float f32x4 __attribute__((ext_vector_type(4)));
typedef float f32x2 __attribute__((ext_vector_type(2)));
#define LDS_WAIT() asm volatile("s_waitcnt lgkmcnt(0)" ::: "memory")
#define VM_WAIT() asm volatile("s_waitcnt vmcnt(0)" ::: "memory")
__device__ __forceinline__ unsigned f2bf(float f) { unsigned u = __builtin_bit_cast(unsigned, f); return (u + 0x7fffu + ((u >> 16) & 1u)) >> 16; }
__device__ __forceinline__ unsigned pk2(float lo, float hi) { return f2bf(lo) | (f2bf(hi) << 16); }
__device__ __forceinline__ float bflo(unsigned u) { return __builtin_bit_cast(float, u << 16); }
__device__ __forceinline__ float bfhi(unsigned u) { return __builtin_bit_cast(float, u & 0xffff0000u); }
__device__ __forceinline__ float bf1(bf16 b) { return __builtin_bit_cast(float, ((unsigned)b) << 16); }
__device__ __forceinline__ float sigmoidf_(float x) { return __builtin_amdgcn_rcpf(1.0f + __expf(-x)); }
__device__ __forceinline__ float gelu_tanh(float x) { const float u = 0.7978845608028654f * (x + 0.044715f * x * x * x); return x * sigmoidf_(2.0f * u); }
__device__ __forceinline__ float wave_sum(float v) {
#pragma unroll
    for (int o = 1; o < 64; o <<= 1) v += __shfl_xor(v, o);
    return v;
}
__device__ __forceinline__ float wave_max(float v) {
#pragma unroll
    for (int o = 1; o < 64; o <<= 1) v = fmaxf(v, __shfl_xor(v, o));
    return v;
}

#define XB_TMO      128
#define XB_XCNT(j)  (256  + 64 * (j))
#define XB_XSUB(j)  (1280 + 64 * (j))
#define XB_XGEN(j)  (2304 + 64 * (j))
#define XB_TOP      3328
#define XB_TOPGEN   3392
#define XCD_BAR_WORDS 3456
#define XB_SPIN_CAP (1u << 18)
__device__ __forceinline__ unsigned xb_ld(unsigned* p)              { return __hip_atomic_load(p, __ATOMIC_RELAXED, __HIP_MEMORY_SCOPE_AGENT); }
__device__ __forceinline__ unsigned xb_add(unsigned* p, unsigned v) { return __hip_atomic_fetch_add(p, v, __ATOMIC_RELAXED, __HIP_MEMORY_SCOPE_AGENT); }
__device__ __forceinline__ unsigned xb_xcc_id() { return (unsigned)__builtin_amdgcn_s_getreg((3 << 11) | 20) & 0xFu; }
#define XB_SPIN(cond, bar) do { unsigned _sp = 0; while (cond) { __builtin_amdgcn_s_sleep(1); \
    if ((++_sp & 255u) == 0u) { if (xb_ld(&(bar)[XB_TMO])) break; if (_sp > XB_SPIN_CAP) { atomicAdd(&(bar)[XB_TMO], 1u); break; } } } } while (0)
struct XcdBarrier { unsigned* bar; unsigned x; volatile LAS unsigned* st; };
__device__ __forceinline__ XcdBarrier xcd_barrier_post(unsigned* bar, volatile LAS unsigned* st) {
    XcdBarrier b; b.bar = bar; b.x = xb_xcc_id(); b.st = st;
    if (threadIdx.x == 0) (void)xb_add(&bar[XB_XCNT(b.x)], 1u);
    return b;
}
__device__ __forceinline__ void xcd_barrier_complete(unsigned* bar, unsigned x, unsigned& nloc, unsigned& nx) {
    const unsigned G = gridDim.x * gridDim.y * gridDim.z;
    unsigned sum, cnt, mine, sp = 0u;
    for (;;) {
        sum = 0u; cnt = 0u; mine = 0u;
#pragma unroll
        for (unsigned j = 0; j < 16; ++j) { const unsigned c = xb_ld(&bar[XB_XCNT(j)]); sum += c; cnt += (c > 0u) ? 1u : 0u; mine = (j == x) ? c : mine; }
        if (sum == G) break;
        __builtin_amdgcn_s_sleep(1);
        if ((++sp & 255u) == 0u) { if (xb_ld(&bar[XB_TMO])) break; if (sp > XB_SPIN_CAP) { atomicAdd(&bar[XB_TMO], 1u); break; } }
    }
    nloc = mine > 0u ? mine : 1u; nx = cnt > 0u ? cnt : 1u;
}
__device__ __forceinline__ void xcd_barrier(const XcdBarrier& b, int tid) {
    asm volatile("s_waitcnt vmcnt(0)" ::: "memory");
    __syncthreads();
    if (tid == 0) {
        unsigned* bar = b.bar;
        __builtin_amdgcn_s_waitcnt(0);
        unsigned nloc = b.st[0], nx = b.st[1];
        if (nloc == 0u) { xcd_barrier_complete(bar, b.x, nloc, nx); b.st[0] = nloc; b.st[1] = nx; }
        const unsigned old = xb_add(&bar[XB_XSUB(b.x)], 1u);
        const unsigned gen = old / nloc;
        if (old + 1u == (gen + 1u) * nloc) {
            __builtin_amdgcn_fence(__ATOMIC_RELEASE, "agent");
            asm volatile("s_waitcnt vmcnt(0)" ::: "memory");
            const unsigned og = xb_add(&bar[XB_TOP], 1u);
            const unsigned tg = og / nx;
            if (og + 1u == (tg + 1u) * nx) xb_add(&bar[XB_TOPGEN], 1u);
            else XB_SPIN(xb_ld(&bar[XB_TOPGEN]) == tg, bar);
            __builtin_amdgcn_fence(__ATOMIC_ACQUIRE, "agent");
            xb_add(&bar[XB_XGEN(b.x)], 1u);
            asm volatile("s_waitcnt vmcnt(0)" ::: "memory");
        } else {
            XB_SPIN(xb_ld(&bar[XB_XGEN(b.x)]) == gen, bar);
            __builtin_amdgcn_fence(__ATOMIC_ACQUIRE, "agent");
            asm volatile("s_waitcnt vmcnt(0)" ::: "memory");
        }
    }
    __syncthreads();
}

struct Args {
    const float* in[26];
    float* out; unsigned char* ws;
    int l_lo, l_hi, ph_lo, ph_hi;
    int fused, pad;
};
enum { I_X = 0, I_N1G, I_WIN, I_LRE, I_LIM, I_LDT, I_BRE, I_BIM, I_CRE, I_CIM, I_SD, I_WGLU, I_BGLU, I_GW2, I_GB2, I_GNG, I_MQG, I_MKG, I_WBS, I_WBG, I_WBM, I_WOUT, I_N2G, I_FWG, I_FWU, I_FWD };

namespace pg8 {
#define EPI_FENCE() asm volatile("" ::: "memory")
__device__ __forceinline__ void load_rstd(const float* ssq, int pm, int wr, int fr, int fq, float (&rs)[2][4]) {
    f32x2 p[2][4];
#pragma unroll
    for (int ai = 0; ai < 2; ++ai)
#pragma unroll
        for (int m = 0; m < 4; ++m) { const int row = pm * BM + ai * HALF + wr * 64 + m * 16 + fr; p[ai][m] = *(const f32x2*)(ssq + (size_t)row * 8 + 2 * fq); }
#pragma unroll
    for (int ai = 0; ai < 2; ++ai)
#pragma unroll
        for (int m = 0; m < 4; ++m) { float s = p[ai][m][0] + p[ai][m][1]; s += __shfl_xor(s, 16); s += __shfl_xor(s, 32); rs[ai][m] = 1.0f / sqrtf(s * (1.0f / DM) + RMS_EPS); }
    EPI_FENCE();
}
struct EpiInProj {
    static constexpr bool CHAIN = false;
    bf16_t* P; const float* ssq;
    __device__ __forceinline__ void operator()(const f32x4 (&acc)[2][2][4][2], const Unit& u, int wr, int wc, int fr, int fq, PG8_LAS unsigned char*) const {
        float rs[2][4]; load_rstd(ssq, u.pm, wr, fr, fq, rs);
        const int row0 = u.pm * BM + wr * 64 + fr, col0 = u.pn * BM + wc * 32 + 8 * fq;
#pragma unroll
        for (int ai = 0; ai < 2; ++ai)
#pragma unroll
            for (int m = 0; m < 4; ++m) { bf16_t* rowp = P + (size_t)(row0 + ai * HALF + m * 16) * NP + col0; const float r = rs[ai][m];
#pragma unroll
                for (int bj = 0; bj < 2; ++bj) { const f32x4 v0 = acc[ai][bj][m][0] * r, v1 = acc[ai][bj][m][1] * r;
                    u32x4 w; w.x = cvt_pk_bf16(v0[0], v0[1]); w.y = cvt_pk_bf16(v0[2], v0[3]); w.z = cvt_pk_bf16(v1[0], v1[1]); w.w = cvt_pk_bf16(v1[2], v1[3]);
                    *(u32x4*)(rowp + bj * HALF) = w; } }
    }
};
struct EpiGLU {
    static constexpr bool CHAIN = false;
    const bf16_t* Z; bf16_t* Y; const float* bias;
    __device__ __forceinline__ void operator()(const f32x4 (&acc)[2][2][4][2], const Unit& u, int wr, int wc, int fr, int fq, PG8_LAS unsigned char*) const {
        const int row0 = u.pm * BM + wr * 64 + fr, col0 = u.pn * BM + wc * 32 + 8 * fq;
        f32x4 bv[2][2];
#pragma unroll
        for (int bj = 0; bj < 2; ++bj)
#pragma unroll
            for (int n = 0; n < 2; ++n) bv[bj][n] = *(const f32x4*)(bias + col0 + bj * HALF + 4 * n);
        u32x4 zb[8][2];
#pragma unroll
        for (int idx = 0; idx < 8; ++idx) { const size_t row = (size_t)(row0 + (idx >> 2) * HALF + (idx & 3) * 16);
#pragma unroll
            for (int bj = 0; bj < 2; ++bj) zb[idx][bj] = *(const u32x4*)(Z + row * 1024 + col0 + bj * HALF); }
#pragma unroll
        for (int idx = 0; idx < 8; ++idx) { const int ai = idx >> 2, m = idx & 3; const size_t row = (size_t)(row0 + ai * HALF + m * 16);
#pragma unroll
            for (int bj = 0; bj < 2; ++bj) { const u32x4 zz = zb[idx][bj];
                const f32x4 g0 = acc[ai][bj][m][0] + bv[bj][0], g1 = acc[ai][bj][m][1] + bv[bj][1];
                u32x4 w;
                w.x = cvt_pk_bf16(bflo(zz.x) * sigmoidf_(g0[0]), bfhi(zz.x) * sigmoidf_(g0[1])); w.y = cvt_pk_bf16(bflo(zz.y) * sigmoidf_(g0[2]), bfhi(zz.y) * sigmoidf_(g0[3]));
                w.z = cvt_pk_bf16(bflo(zz.z) * sigmoidf_(g1[0]), bfhi(zz.z) * sigmoidf_(g1[1])); w.w = cvt_pk_bf16(bflo(zz.w) * sigmoidf_(g1[2]), bfhi(zz.w) * sigmoidf_(g1[3]));
                *(u32x4*)(Y + row * YW + col0 + bj * HALF) = w; } }
        EPI_FENCE();
    }
};
struct EpiBranch {
    static constexpr bool CHAIN = true;
    const bf16_t* P; bf16_t* MB;
    __device__ __forceinline__ void operator()(f32x4 (&acc)[2][2][4][2], const Unit& u, int wr, int wc, int fr, int fq, PG8_LAS unsigned char*) const {
        const int row0 = u.pm * BM + wr * 64 + fr, col0 = u.pn * BM + wc * 32 + 8 * fq;
        const int br = u.br;
        u32x4 ga[4][2], gb[4][2];
#pragma unroll
        for (int bt = 0; bt < 2; ++bt) {
#pragma unroll
            for (int i4 = 0; i4 < 4; ++i4) { const int idx = 4 * bt + i4; const size_t row = (size_t)(row0 + (idx >> 2) * HALF + (idx & 3) * 16);
#pragma unroll
                for (int bj = 0; bj < 2; ++bj) { const bf16_t* gp = P + row * NP + PC_GS + br * DM + col0 + bj * HALF; ga[i4][bj] = *(const u32x4*)gp; if (br != 2) gb[i4][bj] = *(const u32x4*)(gp + DM); } }
#pragma unroll
            for (int i4 = 0; i4 < 4; ++i4) { const int idx = 4 * bt + i4, ai = idx >> 2, m = idx & 3; const size_t row = (size_t)(row0 + ai * HALF + m * 16);
#pragma unroll
                for (int bj = 0; bj < 2; ++bj) { const u32x4 g0 = ga[i4][bj]; const unsigned g0w[4] = {g0.x, g0.y, g0.z, g0.w}; float f[8];
                    if (br != 2) { const u32x4 g1 = gb[i4][bj]; const unsigned g1w[4] = {g1.x, g1.y, g1.z, g1.w};
#pragma unroll
                        for (int e = 0; e < 4; ++e) { f[2 * e] = (1.0f + __expf(-bflo(g1w[e]))) * __builtin_amdgcn_rcpf(1.0f + __expf(-bflo(g0w[e]))); f[2 * e + 1] = (1.0f + __expf(-bfhi(g1w[e]))) * __builtin_amdgcn_rcpf(1.0f + __expf(-bfhi(g0w[e]))); } }
                    else {
#pragma unroll
                        for (int e = 0; e < 4; ++e) { f[2 * e] = sigmoidf_(bflo(g0w[e])); f[2 * e + 1] = sigmoidf_(bfhi(g0w[e])); } }
                    f32x4 v0 = acc[ai][bj][m][0], v1 = acc[ai][bj][m][1];
                    v0[0] *= f[0]; v0[1] *= f[1]; v0[2] *= f[2]; v0[3] *= f[3]; v1[0] *= f[4]; v1[1] *= f[5]; v1[2] *= f[6]; v1[3] *= f[7];
                    if (br != 2) { acc[ai][bj][m][0] = v0; acc[ai][bj][m][1] = v1; }
                    else { u32x4 w; w.x = cvt_pk_bf16(v0[0], v0[1]); w.y = cvt_pk_bf16(v0[2], v0[3]); w.z = cvt_pk_bf16(v1[0], v1[1]); w.w = cvt_pk_bf16(v1[2], v1[3]); *(u32x4*)(MB + row * DM + col0 + bj * HALF) = w; } } }
            EPI_FENCE();
        }
    }
};
struct EpiResid {
    static constexpr bool CHAIN = false;
    const float* xin; float* xout; bf16_t* XB; float* ssq;
    __device__ __forceinline__ void operator()(const f32x4 (&acc)[2][2][4][2], const Unit& u, int wr, int wc, int fr, int fq, PG8_LAS unsigned char* lds) const {
        const int row0 = u.pm * BM + wr * 64 + fr, col0 = u.pn * BM + wc * 32 + 8 * fq;
        PG8_LAS float* T = (PG8_LAS float*)(lds + TAB_OFF);
        f32x4 xb[4][2][2];
#pragma unroll
        for (int bt = 0; bt < 2; ++bt) {
#pragma unroll
            for (int i4 = 0; i4 < 4; ++i4) { const int idx = 4 * bt + i4; const size_t row = (size_t)(row0 + (idx >> 2) * HALF + (idx & 3) * 16);
#pragma unroll
                for (int bj = 0; bj < 2; ++bj) { const size_t o = row * DM + col0 + bj * HALF; xb[i4][bj][0] = *(const f32x4*)(xin + o); xb[i4][bj][1] = *(const f32x4*)(xin + o + 4); } }
#pragma unroll
            for (int i4 = 0; i4 < 4; ++i4) { const int idx = 4 * bt + i4, ai = idx >> 2, m = idx & 3; const size_t row = (size_t)(row0 + ai * HALF + m * 16); float s = 0.f;
#pragma unroll
                for (int bj = 0; bj < 2; ++bj) { const size_t o = row * DM + col0 + bj * HALF;
                    const f32x4 v0 = acc[ai][bj][m][0] + xb[i4][bj][0], v1 = acc[ai][bj][m][1] + xb[i4][bj][1];
                    *(f32x4*)(xout + o) = v0; *(f32x4*)(xout + o + 4) = v1;
                    u32x4 w; w.x = cvt_pk_bf16(v0[0], v0[1]); w.y = cvt_pk_bf16(v0[2], v0[3]); w.z = cvt_pk_bf16(v1[0], v1[1]); w.w = cvt_pk_bf16(v1[2], v1[3]); *(u32x4*)(XB + o) = w;
                    s += (v0[0] * v0[0] + v0[1] * v0[1]) + (v0[2] * v0[2] + v0[3] * v0[3]) + (v1[0] * v1[0] + v1[1] * v1[1]) + (v1[2] * v1[2] + v1[3] * v1[3]); }
                s += __shfl_xor(s, 16); s += __shfl_xor(s, 32);
                if (fq == 0) T[(ai * HALF + wr * 64 + m * 16 + fr) * 4 + wc] = s; }
            EPI_FENCE();
        }
        asm volatile("s_waitcnt lgkmcnt(0)" ::: "memory"); __builtin_amdgcn_s_barrier(); asm volatile("" ::: "memory");
        const int t = (wr * 4 + wc) * 64 + fq * 16 + fr;
        if (t < 256) { const f32x4 p = *(const PG8_LAS f32x4*)(T + t * 4); ssq[(size_t)(u.pm * BM + t) * 8 + u.pn] = (p[0] + p[1]) + (p[2] + p[3]); }
    }
};
struct EpiFFNUp {
    static constexpr bool CHAIN = false;
    bf16_t* H; const float* ssq;
    __device__ __forceinline__ void operator()(const f32x4 (&acc)[2][2][4][2], const Unit& u, int wr, int wc, int fr, int fq, PG8_LAS unsigned char*) const {
        float rs[2][4]; load_rstd(ssq, u.pm, wr, fr, fq, rs);
        const int row0 = u.pm * BM + wr * 64 + fr, col0 = u.pn * HALF + wc * 32 + 8 * fq;
#pragma unroll
        for (int ai = 0; ai < 2; ++ai)
#pragma unroll
            for (int m = 0; m < 4; ++m) { const float r = rs[ai][m]; float h[8];
#pragma unroll
                for (int n = 0; n < 2; ++n)
#pragma unroll
                    for (int e = 0; e < 4; ++e) { const float gv = acc[ai][0][m][n][e] * r, uv = acc[ai][1][m][n][e] * r; h[n * 4 + e] = gv * sigmoidf_(gv) * uv; }
                u32x4 w; w.x = cvt_pk_bf16(h[0], h[1]); w.y = cvt_pk_bf16(h[2], h[3]); w.z = cvt_pk_bf16(h[4], h[5]); w.w = cvt_pk_bf16(h[6], h[7]);
                *(u32x4*)(H + (size_t)(row0 + ai * HALF + m * 16) * FFN + col0) = w; }
    }
};
}

struct Frame {
    __device__ __forceinline__ void refresh() { ws = opaque_ptr(ws0); tid = opaque_tid(wv); lane = tid & 63; wave = __builtin_amdgcn_readfirstlane(tid >> 6); }
    LAS unsigned char* lds;
    volatile LAS unsigned* MISC;
    unsigned* ctl;
    int tid, lane, wave, G, wv;
    const float* const* in;
    unsigned char* ws; unsigned char* ws0;
};

__device__ __forceinline__ void conv_item(const float* W, int ldw, int k0, int src_c0, int nvalid, const float* gk, bf16* WT, int ldt, int dst_r0, int dst_k, LAS float* scr, int lane) {
    const int c4 = 4 * (lane & 15), rq = lane >> 4;
    f32x4 v[16];
#pragma unroll
    for (int i = 0; i < 16; ++i) { const int kk = 4 * i + rq; v[i] = (c4 < nvalid) ? *(const f32x4*)(W + (size_t)(k0 + kk) * ldw + src_c0 + c4) : (f32x4){0.f, 0.f, 0.f, 0.f}; }
    if (gk) {
#pragma unroll
        for (int i = 0; i < 16; ++i) v[i] = v[i] * gk[k0 + 4 * i + rq]; }
#pragma unroll
    for (int i = 0; i < 16; ++i) { LAS float* d = scr + (4 * i + rq) * 65 + c4; d[0] = v[i][0]; d[1] = v[i][1]; d[2] = v[i][2]; d[3] = v[i][3]; }
    LDS_WAIT(); asm volatile("" ::: "memory");
    const int c8 = lane & 7;
#pragma unroll
    for (int j = 0; j < 8; ++j) { const int n = (lane >> 3) + 8 * j; const LAS float* sp = scr + (8 * c8) * 65 + n;
        v4u o; o.x = pk2(sp[0 * 65], sp[1 * 65]); o.y = pk2(sp[2 * 65], sp[3 * 65]); o.z = pk2(sp[4 * 65], sp[5 * 65]); o.w = pk2(sp[6 * 65], sp[7 * 65]);
        *(GAS v4u*)(WT + (size_t)(dst_r0 + n) * ldt + dst_k + 8 * c8) = o; }
    LDS_WAIT(); asm volatile("" ::: "memory");
}
__device__ __forceinline__ void s5_tables_unit(Frame& F, int lg);
__device__ __forceinline__ void p0_prologue(Frame& F) {
    LAS float* scr = (LAS float*)(F.lds + F.wave * 16896);
    const int gw = blockIdx.x * NWAVES + F.wave, NGW = F.G * NWAVES, lane = F.lane;
    constexpr int NB_IN = NP / 64, NB_FF = FFN / 64;
    constexpr int I_IN = 32 * NB_IN, I_GLU = 16 * 16, I_BR = 3 * 16 * 32, I_OUT = 32 * 32, I_GU = 2 * 32 * NB_FF, I_DN = NB_FF * 32;
    constexpr int I_LAYER = I_IN + I_GLU + I_BR + I_OUT + I_GU + I_DN;
#if S5_MFMA
    for (int lg = blockIdx.x; lg < DEPTH * 64; lg += F.G) s5_tables_unit(F, lg);
#endif
    for (int it = gw; it < DEPTH * I_LAYER; it += NGW) {
        const int l = it / I_LAYER; int r = it - l * I_LAYER;
        unsigned char* wl = F.ws + WS_W + (size_t)l * SZ_WLAYER;
        if (r < I_IN) { const int nb = r % NB_IN, kb = r / NB_IN, n0 = 64 * nb; int src, nv;
            if (n0 < 4096) { src = n0; nv = 64; } else if (n0 < PC_GLR) { src = n0 + 16; nv = 64; } else if (n0 == PC_GLR) { src = 4096; nv = 16; } else { src = 0; nv = 0; }
            conv_item(F.in[I_WIN] + (size_t)l * DM * INW, INW, 64 * kb, src, nv, F.in[I_N1G] + l * DM, (bf16*)(wl + OFF_WIN), DM, n0, 64 * kb, scr, lane); continue; } r -= I_IN;
        if (r < I_GLU) { const int nb = r % 16, kb = r / 16;
            conv_item(F.in[I_WGLU] + (size_t)l * 1024 * 1024, 1024, 64 * kb, 64 * nb, 64, nullptr, (bf16*)(wl + OFF_WGLU), 1024, 64 * nb, 64 * kb, scr, lane); continue; } r -= I_GLU;
        if (r < I_BR) { const int br = r / (16 * 32), rr = r % (16 * 32), nb = rr % 32, kb = rr / 32;
            conv_item(F.in[I_WBS + br] + (size_t)l * 1024 * DM, DM, 64 * kb, 64 * nb, 64, nullptr, (bf16*)(wl + OFF_WBR), 3072, 64 * nb, br * 1024 + 64 * kb, scr, lane); continue; } r -= I_BR;
        if (r < I_OUT) { const int nb = r % 32, kb = r / 32;
            conv_item(F.in[I_WOUT] + (size_t)l * DM * DM, DM, 64 * kb, 64 * nb, 64, nullptr, (bf16*)(wl + OFF_WOUT), DM, 64 * nb, 64 * kb, scr, lane); continue; } r -= I_OUT;
        if (r < I_GU) { const int sel = r / (32 * NB_FF), rr = r % (32 * NB_FF), nb = rr % NB_FF, kb = rr / NB_FF, j0 = 64 * nb;
            conv_item(F.in[I_FWG + sel] + (size_t)l * DM * FFN, FFN, 64 * kb, j0, 64, F.in[I_N2G] + l * DM, (bf16*)(wl + OFF_WGU), DM, (j0 / 128) * 256 + sel * 128 + (j0 % 128), 64 * kb, scr, lane); continue; } r -= I_GU;
        { const int nb = r % 32, kb = r / 32;
            conv_item(F.in[I_FWD] + (size_t)l * FFN * DM, DM, 64 * kb, 64 * nb, 64, nullptr, (bf16*)(wl + OFF_WDN), FFN, 64 * nb, 64 * kb, scr, lane); }
    }
    const float* x = F.in[I_X]; bf16* XB = (bf16*)(F.ws + WS_XB); float* ssq = (float*)(F.ws + WS_SSQ);
    for (int m = gw; m < MTOK; m += NGW) {
        const GAS f32x4* xr = (const GAS f32x4*)(x + (size_t)m * DM) + lane; float s = 0.f;
        GAS v2u* o8 = (GAS v2u*)(XB + (size_t)m * DM) + lane;
#pragma unroll
        for (int j = 0; j < 8; ++j) { const f32x4 v = xr[64 * j]; s += (v[0] * v[0] + v[1] * v[1]) + (v[2] * v[2] + v[3] * v[3]); v2u w; w.x = pk2(v[0], v[1]); w.y = pk2(v[2], v[3]); o8[64 * j] = w; }
        s = wave_sum(s);
        if (lane < 8) ssq[(size_t)m * 8 + lane] = (lane == 0) ? s : 0.f;
    }
}

__device__ __forceinline__ void p2a_naive(Frame& F, int l) {
    const bf16* P = (const bf16*)(F.ws + WS_P);
    const int lane = F.lane;
    if (!GLA_MFMA) { float* EG = (float*)(F.ws + WS_EG); const float* w2 = F.in[I_GW2] + (size_t)l * 16 * 512; const float* b2 = F.in[I_GB2] + l * 512;
      for (int idx = blockIdx.x * 512 + F.tid; idx < MTOK * 512; idx += F.G * 512) { const int tok = idx >> 9, dk = idx & 511;
          const v4u g0 = *(const v4u*)(P + (size_t)tok * NP + PC_GLR), g1 = *(const v4u*)(P + (size_t)tok * NP + PC_GLR + 8);
          const unsigned gw_[8] = {g0.x, g0.y, g0.z, g0.w, g1.x, g1.y, g1.z, g1.w}; float a = b2[dk];
#pragma unroll
          for (int r = 0; r < 8; ++r) { a += bflo(gw_[r]) * w2[(2 * r) * 512 + dk]; a += bfhi(gw_[r]) * w2[(2 * r + 1) * 512 + dk]; }
          const float ls = fminf(a, 0.f) - log1pf(__expf(-fabsf(a)));
          EG[idx] = __expf(ls * (1.0f / 16.0f)); } }
    if (!MOBA_MFMA) { bf16* QN = (bf16*)(F.ws + WS_QN); bf16* KN = (bf16*)(F.ws + WS_KN); const float* qg = F.in[I_MQG] + l * 128; const float* kg = F.in[I_MKG] + l * 128;
      const int gw = blockIdx.x * NWAVES + F.wave, NGW = F.G * NWAVES;
      const float g0q = qg[2 * lane] * 0.08838834764831845f, g1q = qg[2 * lane + 1] * 0.08838834764831845f, g0k = kg[2 * lane], g1k = kg[2 * lane + 1];
      for (int it = gw; it < MTOK * 8 * 2; it += NGW) { const int which = it & 1, th = it >> 1, tok = th >> 3, h = th & 7;
          const unsigned w = *(const unsigned*)(P + (size_t)tok * NP + (which ? PC_MK : PC_MQ) + h * 128 + 2 * lane);
          const float x0 = bflo(w), x1 = bfhi(w); const float ss = wave_sum(x0 * x0 + x1 * x1); const float r = 1.0f / sqrtf(ss * (1.0f / 128.0f) + RMS_EPS);
          *(unsigned*)((which ? KN : QN) + (size_t)tok * 1024 + h * 128 + 2 * lane) = which ? pk2(x0 * r * g0k, x1 * r * g1k) : pk2(x0 * r * g0q, x1 * r * g1q); }
      float* KM = (float*)(F.ws + WS_KM);
      for (int it = gw; it < 4 * 8 * 8; it += NGW) { const int kb = it & 7, h = (it >> 3) & 7, b = it >> 6; float a0 = 0.f, a1 = 0.f;
          for (int j = 0; j < 256; ++j) { const int tok = b * SEQ + kb * 256 + j; const unsigned w = *(const unsigned*)(P + (size_t)tok * NP + PC_MK + h * 128 + 2 * lane);
              const float x0 = bflo(w), x1 = bfhi(w); const float ss = wave_sum(x0 * x0 + x1 * x1); const float r = 1.0f / sqrtf(ss * (1.0f / 128.0f) + RMS_EPS); a0 += x0 * r * g0k; a1 += x1 * r * g1k; }
          *(f32x2*)(KM + (size_t)it * 128 + 2 * lane) = (f32x2){a0 * (1.0f / 256.0f), a1 * (1.0f / 256.0f)}; } }
}

__device__ __forceinline__ void s5_naive_item(Frame& F, int l, int item, LAS float* scr) {
    const int lane = F.lane, b = item >> 6, g = item & 63, lg = l * 64 + g;
    const bf16* P = (const bf16*)(F.ws + WS_P); bf16* Z = (bf16*)(F.ws + WS_Z);
    const float lre = F.in[I_LRE][lg * 64 + lane], lim = F.in[I_LIM][lg * 64 + lane], dt = expf(F.in[I_LDT][lg]);
    const float mag = expf(lre * dt), ang = lim * dt, ar = mag * cosf(ang), ai = mag * sinf(ang);
    const float den = lre * lre + lim * lim, nre = ar - 1.0f, nim = ai;
    const float zre = (nre * lre + nim * lim) / den, zim = (nim * lre - nre * lim) / den;
    float bbr[16], bbi[16], cr[16], ci[16];
#pragma unroll
    for (int c = 0; c < 16; ++c) { const float br_ = F.in[I_BRE][(size_t)(lg * 64 + lane) * 16 + c], bi_ = F.in[I_BIM][(size_t)(lg * 64 + lane) * 16 + c];
        bbr[c] = zre * br_ - zim * bi_; bbi[c] = zre * bi_ + zim * br_;
        cr[c] = F.in[I_CRE][(size_t)(lg * 16 + c) * 64 + lane]; ci[c] = F.in[I_CIM][(size_t)(lg * 16 + c) * 64 + lane]; }
    const float dsk = F.in[I_SD][l * 1024 + g * 16 + (lane & 15)];
    float xr = 0.f, xi = 0.f;
    const int cc = lane & 15, qq = lane >> 4;
    for (int t0 = 0; t0 < SEQ; t0 += 4) {
        v4u ub[4][2];
#pragma unroll
        for (int s = 0; s < 4; ++s) { const bf16* up = P + (size_t)(b * SEQ + t0 + s) * NP + PC_SSM + g * 16; ub[s][0] = *(const v4u*)up; ub[s][1] = *(const v4u*)(up + 8); }
#pragma unroll
        for (int s = 0; s < 4; ++s) {
            const unsigned uw[8] = {ub[s][0].x, ub[s][0].y, ub[s][0].z, ub[s][0].w, ub[s][1].x, ub[s][1].y, ub[s][1].z, ub[s][1].w};
            float bur = 0.f, bui = 0.f;
#pragma unroll
            for (int c = 0; c < 8; ++c) { const float u0 = bflo(uw[c]), u1 = bfhi(uw[c]); bur += bbr[2 * c] * u0 + bbr[2 * c + 1] * u1; bui += bbi[2 * c] * u0 + bbi[2 * c + 1] * u1; }
            const float nxr = ar * xr - ai * xi + bur, nxi = ar * xi + ai * xr + bui; xr = nxr; xi = nxi;
#pragma unroll
            for (int c = 0; c < 16; ++c) scr[c * 65 + lane] = cr[c] * xr - ci[c] * xi;
            LDS_WAIT();
            float sum = 0.f;
#pragma unroll
            for (int j = 0; j < 16; ++j) sum += scr[cc * 65 + qq * 16 + j];
            LDS_WAIT();
            sum += __shfl_xor(sum, 16); sum += __shfl_xor(sum, 32);
            const size_t row = (size_t)(b * SEQ + t0 + s);
            if (lane < 16) { const float uv = bf1(P[row * NP + PC_SSM + g * 16 + lane]); const float y = sum + dsk * uv; Z[row * 1024 + g * 16 + lane] = (bf16)f2bf(gelu_tanh(y)); }
        }
    }
}
__device__ __forceinline__ void gla_naive_item(Frame& F, int item, LAS float* scr) {
    const int lane = F.lane, hf = item & 3, qt = (item >> 2) & 3, h = (item >> 4) & 3, b = item >> 6;
    const bf16* P = (const bf16*)(F.ws + WS_P); const float* EG = (const float*)(F.ws + WS_EG); float* OT = (float*)(F.ws + WS_OT) + (size_t)hf * MTOK * 1024;
    float S[32];
#pragma unroll
    for (int i = 0; i < 32; ++i) S[i] = 0.f;
    const int l32 = lane & 31;
    const bf16* pq = P + (size_t)(b * SEQ) * NP + PC_GQ + h * 128 + hf * 32 + l32; const bf16* pv = P + (size_t)(b * SEQ) * NP + PC_GV + h * 256 + qt * 64 + lane;
    const float* pe = EG + (size_t)(b * SEQ) * 512 + h * 128 + hf * 32 + l32; float* po = OT + (size_t)(b * SEQ) * 1024 + h * 256 + qt * 64 + lane;
    for (int t0 = 0; t0 < SEQ; t0 += 2) {
        float qw[2], kw[2], ew[2]; bf16 vw[2];
#pragma unroll
        for (int s = 0; s < 2; ++s) { qw[s] = bf1(pq[(size_t)s * NP]); kw[s] = bf1(pq[(size_t)s * NP + (PC_GK - PC_GQ)]); ew[s] = pe[s * 512]; vw[s] = pv[(size_t)s * NP]; }
#pragma unroll
        for (int s = 0; s < 2; ++s) {
            if (lane < 32) { scr[lane] = qw[s]; scr[32 + lane] = kw[s]; scr[64 + lane] = ew[s]; }
            LDS_WAIT();
            const float v = bf1(vw[s]); float o = 0.f;
#pragma unroll
            for (int d = 0; d < 32; d += 4) { const f32x4 q4 = *(const LAS f32x4*)(scr + d), k4 = *(const LAS f32x4*)(scr + 32 + d), e4 = *(const LAS f32x4*)(scr + 64 + d);
#pragma unroll
                for (int e = 0; e < 4; ++e) { S[d + e] = e4[e] * S[d + e] + k4[e] * v; o += q4[e] * S[d + e]; }
                if ((d & 4) != 0) asm volatile("" ::: "memory"); }
            LDS_WAIT();
            po[s * 1024] = o * 0.08838834764831845f;
        }
        pq += 2 * (size_t)NP; pv += 2 * (size_t)NP; pe += 2 * 512; po += 2 * 1024;
    }
}
__device__ __forceinline__ void moba_naive_query(Frame& F, int qi, LAS float* scr) {
    const int lane = F.lane, t = qi & (SEQ - 1), h = (qi >> 11) & 7, b = qi >> 14, qb = t >> 8;
    const bf16* P = (const bf16*)(F.ws + WS_P); const bf16* QN = (const bf16*)(F.ws + WS_QN); const bf16* KN = (const bf16*)(F.ws + WS_KN); const float* KM = (const float*)(F.ws + WS_KM);
    bf16* Y = (bf16*)(F.ws + WS_Y);
    const unsigned qw = *(const unsigned*)(QN + (size_t)(b * SEQ + t) * 1024 + h * 128 + 2 * lane);
    const float q0 = bflo(qw), q1 = bfhi(qw);
    *(LAS f32x2*)(scr + 2 * lane) = (f32x2){q0, q1};
    LDS_WAIT();
    float sc[8]; unsigned selmask = 0u;
#pragma unroll
    for (int kb = 0; kb < 8; ++kb) { const f32x2 km = *(const f32x2*)(KM + (size_t)(((b * 8 + h) * 8 + kb) * 128) + 2 * lane); const float d = wave_sum(q0 * km[0] + q1 * km[1]); sc[kb] = (kb < qb) ? d : -__builtin_inff(); }
#pragma unroll
    for (int kb = 0; kb < 8; ++kb) { int rank = 0;
#pragma unroll
        for (int j = 0; j < 8; ++j) if (j != kb) rank += ((j < qb) && (sc[j] > sc[kb] || (sc[j] == sc[kb] && j < kb))) ? 1 : 0;
        if (kb < qb && rank < 3) selmask |= 1u << kb; }
    selmask |= 1u << qb;
    float m = -__builtin_inff(), lsum = 0.f, o0 = 0.f, o1 = 0.f;
    for (int kb = 0; kb <= qb; ++kb) {
        if (!((selmask >> kb) & 1u)) continue;
        for (int tile = 0; tile < 4; ++tile) {
            const int key0 = kb * 256 + tile * 64; if (key0 > t) break;
            const int key = key0 + lane;
            const v4u* kp = (const v4u*)(KN + (size_t)(b * SEQ + key) * 1024 + h * 128);
            float s = 0.f;
#pragma unroll
            for (int c = 0; c < 16; ++c) { if (c == 8) asm volatile("" ::: "memory"); const v4u kk = kp[c]; const f32x4 qa = *(const LAS f32x4*)(scr + 8 * c), qb4 = *(const LAS f32x4*)(scr + 8 * c + 4);
                s += qa[0] * bflo(kk.x) + qa[1] * bfhi(kk.x) + qa[2] * bflo(kk.y) + qa[3] * bfhi(kk.y) + qb4[0] * bflo(kk.z) + qb4[1] * bfhi(kk.z) + qb4[2] * bflo(kk.w) + qb4[3] * bfhi(kk.w); }
            if (key > t) s = -__builtin_inff();
            const float mnew = fmaxf(m, wave_max(s)); const float p = __expf(s - mnew), corr = __expf(m - mnew);
            lsum = lsum * corr + wave_sum(p); o0 *= corr; o1 *= corr; m = mnew;
            const bf16* vp = P + (size_t)(b * SEQ + key0) * NP + PC_MV + h * 128 + 2 * lane;
#pragma unroll 16
            for (int j = 0; j < 64; ++j) { const float pj = __shfl(p, j); const unsigned vw = *(const unsigned*)(vp + (size_t)j * NP); o0 += pj * bflo(vw); o1 += pj * bfhi(vw); }
        }
    }
    LDS_WAIT();
    const float inv = 1.0f / lsum;
    *(unsigned*)(Y + (size_t)(b * SEQ + t) * YW + 2048 + h * 128 + 2 * lane) = pk2(o0 * inv, o1 * inv);
}
__device__ __forceinline__ void p2b_naive(Frame& F, int l) {
    { F.refresh(); LAS float* scr = (LAS float*)(F.lds + F.wave * 16384);
#if !S5_MFMA
      if (F.wave == 0) for (int it = blockIdx.x; it < 256; it += F.G) s5_naive_item(F, l, it, scr);
#endif
      (void)scr; }
    { F.refresh(); LAS float* scr = (LAS float*)(F.lds + F.wave * 16384);
#if !GLA_MFMA
      if (F.wave == 1) for (int it = blockIdx.x; it < 256; it += F.G) gla_naive_item(F, it, scr);
#endif
      (void)scr; }
    { F.refresh(); LAS float* scr = (LAS float*)(F.lds + F.wave * 16384);
      unsigned* head = F.ctl + CW_QUEUE + 64 * l;
      for (;;) {
          unsigned qi = 0; if (F.lane == 0) qi = __hip_atomic_fetch_add(head, 1u, __ATOMIC_RELAXED, __HIP_MEMORY_SCOPE_AGENT);
          qi = __builtin_amdgcn_readfirstlane(qi);
          if (qi >= (unsigned)(NBATCH * 8 * SEQ)) break;
          moba_naive_query(F, (int)qi, scr);
      } }
}

typedef short bf16x8_t __attribute__((ext_vector_type(8)));
__device__ __forceinline__ f32x4 mma16(bf16x8_t a, bf16x8_t b, f32x4 c) { return __builtin_amdgcn_mfma_f32_16x16x32_bf16(a, b, c, 0, 0, 0); }
constexpr int S5_USTR = 2064;
constexpr int S5_XSTR = 272;
__device__ __forceinline__ void s5_tables_unit(Frame& F, int lg) {
    LAS float* APr = (LAS float*)F.lds; LAS float* APi = APr + 65 * 64; LAS float* BBr = APi + 65 * 64; LAS float* BBi = BBr + 1024; LAS float* CCr = BBi + 1024; LAS float* CCi = CCr + 1024;
    const int tid = F.tid;
    const float* lre_ = F.in[I_LRE] + lg * 64; const float* lim_ = F.in[I_LIM] + lg * 64; const double dt = exp((double)F.in[I_LDT][lg]);
    for (int idx = tid; idx < 65 * 64; idx += 512) { const int t = idx >> 6, p = idx & 63;
        const double lr = (double)lre_[p], li = (double)lim_[p]; const double mag = exp(lr * dt * (double)t); double ang = li * dt * (double)t;
        ang -= 6.283185307179586476925 * rint(ang * 0.15915494309189533577);
        APr[idx] = (float)(mag * (double)cosf((float)ang)); APi[idx] = (float)(mag * (double)sinf((float)ang)); }
    for (int idx = tid; idx < 1024; idx += 512) { const int p = idx >> 4, c = idx & 15;
        const double lr = (double)lre_[p], li = (double)lim_[p]; const double mag = exp(lr * dt); double ang = li * dt; ang -= 6.283185307179586476925 * rint(ang * 0.15915494309189533577);
        const double ar = mag * (double)cosf((float)ang), ai = mag * (double)sinf((float)ang), den = lr * lr + li * li, nr = ar - 1.0, ni = ai;
        const double zr = (nr * lr + ni * li) / den, zi = (ni * lr - nr * li) / den;
        const double br = (double)F.in[I_BRE][(size_t)(lg * 64 + p) * 16 + c], bi = (double)F.in[I_BIM][(size_t)(lg * 64 + p) * 16 + c];
        BBr[idx] = (float)(zr * br - zi * bi); BBi[idx] = (float)(zr * bi + zi * br);
        CCr[idx] = F.in[I_CRE][(size_t)lg * 1024 + idx]; CCi[idx] = F.in[I_CIM][(size_t)lg * 1024 + idx]; }
    LDS_WAIT(); __syncthreads();
    { const int t = tid >> 3, co0 = 2 * (tid & 7); float acc0[16], acc1[16];
#pragma unroll
      for (int i = 0; i < 16; ++i) { acc0[i] = 0.f; acc1[i] = 0.f; }
      for (int p = 0; p < 64; ++p) { const float ar = APr[t * 64 + p], ai = APi[t * 64 + p];
          const float c0r = CCr[co0 * 64 + p], c0i = CCi[co0 * 64 + p], c1r = CCr[(co0 + 1) * 64 + p], c1i = CCi[(co0 + 1) * 64 + p];
          const float w0r = c0r * ar - c0i * ai, w0i = c0r * ai + c0i * ar, w1r = c1r * ar - c1i * ai, w1i = c1r * ai + c1i * ar;
#pragma unroll
          for (int ci = 0; ci < 16; ++ci) { const float br = BBr[p * 16 + ci], bi = BBi[p * 16 + ci]; acc0[ci] += w0r * br - w0i * bi; acc1[ci] += w1r * br - w1i * bi; } }
      bf16* TK = (bf16*)(F.ws + WS_TK) + (size_t)lg * 64 * 256 + (size_t)(t * 16 + co0) * 16;
      v4u o0, o1, o2, o3; o0.x = pk2(acc0[0], acc0[1]); o0.y = pk2(acc0[2], acc0[3]); o0.z = pk2(acc0[4], acc0[5]); o0.w = pk2(acc0[6], acc0[7]);
      o1.x = pk2(acc0[8], acc0[9]); o1.y = pk2(acc0[10], acc0[11]); o1.z = pk2(acc0[12], acc0[13]); o1.w = pk2(acc0[14], acc0[15]);
      o2.x = pk2(acc1[0], acc1[1]); o2.y = pk2(acc1[2], acc1[3]); o2.z = pk2(acc1[4], acc1[5]); o2.w = pk2(acc1[6], acc1[7]);
      o3.x = pk2(acc1[8], acc1[9]); o3.y = pk2(acc1[10], acc1[11]); o3.z = pk2(acc1[12], acc1[13]); o3.w = pk2(acc1[14], acc1[15]);
      *(v4u*)(TK) = o0; *(v4u*)(TK + 8) = o1; *(v4u*)(TK + 16) = o2; *(v4u*)(TK + 24) = o3; }
    { bf16* TW = (bf16*)(F.ws + WS_TW) + (size_t)lg * 128 * 1024;
      for (int ch = tid; ch < 16384; ch += 512) { const int col = ch >> 7, kc = ch & 127, ri = col >> 6, p = col & 63, j = kc >> 1, c0 = 8 * (kc & 1);
          const float ar = APr[(63 - j) * 64 + p], ai = APi[(63 - j) * 64 + p]; float v[8];
#pragma unroll
          for (int e = 0; e < 8; ++e) { const float br = BBr[p * 16 + c0 + e], bi = BBi[p * 16 + c0 + e]; v[e] = ri ? (ar * bi + ai * br) : (ar * br - ai * bi); }
          v4u o; o.x = pk2(v[0], v[1]); o.y = pk2(v[2], v[3]); o.z = pk2(v[4], v[5]); o.w = pk2(v[6], v[7]);
          *(v4u*)(TW + (size_t)col * 1024 + kc * 8) = o; } }
    { bf16* TC = (bf16*)(F.ws + WS_TC) + (size_t)lg * 1024 * 128;
      for (int ch = tid; ch < 16384; ch += 512) { const int row = ch >> 4, kc = ch & 15, i = row >> 4, co = row & 15, ri = kc >> 3, p0 = 8 * (kc & 7); float v[8];
#pragma unroll
          for (int e = 0; e < 8; ++e) { const int p = p0 + e; const float ar = APr[(i + 1) * 64 + p], ai = APi[(i + 1) * 64 + p], cr = CCr[co * 64 + p], ci = CCi[co * 64 + p];
              v[e] = ri ? -(cr * ai + ci * ar) : (cr * ar - ci * ai); }
          v4u o; o.x = pk2(v[0], v[1]); o.y = pk2(v[2], v[3]); o.z = pk2(v[4], v[5]); o.w = pk2(v[6], v[7]);
          *(v4u*)(TC + (size_t)row * 128 + kc * 8) = o; } }
    if (tid < 128) ((float*)(F.ws + WS_A64))[(size_t)lg * 128 + tid] = (tid < 64) ? APr[64 * 64 + tid] : APi[64 * 64 + tid - 64];
    LDS_WAIT(); __syncthreads();
}
__device__ __forceinline__ void s5_stage_u(Frame& F, int g, int b, LAS unsigned char* U) {
    const bf16* P = (const bf16*)(F.ws + WS_P);
#pragma unroll
    for (int it = 0; it < 8; ++it) { const int ch = F.tid + 512 * it, t = ch >> 1, hf = ch & 1, n = t >> 6, j = t & 63;
        const v4u v = *(const v4u*)(P + (size_t)(b * SEQ + t) * NP + PC_SSM + 16 * g + 8 * hf);
        *(LAS v4u*)(U + n * S5_USTR + (j * 16 + 8 * hf) * 2) = v; }
}
__device__ __forceinline__ void s5_s1_unit(Frame& F, int l, int unit) {
    const int g = unit & 63, b = unit >> 6, lg = l * 64 + g, lane = F.lane, w = F.wave, fr = lane & 15, fq = lane >> 4;
    LAS unsigned char* U = F.lds;
    s5_stage_u(F, g, b, U);
    LDS_WAIT(); __syncthreads();
    const bf16* TW = (const bf16*)(F.ws + WS_TW) + (size_t)lg * 128 * 1024 + (size_t)(16 * w + fr) * 1024 + 8 * fq;
    f32x4 acc[2] = {(f32x4){0.f, 0.f, 0.f, 0.f}, (f32x4){0.f, 0.f, 0.f, 0.f}};
#pragma unroll 4
    for (int ks = 0; ks < 32; ++ks) {
        const bf16x8_t bfr = *(const bf16x8_t*)(TW + 32 * ks);
        const bf16x8_t a0 = *(const LAS bf16x8_t*)(U + fr * S5_USTR + (32 * ks + 8 * fq) * 2), a1 = *(const LAS bf16x8_t*)(U + (16 + fr) * S5_USTR + (32 * ks + 8 * fq) * 2);
        acc[0] = mma16(a0, bfr, acc[0]); acc[1] = mma16(a1, bfr, acc[1]); }
    float* SL = (float*)(F.ws + WS_SL);
#pragma unroll
    for (int mt = 0; mt < 2; ++mt)
#pragma unroll
        for (int r = 0; r < 4; ++r) { const int n = 16 * mt + 4 * fq + r; SL[((size_t)(b * 32 + n) * 64 + g) * 128 + 16 * w + fr] = acc[mt][r]; }
    __syncthreads();
}
__device__ __forceinline__ void s5_s3_unit(Frame& F, int l, int unit) {
    const int g = unit & 63, b = unit >> 6, lg = l * 64 + g, lane = F.lane, w = F.wave, fr = lane & 15, fq = lane >> 4;
    LAS unsigned char* U = F.lds; LAS unsigned char* TKL = F.lds + 32 * S5_USTR; LAS unsigned char* XP = TKL + 32768;
    s5_stage_u(F, g, b, U);
    { const v4u* src = (const v4u*)((const bf16*)(F.ws + WS_TK) + (size_t)lg * 64 * 256);
#pragma unroll
      for (int it = 0; it < 4; ++it) *(LAS v4u*)(TKL + (F.tid + 512 * it) * 16) = src[F.tid + 512 * it]; }
    if (w == 0) {
        const float* SL = (const float*)(F.ws + WS_SL); const float* A64 = (const float*)(F.ws + WS_A64) + (size_t)lg * 128;
        const float ar = A64[lane], ai = A64[64 + lane]; float xr = 0.f, xi = 0.f;
        for (int n0 = 0; n0 < 32; n0 += 8) { float sr[8], si[8];
#pragma unroll
            for (int e = 0; e < 8; ++e) { const float* sp = SL + ((size_t)(b * 32 + n0 + e) * 64 + g) * 128; sr[e] = sp[lane]; si[e] = sp[64 + lane]; }
#pragma unroll
            for (int e = 0; e < 8; ++e) { *(LAS bf16*)(XP + (n0 + e) * S5_XSTR + lane * 2) = (bf16)f2bf(xr); *(LAS bf16*)(XP + (n0 + e) * S5_XSTR + (64 + lane) * 2) = (bf16)f2bf(xi);
                const float nr = ar * xr - ai * xi + sr[e], ni = ar * xi + ai * xr + si[e]; xr = nr; xi = ni; } }
    }
    LDS_WAIT(); __syncthreads();
    f32x4 acc[2][8];
#pragma unroll
    for (int mt = 0; mt < 2; ++mt)
#pragma unroll
        for (int it = 0; it < 8; ++it) acc[mt][it] = (f32x4){0.f, 0.f, 0.f, 0.f};
    for (int ks = 0; ks < 32; ++ks) {
        const bf16x8_t a0 = *(const LAS bf16x8_t*)(U + fr * S5_USTR + (32 * ks + 8 * fq) * 2), a1 = *(const LAS bf16x8_t*)(U + (16 + fr) * S5_USTR + (32 * ks + 8 * fq) * 2);
        const int jl = 2 * ks + (fq >> 1);
#pragma unroll
        for (int it = 0; it < 8; ++it) { const int i = w + 8 * it;
            if (i >= 2 * ks) { const int lag = i - jl; bf16x8_t bfr = *(const LAS bf16x8_t*)(TKL + ((lag < 0 ? 0 : lag) * 16 + fr) * 32 + 16 * (fq & 1));
                if (lag < 0) bfr = (bf16x8_t){0, 0, 0, 0, 0, 0, 0, 0};
                acc[0][it] = mma16(a0, bfr, acc[0][it]); acc[1][it] = mma16(a1, bfr, acc[1][it]); } }
    }
    { const bf16* TC = (const bf16*)(F.ws + WS_TC) + (size_t)lg * 1024 * 128;
#pragma unroll
      for (int ks = 0; ks < 4; ++ks) {
          const bf16x8_t a0 = *(const LAS bf16x8_t*)(XP + fr * S5_XSTR + (32 * ks + 8 * fq) * 2), a1 = *(const LAS bf16x8_t*)(XP + (16 + fr) * S5_XSTR + (32 * ks + 8 * fq) * 2);
#pragma unroll
          for (int it = 0; it < 8; ++it) { const int i = w + 8 * it; const bf16x8_t bfr = *(const bf16x8_t*)(TC + (size_t)(i * 16 + fr) * 128 + 32 * ks + 8 * fq);
              acc[0][it] = mma16(a0, bfr, acc[0][it]); acc[1][it] = mma16(a1, bfr, acc[1][it]); } } }
    { const float dsk = F.in[I_SD][l * 1024 + 16 * g + fr]; bf16* Z = (bf16*)(F.ws + WS_Z);
#pragma unroll
      for (int mt = 0; mt < 2; ++mt)
#pragma unroll
          for (int it = 0; it < 8; ++it)
#pragma unroll
              for (int r = 0; r < 4; ++r) { const int n = 16 * mt + 4 * fq + r, i = w + 8 * it;
                  const float uv = bf1(*(const LAS bf16*)(U + n * S5_USTR + (i * 16 + fr) * 2)); const float y = acc[mt][it][r] + dsk * uv;
                  Z[(size_t)(b * SEQ + 64 * n + i) * 1024 + 16 * g + fr] = (bf16)f2bf(gelu_tanh(y)); } }
    __syncthreads();
}


constexpr int GL_TSTR = 144;
constexpr int GL_DSTR = 272;
__device__ __forceinline__ void gla_g1_unit(Frame& F, int l, int u) {
    const int n = u & 31, h = (u >> 5) & 3, b = u >> 7, tid = F.tid, lane = F.lane, w = F.wave, fr = lane & 15, fq = lane >> 4;
    const size_t tok0 = (size_t)b * SEQ + 64 * n;
    const bf16* P = (const bf16*)(F.ws + WS_P);
    LAS float* GL = (LAS float*)F.lds; LAS float* W2L = (LAS float*)(F.lds + 32768); LAS float* GLR = (LAS float*)(F.lds + 40960);
    LAS unsigned char* KDt = F.lds + 45056; LAS unsigned char* VTt = F.lds + 63488;
    { const float* w2 = F.in[I_GW2] + (size_t)l * 16 * 512;
#pragma unroll
      for (int it = 0; it < 4; ++it) { const int idx = tid + 512 * it, r = idx >> 7, dk = idx & 127; W2L[idx] = w2[r * 512 + h * 128 + dk]; }
#pragma unroll
      for (int it = 0; it < 2; ++it) { const int idx = tid + 512 * it, i = idx >> 4, r = idx & 15; GLR[idx] = bf1(P[(tok0 + i) * NP + PC_GLR + r]); } }
    LDS_WAIT(); __syncthreads();
    const int ti = tid >> 3, dq = tid & 7;
    { const float* b2 = F.in[I_GB2] + l * 512 + h * 128 + 16 * dq; float a[16];
#pragma unroll
      for (int e = 0; e < 16; ++e) a[e] = b2[e];
#pragma unroll
      for (int r = 0; r < 16; ++r) { const float gv = GLR[ti * 16 + r];
#pragma unroll
          for (int e = 0; e < 16; ++e) a[e] += gv * W2L[r * 128 + 16 * dq + e]; }
#pragma unroll
      for (int e = 0; e < 16; ++e) { const float x = a[e]; GL[ti * 128 + 16 * dq + e] = (fminf(x, 0.f) - log1pf(__expf(-fabsf(x)))) * (1.0f / 16.0f); } }
    LDS_WAIT(); __syncthreads();
    if (tid < 128) { float run = 0.f;
        for (int i = 0; i < 64; ++i) { run += GL[i * 128 + tid]; GL[i * 128 + tid] = run; }
        GLR[tid] = run; ((float*)(F.ws + WS_DEC))[(size_t)u * 128 + tid] = __expf(run); }
    LDS_WAIT(); __syncthreads();
    {
      const bf16* qp = P + (tok0 + ti) * NP + PC_GQ + h * 128 + 16 * dq; const bf16* kp = P + (tok0 + ti) * NP + PC_GK + h * 128 + 16 * dq;
      const v4u q0 = *(const v4u*)qp, q1 = *(const v4u*)(qp + 8), k0 = *(const v4u*)kp, k1 = *(const v4u*)(kp + 8);
      const unsigned qw[8] = {q0.x, q0.y, q0.z, q0.w, q1.x, q1.y, q1.z, q1.w}, kw[8] = {k0.x, k0.y, k0.z, k0.w, k1.x, k1.y, k1.z, k1.w};
      float qd[16], ki[16];
#pragma unroll
      for (int e = 0; e < 16; ++e) { const int dk = 16 * dq + e; const float bc = GL[ti * 128 + dk], bl = GLR[dk];
          const float qv = (e & 1) ? bfhi(qw[e >> 1]) : bflo(qw[e >> 1]), kv = (e & 1) ? bfhi(kw[e >> 1]) : bflo(kw[e >> 1]);
          qd[e] = qv * 0.08838834764831845f * __expf(bc); ki[e] = kv * __expf(-bc);
          *(LAS bf16*)(KDt + dk * GL_TSTR + ti * 2) = (bf16)f2bf(kv * __expf(bl - bc)); }
      bf16* QD = (bf16*)(F.ws + WS_QD) + ((size_t)u * 64 + ti) * 128 + 16 * dq; bf16* KI = (bf16*)(F.ws + WS_KI) + ((size_t)u * 64 + ti) * 128 + 16 * dq;
      v4u o; o.x = pk2(qd[0], qd[1]); o.y = pk2(qd[2], qd[3]); o.z = pk2(qd[4], qd[5]); o.w = pk2(qd[6], qd[7]); *(v4u*)QD = o;
      o.x = pk2(qd[8], qd[9]); o.y = pk2(qd[10], qd[11]); o.z = pk2(qd[12], qd[13]); o.w = pk2(qd[14], qd[15]); *(v4u*)(QD + 8) = o;
      o.x = pk2(ki[0], ki[1]); o.y = pk2(ki[2], ki[3]); o.z = pk2(ki[4], ki[5]); o.w = pk2(ki[6], ki[7]); *(v4u*)KI = o;
      o.x = pk2(ki[8], ki[9]); o.y = pk2(ki[10], ki[11]); o.z = pk2(ki[12], ki[13]); o.w = pk2(ki[14], ki[15]); *(v4u*)(KI + 8) = o;
      const bf16* vp = P + (tok0 + ti) * NP + PC_GV + h * 256 + 32 * dq;
#pragma unroll
      for (int c = 0; c < 4; ++c) { const v4u vv = *(const v4u*)(vp + 8 * c); const unsigned vw[4] = {vv.x, vv.y, vv.z, vv.w};
#pragma unroll
          for (int e = 0; e < 4; ++e) { const int dv = 32 * dq + 8 * c + 2 * e;
              *(LAS bf16*)(VTt + dv * GL_TSTR + ti * 2) = (bf16)(vw[e] & 0xffffu); *(LAS bf16*)(VTt + (dv + 1) * GL_TSTR + ti * 2) = (bf16)(vw[e] >> 16); } } }
    LDS_WAIT(); __syncthreads();
    {
      bf16* GVT = (bf16*)(F.ws + WS_GVT) + (size_t)u * 256 * 64; const int row = tid >> 1, hf = tid & 1;
#pragma unroll
      for (int c = 0; c < 4; ++c) *(v4u*)(GVT + row * 64 + 32 * hf + 8 * c) = *(const LAS v4u*)(VTt + row * GL_TSTR + 64 * hf + 16 * c); }
    {
      f32x4 acc[2][8];
#pragma unroll
      for (int mt = 0; mt < 2; ++mt)
#pragma unroll
          for (int nt = 0; nt < 8; ++nt) acc[mt][nt] = (f32x4){0.f, 0.f, 0.f, 0.f};
#pragma unroll
      for (int ks = 0; ks < 2; ++ks) { bf16x8_t a[2];
#pragma unroll
          for (int mt = 0; mt < 2; ++mt) a[mt] = *(const LAS bf16x8_t*)(VTt + (16 * (2 * w + mt) + fr) * GL_TSTR + (32 * ks + 8 * fq) * 2);
#pragma unroll
          for (int nt = 0; nt < 8; ++nt) { const bf16x8_t bb = *(const LAS bf16x8_t*)(KDt + (16 * nt + fr) * GL_TSTR + (32 * ks + 8 * fq) * 2);
              acc[0][nt] = mma16(a[0], bb, acc[0][nt]); acc[1][nt] = mma16(a[1], bb, acc[1][nt]); } }
      float* KV = (float*)(F.ws + WS_KV) + (size_t)u * 256 * 128;
#pragma unroll
      for (int mt = 0; mt < 2; ++mt)
#pragma unroll
          for (int nt = 0; nt < 8; ++nt)
#pragma unroll
              for (int r = 0; r < 4; ++r) KV[(size_t)(16 * (2 * w + mt) + 4 * fq + r) * 128 + 16 * nt + fr] = acc[mt][nt][r]; }
    __syncthreads();
}
__device__ __forceinline__ void gla_g2_scan(Frame& F) {
    const float* KV = (const float*)(F.ws + WS_KV); const float* DEC = (const float*)(F.ws + WS_DEC); bf16* ST = (bf16*)(F.ws + WS_ST);
    for (int e4 = blockIdx.x * 512 + F.tid; e4 < 16 * 256 * 32; e4 += F.G * 512) { const int bh = e4 >> 13, dv = (e4 >> 5) & 255, d4 = e4 & 31;
        f32x4 s = (f32x4){0.f, 0.f, 0.f, 0.f};
        for (int n0 = 0; n0 < 32; n0 += 4) { f32x4 kv[4], dc[4];
#pragma unroll
            for (int e = 0; e < 4; ++e) { const size_t u = (size_t)bh * 32 + n0 + e; kv[e] = *(const f32x4*)(KV + (u * 256 + dv) * 128 + 4 * d4); dc[e] = *(const f32x4*)(DEC + u * 128 + 4 * d4); }
#pragma unroll
            for (int e = 0; e < 4; ++e) { const size_t u = (size_t)bh * 32 + n0 + e; v2u o; o.x = pk2(s[0], s[1]); o.y = pk2(s[2], s[3]); *(v2u*)(ST + (u * 256 + dv) * 128 + 4 * d4) = o; s = dc[e] * s + kv[e]; } } }
}
__device__ __forceinline__ void gla_g3_unit(Frame& F, int l, int u) {
    const int n = u & 31, h = (u >> 5) & 3, b = u >> 7, tid = F.tid, lane = F.lane, w = F.wave, fr = lane & 15, fq = lane >> 4;
    const size_t tok0 = (size_t)b * SEQ + 64 * n;
    LAS unsigned char* QDL = F.lds; LAS unsigned char* KIL = F.lds + 17408; LAS unsigned char* ATL = F.lds + 34816; LAS float* SSQL = (LAS float*)(F.lds + 44032); LAS float* RSL = (LAS float*)(F.lds + 46080);
    { const v4u* qs = (const v4u*)((const bf16*)(F.ws + WS_QD) + (size_t)u * 64 * 128); const v4u* ks_ = (const v4u*)((const bf16*)(F.ws + WS_KI) + (size_t)u * 64 * 128);
#pragma unroll
      for (int it = 0; it < 2; ++it) { const int c = tid + 512 * it, row = c >> 4, c16 = c & 15; *(LAS v4u*)(QDL + row * GL_DSTR + c16 * 16) = qs[c]; *(LAS v4u*)(KIL + row * GL_DSTR + c16 * 16) = ks_[c]; } }
    LDS_WAIT(); __syncthreads();
#pragma unroll
    for (int tt = 0; tt < 2; ++tt) { const int tile = 2 * w + tt, mi = tile >> 2, nj = tile & 3; f32x4 acc = (f32x4){0.f, 0.f, 0.f, 0.f};
        if (nj <= mi) {
#pragma unroll
            for (int ks = 0; ks < 4; ++ks) { const bf16x8_t a = *(const LAS bf16x8_t*)(QDL + (16 * mi + fr) * GL_DSTR + (32 * ks + 8 * fq) * 2), bb = *(const LAS bf16x8_t*)(KIL + (16 * nj + fr) * GL_DSTR + (32 * ks + 8 * fq) * 2);
                acc = mma16(a, bb, acc); } }
#pragma unroll
        for (int r = 0; r < 4; ++r) { const int i = 16 * mi + 4 * fq + r, j = 16 * nj + fr; *(LAS bf16*)(ATL + i * GL_TSTR + j * 2) = (bf16)f2bf(j <= i ? acc[r] : 0.f); } }
    LDS_WAIT(); __syncthreads();
    f32x4 acc[4][2];
#pragma unroll
    for (int mi = 0; mi < 4; ++mi) { acc[mi][0] = (f32x4){0.f, 0.f, 0.f, 0.f}; acc[mi][1] = (f32x4){0.f, 0.f, 0.f, 0.f}; }
    { const bf16* GVT = (const bf16*)(F.ws + WS_GVT) + (size_t)u * 256 * 64;
#pragma unroll
      for (int ks = 0; ks < 2; ++ks) { bf16x8_t bb[2];
#pragma unroll
          for (int nt = 0; nt < 2; ++nt) bb[nt] = *(const bf16x8_t*)(GVT + (size_t)(16 * (2 * w + nt) + fr) * 64 + 32 * ks + 8 * fq);
#pragma unroll
          for (int mi = 0; mi < 4; ++mi) { const bf16x8_t a = *(const LAS bf16x8_t*)(ATL + (16 * mi + fr) * GL_TSTR + (32 * ks + 8 * fq) * 2);
              acc[mi][0] = mma16(a, bb[0], acc[mi][0]); acc[mi][1] = mma16(a, bb[1], acc[mi][1]); } }
      const bf16* ST = (const bf16*)(F.ws + WS_ST) + (size_t)u * 256 * 128;
#pragma unroll
      for (int ks = 0; ks < 4; ++ks) { bf16x8_t bb[2];
#pragma unroll
          for (int nt = 0; nt < 2; ++nt) bb[nt] = *(const bf16x8_t*)(ST + (size_t)(16 * (2 * w + nt) + fr) * 128 + 32 * ks + 8 * fq);
#pragma unroll
          for (int mi = 0; mi < 4; ++mi) { const bf16x8_t a = *(const LAS bf16x8_t*)(QDL + (16 * mi + fr) * GL_DSTR + (32 * ks + 8 * fq) * 2);
              acc[mi][0] = mma16(a, bb[0], acc[mi][0]); acc[mi][1] = mma16(a, bb[1], acc[mi][1]); } } }
#pragma unroll
    for (int mi = 0; mi < 4; ++mi)
#pragma unroll
        for (int r = 0; r < 4; ++r) { float v = acc[mi][0][r] * acc[mi][0][r] + acc[mi][1][r] * acc[mi][1][r];
            v += __shfl_xor(v, 1); v += __shfl_xor(v, 2); v += __shfl_xor(v, 4); v += __shfl_xor(v, 8);
            if (fr == 0) SSQL[w * 64 + 16 * mi + 4 * fq + r] = v; }
    LDS_WAIT(); __syncthreads();
    if (tid < 64) { float s = 0.f;
#pragma unroll
        for (int ww = 0; ww < 8; ++ww) s += SSQL[ww * 64 + tid];
        RSL[tid] = 1.0f / sqrtf(s * (1.0f / 256.0f) + RMS_EPS); }
    LDS_WAIT(); __syncthreads();
    { const bf16* P = (const bf16*)(F.ws + WS_P); bf16* Y = (bf16*)(F.ws + WS_Y); const float* gn = F.in[I_GNG] + l * 256;
#pragma unroll
      for (int nt = 0; nt < 2; ++nt) { const int dv = 32 * w + 16 * nt + fr; const float gv = gn[dv];
#pragma unroll
          for (int mi = 0; mi < 4; ++mi)
#pragma unroll
              for (int r = 0; r < 4; ++r) { const int i = 16 * mi + 4 * fq + r; const float rr = bf1(P[(tok0 + i) * NP + PC_GR + h * 256 + dv]);
                  Y[(tok0 + i) * YW + 1024 + h * 256 + dv] = (bf16)f2bf(acc[mi][nt][r] * RSL[i] * gv * rr * sigmoidf_(rr)); } } }
    __syncthreads();
}


constexpr int MB_KSTR = 272, MB_VSTR = 144, MB_KBYTES = 64 * MB_KSTR, MB_BUF = MB_KBYTES + 128 * MB_VSTR;
__device__ __forceinline__ void moba_prep_unit(Frame& F, int l, int unit) {
    const int kb = unit & 7, h = (unit >> 3) & 7, b = unit >> 6, tid = F.tid;
    const size_t tok0 = (size_t)b * SEQ + 256 * kb;
    const bf16* P = (const bf16*)(F.ws + WS_P);
    LAS unsigned char* TL = F.lds; LAS float* PART = (LAS float*)(F.lds + 69632);
    const int tok = tid >> 1, hf = tid & 1;
#pragma unroll
    for (int which = 0; which < 2; ++which) {
        const bf16* src = P + (tok0 + tok) * NP + (which ? PC_MK : PC_MQ) + h * 128 + 64 * hf; const float* gp = F.in[which ? I_MKG : I_MQG] + l * 128 + 64 * hf;
        v4u x[8]; float ss = 0.f;
#pragma unroll
        for (int c = 0; c < 8; ++c) { x[c] = *(const v4u*)(src + 8 * c); const unsigned xw[4] = {x[c].x, x[c].y, x[c].z, x[c].w};
#pragma unroll
            for (int e = 0; e < 4; ++e) { const float a = bflo(xw[e]), bb = bfhi(xw[e]); ss += a * a + bb * bb; } }
        ss += __shfl_xor(ss, 1);
        const float r = (1.0f / sqrtf(ss * (1.0f / 128.0f) + RMS_EPS)) * (which ? 1.0f : 0.08838834764831845f);
        bf16* dst = (bf16*)(F.ws + (which ? WS_KN : WS_QN)) + (tok0 + tok) * 1024 + h * 128 + 64 * hf;
#pragma unroll
        for (int c = 0; c < 8; ++c) { const unsigned xw[4] = {x[c].x, x[c].y, x[c].z, x[c].w}; const f32x4 g0 = *(const f32x4*)(gp + 8 * c), g1 = *(const f32x4*)(gp + 8 * c + 4);
            v4u o; o.x = pk2(bflo(xw[0]) * r * g0[0], bfhi(xw[0]) * r * g0[1]); o.y = pk2(bflo(xw[1]) * r * g0[2], bfhi(xw[1]) * r * g0[3]);
            o.z = pk2(bflo(xw[2]) * r * g1[0], bfhi(xw[2]) * r * g1[1]); o.w = pk2(bflo(xw[3]) * r * g1[2], bfhi(xw[3]) * r * g1[3]);
            *(v4u*)(dst + 8 * c) = o; if (which) *(LAS v4u*)(TL + tok * MB_KSTR + (64 * hf + 8 * c) * 2) = o; }
    }
    LDS_WAIT(); __syncthreads();
    { const int d = tid & 127, part = tid >> 7; float a = 0.f;
      for (int j = 0; j < 64; ++j) a += bf1(*(const LAS bf16*)(TL + (64 * part + j) * MB_KSTR + d * 2));
      PART[part * 128 + d] = a; }
    LDS_WAIT(); __syncthreads();
    if (tid < 128) ((float*)(F.ws + WS_KM))[(size_t)unit * 128 + tid] = ((PART[tid] + PART[128 + tid]) + (PART[256 + tid] + PART[384 + tid])) * (1.0f / 256.0f);
    { const bf16* src = P + (tok0 + tok) * NP + PC_MV + h * 128 + 64 * hf;
#pragma unroll
      for (int c = 0; c < 8; ++c) *(LAS v4u*)(TL + tok * MB_KSTR + (64 * hf + 8 * c) * 2) = *(const v4u*)(src + 8 * c); }
    LDS_WAIT(); __syncthreads();
    { const int d = tid >> 2, tq = tid & 3; bf16* dst = (bf16*)(F.ws + WS_VT) + ((size_t)(b * 8 + h) * 128 + d) * SEQ + 256 * kb + 64 * tq;
#pragma unroll
      for (int c = 0; c < 8; ++c) { unsigned wv[4];
#pragma unroll
          for (int e = 0; e < 4; ++e) { const unsigned lo = *(const LAS bf16*)(TL + (64 * tq + 8 * c + 2 * e) * MB_KSTR + d * 2), hi = *(const LAS bf16*)(TL + (64 * tq + 8 * c + 2 * e + 1) * MB_KSTR + d * 2); wv[e] = lo | (hi << 16); }
          v4u o; o.x = wv[0]; o.y = wv[1]; o.z = wv[2]; o.w = wv[3]; *(v4u*)(dst + 8 * c) = o; } }
    __syncthreads();
}
__device__ __forceinline__ void moba_attn_unit(Frame& F, int bh, int qt) {
    const int b = bh >> 3, h = bh & 7, tid = F.tid, lane = F.lane, w = F.wave, fr = lane & 15, fq = lane >> 4;
    const int qb = qt >> 1, nt = 2 * (qt + 1), qpos = 128 * qt + 16 * w + fr;
    const bf16* KN = (const bf16*)(F.ws + WS_KN) + (size_t)b * SEQ * 1024 + h * 128; const bf16* VT = (const bf16*)(F.ws + WS_VT) + (size_t)bh * 128 * SEQ;
    LAS float* KML = (LAS float*)(F.lds + 2 * MB_BUF);
    { const float* km = (const float*)(F.ws + WS_KM) + (size_t)bh * 1024; KML[tid] = km[tid]; KML[512 + tid] = km[512 + tid]; }
    bf16x8_t bq[4];
    { const bf16* qp = (const bf16*)(F.ws + WS_QN) + ((size_t)b * SEQ + qpos) * 1024 + h * 128 + 8 * fq;
#pragma unroll
      for (int ks = 0; ks < 4; ++ks) bq[ks] = *(const bf16x8_t*)(qp + 32 * ks); }
    v4u sk[2], sv[2];
#define MB_LOAD(it_) do { _Pragma("unroll") for (int p_ = 0; p_ < 2; ++p_) { const int cc_ = tid + 512 * p_; \
        sk[p_] = *(const v4u*)(KN + (size_t)(64 * (it_) + (cc_ >> 4)) * 1024 + 8 * (cc_ & 15)); sv[p_] = *(const v4u*)(VT + (size_t)(cc_ >> 3) * SEQ + 64 * (it_) + 8 * (cc_ & 7)); } } while (0)
#define MB_STORE(buf_) do { _Pragma("unroll") for (int p_ = 0; p_ < 2; ++p_) { const int cc_ = tid + 512 * p_; \
        *(LAS v4u*)((buf_) + (cc_ >> 4) * MB_KSTR + (cc_ & 15) * 16) = sk[p_]; *(LAS v4u*)((buf_) + MB_KBYTES + (cc_ >> 3) * MB_VSTR + (cc_ & 7) * 16) = sv[p_]; } } while (0)
    MB_LOAD(0);
    LDS_WAIT(); __syncthreads();
    unsigned selmask = 0u;
    { float sc[8];
#pragma unroll
      for (int kb = 0; kb < 8; ++kb) { float a = 0.f;
#pragma unroll
          for (int ks = 0; ks < 4; ++ks) { const LAS float* kp = KML + kb * 128 + 32 * ks + 8 * fq; const f32x4 k0 = *(const LAS f32x4*)kp, k1 = *(const LAS f32x4*)(kp + 4);
              const unsigned q01 = (unsigned)(unsigned short)bq[ks][0] | ((unsigned)(unsigned short)bq[ks][1] << 16), q23 = (unsigned)(unsigned short)bq[ks][2] | ((unsigned)(unsigned short)bq[ks][3] << 16);
              const unsigned q45 = (unsigned)(unsigned short)bq[ks][4] | ((unsigned)(unsigned short)bq[ks][5] << 16), q67 = (unsigned)(unsigned short)bq[ks][6] | ((unsigned)(unsigned short)bq[ks][7] << 16);
              a += bflo(q01) * k0[0] + bfhi(q01) * k0[1] + bflo(q23) * k0[2] + bfhi(q23) * k0[3] + bflo(q45) * k1[0] + bfhi(q45) * k1[1] + bflo(q67) * k1[2] + bfhi(q67) * k1[3]; }
          a += __shfl_xor(a, 16); a += __shfl_xor(a, 32); sc[kb] = (kb < qb) ? a : -__builtin_inff(); }
#pragma unroll
      for (int kb = 0; kb < 8; ++kb) { int rank = 0;
#pragma unroll
          for (int j = 0; j < 8; ++j) if (j != kb) rank += ((j < qb) && (sc[j] > sc[kb] || (sc[j] == sc[kb] && j < kb))) ? 1 : 0;
          if (kb < qb && rank < 3) selmask |= 1u << kb; } }
    MB_STORE(F.lds);
    LDS_WAIT(); __syncthreads();
    f32x4 ao[8];
#pragma unroll
    for (int dt = 0; dt < 8; ++dt) ao[dt] = (f32x4){0.f, 0.f, 0.f, 0.f};
    float m = -__builtin_inff(), lsum = 0.f;
#pragma unroll 1
    for (int it = 0; it < nt; ++it) {
        LAS unsigned char* KB = F.lds + (it & 1) * MB_BUF; LAS unsigned char* VB = KB + MB_KBYTES;
        if (it + 1 < nt) MB_LOAD(it + 1);
        const int kb = it >> 2; const bool past = kb < qb; const bool mine = past ? (((selmask >> kb) & 1u) != 0u) : true;
        if (__any(mine)) {
            f32x4 as[4];
#pragma unroll
            for (int mt = 0; mt < 4; ++mt) { as[mt] = (f32x4){0.f, 0.f, 0.f, 0.f};
#pragma unroll
                for (int ks = 0; ks < 4; ++ks) { const bf16x8_t a = *(const LAS bf16x8_t*)(KB + (16 * mt + fr) * MB_KSTR + (32 * ks + 8 * fq) * 2); as[mt] = mma16(a, bq[ks], as[mt]); } }
            float mx = -__builtin_inff();
#pragma unroll
            for (int mt = 0; mt < 4; ++mt)
#pragma unroll
                for (int r = 0; r < 4; ++r) { const int key = 64 * it + 16 * mt + 4 * fq + r; const bool ok = past ? mine : (key <= qpos); const float sv_ = ok ? as[mt][r] : -__builtin_inff(); as[mt][r] = sv_; mx = fmaxf(mx, sv_); }
            mx = fmaxf(mx, __shfl_xor(mx, 16)); mx = fmaxf(mx, __shfl_xor(mx, 32));
            const float mnew = fmaxf(m, mx), msafe = (mnew == -__builtin_inff()) ? 0.f : mnew, corr = __expf(m - msafe);
            float ps = 0.f;
#pragma unroll
            for (int mt = 0; mt < 4; ++mt)
#pragma unroll
                for (int r = 0; r < 4; ++r) { const float p = __expf(as[mt][r] - msafe); as[mt][r] = p; ps += p; }
            lsum = lsum * corr + ps; m = mnew;
            bf16x8_t pf[2];
#pragma unroll
            for (int k2 = 0; k2 < 2; ++k2) { const unsigned w0 = pk2(as[2 * k2][0], as[2 * k2][1]), w1 = pk2(as[2 * k2][2], as[2 * k2][3]), w2 = pk2(as[2 * k2 + 1][0], as[2 * k2 + 1][1]), w3 = pk2(as[2 * k2 + 1][2], as[2 * k2 + 1][3]);
                v4u t; t.x = w0; t.y = w1; t.z = w2; t.w = w3; pf[k2] = __builtin_bit_cast(bf16x8_t, t); }
#pragma unroll
            for (int dt = 0; dt < 8; ++dt) { ao[dt] = ao[dt] * corr;
#pragma unroll
                for (int k2 = 0; k2 < 2; ++k2) { const LAS unsigned char* vp = VB + (16 * dt + fr) * MB_VSTR + (32 * k2 + 4 * fq) * 2; const v2u lo = *(const LAS v2u*)vp, hi = *(const LAS v2u*)(vp + 32);
                    v4u t; t.x = lo.x; t.y = lo.y; t.z = hi.x; t.w = hi.y; ao[dt] = mma16(__builtin_bit_cast(bf16x8_t, t), pf[k2], ao[dt]); } }
        }
        if (it + 1 < nt) MB_STORE(F.lds + ((it + 1) & 1) * MB_BUF);
        LDS_WAIT(); __syncthreads();
    }
#undef MB_LOAD
#undef MB_STORE
    lsum += __shfl_xor(lsum, 16); lsum += __shfl_xor(lsum, 32);
    const float inv = 1.0f / lsum;
    bf16* yp = (bf16*)(F.ws + WS_Y) + ((size_t)b * SEQ + qpos) * YW + 2048 + h * 128 + 4 * fq;
#pragma unroll
    for (int dt = 0; dt < 8; ++dt) { v2u o; o.x = pk2(ao[dt][0] * inv, ao[dt][1] * inv); o.y = pk2(ao[dt][2] * inv, ao[dt][3] * inv); *(v2u*)(yp + 16 * dt) = o; }
}

__device__ __forceinline__ void p2c_gla_finish(Frame& F, int l) {
    const bf16* P = (const bf16*)(F.ws + WS_P); const float* OT = (const float*)(F.ws + WS_OT); bf16* Y = (bf16*)(F.ws + WS_Y);
    const int lane = F.lane, gw = blockIdx.x * NWAVES + F.wave, NGW = F.G * NWAVES;
    const f32x4 gn = *(const f32x4*)(F.in[I_GNG] + l * 256 + 4 * lane);
    for (int it = gw; it < MTOK * 4; it += NGW) { const int tok = it >> 2, h = it & 3;
        const f32x4 o = (*(const f32x4*)(OT + (size_t)tok * 1024 + h * 256 + 4 * lane) + *(const f32x4*)(OT + (size_t)(MTOK + tok) * 1024 + h * 256 + 4 * lane)) + (*(const f32x4*)(OT + (size_t)(2 * MTOK + tok) * 1024 + h * 256 + 4 * lane) + *(const f32x4*)(OT + (size_t)(3 * MTOK + tok) * 1024 + h * 256 + 4 * lane));
        const float ss = wave_sum((o[0] * o[0] + o[1] * o[1]) + (o[2] * o[2] + o[3] * o[3])); const float rn = 1.0f / sqrtf(ss * (1.0f / 256.0f) + RMS_EPS);
        const v2u rw = *(const v2u*)(P + (size_t)tok * NP + PC_GR + h * 256 + 4 * lane);
        const float r0 = bflo(rw.x), r1 = bfhi(rw.x), r2 = bflo(rw.y), r3 = bfhi(rw.y);
        v2u w; w.x = pk2(o[0] * rn * gn[0] * r0 * sigmoidf_(r0), o[1] * rn * gn[1] * r1 * sigmoidf_(r1)); w.y = pk2(o[2] * rn * gn[2] * r2 * sigmoidf_(r2), o[3] * rn * gn[3] * r3 * sigmoidf_(r3));
        *(v2u*)(Y + (size_t)tok * YW + 1024 + h * 256 + 4 * lane) = w; }
}

constexpr int NPH = 9;
__global__ void __launch_bounds__(NWAVES * 64, 2) fwd_kernel(Args args) {
    extern __shared__ __attribute__((aligned(16))) unsigned char lds[];
    Frame F;
    F.lds = (LAS unsigned char*)lds;
    F.MISC = (volatile LAS unsigned*)(F.lds + MISC_OFF);
    F.tid = threadIdx.x; F.lane = F.tid & 63; F.wave = __builtin_amdgcn_readfirstlane(F.tid >> 6); F.wv = F.wave;
    F.G = gridDim.x; F.in = args.in; F.ws = args.ws; F.ws0 = args.ws; F.ctl = (unsigned*)(args.ws + WS_CTL);
    for (int u = F.tid; u < (LDS_BYTES - LDSCTL_OFF) / 4; u += NWAVES * 64) ((LAS unsigned*)(F.lds + LDSCTL_OFF))[u] = 0u;
    __syncthreads();
    XcdBarrier bar; bar.bar = F.ctl + CW_BAR; bar.x = 0; bar.st = nullptr;
    if (args.fused) bar = xcd_barrier_post(F.ctl + CW_BAR, F.MISC + 8);
#define GRID_BAR() do { if (args.fused) xcd_barrier(bar, opaque_tid(F.wv)); } while (0)
    const int lo = args.ph_lo, hi = args.ph_hi;
#ifndef PH_MASK
#define PH_MASK 0x1ff
#endif
#define IN(k) (((PH_MASK >> (k)) & 1) && lo <= (k) && (k) < hi)
#define WSP(T, off) ((T*)(ws + (off)))

    if (args.l_lo == 0 && IN(0)) for (int rep = 0; rep < NREP(0); ++rep) { F.refresh(); p0_prologue(F); GRID_BAR(); }

    for (int l = args.l_lo; l < args.l_hi; ++l) {
        if (IN(1)) for (int rep = 0; rep < NREP(1); ++rep) {
            unsigned char* ws = opaque_ptr(args.ws); const unsigned char* wl = ws + WS_W + (size_t)l * SZ_WLAYER;
            pg8::Gemm g{WSP(pg8::bf16_t, WS_XB), DM, (const pg8::bf16_t*)(wl + OFF_WIN), DM, DM, 0, 0}; pg8::TileOrder S; S.init(MTOK, NP, F.G, (int)blockIdx.x, 1);
            pg8::EpiInProj E{WSP(pg8::bf16_t, WS_P), WSP(float, WS_SSQ)};
            pg8::gemm_phase(F.lds, g, S, E, F.wv);
            GRID_BAR();
        }
        if (IN(2)) for (int rep = 0; rep < NREP(2); ++rep) { F.refresh(); p2a_naive(F, l);
#if S5_MFMA
            VM_WAIT(); __syncthreads(); F.refresh(); for (int u = blockIdx.x; u < 256; u += F.G) s5_s1_unit(F, l, u);
#endif
#if GLA_MFMA
            VM_WAIT(); __syncthreads(); F.refresh(); for (int u = blockIdx.x; u < 512; u += F.G) gla_g1_unit(F, l, u);
#endif
#if MOBA_MFMA
            VM_WAIT(); __syncthreads(); F.refresh(); for (int u = blockIdx.x; u < 256; u += F.G) moba_prep_unit(F, l, u);
#endif
            GRID_BAR(); }
        if (IN(3)) for (int rep = 0; rep < NREP(3); ++rep) {
#if S5_MFMA
            F.refresh(); for (int u = blockIdx.x; u < 256; u += F.G) s5_s3_unit(F, l, u);
            VM_WAIT(); __syncthreads();
#endif
#if GLA_MFMA
            F.refresh(); gla_g2_scan(F);
#endif
#if MOBA_MFMA
            VM_WAIT(); __syncthreads(); F.refresh();
            for (int pi2 = 2 * blockIdx.x; pi2 < 512; pi2 += 2 * F.G) {
#pragma unroll 1
                for (int hh = 0; hh < 2; ++hh) { const int pi = pi2 >> 1; moba_attn_unit(F, pi >> 3, hh ? (pi & 7) : 15 - (pi & 7)); } }
#else
            F.refresh(); p2b_naive(F, l);
#endif
            GRID_BAR(); }
        if (IN(4)) for (int rep = 0; rep < NREP(4); ++rep) {
#if GLA_MFMA
            const int gh = F.G >= 2 ? F.G / 2 : 1;
            if ((int)blockIdx.x < gh) {
                unsigned char* ws = opaque_ptr(args.ws); const unsigned char* wl = ws + WS_W + (size_t)l * SZ_WLAYER;
                pg8::Gemm g{WSP(pg8::bf16_t, WS_Z), 1024, (const pg8::bf16_t*)(wl + OFF_WGLU), 1024, 1024, 0, 0}; pg8::TileOrder S; S.init(MTOK, 1024, gh, (int)blockIdx.x, 1);
                pg8::EpiGLU E{WSP(pg8::bf16_t, WS_Z), WSP(pg8::bf16_t, WS_Y), args.in[I_BGLU] + l * 1024};
                pg8::gemm_phase(F.lds, g, S, E, F.wv);
            }
            if ((int)blockIdx.x >= gh || F.G < 2) { F.refresh(); const int nb3 = F.G < 2 ? 1 : F.G - gh; for (int u = F.G < 2 ? 0 : (int)blockIdx.x - gh; u < 512; u += nb3) gla_g3_unit(F, l, u); }
#else
            F.refresh(); p2c_gla_finish(F, l);
            VM_WAIT(); __syncthreads();
            unsigned char* ws = opaque_ptr(args.ws); const unsigned char* wl = ws + WS_W + (size_t)l * SZ_WLAYER;
            pg8::Gemm g{WSP(pg8::bf16_t, WS_Z), 1024, (const pg8::bf16_t*)(wl + OFF_WGLU), 1024, 1024, 0, 0}; pg8::TileOrder S; S.init(MTOK, 1024, F.G, (int)blockIdx.x, 1);
            pg8::EpiGLU E{WSP(pg8::bf16_t, WS_Z), WSP(pg8::bf16_t, WS_Y), args.in[I_BGLU] + l * 1024};
            pg8::gemm_phase(F.lds, g, S, E, F.wv);
#endif
            GRID_BAR();
        }
        if (IN(5)) for (int rep = 0; rep < NREP(5); ++rep) {
            unsigned char* ws = opaque_ptr(args.ws); const unsigned char* wl = ws + WS_W + (size_t)l * SZ_WLAYER;
            pg8::Gemm g{WSP(pg8::bf16_t, WS_Y), YW, (const pg8::bf16_t*)(wl + OFF_WBR), 3072, 1024, 1024, 1024}; pg8::TileOrder S; S.init(MTOK, DM, F.G, (int)blockIdx.x, 3);
            pg8::EpiBranch E{WSP(pg8::bf16_t, WS_P), WSP(pg8::bf16_t, WS_MB)};
            pg8::gemm_phase(F.lds, g, S, E, F.wv);
            GRID_BAR();
        }
        if (IN(6)) {
            unsigned char* ws = opaque_ptr(args.ws); const unsigned char* wl = ws + WS_W + (size_t)l * SZ_WLAYER;
            pg8::Gemm g{WSP(pg8::bf16_t, WS_MB), DM, (const pg8::bf16_t*)(wl + OFF_WOUT), DM, DM, 0, 0}; pg8::TileOrder S; S.init(MTOK, DM, F.G, (int)blockIdx.x, 1);
            pg8::EpiResid E{l == 0 ? args.in[I_X] : WSP(float, WS_XR), WSP(float, WS_XR), WSP(pg8::bf16_t, WS_XB), WSP(float, WS_SSQ)};
            pg8::gemm_phase(F.lds, g, S, E, F.wv);
            GRID_BAR();
        }
        if (IN(7)) for (int rep = 0; rep < NREP(7); ++rep) {
            unsigned char* ws = opaque_ptr(args.ws); const unsigned char* wl = ws + WS_W + (size_t)l * SZ_WLAYER;
            pg8::Gemm g{WSP(pg8::bf16_t, WS_XB), DM, (const pg8::bf16_t*)(wl + OFF_WGU), DM, DM, 0, 0}; pg8::TileOrder S; S.init(MTOK, NGU, F.G, (int)blockIdx.x, 1);
            pg8::EpiFFNUp E{WSP(pg8::bf16_t, WS_H), WSP(float, WS_SSQ)};
            pg8::gemm_phase(F.lds, g, S, E, F.wv);
            GRID_BAR();
        }
        if (IN(8)) {
            unsigned char* ws = opaque_ptr(args.ws); const unsigned char* wl = ws + WS_W + (size_t)l * SZ_WLAYER;
            pg8::Gemm g{WSP(pg8::bf16_t, WS_H), FFN, (const pg8::bf16_t*)(wl + OFF_WDN), FFN, FFN, 0, 0}; pg8::TileOrder S; S.init(MTOK, DM, F.G, (int)blockIdx.x, 1);
            pg8::EpiResid E{WSP(float, WS_XR), l == DEPTH - 1 ? args.out : WSP(float, WS_XR), WSP(pg8::bf16_t, WS_XB), WSP(float, WS_SSQ)};
            pg8::gemm_phase(F.lds, g, S, E, F.wv);
            if (l + 1 < DEPTH) GRID_BAR();
        }
    }
#undef IN
#undef GRID_BAR
}

extern "C" void kernel_launch(void* const* d_in, const int* in_sizes, int n_in, void* d_out, int out_size, void* d_ws, size_t ws_size, hipStream_t stream) {
    static int grid = 0;
    if (grid == 0) {
        if (n_in != 26 || out_size != MTOK * DM || ws_size < WS_END) { fprintf(stderr, "kernel_launch: unexpected problem (n_in %d out %d ws %zu need %zu)\n", n_in, out_size, ws_size, (size_t)WS_END); grid = -1; return; }
        int dev = 0, cus = 0, per_cu = 0;
        if (hipGetDevice(&dev) != hipSuccess || hipDeviceGetAttribute(&cus, hipDeviceAttributeMultiprocessorCount, dev) != hipSuccess) { grid = -1; return; }
        if (hipFuncSetAttribute((const void*)fwd_kernel, hipFuncAttributeMaxDynamicSharedMemorySize, LDS_BYTES) != hipSuccess) { fprintf(stderr, "kernel_launch: hipFuncSetAttribute failed\n"); grid = -1; return; }
        if (hipOccupancyMaxActiveBlocksPerMultiprocessor(&per_cu, (const void*)fwd_kernel, NWAVES * 64, LDS_BYTES) != hipSuccess || per_cu < 1) { fprintf(stderr, "kernel_launch: occupancy query says %d\n", per_cu); }
        (void)hipGetLastError();
        grid = cus;
    }
    if (grid < 0) return;
    if (hipMemsetAsync((char*)d_ws + WS_CTL, 0, CTL_ZERO_BYTES, stream) != hipSuccess) return;
    Args a{};
    for (int i = 0; i < 26; ++i) a.in[i] = (const float*)d_in[i];
    a.out = (float*)d_out; a.ws = (unsigned char*)d_ws; a.pad = 0;
#if MK_FUSED
    a.l_lo = 0; a.l_hi = DEPTH; a.ph_lo = 0; a.ph_hi = NPH; a.fused = 1;
    hipLaunchKernelGGL(fwd_kernel, dim3(grid), dim3(NWAVES * 64), LDS_BYTES, stream, a);
#else
    a.fused = 0;
    for (int l = 0; l < DEPTH; ++l)
        for (int ph = (l == 0 ? 0 : 1); ph < NPH; ++ph) { a.l_lo = l; a.l_hi = l + 1; a.ph_lo = ph; a.ph_hi = ph + 1; hipLaunchKernelGGL(fwd_kernel, dim3(grid), dim3(NWAVES * 64), LDS_BYTES, stream, a); }
#endif
}
```

```cpp
#include <hip/hip_runtime.h>
#include <cstdio>
#include <cstdint>

#ifndef S5_MFMA
#define S5_MFMA 1
#endif
#ifndef GLA_MFMA
#define GLA_MFMA 1
#endif
#ifndef REPEAT_MASK
#define REPEAT_MASK 0
#endif
#define NREP(k) (1 + ((REPEAT_MASK >> (k)) & 1))
#ifndef PROBE2
#define PROBE2 0
#endif
#ifndef PR_A0
#define PR_A0 0
#define PR_A1 1
#define PR_B0 1
#define PR_B1 2
#endif
#ifndef MOBA_MFMA
#define MOBA_MFMA 1
#endif
#ifndef MK_FUSED
#define MK_FUSED 1
#endif

__device__ __forceinline__ unsigned char* opaque_ptr(unsigned char* p) { asm volatile("" : "+s"(p)); return p; }
__device__ __forceinline__ int opaque_tid(int wv) { int ln; asm volatile("v_mbcnt_lo_u32_b32 %0, -1, 0\n\tv_mbcnt_hi_u32_b32 %0, -1, %0" : "=v"(ln)); return (wv << 6) | ln; }

namespace pg8 {
#define PG8_LAS __attribute__((address_space(3)))
typedef unsigned short bf16_t;
typedef short bf16x8 __attribute__((ext_vector_type(8)));
typedef float f32x4 __attribute__((ext_vector_type(4)));
typedef unsigned u32x4 __attribute__((ext_vector_type(4)));
typedef unsigned u32x2 __attribute__((ext_vector_type(2)));
constexpr int BM = 256, BK = 64, HALF = 128, HTB = HALF * BK * 2, STAGE_BYTES = 8 * HTB, NXCD = 8, WGM = 8;

__host__ __device__ __forceinline__ int lds_byte(int r, int c) { const int st = (r >> 4) * 2 + (c >> 5), rr = r & 15, cc = c & 31, ob = rr * 64 + cc * 2; return st * 1024 + (ob ^ (((ob >> 9) & 1) << 5)); }
__host__ __device__ __forceinline__ void stage_rc(int b, int& R, int& C) { const int st = b / 1024, sb = b % 1024, swz = sb ^ (((sb >> 9) & 1) << 5); R = (st >> 1) * 16 + swz / 64; C = (st & 1) * 32 + (swz % 64) / 2; }
__host__ __device__ __forceinline__ int perm32(int rho) { const int n = rho >> 4, i = rho & 15; return 8 * (i >> 2) + 4 * n + (i & 3); }

struct Unit { int pm, pn, br; };
struct Gemm { const __attribute__((address_space(1))) bf16_t* A; int lda; const __attribute__((address_space(1))) bf16_t* Bt; int ldb; int K; int abr, bbr; };

struct TileOrder {
    int nM, nN, nwg, G, c, nbr;
    __device__ __forceinline__ void init(int M, int N, int G_, int c_, int nbr_) { asm volatile("" : "+s"(G_), "+s"(c_)); nM = M / BM; nN = N / BM; nwg = nM * nN; G = G_; c = c_; nbr = nbr_; }
    __device__ __forceinline__ bool next(int i, Unit& u) const {
        const int it = i / nbr; u.br = i - it * nbr;
        const long L = (long)it * G + c; if (L >= nwg) return false;
        int wgid = (int)L; { const int q = nwg / NXCD, r = nwg % NXCD, xcd = wgid % NXCD, off = wgid / NXCD; wgid = (xcd < r ? xcd * (q + 1) : r * (q + 1) + (xcd - r) * q) + off; }
        const int nig = WGM * nN, gid = wgid / nig, fm = gid * WGM, gsz = (nM - fm) < WGM ? (nM - fm) : WGM;
        u.pm = __builtin_amdgcn_readfirstlane(fm + ((wgid % nig) % gsz)); u.pn = __builtin_amdgcn_readfirstlane((wgid % nig) / gsz); return true;
    }
};

__device__ __forceinline__ unsigned cvt_pk_bf16(float lo, float hi) { unsigned r; asm volatile("v_cvt_pk_bf16_f32 %0, %1, %2" : "=v"(r) : "v"(lo), "v"(hi)); return r; }

template <class Epi, class Sched>
__device__ __forceinline__ void gemm_phase(PG8_LAS unsigned char* lds, const Gemm g, const Sched& S, const Epi& E, int wv) {
    const int tid = opaque_tid(wv), wid = __builtin_amdgcn_readfirstlane(tid >> 6), lane = tid & 63, wr = wid >> 2, wc = wid & 3, fr = lane & 15, fq = lane >> 4;
    const int K = g.K, nt = K / BK;
    unsigned voffA[2], voffB[2];
#pragma unroll
    for (int i = 0; i < 2; ++i) { int R, C; stage_rc(tid * 16 + i * 8192, R, C); const int Rb = (R & ~31) + perm32(R & 31);
        voffA[i] = (unsigned)(R * g.lda + C) * 2u; voffB[i] = (unsigned)(Rb * g.ldb + C) * 2u; }
    const size_t kstep = (size_t)(BK * 2);
    const size_t hstepA = (size_t)HALF * g.lda * 2, hstepB = (size_t)HALF * g.ldb * 2;
    const size_t tstepA = 2 * hstepA, tstepB = 2 * hstepB;
    const unsigned ldsw = (unsigned)wid * 1024u;
    const int aoff = lds_byte(wr * 64 + fr, fq * 8), boff = lds_byte(wc * 32 + fr, fq * 8);
#define PG8_SA(b, h) (((b) * 2 + (h)) * HTB)
#define PG8_SB(b, h) ((4 + (b) * 2 + (h)) * HTB)
#define PG8_STAGE(bufoff, gbase, voff) do { _Pragma("unroll") for (int _i = 0; _i < 2; ++_i) \
        __builtin_amdgcn_global_load_lds((const unsigned*)((const char*)(gbase) + (voff)[_i]), (PG8_LAS unsigned*)(lds + (bufoff) + ldsw + _i * 8192), 16, 0, 0); } while (0)
#define PG8_LDA(dst, b, h) do { _Pragma("unroll") for (int m = 0; m < 4; ++m) _Pragma("unroll") for (int k = 0; k < 2; ++k) dst[m][k] = *(const PG8_LAS bf16x8*)(lds + PG8_SA(b, h) + aoff + m * 2048 + k * 1024); } while (0)
#define PG8_LDB(dst, b, h) do { _Pragma("unroll") for (int n = 0; n < 2; ++n) _Pragma("unroll") for (int k = 0; k < 2; ++k) dst[n][k] = *(const PG8_LAS bf16x8*)(lds + PG8_SB(b, h) + boff + n * 2048 + k * 1024); } while (0)
#define PG8_MMA(ai, bj, At, Bt) do { __builtin_amdgcn_s_setprio(1); _Pragma("unroll") for (int m = 0; m < 4; ++m) _Pragma("unroll") for (int n = 0; n < 2; ++n) _Pragma("unroll") for (int k = 0; k < 2; ++k) \
        acc[ai][bj][m][n] = __builtin_amdgcn_mfma_f32_16x16x32_bf16(Bt[n][k], At[m][k], acc[ai][bj][m][n], 0, 0, 0); __builtin_amdgcn_s_setprio(0); } while (0)
#define PG8_WAIT_V(n) asm volatile("s_waitcnt vmcnt(" #n ")" ::: "memory")
#define PG8_WAIT_L(n) asm volatile("s_waitcnt lgkmcnt(" #n ")" ::: "memory")
#define PG8_BAR __builtin_amdgcn_s_barrier()
#define PG8_SCHED __builtin_amdgcn_sched_barrier(0)
    Unit cur, nxt; int ui = 0;
    if (!S.next(0, cur)) return;
    f32x4 acc[2][2][4][2];
#pragma unroll
    for (int a = 0; a < 2; ++a)
#pragma unroll
        for (int b = 0; b < 2; ++b)
#pragma unroll
            for (int m = 0; m < 4; ++m)
#pragma unroll
                for (int n = 0; n < 2; ++n) acc[a][b][m][n] = (f32x4){0.f, 0.f, 0.f, 0.f};
    bf16x8 At[4][2], B0[2][2], B1[2][2];
    const char* cA = (const char*)g.A + (size_t)cur.pm * tstepA + (size_t)cur.br * g.abr * 2; const char* cB = (const char*)g.Bt + (size_t)cur.pn * tstepB + (size_t)cur.br * g.bbr * 2;
    PG8_STAGE(PG8_SB(0, 0), cB, voffB); PG8_STAGE(PG8_SB(0, 1), cB + hstepB, voffB); PG8_STAGE(PG8_SA(0, 0), cA, voffA); PG8_STAGE(PG8_SA(0, 1), cA + hstepA, voffA);
    if (wr == 1) PG8_BAR;
    PG8_WAIT_V(2); PG8_BAR;
    PG8_STAGE(PG8_SB(1, 0), cB + kstep, voffB); PG8_STAGE(PG8_SA(1, 0), cA + kstep, voffA); PG8_STAGE(PG8_SB(1, 1), cB + hstepB + kstep, voffB);
    PG8_WAIT_V(6); PG8_BAR;
    for (;;) {
        const bool has_next = S.next(ui + 1, nxt);
        const char* nA = has_next ? (const char*)g.A + (size_t)nxt.pm * tstepA + (size_t)nxt.br * g.abr * 2 : cA; const char* nB = has_next ? (const char*)g.Bt + (size_t)nxt.pn * tstepB + (size_t)nxt.br * g.bbr * 2 : cB;
        for (int t = 0; t < nt; t += 2) {
            const bool last = (t == nt - 2);
            const char* a1 = cA + (size_t)(t + 1) * kstep;
            const char* a2 = last ? nA : cA + (size_t)(t + 2) * kstep; const char* b2 = last ? nB : cB + (size_t)(t + 2) * kstep;
            const char* a3 = a2 + kstep; const char* b3 = b2 + kstep;
            PG8_LDB(B0, 0, 0); PG8_LDB(B1, 0, 1); PG8_SCHED; PG8_LDA(At, 0, 0); PG8_STAGE(PG8_SA(1, 1), a1 + hstepA, voffA);
            PG8_WAIT_V(8); PG8_WAIT_L(0); PG8_BAR; PG8_MMA(0, 0, At, B0); PG8_MMA(0, 1, At, B1); PG8_BAR; PG8_SCHED;
            PG8_LDA(At, 0, 1); PG8_STAGE(PG8_SB(0, 0), b2, voffB); PG8_STAGE(PG8_SB(0, 1), b2 + hstepB, voffB); PG8_STAGE(PG8_SA(0, 0), a2, voffA);
            PG8_WAIT_V(8); PG8_WAIT_L(0); PG8_BAR; PG8_MMA(1, 0, At, B0); PG8_MMA(1, 1, At, B1); PG8_BAR; PG8_SCHED;
            PG8_LDB(B0, 1, 0); PG8_LDB(B1, 1, 1); PG8_SCHED; PG8_LDA(At, 1, 0); PG8_STAGE(PG8_SA(0, 1), a2 + hstepA, voffA);
            PG8_WAIT_V(8); PG8_WAIT_L(0); PG8_BAR; PG8_MMA(0, 0, At, B0); PG8_MMA(0, 1, At, B1); PG8_BAR; PG8_SCHED;
            PG8_LDA(At, 1, 1); PG8_STAGE(PG8_SB(1, 0), b3, voffB); PG8_STAGE(PG8_SB(1, 1), b3 + hstepB, voffB); PG8_STAGE(PG8_SA(1, 0), a3, voffA);
            PG8_WAIT_V(8); PG8_WAIT_L(0); PG8_BAR; PG8_MMA(1, 0, At, B0); PG8_MMA(1, 1, At, B1); PG8_BAR; PG8_SCHED;
        }
        if (wr == 0) PG8_BAR;
        E(acc, cur, wr, wc, fr, fq, lds);
        if (!has_next) break;
        if (!Epi::CHAIN || cur.br == S.nbr - 1) {
#pragma unroll
        for (int a = 0; a < 2; ++a)
#pragma unroll
            for (int b = 0; b < 2; ++b)
#pragma unroll
                for (int m = 0; m < 4; ++m)
#pragma unroll
                    for (int n = 0; n < 2; ++n) acc[a][b][m][n] = (f32x4){0.f, 0.f, 0.f, 0.f};
        }
        cur = nxt; cA = nA; cB = nB; ++ui;
        if (wr == 1) PG8_BAR;
    }
    PG8_WAIT_V(0);
    PG8_BAR;
#undef PG8_SA
#undef PG8_SB
#undef PG8_STAGE
#undef PG8_LDA
#undef PG8_LDB
#undef PG8_MMA
#undef PG8_WAIT_V
#undef PG8_WAIT_L
#undef PG8_BAR
#undef PG8_SCHED
}
}

constexpr int NWAVES = 8;
constexpr int DM = 2048, NBATCH = 4, SEQ = 2048, DEPTH = 4, MTOK = NBATCH * SEQ;
constexpr int INW = 13328;
constexpr int NP = 13568;
constexpr int PC_SSM = 0, PC_GQ = 1024, PC_GK = 1536, PC_GV = 2048, PC_GR = 3072, PC_MQ = 4096, PC_MK = 5120, PC_MV = 6144, PC_GS = 7168, PC_GLR = 13312;
constexpr int FFN = 5632, NGU = 2 * FFN;
constexpr int YW = 3072;
constexpr float RMS_EPS = 1e-6f;

constexpr size_t MiB = 1u << 20;
constexpr size_t WS_CTL = 0, CTL_ZERO_BYTES = 1 * MiB;
constexpr size_t SZ_WIN = (size_t)NP * DM * 2, SZ_WGLU = (size_t)1024 * 1024 * 2, SZ_WBR = (size_t)DM * 3072 * 2, SZ_WOUT = (size_t)DM * DM * 2, SZ_WGU = (size_t)NGU * DM * 2, SZ_WDN = (size_t)DM * FFN * 2;
constexpr size_t OFF_WIN = 0, OFF_WGLU = OFF_WIN + SZ_WIN, OFF_WBR = OFF_WGLU + SZ_WGLU, OFF_WOUT = OFF_WBR + SZ_WBR, OFF_WGU = OFF_WOUT + SZ_WOUT, OFF_WDN = OFF_WGU + SZ_WGU, SZ_WLAYER = OFF_WDN + SZ_WDN;
constexpr size_t WS_W = 2 * MiB;
constexpr size_t WS_P = WS_W + ((DEPTH * SZ_WLAYER + MiB - 1) / MiB) * MiB;
constexpr size_t WS_Z = WS_P + (size_t)MTOK * NP * 2;
constexpr size_t WS_Y = WS_Z + (size_t)MTOK * 1024 * 2;
constexpr size_t WS_MG = WS_Y + (size_t)MTOK * YW * 2;
constexpr size_t WS_MB = WS_MG + (size_t)MTOK * DM * 4;
constexpr size_t WS_XR = WS_MB + (size_t)MTOK * DM * 2;
constexpr size_t WS_XB = WS_XR + (size_t)MTOK * DM * 4;
constexpr size_t WS_H = WS_XB + (size_t)MTOK * DM * 2;
constexpr size_t WS_SSQ = WS_H + (size_t)MTOK * FFN * 2;
constexpr size_t WS_EG = WS_SSQ + (size_t)MTOK * 8 * 4;
constexpr size_t WS_OT = WS_EG + (size_t)MTOK * 512 * 4;
constexpr size_t WS_QN = WS_OT + (size_t)4 * MTOK * 1024 * 4;
constexpr size_t WS_KN = WS_QN + (size_t)MTOK * 1024 * 2;
constexpr size_t WS_KM = WS_KN + (size_t)MTOK * 1024 * 2;
constexpr size_t WS_TK = WS_KM + (size_t)4 * 8 * 8 * 128 * 4;
constexpr size_t WS_TW = WS_TK + (size_t)DEPTH * 64 * 64 * 256 * 2;
constexpr size_t WS_TC = WS_TW + (size_t)DEPTH * 64 * 128 * 1024 * 2;
constexpr size_t WS_A64 = WS_TC + (size_t)DEPTH * 64 * 1024 * 128 * 2;
constexpr size_t WS_SL = WS_A64 + (size_t)DEPTH * 64 * 128 * 4;
constexpr size_t WS_QD = WS_SL + (size_t)NBATCH * 32 * 64 * 128 * 4;
constexpr size_t WS_KI = WS_QD + (size_t)512 * 64 * 128 * 2;
constexpr size_t WS_GVT = WS_KI + (size_t)512 * 64 * 128 * 2;
constexpr size_t WS_KV = WS_GVT + (size_t)512 * 256 * 64 * 2;
constexpr size_t WS_DEC = WS_KV + (size_t)512 * 256 * 128 * 4;
constexpr size_t WS_ST = WS_DEC + (size_t)512 * 128 * 4;
constexpr size_t WS_VT = WS_ST + (size_t)512 * 256 * 128 * 2;
constexpr size_t WS_US = WS_VT + (size_t)NBATCH * 8 * 128 * SEQ * 2;
constexpr size_t WS_END = WS_US + (size_t)MTOK * 1024 * 2;
constexpr int CW_BAR = 4096;
constexpr int CW_QUEUE = 16384;

constexpr int RING_BYTES = 135168;
constexpr int LDSCTL_OFF = RING_BYTES, MISC_OFF = LDSCTL_OFF + 320;
constexpr int TAB_OFF = RING_BYTES + 1024;
constexpr int LDS_BYTES = 147456;

#define GAS __attribute__((address_space(1)))
#define LAS __attribute__((address_space(3)))
typedef unsigned short bf16;
typedef unsigned v4u __attribute__((ext_vector_type(4)));
typedef unsigned v2u __attribute__((ext_vector_type(2)));
typedef float f32x4 __attribute__((ext_vector_type(4)));
typedef float f32x2 __attribute__((ext_vector_type(2)));
#define LDS_WAIT() asm volatile("s_waitcnt lgkmcnt(0)" ::: "memory")
#define VM_WAIT() asm volatile("s_waitcnt vmcnt(0)" ::: "memory")
__device__ __forceinline__ unsigned f2bf(float f) { unsigned u = __builtin_bit_cast(unsigned, f); return (u + 0x7fffu + ((u >> 16) & 1u)) >> 16; }
__device__ __forceinline__ unsigned pk2(float lo, float hi) { return f2bf(lo) | (f2bf(hi) << 16); }
__device__ __forceinline__ float bflo(unsigned u) { return __builtin_bit_cast(float, u << 16); }
__device__ __forceinline__ float bfhi(unsigned u) { return __builtin_bit_cast(float, u & 0xffff0000u); }
__device__ __forceinline__ float bf1(bf16 b) { return __builtin_bit_cast(float, ((unsigned)b) << 16); }
__device__ __forceinline__ float sigmoidf_(float x) { return __builtin_amdgcn_rcpf(1.0f + __expf(-x)); }
__device__ __forceinline__ float gelu_tanh(float x) { const float u = 0.7978845608028654f * (x + 0.044715f * x * x * x); return x * sigmoidf_(2.0f * u); }
__device__ __forceinline__ float wave_sum(float v) {
#pragma unroll
    for (int o = 1; o < 64; o <<= 1) v += __shfl_xor(v, o);
    return v;
}
__device__ __forceinline__ float wave_max(float v) {
#pragma unroll
    for (int o = 1; o < 64; o <<= 1) v = fmaxf(v, __shfl_xor(v, o));
    return v;
}

#define XB_TMO      128
#define XB_XCNT(j)  (256  + 64 * (j))
#define XB_XSUB(j)  (1280 + 64 * (j))
#define XB_XGEN(j)  (2304 + 64 * (j))
#define XB_TOP      3328
#define XB_TOPGEN   3392
#define XCD_BAR_WORDS 3456
#define XB_SPIN_CAP (1u << 18)
__device__ __forceinline__ unsigned xb_ld(unsigned* p)              { return __hip_atomic_load(p, __ATOMIC_RELAXED, __HIP_MEMORY_SCOPE_AGENT); }
__device__ __forceinline__ unsigned xb_add(unsigned* p, unsigned v) { return __hip_atomic_fetch_add(p, v, __ATOMIC_RELAXED, __HIP_MEMORY_SCOPE_AGENT); }
__device__ __forceinline__ unsigned xb_xcc_id() { return (unsigned)__builtin_amdgcn_s_getreg((3 << 11) | 20) & 0xFu; }
#define XB_SPIN(cond, bar) do { unsigned _sp = 0; while (cond) { __builtin_amdgcn_s_sleep(1); \
    if ((++_sp & 255u) == 0u) { if (xb_ld(&(bar)[XB_TMO])) break; if (_sp > XB_SPIN_CAP) { atomicAdd(&(bar)[XB_TMO], 1u); break; } } } } while (0)
struct XcdBarrier { unsigned* bar; unsigned x; volatile LAS unsigned* st; };
__device__ __forceinline__ XcdBarrier xcd_barrier_post(unsigned* bar, volatile LAS unsigned* st) {
    XcdBarrier b; b.bar = bar; b.x = xb_xcc_id(); b.st = st;
    if (threadIdx.x == 0) (void)xb_add(&bar[XB_XCNT(b.x)], 1u);
    return b;
}
__device__ __forceinline__ void xcd_barrier_complete(unsigned* bar, unsigned x, unsigned& nloc, unsigned& nx) {
    const unsigned G = gridDim.x * gridDim.y * gridDim.z;
    unsigned sum, cnt, mine, sp = 0u;
    for (;;) {
        sum = 0u; cnt = 0u; mine = 0u;
#pragma unroll
        for (unsigned j = 0; j < 16; ++j) { const unsigned c = xb_ld(&bar[XB_XCNT(j)]); sum += c; cnt += (c > 0u) ? 1u : 0u; mine = (j == x) ? c : mine; }
        if (sum == G) break;
        __builtin_amdgcn_s_sleep(1);
        if ((++sp & 255u) == 0u) { if (xb_ld(&bar[XB_TMO])) break; if (sp > XB_SPIN_CAP) { atomicAdd(&bar[XB_TMO], 1u); break; } }
    }
    nloc = mine > 0u ? mine : 1u; nx = cnt > 0u ? cnt : 1u;
}
__device__ __forceinline__ void xcd_barrier(const XcdBarrier& b, int tid) {
    asm volatile("s_waitcnt vmcnt(0)" ::: "memory");
    __syncthreads();
    if (tid == 0) {
        unsigned* bar = b.bar;
        __builtin_amdgcn_s_waitcnt(0);
        unsigned nloc = b.st[0], nx = b.st[1];
        if (nloc == 0u) { xcd_barrier_complete(bar, b.x, nloc, nx); b.st[0] = nloc; b.st[1] = nx; }
        const unsigned old = xb_add(&bar[XB_XSUB(b.x)], 1u);
        const unsigned gen = old / nloc;
        if (old + 1u == (gen + 1u) * nloc) {
            __builtin_amdgcn_fence(__ATOMIC_RELEASE, "agent");
            asm volatile("s_waitcnt vmcnt(0)" ::: "memory");
            const unsigned og = xb_add(&bar[XB_TOP], 1u);
            const unsigned tg = og / nx;
            if (og + 1u == (tg + 1u) * nx) xb_add(&bar[XB_TOPGEN], 1u);
            else XB_SPIN(xb_ld(&bar[XB_TOPGEN]) == tg, bar);
            __builtin_amdgcn_fence(__ATOMIC_ACQUIRE, "agent");
            xb_add(&bar[XB_XGEN(b.x)], 1u);
            asm volatile("s_waitcnt vmcnt(0)" ::: "memory");
        } else {
            XB_SPIN(xb_ld(&bar[XB_XGEN(b.x)]) == gen, bar);
            __builtin_amdgcn_fence(__ATOMIC_ACQUIRE, "agent");
            asm volatile("s_waitcnt vmcnt(0)" ::: "memory");
        }
    }
    __syncthreads();
}

struct Args {
    const float* in[26];
    float* out; unsigned char* ws;
    int l_lo, l_hi, ph_lo, ph_hi;
    int fused, pad;
};
enum { I_X = 0, I_N1G, I_WIN, I_LRE, I_LIM, I_LDT, I_BRE, I_BIM, I_CRE, I_CIM, I_SD, I_WGLU, I_BGLU, I_GW2, I_GB2, I_GNG, I_MQG, I_MKG, I_WBS, I_WBG, I_WBM, I_WOUT, I_N2G, I_FWG, I_FWU, I_FWD };

namespace pg8 {
#define EPI_FENCE() asm volatile("" ::: "memory")
__device__ __forceinline__ void load_rstd(const GAS float* ssq, int pm, int wr, int fr, int fq, float (&rs)[2][4]) {
    f32x2 p[2][4];
#pragma unroll
    for (int ai = 0; ai < 2; ++ai)
#pragma unroll
        for (int m = 0; m < 4; ++m) { const int row = pm * BM + ai * HALF + wr * 64 + m * 16 + fr; p[ai][m] = *(const GAS f32x2*)(ssq + (size_t)row * 8 + 2 * fq); }
#pragma unroll
    for (int ai = 0; ai < 2; ++ai)
#pragma unroll
        for (int m = 0; m < 4; ++m) { float s = p[ai][m][0] + p[ai][m][1]; s += __shfl_xor(s, 16); s += __shfl_xor(s, 32); rs[ai][m] = 1.0f / sqrtf(s * (1.0f / DM) + RMS_EPS); }
    EPI_FENCE();
}
struct EpiInProj {
    static constexpr bool CHAIN = false;
    GAS bf16_t* P; const GAS float* ssq; GAS bf16_t* US;
    __device__ __forceinline__ void operator()(const f32x4 (&acc)[2][2][4][2], const Unit& u, int wr, int wc, int fr, int fq, PG8_LAS unsigned char*) const {
        float rs[2][4]; load_rstd(ssq, u.pm, wr, fr, fq, rs);
        const int row0 = u.pm * BM + wr * 64 + fr, col0 = u.pn * BM + wc * 32 + 8 * fq;
        const bool ssm = u.pn < 4;
#pragma unroll
        for (int ai = 0; ai < 2; ++ai)
#pragma unroll
            for (int m = 0; m < 4; ++m) { const int row = row0 + ai * HALF + m * 16; GAS bf16_t* rowp = P + (size_t)row * NP + col0; const float r = rs[ai][m];
#pragma unroll
                for (int bj = 0; bj < 2; ++bj) { const f32x4 v0 = acc[ai][bj][m][0] * r, v1 = acc[ai][bj][m][1] * r;
                    u32x4 w; w.x = cvt_pk_bf16(v0[0], v0[1]); w.y = cvt_pk_bf16(v0[2], v0[3]); w.z = cvt_pk_bf16(v1[0], v1[1]); w.w = cvt_pk_bf16(v1[2], v1[3]);
                    if (ssm) { const int col = col0 + bj * HALF; *(GAS u32x4*)(US + ((size_t)((row >> 11) * 64 + (col >> 4)) * SEQ + (row & (SEQ - 1))) * 16 + (col & 8)) = w; }
                    else *(GAS u32x4*)(rowp + bj * HALF) = w; } }
    }
};
struct EpiGLU {
    static constexpr bool CHAIN = false;
    const GAS bf16_t* Z; GAS bf16_t* Y; const GAS float* bias;
    __device__ __forceinline__ void operator()(const f32x4 (&acc)[2][2][4][2], const Unit& u, int wr, int wc, int fr, int fq, PG8_LAS unsigned char*) const {
        const int row0 = u.pm * BM + wr * 64 + fr, col0 = u.pn * BM + wc * 32 + 8 * fq;
        f32x4 bv[2][2];
#pragma unroll
        for (int bj = 0; bj < 2; ++bj)
#pragma unroll
            for (int n = 0; n < 2; ++n) bv[bj][n] = *(const GAS f32x4*)(bias + col0 + bj * HALF + 4 * n);
        u32x4 zb[4][2];
#pragma unroll
        for (int bt = 0; bt < 2; ++bt) {
#pragma unroll
            for (int i4 = 0; i4 < 4; ++i4) { const int idx = 4 * bt + i4; const size_t row = (size_t)(row0 + (idx >> 2) * HALF + (idx & 3) * 16);
#pragma unroll
                for (int bj = 0; bj < 2; ++bj) zb[i4][bj] = *(const GAS u32x4*)(Z + row * 1024 + col0 + bj * HALF); }
#pragma unroll
            for (int i4 = 0; i4 < 4; ++i4) { const int idx = 4 * bt + i4, ai = idx >> 2, m = idx & 3; const size_t row = (size_t)(row0 + ai * HALF + m * 16);
#pragma unroll
                for (int bj = 0; bj < 2; ++bj) { const u32x4 zz = zb[i4][bj];
                    const f32x4 g0 = acc[ai][bj][m][0] + bv[bj][0], g1 = acc[ai][bj][m][1] + bv[bj][1];
                    u32x4 w;
                    w.x = cvt_pk_bf16(bflo(zz.x) * sigmoidf_(g0[0]), bfhi(zz.x) * sigmoidf_(g0[1])); w.y = cvt_pk_bf16(bflo(zz.y) * sigmoidf_(g0[2]), bfhi(zz.y) * sigmoidf_(g0[3]));
                    w.z = cvt_pk_bf16(bflo(zz.z) * sigmoidf_(g1[0]), bfhi(zz.z) * sigmoidf_(g1[1])); w.w = cvt_pk_bf16(bflo(zz.w) * sigmoidf_(g1[2]), bfhi(zz.w) * sigmoidf_(g1[3]));
                    *(GAS u32x4*)(Y + row * YW + col0 + bj * HALF) = w; } }
            EPI_FENCE();
        }
    }
};
struct EpiBranch {
    static constexpr bool CHAIN = true;
    const GAS bf16_t* P; GAS bf16_t* MB;
    __device__ __forceinline__ void operator()(f32x4 (&acc)[2][2][4][2], const Unit& u, int wr, int wc, int fr, int fq, PG8_LAS unsigned char*) const {
        const int row0 = u.pm * BM + wr * 64 + fr, col0 = u.pn * BM + wc * 32 + 8 * fq;
        const int br = u.br;
        u32x4 ga[2][2], gb[2][2];
#pragma unroll
        for (int bt = 0; bt < 4; ++bt) {
#pragma unroll
            for (int i4 = 0; i4 < 2; ++i4) { const int idx = 2 * bt + i4; const size_t row = (size_t)(row0 + (idx >> 2) * HALF + (idx & 3) * 16);
#pragma unroll
                for (int bj = 0; bj < 2; ++bj) { const GAS bf16_t* gp = P + row * NP + PC_GS + br * DM + col0 + bj * HALF; ga[i4][bj] = *(const GAS u32x4*)gp; if (br != 2) gb[i4][bj] = *(const GAS u32x4*)(gp + DM); } }
#pragma unroll
            for (int i4 = 0; i4 < 2; ++i4) { const int idx = 2 * bt + i4, ai = idx >> 2, m = idx & 3; const size_t row = (size_t)(row0 + ai * HALF + m * 16);
#pragma unroll
                for (int bj = 0; bj < 2; ++bj) { const u32x4 g0 = ga[i4][bj]; const unsigned g0w[4] = {g0.x, g0.y, g0.z, g0.w}; float f[8];
                    if (br != 2) { const u32x4 g1 = gb[i4][bj]; const unsigned g1w[4] = {g1.x, g1.y, g1.z, g1.w};
#pragma unroll
                        for (int e = 0; e < 4; ++e) { f[2 * e] = (1.0f + __expf(-bflo(g1w[e]))) * __builtin_amdgcn_rcpf(1.0f + __expf(-bflo(g0w[e]))); f[2 * e + 1] = (1.0f + __expf(-bfhi(g1w[e]))) * __builtin_amdgcn_rcpf(1.0f + __expf(-bfhi(g0w[e]))); } }
                    else {
#pragma unroll
                        for (int e = 0; e < 4; ++e) { f[2 * e] = sigmoidf_(bflo(g0w[e])); f[2 * e + 1] = sigmoidf_(bfhi(g0w[e])); } }
                    f32x4 v0 = acc[ai][bj][m][0], v1 = acc[ai][bj][m][1];
                    v0[0] *= f[0]; v0[1] *= f[1]; v0[2] *= f[2]; v0[3] *= f[3]; v1[0] *= f[4]; v1[1] *= f[5]; v1[2] *= f[6]; v1[3] *= f[7];
                    if (br != 2) { acc[ai][bj][m][0] = v0; acc[ai][bj][m][1] = v1; }
                    else { u32x4 w; w.x = cvt_pk_bf16(v0[0], v0[1]); w.y = cvt_pk_bf16(v0[2], v0[3]); w.z = cvt_pk_bf16(v1[0], v1[1]); w.w = cvt_pk_bf16(v1[2], v1[3]); *(GAS u32x4*)(MB + row * DM + col0 + bj * HALF) = w; } } }
            EPI_FENCE();
        }
    }
};
template <bool FIRST, bool LAST> struct EpiResid {
    static constexpr bool CHAIN = false;
    const GAS float* xin; GAS float* xout; GAS bf16_t* XB; GAS float* ssq;
    __device__ __forceinline__ void operator()(const f32x4 (&acc)[2][2][4][2], const Unit& u, int wr, int wc, int fr, int fq, PG8_LAS unsigned char* lds) const {
        const int row0 = u.pm * BM + wr * 64 + fr, col0 = u.pn * BM + wc * 32 + 8 * fq;
        PG8_LAS float* T = (PG8_LAS float*)(lds + TAB_OFF);
        f32x4 xf[FIRST ? 4 : 1][2][2]; u32x4 xh[FIRST ? 1 : 8][2];
#pragma unroll
        for (int bt = 0; bt < (FIRST ? 2 : 1); ++bt) {
#pragma unroll
            for (int i4 = 0; i4 < (FIRST ? 4 : 8); ++i4) { const int idx = (FIRST ? 4 * bt : 0) + i4; const size_t row = (size_t)(row0 + (idx >> 2) * HALF + (idx & 3) * 16);
#pragma unroll
                for (int bj = 0; bj < 2; ++bj) { const size_t o = row * DM + col0 + bj * HALF;
                    if (FIRST) { xf[i4 & 3][bj][0] = *(const GAS f32x4*)(xin + o); xf[i4 & 3][bj][1] = *(const GAS f32x4*)(xin + o + 4); } else xh[FIRST ? 0 : i4][bj] = *(const GAS u32x4*)(XB + o); } }
#pragma unroll
            for (int i4 = 0; i4 < (FIRST ? 4 : 8); ++i4) { const int idx = (FIRST ? 4 * bt : 0) + i4, ai = idx >> 2, m = idx & 3; const size_t row = (size_t)(row0 + ai * HALF + m * 16); float s = 0.f;
#pragma unroll
                for (int bj = 0; bj < 2; ++bj) { const size_t o = row * DM + col0 + bj * HALF; f32x4 v0, v1;
                    if (FIRST) { v0 = acc[ai][bj][m][0] + xf[i4 & 3][bj][0]; v1 = acc[ai][bj][m][1] + xf[i4 & 3][bj][1]; }
                    else { const u32x4 h = xh[FIRST ? 0 : i4][bj]; v0 = acc[ai][bj][m][0] + (f32x4){bflo(h.x), bfhi(h.x), bflo(h.y), bfhi(h.y)}; v1 = acc[ai][bj][m][1] + (f32x4){bflo(h.z), bfhi(h.z), bflo(h.w), bfhi(h.w)}; }
                    if (LAST) { *(GAS f32x4*)(xout + o) = v0; *(GAS f32x4*)(xout + o + 4) = v1; }
                    else { u32x4 w; w.x = cvt_pk_bf16(v0[0], v0[1]); w.y = cvt_pk_bf16(v0[2], v0[3]); w.z = cvt_pk_bf16(v1[0], v1[1]); w.w = cvt_pk_bf16(v1[2], v1[3]); *(GAS u32x4*)(XB + o) = w;
                        v0 = (f32x4){bflo(w.x), bfhi(w.x), bflo(w.y), bfhi(w.y)}; v1 = (f32x4){bflo(w.z), bfhi(w.z), bflo(w.w), bfhi(w.w)}; }
                    s += (v0[0] * v0[0] + v0[1] * v0[1]) + (v0[2] * v0[2] + v0[3] * v0[3]) + (v1[0] * v1[0] + v1[1] * v1[1]) + (v1[2] * v1[2] + v1[3] * v1[3]); }
                if (!LAST) { s += __shfl_xor(s, 16); s += __shfl_xor(s, 32);
                    if (fq == 0) T[(ai * HALF + wr * 64 + m * 16 + fr) * 4 + wc] = s; } }
            EPI_FENCE();
        }
        if (!LAST) {
            asm volatile("s_waitcnt lgkmcnt(0)" ::: "memory"); __builtin_amdgcn_s_barrier(); asm volatile("" ::: "memory");
            const int t = (wr * 4 + wc) * 64 + fq * 16 + fr;
            if (t < 256) { const f32x4 p = *(const PG8_LAS f32x4*)(T + t * 4); ssq[(size_t)(u.pm * BM + t) * 8 + u.pn] = (p[0] + p[1]) + (p[2] + p[3]); }
        }
    }
};
struct EpiFFNUp {
    static constexpr bool CHAIN = false;
    GAS bf16_t* H; const GAS float* ssq;
    __device__ __forceinline__ void operator()(const f32x4 (&acc)[2][2][4][2], const Unit& u, int wr, int wc, int fr, int fq, PG8_LAS unsigned char*) const {
        float rs[2][4]; load_rstd(ssq, u.pm, wr, fr, fq, rs);
        const int row0 = u.pm * BM + wr * 64 + fr, col0 = u.pn * HALF + wc * 32 + 8 * fq;
#pragma unroll
        for (int ai = 0; ai < 2; ++ai)
#pragma unroll
            for (int m = 0; m < 4; ++m) { const float r = rs[ai][m]; float h[8];
#pragma unroll
                for (int n = 0; n < 2; ++n)
#pragma unroll
                    for (int e = 0; e < 4; ++e) { const float gv = acc[ai][0][m][n][e] * r, uv = acc[ai][1][m][n][e] * r; h[n * 4 + e] = gv * sigmoidf_(gv) * uv; }
                u32x4 w; w.x = cvt_pk_bf16(h[0], h[1]); w.y = cvt_pk_bf16(h[2], h[3]); w.z = cvt_pk_bf16(h[4], h[5]); w.w = cvt_pk_bf16(h[6], h[7]);
                *(GAS u32x4*)(H + (size_t)(row0 + ai * HALF + m * 16) * FFN + col0) = w; }
    }
};
}

struct Frame {
    __device__ __forceinline__ void refresh() { ws = (GAS unsigned char*)opaque_ptr(ws0); tid = opaque_tid(wv); lane = tid & 63; wave = __builtin_amdgcn_readfirstlane(tid >> 6); }
    LAS unsigned char* lds;
    volatile LAS unsigned* MISC;
    unsigned* ctl;
    int tid, lane, wave, G, wv;
    const float* const* in;
    GAS unsigned char* ws; unsigned char* ws0;
};

__device__ __forceinline__ void conv_item(const GAS float* W, int ldw, int k0, int src_c0, int nvalid, const GAS float* gk, GAS bf16* WT, int ldt, int dst_r0, int dst_k, LAS float* scr, int lane) {
    const int c4 = 4 * (lane & 15), rq = lane >> 4;
    f32x4 v[16];
#pragma unroll
    for (int i = 0; i < 16; ++i) { const int kk = 4 * i + rq; v[i] = (c4 < nvalid) ? __builtin_nontemporal_load((const GAS f32x4*)(W + (size_t)(k0 + kk) * ldw + src_c0 + c4)) : (f32x4){0.f, 0.f, 0.f, 0.f}; }
    if (gk) {
#pragma unroll
        for (int i = 0; i < 16; ++i) v[i] = v[i] * gk[k0 + 4 * i + rq]; }
#pragma unroll
    for (int i = 0; i < 16; ++i) { LAS float* d = scr + (4 * i + rq) * 65 + c4; d[0] = v[i][0]; d[1] = v[i][1]; d[2] = v[i][2]; d[3] = v[i][3]; }
    LDS_WAIT(); asm volatile("" ::: "memory");
    const int c8 = lane & 7;
#pragma unroll
    for (int j = 0; j < 8; ++j) { const int n = (lane >> 3) + 8 * j; const LAS float* sp = scr + (8 * c8) * 65 + n;
        v4u o; o.x = pk2(sp[0 * 65], sp[1 * 65]); o.y = pk2(sp[2 * 65], sp[3 * 65]); o.z = pk2(sp[4 * 65], sp[5 * 65]); o.w = pk2(sp[6 * 65], sp[7 * 65]);
        *(GAS v4u*)(WT + (size_t)(dst_r0 + n) * ldt + dst_k + 8 * c8) = o; }
    LDS_WAIT(); asm volatile("" ::: "memory");
}
constexpr int CV_NB_IN = NP / 64, CV_NB_FF = FFN / 64;
constexpr int CV_I_IN = 32 * CV_NB_IN, CV_I_GLU = 16 * 16, CV_I_BR = 3 * 16 * 32, CV_I_OUT = 32 * 32, CV_I_GU = 2 * 32 * CV_NB_FF, CV_I_DN = CV_NB_FF * 32;
constexpr int CV_I_LAYER = CV_I_IN + CV_I_GLU + CV_I_BR + CV_I_OUT + CV_I_GU + CV_I_DN;
constexpr int CV_Q1 = 4, CV_Q7 = 4;
__device__ __forceinline__ void conv_layer_item(Frame& F, int l, int r, LAS float* scr, int lane) {
    GAS unsigned char* wl = F.ws + WS_W + (size_t)l * SZ_WLAYER;
    if (r < CV_I_IN) { const int nb = r % CV_NB_IN, kb = r / CV_NB_IN, n0 = 64 * nb; int src, nv;
        if (n0 < 4096) { src = n0; nv = 64; } else if (n0 < PC_GLR) { src = n0 + 16; nv = 64; } else if (n0 == PC_GLR) { src = 4096; nv = 16; } else { src = 0; nv = 0; }
        conv_item(((const GAS float*)F.in[I_WIN]) + (size_t)l * DM * INW, INW, 64 * kb, src, nv, ((const GAS float*)F.in[I_N1G]) + l * DM, (GAS bf16*)(wl + OFF_WIN), DM, n0, 64 * kb, scr, lane); return; } r -= CV_I_IN;
    if (r < CV_I_GLU) { const int nb = r % 16, kb = r / 16;
        conv_item(((const GAS float*)F.in[I_WGLU]) + (size_t)l * 1024 * 1024, 1024, 64 * kb, 64 * nb, 64, nullptr, (GAS bf16*)(wl + OFF_WGLU), 1024, 64 * nb, 64 * kb, scr, lane); return; } r -= CV_I_GLU;
    if (r < CV_I_BR) { const int br = r / (16 * 32), rr = r % (16 * 32), nb = rr % 32, kb = rr / 32;
        conv_item(((const GAS float*)F.in[I_WBS + br]) + (size_t)l * 1024 * DM, DM, 64 * kb, 64 * nb, 64, nullptr, (GAS bf16*)(wl + OFF_WBR), 3072, 64 * nb, br * 1024 + 64 * kb, scr, lane); return; } r -= CV_I_BR;
    if (r < CV_I_OUT) { const int nb = r % 32, kb = r / 32;
        conv_item(((const GAS float*)F.in[I_WOUT]) + (size_t)l * DM * DM, DM, 64 * kb, 64 * nb, 64, nullptr, (GAS bf16*)(wl + OFF_WOUT), DM, 64 * nb, 64 * kb, scr, lane); return; } r -= CV_I_OUT;
    if (r < CV_I_GU) { const int sel = r / (32 * CV_NB_FF), rr = r % (32 * CV_NB_FF), nb = rr % CV_NB_FF, kb = rr / CV_NB_FF, j0 = 64 * nb;
        conv_item(((const GAS float*)F.in[I_FWG + sel]) + (size_t)l * DM * FFN, FFN, 64 * kb, j0, 64, ((const GAS float*)F.in[I_N2G]) + l * DM, (GAS bf16*)(wl + OFF_WGU), DM, (j0 / 128) * 256 + sel * 128 + (j0 % 128), 64 * kb, scr, lane); return; } r -= CV_I_GU;
    { const int nb = r % 32, kb = r / 32;
        conv_item(((const GAS float*)F.in[I_FWD]) + (size_t)l * FFN * DM, DM, 64 * kb, 64 * nb, 64, nullptr, (GAS bf16*)(wl + OFF_WDN), FFN, 64 * nb, 64 * kb, scr, lane); }
}
__device__ __forceinline__ int cv_ntail(int nwg, int G) { const int nr = (nwg + G - 1) / G; return nr * G - nwg; }
__device__ __forceinline__ void cv_split(int G, int& R, int& T1) {
    const int t1 = cv_ntail((MTOK / 256) * (NP / 256), G) * NWAVES * CV_Q1, t7 = cv_ntail((MTOK / 256) * (NGU / 256), G) * NWAVES * CV_Q7;
    int r = CV_I_LAYER - t1 - t7; int tt1 = t1; if (r < 0) { r = 0; tt1 = t1 < CV_I_LAYER ? t1 : CV_I_LAYER; }
    R = r; T1 = tt1;
}
__device__ __forceinline__ void cv_tail(Frame& F, int l, int which) {
    if (l + 1 >= DEPTH) return;
    const int nwg = (MTOK / 256) * ((which ? NGU : NP) / 256), ntail = cv_ntail(nwg, F.G), first = F.G - ntail;
    if ((int)blockIdx.x < first) return;
    int R, T1; cv_split(F.G, R, T1);
    const int lo = which ? R + T1 : R, hi = which ? CV_I_LAYER : R + T1;
    LAS float* scr = (LAS float*)(F.lds + F.wave * 16896);
    for (int r = lo + ((int)blockIdx.x - first) * NWAVES + F.wave; r < hi; r += ntail * NWAVES) conv_layer_item(F, l + 1, r, scr, F.lane);
}
__device__ __forceinline__ void s5_tables_unit(Frame& F, int lg);
__device__ __forceinline__ void p0_prologue(Frame& F) {
    LAS float* scr = (LAS float*)(F.lds + F.wave * 16896);
    const int gw = blockIdx.x * NWAVES + F.wave, NGW = F.G * NWAVES, lane = F.lane;
#if S5_MFMA
    for (int lg = blockIdx.x; lg < DEPTH * 64; lg += F.G) s5_tables_unit(F, lg);
#endif
    int R, T1; cv_split(F.G, R, T1);
    for (int it = gw; it < CV_I_LAYER + (DEPTH - 1) * R; it += NGW) {
        int l, r; if (it < CV_I_LAYER) { l = 0; r = it; } else { const int q = it - CV_I_LAYER; l = 1 + q / R; r = q - (l - 1) * R; }
        conv_layer_item(F, l, r, scr, lane);
    }
    const GAS float* x = ((const GAS float*)F.in[I_X]); GAS bf16* XB = (GAS bf16*)(F.ws + WS_XB); GAS float* ssq = (GAS float*)(F.ws + WS_SSQ);
    for (int m = gw; m < MTOK; m += NGW) {
        const GAS f32x4* xr = (const GAS f32x4*)(x + (size_t)m * DM) + lane; float s = 0.f;
        GAS v2u* o8 = (GAS v2u*)(XB + (size_t)m * DM) + lane;
#pragma unroll
        for (int j = 0; j < 8; ++j) { const f32x4 v = xr[64 * j]; s += (v[0] * v[0] + v[1] * v[1]) + (v[2] * v[2] + v[3] * v[3]); v2u w; w.x = pk2(v[0], v[1]); w.y = pk2(v[2], v[3]); o8[64 * j] = w; }
        s = wave_sum(s);
        if (lane < 8) ssq[(size_t)m * 8 + lane] = (lane == 0) ? s : 0.f;
    }
}

__device__ __forceinline__ void p2a_naive(Frame& F, int l) {
    const GAS bf16* P = (const GAS bf16*)(F.ws + WS_P);
    const int lane = F.lane;
    if (!GLA_MFMA) { GAS float* EG = (GAS float*)(F.ws + WS_EG); const GAS float* w2 = ((const GAS float*)F.in[I_GW2]) + (size_t)l * 16 * 512; const GAS float* b2 = ((const GAS float*)F.in[I_GB2]) + l * 512;
      for (int idx = blockIdx.x * 512 + F.tid; idx < MTOK * 512; idx += F.G * 512) { const int tok = idx >> 9, dk = idx & 511;
          const v4u g0 = *(const GAS v4u*)(P + (size_t)tok * NP + PC_GLR), g1 = *(const GAS v4u*)(P + (size_t)tok * NP + PC_GLR + 8);
          const unsigned gw_[8] = {g0.x, g0.y, g0.z, g0.w, g1.x, g1.y, g1.z, g1.w}; float a = b2[dk];
#pragma unroll
          for (int r = 0; r < 8; ++r) { a += bflo(gw_[r]) * w2[(2 * r) * 512 + dk]; a += bfhi(gw_[r]) * w2[(2 * r + 1) * 512 + dk]; }
          const float ls = fminf(a, 0.f) - log1pf(__expf(-fabsf(a)));
          EG[idx] = __expf(ls * (1.0f / 16.0f)); } }
    if (!MOBA_MFMA) { GAS bf16* QN = (GAS bf16*)(F.ws + WS_QN); GAS bf16* KN = (GAS bf16*)(F.ws + WS_KN); const GAS float* qg = ((const GAS float*)F.in[I_MQG]) + l * 128; const GAS float* kg = ((const GAS float*)F.in[I_MKG]) + l * 128;
      const int gw = blockIdx.x * NWAVES + F.wave, NGW = F.G * NWAVES;
      const float g0q = qg[2 * lane] * 0.08838834764831845f, g1q = qg[2 * lane + 1] * 0.08838834764831845f, g0k = kg[2 * lane], g1k = kg[2 * lane + 1];
      for (int it = gw; it < MTOK * 8 * 2; it += NGW) { const int which = it & 1, th = it >> 1, tok = th >> 3, h = th & 7;
          const unsigned w = *(const GAS unsigned*)(P + (size_t)tok * NP + (which ? PC_MK : PC_MQ) + h * 128 + 2 * lane);
          const float x0 = bflo(w), x1 = bfhi(w); const float ss = wave_sum(x0 * x0 + x1 * x1); const float r = 1.0f / sqrtf(ss * (1.0f / 128.0f) + RMS_EPS);
          *(GAS unsigned*)((which ? KN : QN) + (size_t)tok * 1024 + h * 128 + 2 * lane) = which ? pk2(x0 * r * g0k, x1 * r * g1k) : pk2(x0 * r * g0q, x1 * r * g1q); }
      GAS float* KM = (GAS float*)(F.ws + WS_KM);
      for (int it = gw; it < 4 * 8 * 8; it += NGW) { const int kb = it & 7, h = (it >> 3) & 7, b = it >> 6; float a0 = 0.f, a1 = 0.f;
          for (int j = 0; j < 256; ++j) { const int tok = b * SEQ + kb * 256 + j; const unsigned w = *(const GAS unsigned*)(P + (size_t)tok * NP + PC_MK + h * 128 + 2 * lane);
              const float x0 = bflo(w), x1 = bfhi(w); const float ss = wave_sum(x0 * x0 + x1 * x1); const float r = 1.0f / sqrtf(ss * (1.0f / 128.0f) + RMS_EPS); a0 += x0 * r * g0k; a1 += x1 * r * g1k; }
          *(GAS f32x2*)(KM + (size_t)it * 128 + 2 * lane) = (f32x2){a0 * (1.0f / 256.0f), a1 * (1.0f / 256.0f)}; } }
}

__device__ __forceinline__ void s5_naive_item(Frame& F, int l, int item, LAS float* scr) {
    const int lane = F.lane, b = item >> 6, g = item & 63, lg = l * 64 + g;
    const GAS bf16* P = (const GAS bf16*)(F.ws + WS_P); GAS bf16* Z = (GAS bf16*)(F.ws + WS_Z);
    const float lre = ((const GAS float*)F.in[I_LRE])[lg * 64 + lane], lim = ((const GAS float*)F.in[I_LIM])[lg * 64 + lane], dt = expf(((const GAS float*)F.in[I_LDT])[lg]);
    const float mag = expf(lre * dt), ang = lim * dt, ar = mag * cosf(ang), ai = mag * sinf(ang);
    const float den = lre * lre + lim * lim, nre = ar - 1.0f, nim = ai;
    const float zre = (nre * lre + nim * lim) / den, zim = (nim * lre - nre * lim) / den;
    float bbr[16], bbi[16], cr[16], ci[16];
#pragma unroll
    for (int c = 0; c < 16; ++c) { const float br_ = ((const GAS float*)F.in[I_BRE])[(size_t)(lg * 64 + lane) * 16 + c], bi_ = ((const GAS float*)F.in[I_BIM])[(size_t)(lg * 64 + lane) * 16 + c];
        bbr[c] = zre * br_ - zim * bi_; bbi[c] = zre * bi_ + zim * br_;
        cr[c] = ((const GAS float*)F.in[I_CRE])[(size_t)(lg * 16 + c) * 64 + lane]; ci[c] = ((const GAS float*)F.in[I_CIM])[(size_t)(lg * 16 + c) * 64 + lane]; }
    const float dsk = ((const GAS float*)F.in[I_SD])[l * 1024 + g * 16 + (lane & 15)];
    float xr = 0.f, xi = 0.f;
    const int cc = lane & 15, qq = lane >> 4;
    for (int t0 = 0; t0 < SEQ; t0 += 4) {
        v4u ub[4][2];
#pragma unroll
        for (int s = 0; s < 4; ++s) { const GAS bf16* up = P + (size_t)(b * SEQ + t0 + s) * NP + PC_SSM + g * 16; ub[s][0] = *(const GAS v4u*)up; ub[s][1] = *(const GAS v4u*)(up + 8); }
#pragma unroll
        for (int s = 0; s < 4; ++s) {
            const unsigned uw[8] = {ub[s][0].x, ub[s][0].y, ub[s][0].z, ub[s][0].w, ub[s][1].x, ub[s][1].y, ub[s][1].z, ub[s][1].w};
            float bur = 0.f, bui = 0.f;
#pragma unroll
            for (int c = 0; c < 8; ++c) { const float u0 = bflo(uw[c]), u1 = bfhi(uw[c]); bur += bbr[2 * c] * u0 + bbr[2 * c + 1] * u1; bui += bbi[2 * c] * u0 + bbi[2 * c + 1] * u1; }
            const float nxr = ar * xr - ai * xi + bur, nxi = ar * xi + ai * xr + bui; xr = nxr; xi = nxi;
#pragma unroll
            for (int c = 0; c < 16; ++c) scr[c * 65 + lane] = cr[c] * xr - ci[c] * xi;
            LDS_WAIT();
            float sum = 0.f;
#pragma unroll
            for (int j = 0; j < 16; ++j) sum += scr[cc * 65 + qq * 16 + j];
            LDS_WAIT();
            sum += __shfl_xor(sum, 16); sum += __shfl_xor(sum, 32);
            const size_t row = (size_t)(b * SEQ + t0 + s);
            if (lane < 16) { const float uv = bf1(P[row * NP + PC_SSM + g * 16 + lane]); const float y = sum + dsk * uv; Z[row * 1024 + g * 16 + lane] = (bf16)f2bf(gelu_tanh(y)); }
        }
    }
}
__device__ __forceinline__ void gla_naive_item(Frame& F, int item, LAS float* scr) {
    const int lane = F.lane, hf = item & 3, qt = (item >> 2) & 3, h = (item >> 4) & 3, b = item >> 6;
    const GAS bf16* P = (const GAS bf16*)(F.ws + WS_P); const GAS float* EG = (const GAS float*)(F.ws + WS_EG); GAS float* OT = (GAS float*)(F.ws + WS_OT) + (size_t)hf * MTOK * 1024;
    float S[32];
#pragma unroll
    for (int i = 0; i < 32; ++i) S[i] = 0.f;
    const int l32 = lane & 31;
    const GAS bf16* pq = P + (size_t)(b * SEQ) * NP + PC_GQ + h * 128 + hf * 32 + l32; const GAS bf16* pv = P + (size_t)(b * SEQ) * NP + PC_GV + h * 256 + qt * 64 + lane;
    const GAS float* pe = EG + (size_t)(b * SEQ) * 512 + h * 128 + hf * 32 + l32; GAS float* po = OT + (size_t)(b * SEQ) * 1024 + h * 256 + qt * 64 + lane;
    for (int t0 = 0; t0 < SEQ; t0 += 2) {
        float qw[2], kw[2], ew[2]; bf16 vw[2];
#pragma unroll
        for (int s = 0; s < 2; ++s) { qw[s] = bf1(pq[(size_t)s * NP]); kw[s] = bf1(pq[(size_t)s * NP + (PC_GK - PC_GQ)]); ew[s] = pe[s * 512]; vw[s] = pv[(size_t)s * NP]; }
#pragma unroll
        for (int s = 0; s < 2; ++s) {
            if (lane < 32) { scr[lane] = qw[s]; scr[32 + lane] = kw[s]; scr[64 + lane] = ew[s]; }
            LDS_WAIT();
            const float v = bf1(vw[s]); float o = 0.f;
#pragma unroll
            for (int d = 0; d < 32; d += 4) { const f32x4 q4 = *(const LAS f32x4*)(scr + d), k4 = *(const LAS f32x4*)(scr + 32 + d), e4 = *(const LAS f32x4*)(scr + 64 + d);
#pragma unroll
                for (int e = 0; e < 4; ++e) { S[d + e] = e4[e] * S[d + e] + k4[e] * v; o += q4[e] * S[d + e]; }
                if ((d & 4) != 0) asm volatile("" ::: "memory"); }
            LDS_WAIT();
            po[s * 1024] = o * 0.08838834764831845f;
        }
        pq += 2 * (size_t)NP; pv += 2 * (size_t)NP; pe += 2 * 512; po += 2 * 1024;
    }
}
__device__ __forceinline__ void moba_naive_query(Frame& F, int qi, LAS float* scr) {
    const int lane = F.lane, t = qi & (SEQ - 1), h = (qi >> 11) & 7, b = qi >> 14, qb = t >> 8;
    const GAS bf16* P = (const GAS bf16*)(F.ws + WS_P); const GAS bf16* QN = (const GAS bf16*)(F.ws + WS_QN); const GAS bf16* KN = (const GAS bf16*)(F.ws + WS_KN); const GAS float* KM = (const GAS float*)(F.ws + WS_KM);
    GAS bf16* Y = (GAS bf16*)(F.ws + WS_Y);
    const unsigned qw = *(const GAS unsigned*)(QN + (size_t)(b * SEQ + t) * 1024 + h * 128 + 2 * lane);
    const float q0 = bflo(qw), q1 = bfhi(qw);
    *(LAS f32x2*)(scr + 2 * lane) = (f32x2){q0, q1};
    LDS_WAIT();
    float sc[8]; unsigned selmask = 0u;
#pragma unroll
    for (int kb = 0; kb < 8; ++kb) { const f32x2 km = *(const GAS f32x2*)(KM + (size_t)(((b * 8 + h) * 8 + kb) * 128) + 2 * lane); const float d = wave_sum(q0 * km[0] + q1 * km[1]); sc[kb] = (kb < qb) ? d : -__builtin_inff(); }
#pragma unroll
    for (int kb = 0; kb < 8; ++kb) { int rank = 0;
#pragma unroll
        for (int j = 0; j < 8; ++j) if (j != kb) rank += ((j < qb) && (sc[j] > sc[kb] || (sc[j] == sc[kb] && j < kb))) ? 1 : 0;
        if (kb < qb && rank < 3) selmask |= 1u << kb; }
    selmask |= 1u << qb;
    float m = -__builtin_inff(), lsum = 0.f, o0 = 0.f, o1 = 0.f;
    for (int kb = 0; kb <= qb; ++kb) {
        if (!((selmask >> kb) & 1u)) continue;
        for (int tile = 0; tile < 4; ++tile) {
            const int key0 = kb * 256 + tile * 64; if (key0 > t) break;
            const int key = key0 + lane;
            const GAS v4u* kp = (const GAS v4u*)(KN + (size_t)(b * SEQ + key) * 1024 + h * 128);
            float s = 0.f;
#pragma unroll
            for (int c = 0; c < 16; ++c) { if (c == 8) asm volatile("" ::: "memory"); const v4u kk = kp[c]; const f32x4 qa = *(const LAS f32x4*)(scr + 8 * c), qb4 = *(const LAS f32x4*)(scr + 8 * c + 4);
                s += qa[0] * bflo(kk.x) + qa[1] * bfhi(kk.x) + qa[2] * bflo(kk.y) + qa[3] * bfhi(kk.y) + qb4[0] * bflo(kk.z) + qb4[1] * bfhi(kk.z) + qb4[2] * bflo(kk.w) + qb4[3] * bfhi(kk.w); }
            if (key > t) s = -__builtin_inff();
            const float mnew = fmaxf(m, wave_max(s)); const float p = __expf(s - mnew), corr = __expf(m - mnew);
            lsum = lsum * corr + wave_sum(p); o0 *= corr; o1 *= corr; m = mnew;
            const GAS bf16* vp = P + (size_t)(b * SEQ + key0) * NP + PC_MV + h * 128 + 2 * lane;
#pragma unroll 16
            for (int j = 0; j < 64; ++j) { const float pj = __shfl(p, j); const unsigned vw = *(const GAS unsigned*)(vp + (size_t)j * NP); o0 += pj * bflo(vw); o1 += pj * bfhi(vw); }
        }
    }
    LDS_WAIT();
    const float inv = 1.0f / lsum;
    *(GAS unsigned*)(Y + (size_t)(b * SEQ + t) * YW + 2048 + h * 128 + 2 * lane) = pk2(o0 * inv, o1 * inv);
}
__device__ __forceinline__ void p2b_naive(Frame& F, int l) {
    { F.refresh(); LAS float* scr = (LAS float*)(F.lds + F.wave * 16384);
#if !S5_MFMA
      if (F.wave == 0) for (int it = blockIdx.x; it < 256; it += F.G) s5_naive_item(F, l, it, scr);
#endif
      (void)scr; }
    { F.refresh(); LAS float* scr = (LAS float*)(F.lds + F.wave * 16384);
#if !GLA_MFMA
      if (F.wave == 1) for (int it = blockIdx.x; it < 256; it += F.G) gla_naive_item(F, it, scr);
#endif
      (void)scr; }
    { F.refresh(); LAS float* scr = (LAS float*)(F.lds + F.wave * 16384);
      GAS unsigned* head = (GAS unsigned*)(F.ctl + CW_QUEUE + 64 * l);
      for (;;) {
          unsigned qi = 0; if (F.lane == 0) qi = __hip_atomic_fetch_add(head, 1u, __ATOMIC_RELAXED, __HIP_MEMORY_SCOPE_AGENT);
          qi = __builtin_amdgcn_readfirstlane(qi);
          if (qi >= (unsigned)(NBATCH * 8 * SEQ)) break;
          moba_naive_query(F, (int)qi, scr);
      } }
}

#if PROBE2
#define PR_STAMP(k) do { if (blockIdx.x == 0 && F.tid == 0) { volatile LAS unsigned long long* sl_ = (volatile LAS unsigned long long*)(F.lds + MISC_OFF + 64) + (k); if (*sl_ == 0ull) *sl_ = wall_clock64(); } } while (0)
#else
#define PR_STAMP(k) do { } while (0)
#endif
typedef short bf16x8_t __attribute__((ext_vector_type(8)));
__device__ __forceinline__ f32x4 mma16(bf16x8_t a, bf16x8_t b, f32x4 c) { return __builtin_amdgcn_mfma_f32_16x16x32_bf16(a, b, c, 0, 0, 0); }
constexpr int S5_USTR = 2064;
constexpr int S5_XSTR = 272;
__device__ __forceinline__ void s5_tables_unit(Frame& F, int lg) {
    LAS float* APr = (LAS float*)F.lds; LAS float* APi = APr + 65 * 64; LAS float* BBr = APi + 65 * 64; LAS float* BBi = BBr + 1024; LAS float* CCr = BBi + 1024; LAS float* CCi = CCr + 1024;
    const int tid = F.tid;
    const GAS float* lre_ = ((const GAS float*)F.in[I_LRE]) + lg * 64; const GAS float* lim_ = ((const GAS float*)F.in[I_LIM]) + lg * 64; const double dt = exp((double)((const GAS float*)F.in[I_LDT])[lg]);
    for (int idx = tid; idx < 65 * 64; idx += 512) { const int t = idx >> 6, p = idx & 63;
        const double lr = (double)lre_[p], li = (double)lim_[p]; const double mag = exp(lr * dt * (double)t); double ang = li * dt * (double)t;
        ang -= 6.283185307179586476925 * rint(ang * 0.15915494309189533577);
        APr[idx] = (float)(mag * (double)cosf((float)ang)); APi[idx] = (float)(mag * (double)sinf((float)ang)); }
    for (int idx = tid; idx < 1024; idx += 512) { const int p = idx >> 4, c = idx & 15;
        const double lr = (double)lre_[p], li = (double)lim_[p]; const double mag = exp(lr * dt); double ang = li * dt; ang -= 6.283185307179586476925 * rint(ang * 0.15915494309189533577);
        const double ar = mag * (double)cosf((float)ang), ai = mag * (double)sinf((float)ang), den = lr * lr + li * li, nr = ar - 1.0, ni = ai;
        const double zr = (nr * lr + ni * li) / den, zi = (ni * lr - nr * li) / den;
        const double br = (double)((const GAS float*)F.in[I_BRE])[(size_t)(lg * 64 + p) * 16 + c], bi = (double)((const GAS float*)F.in[I_BIM])[(size_t)(lg * 64 + p) * 16 + c];
        BBr[idx] = (float)(zr * br - zi * bi); BBi[idx] = (float)(zr * bi + zi * br);
        CCr[idx] = ((const GAS float*)F.in[I_CRE])[(size_t)lg * 1024 + idx]; CCi[idx] = ((const GAS float*)F.in[I_CIM])[(size_t)lg * 1024 + idx]; }
    LDS_WAIT(); __syncthreads();
    { const int t = tid >> 3, co0 = 2 * (tid & 7); float acc0[16], acc1[16];
#pragma unroll
      for (int i = 0; i < 16; ++i) { acc0[i] = 0.f; acc1[i] = 0.f; }
      for (int p = 0; p < 64; ++p) { const float ar = APr[t * 64 + p], ai = APi[t * 64 + p];
          const float c0r = CCr[co0 * 64 + p], c0i = CCi[co0 * 64 + p], c1r = CCr[(co0 + 1) * 64 + p], c1i = CCi[(co0 + 1) * 64 + p];
          const float w0r = c0r * ar - c0i * ai, w0i = c0r * ai + c0i * ar, w1r = c1r * ar - c1i * ai, w1i = c1r * ai + c1i * ar;
#pragma unroll
          for (int ci = 0; ci < 16; ++ci) { const float br = BBr[p * 16 + ci], bi = BBi[p * 16 + ci]; acc0[ci] += w0r * br - w0i * bi; acc1[ci] += w1r * br - w1i * bi; } }
      GAS bf16* TK = (GAS bf16*)(F.ws + WS_TK) + (size_t)lg * 64 * 256 + (size_t)(t * 16 + co0) * 16;
      v4u o0, o1, o2, o3; o0.x = pk2(acc0[0], acc0[1]); o0.y = pk2(acc0[2], acc0[3]); o0.z = pk2(acc0[4], acc0[5]); o0.w = pk2(acc0[6], acc0[7]);
      o1.x = pk2(acc0[8], acc0[9]); o1.y = pk2(acc0[10], acc0[11]); o1.z = pk2(acc0[12], acc0[13]); o1.w = pk2(acc0[14], acc0[15]);
      o2.x = pk2(acc1[0], acc1[1]); o2.y = pk2(acc1[2], acc1[3]); o2.z = pk2(acc1[4], acc1[5]); o2.w = pk2(acc1[6], acc1[7]);
      o3.x = pk2(acc1[8], acc1[9]); o3.y = pk2(acc1[10], acc1[11]); o3.z = pk2(acc1[12], acc1[13]); o3.w = pk2(acc1[14], acc1[15]);
      *(GAS v4u*)(TK) = o0; *(GAS v4u*)(TK + 8) = o1; *(GAS v4u*)(TK + 16) = o2; *(GAS v4u*)(TK + 24) = o3; }
    { GAS bf16* TW = (GAS bf16*)(F.ws + WS_TW) + (size_t)lg * 128 * 1024;
      for (int ch = tid; ch < 16384; ch += 512) { const int col = ch >> 7, kc = ch & 127, ri = col >> 6, p = col & 63, j = kc >> 1, c0 = 8 * (kc & 1);
          const float ar = APr[(63 - j) * 64 + p], ai = APi[(63 - j) * 64 + p]; float v[8];
#pragma unroll
          for (int e = 0; e < 8; ++e) { const float br = BBr[p * 16 + c0 + e], bi = BBi[p * 16 + c0 + e]; v[e] = ri ? (ar * bi + ai * br) : (ar * br - ai * bi); }
          v4u o; o.x = pk2(v[0], v[1]); o.y = pk2(v[2], v[3]); o.z = pk2(v[4], v[5]); o.w = pk2(v[6], v[7]);
          *(GAS v4u*)(TW + (size_t)col * 1024 + kc * 8) = o; } }
    { GAS bf16* TC = (GAS bf16*)(F.ws + WS_TC) + (size_t)lg * 1024 * 128;
      for (int ch = tid; ch < 16384; ch += 512) { const int row = ch >> 4, kc = ch & 15, i = row >> 4, co = row & 15, ri = kc >> 3, p0 = 8 * (kc & 7); float v[8];
#pragma unroll
          for (int e = 0; e < 8; ++e) { const int p = p0 + e; const float ar = APr[(i + 1) * 64 + p], ai = APi[(i + 1) * 64 + p], cr = CCr[co * 64 + p], ci = CCi[co * 64 + p];
              v[e] = ri ? -(cr * ai + ci * ar) : (cr * ar - ci * ai); }
          v4u o; o.x = pk2(v[0], v[1]); o.y = pk2(v[2], v[3]); o.z = pk2(v[4], v[5]); o.w = pk2(v[6], v[7]);
          *(GAS v4u*)(TC + (size_t)row * 128 + kc * 8) = o; } }
    if (tid < 128) ((GAS float*)(F.ws + WS_A64))[(size_t)lg * 128 + tid] = (tid < 64) ? APr[64 * 64 + tid] : APi[64 * 64 + tid - 64];
    LDS_WAIT(); __syncthreads();
}
__device__ __forceinline__ void s5_stage_u(Frame& F, int g, int b, LAS unsigned char* U) {
    const GAS v4u* src = (const GAS v4u*)((const GAS bf16*)(F.ws + WS_US) + (size_t)(b * 64 + g) * SEQ * 16);
#pragma unroll
    for (int it = 0; it < 8; ++it) { const int ch = F.tid + 512 * it, t = ch >> 1, hf = ch & 1, n = t >> 6, j = t & 63;
        *(LAS v4u*)(U + n * S5_USTR + (j * 16 + 8 * hf) * 2) = src[ch]; }
}
__device__ __forceinline__ void s5_s1_unit(Frame& F, int l, int unit) {
    const int g = unit & 63, b = unit >> 6, lg = l * 64 + g, lane = F.lane, w = F.wave, fr = lane & 15, fq = lane >> 4;
    LAS unsigned char* U = F.lds;
    s5_stage_u(F, g, b, U);
    LDS_WAIT(); __syncthreads();
    const GAS bf16* TW = (const GAS bf16*)(F.ws + WS_TW) + (size_t)lg * 128 * 1024 + (size_t)(16 * w + fr) * 1024 + 8 * fq;
    f32x4 acc[2] = {(f32x4){0.f, 0.f, 0.f, 0.f}, (f32x4){0.f, 0.f, 0.f, 0.f}};
#pragma unroll 4
    for (int ks = 0; ks < 32; ++ks) {
        const bf16x8_t bfr = *(const GAS bf16x8_t*)(TW + 32 * ks);
        const bf16x8_t a0 = *(const LAS bf16x8_t*)(U + fr * S5_USTR + (32 * ks + 8 * fq) * 2), a1 = *(const LAS bf16x8_t*)(U + (16 + fr) * S5_USTR + (32 * ks + 8 * fq) * 2);
        acc[0] = mma16(a0, bfr, acc[0]); acc[1] = mma16(a1, bfr, acc[1]); }
    GAS float* SL = (GAS float*)(F.ws + WS_SL);
#pragma unroll
    for (int mt = 0; mt < 2; ++mt)
#pragma unroll
        for (int r = 0; r < 4; ++r) { const int n = 16 * mt + 4 * fq + r; SL[((size_t)(b * 32 + n) * 64 + g) * 128 + 16 * w + fr] = acc[mt][r]; }
    __syncthreads();
}
__device__ __forceinline__ void s5_s3_unit(Frame& F, int l, int unit) {
    const int g = unit & 63, b = unit >> 6, lg = l * 64 + g, lane = F.lane, w = F.wave, fr = lane & 15, fq = lane >> 4;
    LAS unsigned char* U = F.lds; LAS unsigned char* TKL = F.lds + 32 * S5_USTR; LAS unsigned char* XP = TKL + 32768;
    PR_STAMP(0);
    float sr[32], si[32]; float a64r = 0.f, a64i = 0.f;
    if (w == 0) { const GAS float* SL = (const GAS float*)(F.ws + WS_SL) + ((size_t)(b * 32) * 64 + g) * 128; const GAS float* A64 = (const GAS float*)(F.ws + WS_A64) + (size_t)lg * 128;
        a64r = A64[lane]; a64i = A64[64 + lane];
#pragma unroll
        for (int e = 0; e < 32; ++e) { sr[e] = SL[(size_t)e * 64 * 128 + lane]; si[e] = SL[(size_t)e * 64 * 128 + 64 + lane]; } }
    s5_stage_u(F, g, b, U);
    { const GAS v4u* src = (const GAS v4u*)((const GAS bf16*)(F.ws + WS_TK) + (size_t)lg * 64 * 256);
#pragma unroll
      for (int it = 0; it < 4; ++it) *(LAS v4u*)(TKL + (F.tid + 512 * it) * 16) = src[F.tid + 512 * it]; }
    const GAS bf16* TC = (const GAS bf16*)(F.ws + WS_TC) + (size_t)lg * 1024 * 128 + (size_t)fr * 128 + 8 * fq;
    bf16x8_t tcf[8];
#pragma unroll
    for (int it = 0; it < 8; ++it) tcf[it] = *(const GAS bf16x8_t*)(TC + (size_t)((w + 8 * it) * 16) * 128);
    if (w == 0) {
        float xr = 0.f, xi = 0.f;
#pragma unroll
        for (int e = 0; e < 32; ++e) { *(LAS bf16*)(XP + e * S5_XSTR + lane * 2) = (bf16)f2bf(xr); *(LAS bf16*)(XP + e * S5_XSTR + (64 + lane) * 2) = (bf16)f2bf(xi);
            const float nr = a64r * xr - a64i * xi + sr[e], ni = a64r * xi + a64i * xr + si[e]; xr = nr; xi = ni; }
    }
    LDS_WAIT(); __syncthreads();
    PR_STAMP(1);
    f32x4 acc[2][8];
#pragma unroll
    for (int mt = 0; mt < 2; ++mt)
#pragma unroll
        for (int it = 0; it < 8; ++it) acc[mt][it] = (f32x4){0.f, 0.f, 0.f, 0.f};
#pragma unroll 1
    for (int c = 0; c < 4; ++c) {
        bf16x8_t bfr[8];
#pragma unroll
        for (int it = 0; it < 8; ++it) { const int lag = w + 8 * it - 2 * c - (fq >> 1); bfr[it] = *(const LAS bf16x8_t*)(TKL + ((lag < 0 ? 0 : lag) * 16 + fr) * 32 + 16 * (fq & 1)); if (lag < 0) bfr[it] = (bf16x8_t){0, 0, 0, 0, 0, 0, 0, 0}; }
        const bool first_ok = (w >= 2 * c);
#pragma unroll
        for (int sgrp = 0; sgrp < 8; ++sgrp) { const int ks = c + 4 * sgrp;
            const bf16x8_t a0 = *(const LAS bf16x8_t*)(U + fr * S5_USTR + (32 * ks + 8 * fq) * 2), a1 = *(const LAS bf16x8_t*)(U + (16 + fr) * S5_USTR + (32 * ks + 8 * fq) * 2);
#pragma unroll
            for (int it = sgrp; it < 8; ++it) { if (it > sgrp || first_ok) { acc[0][it] = mma16(a0, bfr[it - sgrp], acc[0][it]); acc[1][it] = mma16(a1, bfr[it - sgrp], acc[1][it]); } } }
    }
    PR_STAMP(2);
#pragma unroll
    for (int ks = 0; ks < 4; ++ks) {
        if (ks > 0) {
#pragma unroll
            for (int it = 0; it < 8; ++it) tcf[it] = *(const GAS bf16x8_t*)(TC + (size_t)((w + 8 * it) * 16) * 128 + 32 * ks); }
        const bf16x8_t a0 = *(const LAS bf16x8_t*)(XP + fr * S5_XSTR + (32 * ks + 8 * fq) * 2), a1 = *(const LAS bf16x8_t*)(XP + (16 + fr) * S5_XSTR + (32 * ks + 8 * fq) * 2);
#pragma unroll
        for (int it = 0; it < 8; ++it) { acc[0][it] = mma16(a0, tcf[it], acc[0][it]); acc[1][it] = mma16(a1, tcf[it], acc[1][it]); } }
    PR_STAMP(3);
    unsigned zp[2][8][2];
    { const float dsk = ((const GAS float*)F.in[I_SD])[l * 1024 + 16 * g + fr];
#pragma unroll
      for (int mt = 0; mt < 2; ++mt)
#pragma unroll
          for (int it = 0; it < 8; ++it) { float z[4];
#pragma unroll
              for (int r = 0; r < 4; ++r) { const int n = 16 * mt + 4 * fq + r, i = w + 8 * it;
                  const float uv = bf1(*(const LAS bf16*)(U + n * S5_USTR + (i * 16 + fr) * 2)); z[r] = gelu_tanh(acc[mt][it][r] + dsk * uv); }
              zp[mt][it][0] = pg8::cvt_pk_bf16(z[0], z[1]); zp[mt][it][1] = pg8::cvt_pk_bf16(z[2], z[3]); } }
    LDS_WAIT(); __syncthreads();
#pragma unroll
    for (int mt = 0; mt < 2; ++mt)
#pragma unroll
        for (int it = 0; it < 8; ++it)
#pragma unroll
            for (int r = 0; r < 4; ++r) { const int tkn = 64 * (16 * mt + 4 * fq + r) + w + 8 * it; const unsigned v = zp[mt][it][r >> 1];
                *(LAS bf16*)(U + tkn * 32 + fr * 2) = (bf16)((r & 1) ? (v >> 16) : (v & 0xffffu)); }
    LDS_WAIT(); __syncthreads();
    { GAS bf16* Z = (GAS bf16*)(F.ws + WS_Z) + (size_t)b * SEQ * 1024 + 16 * g;
#pragma unroll
      for (int j = 0; j < 8; ++j) { const int c = F.tid + 512 * j; *(GAS v4u*)(Z + (size_t)(c >> 1) * 1024 + 8 * (c & 1)) = *(const LAS v4u*)(U + c * 16); } }
    __syncthreads();
    PR_STAMP(4);
}

constexpr int GL_TSTR = 144;
constexpr int GL_DSTR = 272;
__device__ __forceinline__ void gla_g1_unit(Frame& F, int l, int u) {
    const int n = u & 31, h = (u >> 5) & 3, b = u >> 7, tid = F.tid, lane = F.lane, w = F.wave, fr = lane & 15, fq = lane >> 4;
    const size_t tok0 = (size_t)b * SEQ + 64 * n;
    const GAS bf16* P = (const GAS bf16*)(F.ws + WS_P);
    LAS float* GL = (LAS float*)F.lds; LAS float* W2L = (LAS float*)(F.lds + 32768); LAS float* GLR = (LAS float*)(F.lds + 40960);
    LAS unsigned char* KDt = F.lds + 45056; LAS unsigned char* VTt = F.lds + 63488;
    { const GAS float* w2 = ((const GAS float*)F.in[I_GW2]) + (size_t)l * 16 * 512;
#pragma unroll
      for (int it = 0; it < 4; ++it) { const int idx = tid + 512 * it, r = idx >> 7, dk = idx & 127; W2L[idx] = w2[r * 512 + h * 128 + dk]; }
#pragma unroll
      for (int it = 0; it < 2; ++it) { const int idx = tid + 512 * it, i = idx >> 4, r = idx & 15; GLR[idx] = bf1(P[(tok0 + i) * NP + PC_GLR + r]); } }
    LDS_WAIT(); __syncthreads();
    const int ti = tid >> 3, dq = tid & 7;
    { const GAS float* b2 = ((const GAS float*)F.in[I_GB2]) + l * 512 + h * 128 + 16 * dq; float a[16];
#pragma unroll
      for (int e = 0; e < 16; ++e) a[e] = b2[e];
#pragma unroll
      for (int r = 0; r < 16; ++r) { const float gv = GLR[ti * 16 + r];
#pragma unroll
          for (int e = 0; e < 16; ++e) a[e] += gv * W2L[r * 128 + 16 * dq + e]; }
#pragma unroll
      for (int e = 0; e < 16; ++e) { const float x = a[e]; GL[ti * 128 + 16 * dq + e] = (fminf(x, 0.f) - log1pf(__expf(-fabsf(x)))) * (1.0f / 16.0f); } }
    LDS_WAIT(); __syncthreads();
    if (tid < 128) { float run = 0.f;
        for (int i = 0; i < 64; ++i) { run += GL[i * 128 + tid]; GL[i * 128 + tid] = run; }
        GLR[tid] = run; ((GAS float*)(F.ws + WS_DEC))[(size_t)u * 128 + tid] = __expf(run); }
    LDS_WAIT(); __syncthreads();
    {
      const GAS bf16* qp = P + (tok0 + ti) * NP + PC_GQ + h * 128 + 16 * dq; const GAS bf16* kp = P + (tok0 + ti) * NP + PC_GK + h * 128 + 16 * dq;
      const v4u q0 = *(const GAS v4u*)qp, q1 = *(const GAS v4u*)(qp + 8), k0 = *(const GAS v4u*)kp, k1 = *(const GAS v4u*)(kp + 8);
      const unsigned qw[8] = {q0.x, q0.y, q0.z, q0.w, q1.x, q1.y, q1.z, q1.w}, kw[8] = {k0.x, k0.y, k0.z, k0.w, k1.x, k1.y, k1.z, k1.w};
      float qd[16], ki[16];
#pragma unroll
      for (int e = 0; e < 16; ++e) { const int dk = 16 * dq + e; const float bc = GL[ti * 128 + dk], bl = GLR[dk];
          const float qv = (e & 1) ? bfhi(qw[e >> 1]) : bflo(qw[e >> 1]), kv = (e & 1) ? bfhi(kw[e >> 1]) : bflo(kw[e >> 1]);
          qd[e] = qv * 0.08838834764831845f * __expf(bc); ki[e] = kv * __expf(-bc);
          *(LAS bf16*)(KDt + dk * GL_TSTR + ti * 2) = (bf16)f2bf(kv * __expf(bl - bc)); }
      GAS bf16* QD = (GAS bf16*)(F.ws + WS_QD) + ((size_t)u * 64 + ti) * 128 + 16 * dq; GAS bf16* KI = (GAS bf16*)(F.ws + WS_KI) + ((size_t)u * 64 + ti) * 128 + 16 * dq;
      v4u o; o.x = pk2(qd[0], qd[1]); o.y = pk2(qd[2], qd[3]); o.z = pk2(qd[4], qd[5]); o.w = pk2(qd[6], qd[7]); *(GAS v4u*)QD = o;
      o.x = pk2(qd[8], qd[9]); o.y = pk2(qd[10], qd[11]); o.z = pk2(qd[12], qd[13]); o.w = pk2(qd[14], qd[15]); *(GAS v4u*)(QD + 8) = o;
      o.x = pk2(ki[0], ki[1]); o.y = pk2(ki[2], ki[3]); o.z = pk2(ki[4], ki[5]); o.w = pk2(ki[6], ki[7]); *(GAS v4u*)KI = o;
      o.x = pk2(ki[8], ki[9]); o.y = pk2(ki[10], ki[11]); o.z = pk2(ki[12], ki[13]); o.w = pk2(ki[14], ki[15]); *(GAS v4u*)(KI + 8) = o;
      const GAS bf16* vp = P + (tok0 + ti) * NP + PC_GV + h * 256 + 32 * dq;
#pragma unroll
      for (int c = 0; c < 4; ++c) { const v4u vv = *(const GAS v4u*)(vp + 8 * c); const unsigned vw[4] = {vv.x, vv.y, vv.z, vv.w};
#pragma unroll
          for (int e = 0; e < 4; ++e) { const int dv = 32 * dq + 8 * c + 2 * e;
              *(LAS bf16*)(VTt + dv * GL_TSTR + ti * 2) = (bf16)(vw[e] & 0xffffu); *(LAS bf16*)(VTt + (dv + 1) * GL_TSTR + ti * 2) = (bf16)(vw[e] >> 16); } } }
    LDS_WAIT(); __syncthreads();
    {
      GAS bf16* GVT = (GAS bf16*)(F.ws + WS_GVT) + (size_t)u * 256 * 64; const int row = tid >> 1, hf = tid & 1;
#pragma unroll
      for (int c = 0; c < 4; ++c) *(GAS v4u*)(GVT + row * 64 + 32 * hf + 8 * c) = *(const LAS v4u*)(VTt + row * GL_TSTR + 64 * hf + 16 * c); }
    {
      f32x4 acc[2][8];
#pragma unroll
      for (int mt = 0; mt < 2; ++mt)
#pragma unroll
          for (int nt = 0; nt < 8; ++nt) acc[mt][nt] = (f32x4){0.f, 0.f, 0.f, 0.f};
#pragma unroll
      for (int ks = 0; ks < 2; ++ks) { bf16x8_t a[2];
#pragma unroll
          for (int mt = 0; mt < 2; ++mt) a[mt] = *(const LAS bf16x8_t*)(VTt + (16 * (2 * w + mt) + fr) * GL_TSTR + (32 * ks + 8 * fq) * 2);
#pragma unroll
          for (int nt = 0; nt < 8; ++nt) { const bf16x8_t bb = *(const LAS bf16x8_t*)(KDt + (16 * nt + fr) * GL_TSTR + (32 * ks + 8 * fq) * 2);
              acc[0][nt] = mma16(a[0], bb, acc[0][nt]); acc[1][nt] = mma16(a[1], bb, acc[1][nt]); } }
      GAS bf16* KV = (GAS bf16*)(F.ws + WS_KV) + (size_t)u * 256 * 128;
#pragma unroll
      for (int mt = 0; mt < 2; ++mt)
#pragma unroll
          for (int nt = 0; nt < 8; ++nt)
#pragma unroll
              for (int r = 0; r < 4; ++r) KV[(size_t)(16 * (2 * w + mt) + 4 * fq + r) * 128 + 16 * nt + fr] = (bf16)f2bf(acc[mt][nt][r]); }
    __syncthreads();
}
__device__ __forceinline__ void gla_g2_scan(Frame& F) {
    const GAS bf16* KV = (const GAS bf16*)(F.ws + WS_KV); const GAS float* DEC = (const GAS float*)(F.ws + WS_DEC); GAS bf16* ST = (GAS bf16*)(F.ws + WS_ST);
    for (int e8 = blockIdx.x * 512 + F.tid; e8 < 16 * 256 * 16; e8 += F.G * 512) { const int bh = e8 >> 12, dv = (e8 >> 4) & 255, d8 = e8 & 15;
        float s[8];
#pragma unroll
        for (int j = 0; j < 8; ++j) s[j] = 0.f;
        for (int n0 = 0; n0 < 32; n0 += 4) { v4u kv[4]; f32x4 dc[4][2];
#pragma unroll
            for (int e = 0; e < 4; ++e) { const size_t u = (size_t)bh * 32 + n0 + e; kv[e] = *(const GAS v4u*)(KV + (u * 256 + dv) * 128 + 8 * d8); dc[e][0] = *(const GAS f32x4*)(DEC + u * 128 + 8 * d8); dc[e][1] = *(const GAS f32x4*)(DEC + u * 128 + 8 * d8 + 4); }
#pragma unroll
            for (int e = 0; e < 4; ++e) { const size_t u = (size_t)bh * 32 + n0 + e; v4u o; o.x = pk2(s[0], s[1]); o.y = pk2(s[2], s[3]); o.z = pk2(s[4], s[5]); o.w = pk2(s[6], s[7]); *(GAS v4u*)(ST + (u * 256 + dv) * 128 + 8 * d8) = o;
                const unsigned kw[4] = {kv[e].x, kv[e].y, kv[e].z, kv[e].w};
#pragma unroll
                for (int j = 0; j < 4; ++j) { s[2 * j] = dc[e][j >> 1][(2 * j) & 3] * s[2 * j] + bflo(kw[j]); s[2 * j + 1] = dc[e][j >> 1][(2 * j + 1) & 3] * s[2 * j + 1] + bfhi(kw[j]); } } } }
}
__device__ __forceinline__ void gla_g3_unit(Frame& F, int l, int u) {
    const int n = u & 31, h = (u >> 5) & 3, b = u >> 7, tid = F.tid, lane = F.lane, w = F.wave, fr = lane & 15, fq = lane >> 4;
    const size_t tok0 = (size_t)b * SEQ + 64 * n;
    LAS unsigned char* QDL = F.lds; LAS unsigned char* KIL = F.lds + 17408; LAS unsigned char* ATL = F.lds + 34816; LAS float* SSQL = (LAS float*)(F.lds + 44032); LAS float* RSL = (LAS float*)(F.lds + 46080);
    { const GAS v4u* qs = (const GAS v4u*)((const GAS bf16*)(F.ws + WS_QD) + (size_t)u * 64 * 128); const GAS v4u* ks_ = (const GAS v4u*)((const GAS bf16*)(F.ws + WS_KI) + (size_t)u * 64 * 128);
#pragma unroll
      for (int it = 0; it < 2; ++it) { const int c = tid + 512 * it, row = c >> 4, c16 = c & 15; *(LAS v4u*)(QDL + row * GL_DSTR + c16 * 16) = qs[c]; *(LAS v4u*)(KIL + row * GL_DSTR + c16 * 16) = ks_[c]; } }
    LDS_WAIT(); __syncthreads();
#pragma unroll
    for (int tt = 0; tt < 2; ++tt) { const int tile = 2 * w + tt, mi = tile >> 2, nj = tile & 3; f32x4 acc = (f32x4){0.f, 0.f, 0.f, 0.f};
        if (nj <= mi) {
#pragma unroll
            for (int ks = 0; ks < 4; ++ks) { const bf16x8_t a = *(const LAS bf16x8_t*)(QDL + (16 * mi + fr) * GL_DSTR + (32 * ks + 8 * fq) * 2), bb = *(const LAS bf16x8_t*)(KIL + (16 * nj + fr) * GL_DSTR + (32 * ks + 8 * fq) * 2);
                acc = mma16(a, bb, acc); } }
#pragma unroll
        for (int r = 0; r < 4; ++r) { const int i = 16 * mi + 4 * fq + r, j = 16 * nj + fr; *(LAS bf16*)(ATL + i * GL_TSTR + j * 2) = (bf16)f2bf(j <= i ? acc[r] : 0.f); } }
    LDS_WAIT(); __syncthreads();
    f32x4 acc[4][2];
#pragma unroll
    for (int mi = 0; mi < 4; ++mi) { acc[mi][0] = (f32x4){0.f, 0.f, 0.f, 0.f}; acc[mi][1] = (f32x4){0.f, 0.f, 0.f, 0.f}; }
    { const GAS bf16* GVT = (const GAS bf16*)(F.ws + WS_GVT) + (size_t)u * 256 * 64;
#pragma unroll
      for (int ks = 0; ks < 2; ++ks) { bf16x8_t bb[2];
#pragma unroll
          for (int nt = 0; nt < 2; ++nt) bb[nt] = *(const GAS bf16x8_t*)(GVT + (size_t)(16 * (2 * w + nt) + fr) * 64 + 32 * ks + 8 * fq);
#pragma unroll
          for (int mi = 0; mi < 4; ++mi) { const bf16x8_t a = *(const LAS bf16x8_t*)(ATL + (16 * mi + fr) * GL_TSTR + (32 * ks + 8 * fq) * 2);
              acc[mi][0] = mma16(a, bb[0], acc[mi][0]); acc[mi][1] = mma16(a, bb[1], acc[mi][1]); } }
      const GAS bf16* ST = (const GAS bf16*)(F.ws + WS_ST) + (size_t)u * 256 * 128;
#pragma unroll
      for (int ks = 0; ks < 4; ++ks) { bf16x8_t bb[2];
#pragma unroll
          for (int nt = 0; nt < 2; ++nt) bb[nt] = *(const GAS bf16x8_t*)(ST + (size_t)(16 * (2 * w + nt) + fr) * 128 + 32 * ks + 8 * fq);
#pragma unroll
          for (int mi = 0; mi < 4; ++mi) { const bf16x8_t a = *(const LAS bf16x8_t*)(QDL + (16 * mi + fr) * GL_DSTR + (32 * ks + 8 * fq) * 2);
              acc[mi][0] = mma16(a, bb[0], acc[mi][0]); acc[mi][1] = mma16(a, bb[1], acc[mi][1]); } } }
#pragma unroll
    for (int mi = 0; mi < 4; ++mi)
#pragma unroll
        for (int r = 0; r < 4; ++r) { float v = acc[mi][0][r] * acc[mi][0][r] + acc[mi][1][r] * acc[mi][1][r];
            v += __shfl_xor(v, 1); v += __shfl_xor(v, 2); v += __shfl_xor(v, 4); v += __shfl_xor(v, 8);
            if (fr == 0) SSQL[w * 64 + 16 * mi + 4 * fq + r] = v; }
    LDS_WAIT(); __syncthreads();
    if (tid < 64) { float s = 0.f;
#pragma unroll
        for (int ww = 0; ww < 8; ++ww) s += SSQL[ww * 64 + tid];
        RSL[tid] = 1.0f / sqrtf(s * (1.0f / 256.0f) + RMS_EPS); }
    LDS_WAIT(); __syncthreads();
    { const GAS bf16* P = (const GAS bf16*)(F.ws + WS_P); GAS bf16* Y = (GAS bf16*)(F.ws + WS_Y); const GAS float* gn = ((const GAS float*)F.in[I_GNG]) + l * 256;
#pragma unroll
      for (int nt = 0; nt < 2; ++nt) { const int dv = 32 * w + 16 * nt + fr; const float gv = gn[dv];
#pragma unroll
          for (int mi = 0; mi < 4; ++mi)
#pragma unroll
              for (int r = 0; r < 4; ++r) { const int i = 16 * mi + 4 * fq + r; const float rr = bf1(P[(tok0 + i) * NP + PC_GR + h * 256 + dv]);
                  Y[(tok0 + i) * YW + 1024 + h * 256 + dv] = (bf16)f2bf(acc[mi][nt][r] * RSL[i] * gv * rr * sigmoidf_(rr)); } } }
    __syncthreads();
}


constexpr int MB_KSTR = 272, MB_VSTR = 144, MB_KBYTES = 64 * MB_KSTR, MB_BUF = MB_KBYTES + 128 * MB_VSTR;
__device__ __forceinline__ void moba_prep_unit(Frame& F, int l, int unit) {
    const int kb = unit & 7, h = (unit >> 3) & 7, b = unit >> 6, tid = F.tid;
    const size_t tok0 = (size_t)b * SEQ + 256 * kb;
    const GAS bf16* P = (const GAS bf16*)(F.ws + WS_P);
    LAS unsigned char* TL = F.lds; LAS float* PART = (LAS float*)(F.lds + 69632);
    const int c16 = tid & 15, tg = tid >> 4;
    v4u xq[8], xk[8], xv[8];
    { const GAS bf16* src = P + (tok0 + tg) * NP + h * 128 + 8 * c16;
#pragma unroll
      for (int j = 0; j < 8; ++j) { xq[j] = *(const GAS v4u*)(src + (size_t)(32 * j) * NP + PC_MQ); xk[j] = *(const GAS v4u*)(src + (size_t)(32 * j) * NP + PC_MK); xv[j] = *(const GAS v4u*)(src + (size_t)(32 * j) * NP + PC_MV); } }
#pragma unroll
    for (int which = 0; which < 2; ++which) {
        const GAS float* gp = (const GAS float*)F.in[which ? I_MKG : I_MQG] + l * 128 + 8 * c16;
        const f32x4 g0 = *(const GAS f32x4*)gp, g1 = *(const GAS f32x4*)(gp + 4);
#pragma unroll
        for (int j = 0; j < 8; ++j) { const v4u xx = which ? xk[j] : xq[j]; const unsigned xw[4] = {xx.x, xx.y, xx.z, xx.w}; float ss = 0.f;
#pragma unroll
            for (int e = 0; e < 4; ++e) { const float a = bflo(xw[e]), bb = bfhi(xw[e]); ss += a * a + bb * bb; }
            ss += __shfl_xor(ss, 1); ss += __shfl_xor(ss, 2); ss += __shfl_xor(ss, 4); ss += __shfl_xor(ss, 8);
            const float r = (1.0f / sqrtf(ss * (1.0f / 128.0f) + RMS_EPS)) * (which ? 1.0f : 0.08838834764831845f);
            const int tok = tg + 32 * j;
            v4u o; o.x = pg8::cvt_pk_bf16(bflo(xw[0]) * r * g0[0], bfhi(xw[0]) * r * g0[1]); o.y = pg8::cvt_pk_bf16(bflo(xw[1]) * r * g0[2], bfhi(xw[1]) * r * g0[3]);
            o.z = pg8::cvt_pk_bf16(bflo(xw[2]) * r * g1[0], bfhi(xw[2]) * r * g1[1]); o.w = pg8::cvt_pk_bf16(bflo(xw[3]) * r * g1[2], bfhi(xw[3]) * r * g1[3]);
            *(GAS v4u*)((GAS bf16*)(F.ws + (which ? WS_KN : WS_QN)) + (tok0 + tok) * 1024 + h * 128 + 8 * c16) = o; if (which) *(LAS v4u*)(TL + tok * MB_KSTR + 16 * c16) = o; }
    }
    LDS_WAIT(); __syncthreads();
    { const int d = tid & 127, part = tid >> 7; float a = 0.f;
#pragma unroll 8
      for (int j = 0; j < 64; ++j) a += bf1(*(const LAS bf16*)(TL + (64 * part + j) * MB_KSTR + d * 2));
      PART[part * 128 + d] = a; }
    LDS_WAIT(); __syncthreads();
    if (tid < 128) ((GAS float*)(F.ws + WS_KM))[(size_t)unit * 128 + tid] = ((PART[tid] + PART[128 + tid]) + (PART[256 + tid] + PART[384 + tid])) * (1.0f / 256.0f);
#pragma unroll
    for (int j = 0; j < 8; ++j) *(LAS v4u*)(TL + (tg + 32 * j) * MB_KSTR + 16 * c16) = xv[j];
    LDS_WAIT(); __syncthreads();
    { const int d = tid >> 2, tq = tid & 3; GAS bf16* dst = (GAS bf16*)(F.ws + WS_VT) + ((size_t)(b * 8 + h) * 128 + d) * SEQ + 256 * kb + 64 * tq;
#pragma unroll
      for (int c = 0; c < 8; ++c) { unsigned wv[4];
#pragma unroll
          for (int e = 0; e < 4; ++e) { const unsigned lo = *(const LAS bf16*)(TL + (64 * tq + 8 * c + 2 * e) * MB_KSTR + d * 2), hi = *(const LAS bf16*)(TL + (64 * tq + 8 * c + 2 * e + 1) * MB_KSTR + d * 2); wv[e] = lo | (hi << 16); }
          v4u o; o.x = wv[0]; o.y = wv[1]; o.z = wv[2]; o.w = wv[3]; *(GAS v4u*)(dst + 8 * c) = o; } }
    __syncthreads();
}
__device__ __forceinline__ void moba_attn_unit(Frame& F, int bh, int qt) {
    const int b = bh >> 3, h = bh & 7, tid = F.tid, lane = F.lane, w = F.wave, fr = lane & 15, fq = lane >> 4;
    const int qb = qt >> 1, nt = 2 * (qt + 1), qpos = 128 * qt + 16 * w + fr;
    const GAS bf16* KN = (const GAS bf16*)(F.ws + WS_KN) + (size_t)b * SEQ * 1024 + h * 128; const GAS bf16* VT = (const GAS bf16*)(F.ws + WS_VT) + (size_t)bh * 128 * SEQ;
    LAS float* KML = (LAS float*)(F.lds + 2 * MB_BUF);
    { const GAS float* km = (const GAS float*)(F.ws + WS_KM) + (size_t)bh * 1024; KML[tid] = km[tid]; KML[512 + tid] = km[512 + tid]; }
    bf16x8_t bq[4];
    { const GAS bf16* qp = (const GAS bf16*)(F.ws + WS_QN) + ((size_t)b * SEQ + qpos) * 1024 + h * 128 + 8 * fq;
#pragma unroll
      for (int ks = 0; ks < 4; ++ks) bq[ks] = *(const GAS bf16x8_t*)(qp + 32 * ks); }
    v4u sk[2][2], sv[2][2];
#define MB_LOAD(S_, it_) do { _Pragma("unroll") for (int p_ = 0; p_ < 2; ++p_) { const int cc_ = tid + 512 * p_; \
        sk[S_][p_] = *(const GAS v4u*)(KN + (size_t)(64 * (it_) + (cc_ >> 4)) * 1024 + 8 * (cc_ & 15)); sv[S_][p_] = *(const GAS v4u*)(VT + (size_t)(cc_ >> 3) * SEQ + 64 * (it_) + 8 * (cc_ & 7)); } } while (0)
#define MB_STORE(buf_, S_) do { _Pragma("unroll") for (int p_ = 0; p_ < 2; ++p_) { const int cc_ = tid + 512 * p_; \
        *(LAS v4u*)((buf_) + (cc_ >> 4) * MB_KSTR + (cc_ & 15) * 16) = sk[S_][p_]; *(LAS v4u*)((buf_) + MB_KBYTES + (cc_ >> 3) * MB_VSTR + (cc_ & 7) * 16) = sv[S_][p_]; } } while (0)
    MB_LOAD(0, 0); MB_LOAD(1, 1);
    LDS_WAIT(); __syncthreads();
    unsigned selmask = 0u;
    { float sc[8];
#pragma unroll
      for (int kb = 0; kb < 8; ++kb) { float a = 0.f;
#pragma unroll
          for (int ks = 0; ks < 4; ++ks) { const LAS float* kp = KML + kb * 128 + 32 * ks + 8 * fq; const f32x4 k0 = *(const LAS f32x4*)kp, k1 = *(const LAS f32x4*)(kp + 4);
              const unsigned q01 = (unsigned)(unsigned short)bq[ks][0] | ((unsigned)(unsigned short)bq[ks][1] << 16), q23 = (unsigned)(unsigned short)bq[ks][2] | ((unsigned)(unsigned short)bq[ks][3] << 16);
              const unsigned q45 = (unsigned)(unsigned short)bq[ks][4] | ((unsigned)(unsigned short)bq[ks][5] << 16), q67 = (unsigned)(unsigned short)bq[ks][6] | ((unsigned)(unsigned short)bq[ks][7] << 16);
              a += bflo(q01) * k0[0] + bfhi(q01) * k0[1] + bflo(q23) * k0[2] + bfhi(q23) * k0[3] + bflo(q45) * k1[0] + bfhi(q45) * k1[1] + bflo(q67) * k1[2] + bfhi(q67) * k1[3]; }
          a += __shfl_xor(a, 16); a += __shfl_xor(a, 32); sc[kb] = (kb < qb) ? a : -__builtin_inff(); }
#pragma unroll
      for (int kb = 0; kb < 8; ++kb) { int rank = 0;
#pragma unroll
          for (int j = 0; j < 8; ++j) if (j != kb) rank += ((j < qb) && (sc[j] > sc[kb] || (sc[j] == sc[kb] && j < kb))) ? 1 : 0;
          if (kb < qb && rank < 3) selmask |= 1u << kb; } }
    MB_STORE(F.lds, 0);
    LDS_WAIT(); __syncthreads();
    f32x4 ao[8];
#pragma unroll
    for (int dt = 0; dt < 8; ++dt) ao[dt] = (f32x4){0.f, 0.f, 0.f, 0.f};
    float m = -__builtin_inff(), lsum = 0.f;
#pragma unroll 1
    for (int it0 = 0; it0 < nt; it0 += 2) {
#pragma unroll
      for (int hf = 0; hf < 2; ++hf) { const int it = it0 + hf;
        LAS unsigned char* KB = F.lds + hf * MB_BUF; LAS unsigned char* VB = KB + MB_KBYTES;
        if (it + 2 < nt) MB_LOAD(hf, it + 2);
        const int kb = it >> 2; const bool past = kb < qb; const bool mine = past ? (((selmask >> kb) & 1u) != 0u) : true;
        if (__any(mine)) {
            const int lim = (past ? (mine ? 0x7fffffff : -1) : qpos - 64 * it) - 4 * fq;
            f32x4 as[4];
#pragma unroll
            for (int mh = 0; mh < 2; ++mh) { bf16x8_t fragA[2][4];
#pragma unroll
                for (int mt = 0; mt < 2; ++mt)
#pragma unroll
                    for (int ks = 0; ks < 4; ++ks) fragA[mt][ks] = *(const LAS bf16x8_t*)(KB + (16 * (2 * mh + mt) + fr) * MB_KSTR + (32 * ks + 8 * fq) * 2);
                __builtin_amdgcn_sched_barrier(0);
#pragma unroll
                for (int mt = 0; mt < 2; ++mt) { as[2 * mh + mt] = (f32x4){0.f, 0.f, 0.f, 0.f};
#pragma unroll
                    for (int ks = 0; ks < 4; ++ks) as[2 * mh + mt] = mma16(fragA[mt][ks], bq[ks], as[2 * mh + mt]); }
                __builtin_amdgcn_sched_barrier(0); }
            v2u vlo[4][2], vhi[4][2];
#pragma unroll
            for (int dt = 0; dt < 4; ++dt)
#pragma unroll
                for (int k2 = 0; k2 < 2; ++k2) { const LAS unsigned char* vp = VB + (16 * dt + fr) * MB_VSTR + (32 * k2 + 4 * fq) * 2; vlo[dt][k2] = *(const LAS v2u*)vp; vhi[dt][k2] = *(const LAS v2u*)(vp + 32); }
            __builtin_amdgcn_sched_barrier(0);
            float mx = -__builtin_inff();
#pragma unroll
            for (int mt = 0; mt < 4; ++mt)
#pragma unroll
                for (int r = 0; r < 4; ++r) { const float sv_ = (16 * mt + r <= lim) ? as[mt][r] : -__builtin_inff(); as[mt][r] = sv_; mx = fmaxf(mx, sv_); }
            mx = fmaxf(mx, __shfl_xor(mx, 16)); mx = fmaxf(mx, __shfl_xor(mx, 32));
            const float mnew = fmaxf(m, mx), msafe = (mnew == -__builtin_inff()) ? 0.f : mnew, corr = __expf(m - msafe);
            float ps = 0.f;
#pragma unroll
            for (int mt = 0; mt < 4; ++mt)
#pragma unroll
                for (int r = 0; r < 4; ++r) { const float p = __expf(as[mt][r] - msafe); as[mt][r] = p; ps += p; }
            lsum = lsum * corr + ps; m = mnew;
            bf16x8_t pf[2];
#pragma unroll
            for (int k2 = 0; k2 < 2; ++k2) { v4u t; t.x = pg8::cvt_pk_bf16(as[2 * k2][0], as[2 * k2][1]); t.y = pg8::cvt_pk_bf16(as[2 * k2][2], as[2 * k2][3]); t.z = pg8::cvt_pk_bf16(as[2 * k2 + 1][0], as[2 * k2 + 1][1]); t.w = pg8::cvt_pk_bf16(as[2 * k2 + 1][2], as[2 * k2 + 1][3]);
                pf[k2] = __builtin_bit_cast(bf16x8_t, t); }
#pragma unroll
            for (int dt = 0; dt < 8; ++dt) ao[dt] = ao[dt] * corr;
            __builtin_amdgcn_sched_barrier(0);
#pragma unroll
            for (int dh = 0; dh < 2; ++dh) {
                if (dh == 1) {
#pragma unroll
                    for (int dt = 0; dt < 4; ++dt)
#pragma unroll
                        for (int k2 = 0; k2 < 2; ++k2) { const LAS unsigned char* vp = VB + (16 * (4 + dt) + fr) * MB_VSTR + (32 * k2 + 4 * fq) * 2; vlo[dt][k2] = *(const LAS v2u*)vp; vhi[dt][k2] = *(const LAS v2u*)(vp + 32); }
                    __builtin_amdgcn_sched_barrier(0); }
#pragma unroll
                for (int dt = 0; dt < 4; ++dt)
#pragma unroll
                    for (int k2 = 0; k2 < 2; ++k2) { v4u t; t.x = vlo[dt][k2].x; t.y = vlo[dt][k2].y; t.z = vhi[dt][k2].x; t.w = vhi[dt][k2].y; ao[4 * dh + dt] = mma16(__builtin_bit_cast(bf16x8_t, t), pf[k2], ao[4 * dh + dt]); }
                __builtin_amdgcn_sched_barrier(0); }
        }
        if (it + 1 < nt) MB_STORE(F.lds + (hf ^ 1) * MB_BUF, hf ^ 1);
        LDS_WAIT(); __syncthreads();
      }
    }
#undef MB_LOAD
#undef MB_STORE
    lsum += __shfl_xor(lsum, 16); lsum += __shfl_xor(lsum, 32);
    const float inv = 1.0f / lsum;
    GAS bf16* yp = (GAS bf16*)(F.ws + WS_Y) + ((size_t)b * SEQ + qpos) * YW + 2048 + h * 128 + 4 * fq;
#pragma unroll
    for (int dt = 0; dt < 8; ++dt) { v2u o; o.x = pk2(ao[dt][0] * inv, ao[dt][1] * inv); o.y = pk2(ao[dt][2] * inv, ao[dt][3] * inv); *(GAS v2u*)(yp + 16 * dt) = o; }
}

__device__ __forceinline__ void p2c_gla_finish(Frame& F, int l) {
    const GAS bf16* P = (const GAS bf16*)(F.ws + WS_P); const GAS float* OT = (const GAS float*)(F.ws + WS_OT); GAS bf16* Y = (GAS bf16*)(F.ws + WS_Y);
    const int lane = F.lane, gw = blockIdx.x * NWAVES + F.wave, NGW = F.G * NWAVES;
    const f32x4 gn = *(const GAS f32x4*)(((const GAS float*)F.in[I_GNG]) + l * 256 + 4 * lane);
    for (int it = gw; it < MTOK * 4; it += NGW) { const int tok = it >> 2, h = it & 3;
        const f32x4 o = (*(const GAS f32x4*)(OT + (size_t)tok * 1024 + h * 256 + 4 * lane) + *(const GAS f32x4*)(OT + (size_t)(MTOK + tok) * 1024 + h * 256 + 4 * lane)) + (*(const GAS f32x4*)(OT + (size_t)(2 * MTOK + tok) * 1024 + h * 256 + 4 * lane) + *(const GAS f32x4*)(OT + (size_t)(3 * MTOK + tok) * 1024 + h * 256 + 4 * lane));
        const float ss = wave_sum((o[0] * o[0] + o[1] * o[1]) + (o[2] * o[2] + o[3] * o[3])); const float rn = 1.0f / sqrtf(ss * (1.0f / 256.0f) + RMS_EPS);
        const v2u rw = *(const GAS v2u*)(P + (size_t)tok * NP + PC_GR + h * 256 + 4 * lane);
        const float r0 = bflo(rw.x), r1 = bfhi(rw.x), r2 = bflo(rw.y), r3 = bfhi(rw.y);
        v2u w; w.x = pk2(o[0] * rn * gn[0] * r0 * sigmoidf_(r0), o[1] * rn * gn[1] * r1 * sigmoidf_(r1)); w.y = pk2(o[2] * rn * gn[2] * r2 * sigmoidf_(r2), o[3] * rn * gn[3] * r3 * sigmoidf_(r3));
        *(GAS v2u*)(Y + (size_t)tok * YW + 1024 + h * 256 + 4 * lane) = w; }
}

constexpr int NPH = 9;
__global__ void __launch_bounds__(NWAVES * 64, 2) fwd_kernel(Args args) {
    extern __shared__ __attribute__((aligned(16))) unsigned char lds[];
    Frame F;
    F.lds = (LAS unsigned char*)lds;
    F.MISC = (volatile LAS unsigned*)(F.lds + MISC_OFF);
    F.tid = threadIdx.x; F.lane = F.tid & 63; F.wave = __builtin_amdgcn_readfirstlane(F.tid >> 6); F.wv = F.wave;
    F.G = gridDim.x; F.in = args.in; F.ws = (GAS unsigned char*)args.ws; F.ws0 = args.ws; F.ctl = (unsigned*)(args.ws + WS_CTL);
    for (int u = F.tid; u < (LDS_BYTES - LDSCTL_OFF) / 4; u += NWAVES * 64) ((LAS unsigned*)(F.lds + LDSCTL_OFF))[u] = 0u;
    __syncthreads();
    XcdBarrier bar; bar.bar = F.ctl + CW_BAR; bar.x = 0; bar.st = nullptr;
    if (args.fused) bar = xcd_barrier_post(F.ctl + CW_BAR, F.MISC + 8);
#define GRID_BAR() do { if (args.fused) xcd_barrier(bar, opaque_tid(F.wv)); } while (0)
    const int lo = args.ph_lo, hi = args.ph_hi;
#ifndef PH_MASK
#define PH_MASK 0x1ff
#endif
#define IN(k) (((PH_MASK >> (k)) & 1) && lo <= (k) && (k) < hi)
#define WSP(T, off) ((GAS T*)(ws + (off)))

    if (args.l_lo == 0 && IN(0)) for (int rep = 0; rep < NREP(0); ++rep) { F.refresh(); p0_prologue(F); GRID_BAR(); }

    for (int l = args.l_lo; l < args.l_hi; ++l) {
        if (IN(1)) for (int rep = 0; rep < NREP(1); ++rep) {
            GAS unsigned char* ws = (GAS unsigned char*)opaque_ptr(args.ws); const GAS unsigned char* wl = ws + WS_W + (size_t)l * SZ_WLAYER;
            pg8::Gemm g{WSP(pg8::bf16_t, WS_XB), DM, (const GAS pg8::bf16_t*)(wl + OFF_WIN), DM, DM, 0, 0}; pg8::TileOrder S; S.init(MTOK, NP, F.G, (int)blockIdx.x, 1);
            pg8::EpiInProj E{WSP(pg8::bf16_t, WS_P), WSP(float, WS_SSQ), WSP(pg8::bf16_t, WS_US)};
            pg8::gemm_phase(F.lds, g, S, E, F.wv);
            if (rep == 0) { F.refresh(); cv_tail(F, l, 0); }
            GRID_BAR();
        }
        if (IN(2)) for (int rep = 0; rep < NREP(2); ++rep) { F.refresh(); p2a_naive(F, l);
#if S5_MFMA
            VM_WAIT(); __syncthreads(); F.refresh(); for (int rp = 0; rp < NREP(12); ++rp) for (int u = blockIdx.x; u < 256; u += F.G) s5_s1_unit(F, l, u);
#endif
#if GLA_MFMA
            VM_WAIT(); __syncthreads(); F.refresh(); for (int rp = 0; rp < NREP(13); ++rp) for (int u = blockIdx.x; u < 512; u += F.G) gla_g1_unit(F, l, u);
#endif
#if MOBA_MFMA
            VM_WAIT(); __syncthreads(); F.refresh(); for (int rp = 0; rp < NREP(14); ++rp) for (int u = blockIdx.x; u < 256; u += F.G) moba_prep_unit(F, l, u);
#endif
            GRID_BAR(); }
        if (IN(3)) for (int rep = 0; rep < NREP(3); ++rep) {
#if S5_MFMA
            F.refresh(); for (int rp = 0; rp < NREP(9); ++rp) for (int u = blockIdx.x; u < 256; u += F.G) s5_s3_unit(F, l, u);
            VM_WAIT(); __syncthreads();
#endif
#if GLA_MFMA
            F.refresh(); for (int rp = 0; rp < NREP(10); ++rp) gla_g2_scan(F);
#endif
#if MOBA_MFMA
            VM_WAIT(); __syncthreads(); F.refresh();
            for (int rp = 0; rp < NREP(11); ++rp) for (int pi2 = 2 * blockIdx.x; pi2 < 512; pi2 += 2 * F.G) {
#pragma unroll 1
                for (int hh = 0; hh < 2; ++hh) { const int pi = pi2 >> 1; moba_attn_unit(F, pi >> 3, hh ? (pi & 7) : 15 - (pi & 7)); } }
#else
            F.refresh(); p2b_naive(F, l);
#endif
            GRID_BAR(); }
        if (IN(4)) for (int rep = 0; rep < NREP(4); ++rep) {
#if GLA_MFMA
            const int gh = F.G >= 2 ? F.G / 2 : 1;
            if ((int)blockIdx.x < gh) {
                GAS unsigned char* ws = (GAS unsigned char*)opaque_ptr(args.ws); const GAS unsigned char* wl = ws + WS_W + (size_t)l * SZ_WLAYER;
                pg8::Gemm g{WSP(pg8::bf16_t, WS_Z), 1024, (const GAS pg8::bf16_t*)(wl + OFF_WGLU), 1024, 1024, 0, 0}; pg8::TileOrder S; S.init(MTOK, 1024, gh, (int)blockIdx.x, 1);
                pg8::EpiGLU E{WSP(pg8::bf16_t, WS_Z), WSP(pg8::bf16_t, WS_Y), ((const GAS float*)args.in[I_BGLU]) + l * 1024};
                pg8::gemm_phase(F.lds, g, S, E, F.wv);
            }
            if ((int)blockIdx.x >= gh || F.G < 2) { F.refresh(); const int nb3 = F.G < 2 ? 1 : F.G - gh; for (int u = F.G < 2 ? 0 : (int)blockIdx.x - gh; u < 512; u += nb3) gla_g3_unit(F, l, u); }
#else
            F.refresh(); p2c_gla_finish(F, l);
            VM_WAIT(); __syncthreads();
            GAS unsigned char* ws = (GAS unsigned char*)opaque_ptr(args.ws); const GAS unsigned char* wl = ws + WS_W + (size_t)l * SZ_WLAYER;
            pg8::Gemm g{WSP(pg8::bf16_t, WS_Z), 1024, (const GAS pg8::bf16_t*)(wl + OFF_WGLU), 1024, 1024, 0, 0}; pg8::TileOrder S; S.init(MTOK, 1024, F.G, (int)blockIdx.x, 1);
            pg8::EpiGLU E{WSP(pg8::bf16_t, WS_Z), WSP(pg8::bf16_t, WS_Y), ((const GAS float*)args.in[I_BGLU]) + l * 1024};
            pg8::gemm_phase(F.lds, g, S, E, F.wv);
#endif
            GRID_BAR();
        }
        if (IN(5)) for (int rep = 0; rep < NREP(5); ++rep) {
            GAS unsigned char* ws = (GAS unsigned char*)opaque_ptr(args.ws); const GAS unsigned char* wl = ws + WS_W + (size_t)l * SZ_WLAYER;
            pg8::Gemm g{WSP(pg8::bf16_t, WS_Y), YW, (const GAS pg8::bf16_t*)(wl + OFF_WBR), 3072, 1024, 1024, 1024}; pg8::TileOrder S; S.init(MTOK, DM, F.G, (int)blockIdx.x, 3);
            pg8::EpiBranch E{WSP(pg8::bf16_t, WS_P), WSP(pg8::bf16_t, WS_MB)};
            pg8::gemm_phase(F.lds, g, S, E, F.wv);
            GRID_BAR();
        }
        if (IN(6)) {
            GAS unsigned char* ws = (GAS unsigned char*)opaque_ptr(args.ws); const GAS unsigned char* wl = ws + WS_W + (size_t)l * SZ_WLAYER;
            pg8::Gemm g{WSP(pg8::bf16_t, WS_MB), DM, (const GAS pg8::bf16_t*)(wl + OFF_WOUT), DM, DM, 0, 0}; pg8::TileOrder S; S.init(MTOK, DM, F.G, (int)blockIdx.x, 1);
            if (l == 0) { pg8::EpiResid<true, false> E{((const GAS float*)args.in[I_X]), nullptr, WSP(pg8::bf16_t, WS_XB), WSP(float, WS_SSQ)}; pg8::gemm_phase(F.lds, g, S, E, F.wv); }
            else { pg8::EpiResid<false, false> E{nullptr, nullptr, WSP(pg8::bf16_t, WS_XB), WSP(float, WS_SSQ)}; pg8::gemm_phase(F.lds, g, S, E, F.wv); }
            GRID_BAR();
        }
        if (IN(7)) for (int rep = 0; rep < NREP(7); ++rep) {
            GAS unsigned char* ws = (GAS unsigned char*)opaque_ptr(args.ws); const GAS unsigned char* wl = ws + WS_W + (size_t)l * SZ_WLAYER;
            pg8::Gemm g{WSP(pg8::bf16_t, WS_XB), DM, (const GAS pg8::bf16_t*)(wl + OFF_WGU), DM, DM, 0, 0}; pg8::TileOrder S; S.init(MTOK, NGU, F.G, (int)blockIdx.x, 1);
            pg8::EpiFFNUp E{WSP(pg8::bf16_t, WS_H), WSP(float, WS_SSQ)};
            pg8::gemm_phase(F.lds, g, S, E, F.wv);
            if (rep == 0) { F.refresh(); cv_tail(F, l, 1); }
            GRID_BAR();
        }
        if (IN(8)) {
            GAS unsigned char* ws = (GAS unsigned char*)opaque_ptr(args.ws); const GAS unsigned char* wl = ws + WS_W + (size_t)l * SZ_WLAYER;
            pg8::Gemm g{WSP(pg8::bf16_t, WS_H), FFN, (const GAS pg8::bf16_t*)(wl + OFF_WDN), FFN, FFN, 0, 0}; pg8::TileOrder S; S.init(MTOK, DM, F.G, (int)blockIdx.x, 1);
            if (l == DEPTH - 1) { pg8::EpiResid<false, true> E{nullptr, (GAS float*)args.out, WSP(pg8::bf16_t, WS_XB), WSP(float, WS_SSQ)}; pg8::gemm_phase(F.lds, g, S, E, F.wv); }
            else { pg8::EpiResid<false, false> E{nullptr, nullptr, WSP(pg8::bf16_t, WS_XB), WSP(float, WS_SSQ)}; pg8::gemm_phase(F.lds, g, S, E, F.wv); }
            if (l + 1 < DEPTH) GRID_BAR();
        }
    }
#if PROBE2
    GRID_BAR();
    if (blockIdx.x == 0) { volatile LAS unsigned long long* sl_ = (volatile LAS unsigned long long*)(F.lds + MISC_OFF + 64);
        const float ta = (float)(sl_[PR_A1] - sl_[PR_A0]) * 0.01f, tb = (float)(sl_[PR_B1] - sl_[PR_B0]) * 0.01f;
        const float qa = exp2f(rintf(log2f(fmaxf(ta, 0.01f)) * 4.0f) * 0.25f), qb = exp2f(rintf(log2f(fmaxf(tb, 0.01f)) * 4.0f) * 0.25f);
        for (int i = threadIdx.x; i < (1 << 20); i += 512) ((GAS float*)args.out)[(1 << 20) + i] = 1.0e3f * qb;
        if (threadIdx.x == 0) ((GAS float*)args.out)[0] = 1.0e5f * qa; }
#endif
#undef IN
#undef GRID_BAR
}

extern "C" void kernel_launch(void* const* d_in, const int* in_sizes, int n_in, void* d_out, int out_size, void* d_ws, size_t ws_size, hipStream_t stream) {
    static int grid = 0;
    if (grid == 0) {
        if (n_in != 26 || out_size != MTOK * DM || ws_size < WS_END) { fprintf(stderr, "kernel_launch: unexpected problem (n_in %d out %d ws %zu need %zu)\n", n_in, out_size, ws_size, (size_t)WS_END); grid = -1; return; }
        int dev = 0, cus = 0, per_cu = 0;
        if (hipGetDevice(&dev) != hipSuccess || hipDeviceGetAttribute(&cus, hipDeviceAttributeMultiprocessorCount, dev) != hipSuccess) { grid = -1; return; }
        if (hipFuncSetAttribute((const void*)fwd_kernel, hipFuncAttributeMaxDynamicSharedMemorySize, LDS_BYTES) != hipSuccess) { fprintf(stderr, "kernel_launch: hipFuncSetAttribute failed\n"); grid = -1; return; }
        if (hipOccupancyMaxActiveBlocksPerMultiprocessor(&per_cu, (const void*)fwd_kernel, NWAVES * 64, LDS_BYTES) != hipSuccess || per_cu < 1) { fprintf(stderr, "kernel_launch: occupancy query says %d\n", per_cu); }
        (void)hipGetLastError();
        grid = cus;
    }
    if (grid < 0) return;
    if (hipMemsetAsync((char*)d_ws + WS_CTL, 0, CTL_ZERO_BYTES, stream) != hipSuccess) return;
    Args a{};
    for (int i = 0; i < 26; ++i) a.in[i] = (const float*)d_in[i];
    a.out = (float*)d_out; a.ws = (unsigned char*)d_ws; a.pad = 0;
#if MK_FUSED
    a.l_lo = 0; a.l_hi = DEPTH; a.ph_lo = 0; a.ph_hi = NPH; a.fused = 1;
    hipLaunchKernelGGL(fwd_kernel, dim3(grid), dim3(NWAVES * 64), LDS_BYTES, stream, a);
#else
    a.fused = 0;
    for (int l = 0; l < DEPTH; ++l)
        for (int ph = (l == 0 ? 0 : 1); ph < NPH; ++ph) { a.l_lo = l; a.l_hi = l + 1; a.ph_lo = ph; a.ph_hi = ph + 1; hipLaunchKernelGGL(fwd_kernel, dim3(grid), dim3(NWAVES * 64), LDS_BYTES, stream, a); }
#endif
}
```

```cpp
#include <hip/hip_runtime.h>
#include <cstdio>
#include <cstdint>

#ifndef S5_MFMA
#define S5_MFMA 1
#endif
#ifndef GLA_MFMA
#define GLA_MFMA 1
#endif
#ifndef REPEAT_MASK
#define REPEAT_MASK 0
#endif
#define NREP(k) (1 + ((REPEAT_MASK >> (k)) & 1))
#ifndef PROBE2
#define PROBE2 0
#endif
#ifndef PR_A0
#define PR_A0 0
#define PR_A1 1
#define PR_B0 1
#define PR_B1 2
#endif
#ifndef MOBA_MFMA
#define MOBA_MFMA 1
#endif
#ifndef MK_FUSED
#define MK_FUSED 1
#endif

__device__ __forceinline__ unsigned char* opaque_ptr(unsigned char* p) { asm volatile("" : "+s"(p)); return p; }
__device__ __forceinline__ int opaque_tid(int wv) { int ln; asm volatile("v_mbcnt_lo_u32_b32 %0, -1, 0\n\tv_mbcnt_hi_u32_b32 %0, -1, %0" : "=v"(ln)); return (wv << 6) | ln; }

namespace pg8 {
#define PG8_LAS __attribute__((address_space(3)))
typedef unsigned short bf16_t;
typedef short bf16x8 __attribute__((ext_vector_type(8)));
typedef float f32x4 __attribute__((ext_vector_type(4)));
typedef unsigned u32x4 __attribute__((ext_vector_type(4)));
typedef unsigned u32x2 __attribute__((ext_vector_type(2)));
constexpr int BM = 256, BK = 64, HALF = 128, HTB = HALF * BK * 2, STAGE_BYTES = 8 * HTB, NXCD = 8, WGM = 8;

__host__ __device__ __forceinline__ int lds_byte(int r, int c) { const int st = (r >> 4) * 2 + (c >> 5), rr = r & 15, cc = c & 31, ob = rr * 64 + cc * 2; return st * 1024 + (ob ^ (((ob >> 9) & 1) << 5)); }
__host__ __device__ __forceinline__ void stage_rc(int b, int& R, int& C) { const int st = b / 1024, sb = b % 1024, swz = sb ^ (((sb >> 9) & 1) << 5); R = (st >> 1) * 16 + swz / 64; C = (st & 1) * 32 + (swz % 64) / 2; }
__host__ __device__ __forceinline__ int perm32(int rho) { const int n = rho >> 4, i = rho & 15; return 8 * (i >> 2) + 4 * n + (i & 3); }

struct Unit { int pm, pn, br; };
struct Gemm { const __attribute__((address_space(1))) bf16_t* A; int lda; const __attribute__((address_space(1))) bf16_t* Bt; int ldb; int K; int abr, bbr; };

struct TileOrder {
    int nM, nN, nwg, G, c, nbr;
    __device__ __forceinline__ void init(int M, int N, int G_, int c_, int nbr_) { asm volatile("" : "+s"(G_), "+s"(c_)); nM = M / BM; nN = N / BM; nwg = nM * nN; G = G_; c = c_; nbr = nbr_; }
    __device__ __forceinline__ bool next(int i, Unit& u) const {
        const int it = i / nbr; u.br = i - it * nbr;
        const long L = (long)it * G + c; if (L >= nwg) return false;
        int wgid = (int)L; { const int q = nwg / NXCD, r = nwg % NXCD, xcd = wgid % NXCD, off = wgid / NXCD; wgid = (xcd < r ? xcd * (q + 1) : r * (q + 1) + (xcd - r) * q) + off; }
        const int nig = WGM * nN, gid = wgid / nig, fm = gid * WGM, gsz = (nM - fm) < WGM ? (nM - fm) : WGM;
        u.pm = __builtin_amdgcn_readfirstlane(fm + ((wgid % nig) % gsz)); u.pn = __builtin_amdgcn_readfirstlane((wgid % nig) / gsz); return true;
    }
};

__device__ __forceinline__ unsigned cvt_pk_bf16(float lo, float hi) { unsigned r; asm volatile("v_cvt_pk_bf16_f32 %0, %1, %2" : "=v"(r) : "v"(lo), "v"(hi)); return r; }

template <class Epi, class Sched>
__device__ __forceinline__ void gemm_phase(PG8_LAS unsigned char* lds, const Gemm g, const Sched& S, const Epi& E, int wv) {
    const int tid = opaque_tid(wv), wid = __builtin_amdgcn_readfirstlane(tid >> 6), lane = tid & 63, wr = wid >> 2, wc = wid & 3, fr = lane & 15, fq = lane >> 4;
    const int K = g.K, nt = K / BK;
    unsigned voffA[2], voffB[2];
#pragma unroll
    for (int i = 0; i < 2; ++i) { int R, C; stage_rc(tid * 16 + i * 8192, R, C); const int Rb = (R & ~31) + perm32(R & 31);
        voffA[i] = (unsigned)(R * g.lda + C) * 2u; voffB[i] = (unsigned)(Rb * g.ldb + C) * 2u; }
    const size_t kstep = (size_t)(BK * 2);
    const size_t hstepA = (size_t)HALF * g.lda * 2, hstepB = (size_t)HALF * g.ldb * 2;
    const size_t tstepA = 2 * hstepA, tstepB = 2 * hstepB;
    const unsigned ldsw = (unsigned)wid * 1024u;
    const int aoff = lds_byte(wr * 64 + fr, fq * 8), boff = lds_byte(wc * 32 + fr, fq * 8);
#define PG8_SA(b, h) (((b) * 2 + (h)) * HTB)
#define PG8_SB(b, h) ((4 + (b) * 2 + (h)) * HTB)
#define PG8_STAGE(bufoff, gbase, voff) do { _Pragma("unroll") for (int _i = 0; _i < 2; ++_i) \
        __builtin_amdgcn_global_load_lds((const unsigned*)((const char*)(gbase) + (voff)[_i]), (PG8_LAS unsigned*)(lds + (bufoff) + ldsw + _i * 8192), 16, 0, 0); } while (0)
#define PG8_LDA(dst, b, h) do { _Pragma("unroll") for (int m = 0; m < 4; ++m) _Pragma("unroll") for (int k = 0; k < 2; ++k) dst[m][k] = *(const PG8_LAS bf16x8*)(lds + PG8_SA(b, h) + aoff + m * 2048 + k * 1024); } while (0)
#define PG8_LDB(dst, b, h) do { _Pragma("unroll") for (int n = 0; n < 2; ++n) _Pragma("unroll") for (int k = 0; k < 2; ++k) dst[n][k] = *(const PG8_LAS bf16x8*)(lds + PG8_SB(b, h) + boff + n * 2048 + k * 1024); } while (0)
#define PG8_MMA(ai, bj, At, Bt) do { __builtin_amdgcn_s_setprio(1); _Pragma("unroll") for (int m = 0; m < 4; ++m) _Pragma("unroll") for (int n = 0; n < 2; ++n) _Pragma("unroll") for (int k = 0; k < 2; ++k) \
        acc[ai][bj][m][n] = __builtin_amdgcn_mfma_f32_16x16x32_bf16(Bt[n][k], At[m][k], acc[ai][bj][m][n], 0, 0, 0); __builtin_amdgcn_s_setprio(0); } while (0)
#define PG8_WAIT_V(n) asm volatile("s_waitcnt vmcnt(" #n ")" ::: "memory")
#define PG8_WAIT_L(n) asm volatile("s_waitcnt lgkmcnt(" #n ")" ::: "memory")
#define PG8_BAR __builtin_amdgcn_s_barrier()
#define PG8_SCHED __builtin_amdgcn_sched_barrier(0)
    Unit cur, nxt; int ui = 0;
    if (!S.next(0, cur)) return;
    f32x4 acc[2][2][4][2];
#pragma unroll
    for (int a = 0; a < 2; ++a)
#pragma unroll
        for (int b = 0; b < 2; ++b)
#pragma unroll
            for (int m = 0; m < 4; ++m)
#pragma unroll
                for (int n = 0; n < 2; ++n) acc[a][b][m][n] = (f32x4){0.f, 0.f, 0.f, 0.f};
    bf16x8 At[4][2], B0[2][2], B1[2][2];
    const char* cA = (const char*)g.A + (size_t)cur.pm * tstepA + (size_t)cur.br * g.abr * 2; const char* cB = (const char*)g.Bt + (size_t)cur.pn * tstepB + (size_t)cur.br * g.bbr * 2;
    PG8_STAGE(PG8_SB(0, 0), cB, voffB); PG8_STAGE(PG8_SB(0, 1), cB + hstepB, voffB); PG8_STAGE(PG8_SA(0, 0), cA, voffA); PG8_STAGE(PG8_SA(0, 1), cA + hstepA, voffA);
    if (wr == 1) PG8_BAR;
    PG8_WAIT_V(2); PG8_BAR;
    PG8_STAGE(PG8_SB(1, 0), cB + kstep, voffB); PG8_STAGE(PG8_SA(1, 0), cA + kstep, voffA); PG8_STAGE(PG8_SB(1, 1), cB + hstepB + kstep, voffB);
    PG8_WAIT_V(6); PG8_BAR;
    for (;;) {
        const bool has_next = S.next(ui + 1, nxt);
        const char* nA = has_next ? (const char*)g.A + (size_t)nxt.pm * tstepA + (size_t)nxt.br * g.abr * 2 : cA; const char* nB = has_next ? (const char*)g.Bt + (size_t)nxt.pn * tstepB + (size_t)nxt.br * g.bbr * 2 : cB;
        for (int t = 0; t < nt; t += 2) {
            const bool last = (t == nt - 2);
            const char* a1 = cA + (size_t)(t + 1) * kstep;
            const char* a2 = last ? nA : cA + (size_t)(t + 2) * kstep; const char* b2 = last ? nB : cB + (size_t)(t + 2) * kstep;
            const char* a3 = a2 + kstep; const char* b3 = b2 + kstep;
            PG8_LDB(B0, 0, 0); PG8_LDB(B1, 0, 1); PG8_SCHED; PG8_LDA(At, 0, 0); PG8_STAGE(PG8_SA(1, 1), a1 + hstepA, voffA);
            PG8_WAIT_V(8); PG8_WAIT_L(0); PG8_BAR; PG8_MMA(0, 0, At, B0); PG8_MMA(0, 1, At, B1); PG8_BAR; PG8_SCHED;
            PG8_LDA(At, 0, 1); PG8_STAGE(PG8_SB(0, 0), b2, voffB); PG8_STAGE(PG8_SB(0, 1), b2 + hstepB, voffB); PG8_STAGE(PG8_SA(0, 0), a2, voffA);
            PG8_WAIT_V(8); PG8_WAIT_L(0); PG8_BAR; PG8_MMA(1, 0, At, B0); PG8_MMA(1, 1, At, B1); PG8_BAR; PG8_SCHED;
            PG8_LDB(B0, 1, 0); PG8_LDB(B1, 1, 1); PG8_SCHED; PG8_LDA(At, 1, 0); PG8_STAGE(PG8_SA(0, 1), a2 + hstepA, voffA);
            PG8_WAIT_V(8); PG8_WAIT_L(0); PG8_BAR; PG8_MMA(0, 0, At, B0); PG8_MMA(0, 1, At, B1); PG8_BAR; PG8_SCHED;
            PG8_LDA(At, 1, 1); PG8_STAGE(PG8_SB(1, 0), b3, voffB); PG8_STAGE(PG8_SB(1, 1), b3 + hstepB, voffB); PG8_STAGE(PG8_SA(1, 0), a3, voffA);
            PG8_WAIT_V(8); PG8_WAIT_L(0); PG8_BAR; PG8_MMA(1, 0, At, B0); PG8_MMA(1, 1, At, B1); PG8_BAR; PG8_SCHED;
        }
        if (wr == 0) PG8_BAR;
        E(acc, cur, wr, wc, fr, fq, lds);
        if (!has_next) break;
        if (!Epi::CHAIN || cur.br == S.nbr - 1) {
#pragma unroll
        for (int a = 0; a < 2; ++a)
#pragma unroll
            for (int b = 0; b < 2; ++b)
#pragma unroll
                for (int m = 0; m < 4; ++m)
#pragma unroll
                    for (int n = 0; n < 2; ++n) acc[a][b][m][n] = (f32x4){0.f, 0.f, 0.f, 0.f};
        }
        cur = nxt; cA = nA; cB = nB; ++ui;
        if (wr == 1) PG8_BAR;
    }
    PG8_WAIT_V(0);
    PG8_BAR;
#undef PG8_SA
#undef PG8_SB
#undef PG8_STAGE
#undef PG8_LDA
#undef PG8_LDB
#undef PG8_MMA
#undef PG8_WAIT_V
#undef PG8_WAIT_L
#undef PG8_BAR
#undef PG8_SCHED
}
}

constexpr int NWAVES = 8;
constexpr int DM = 2048, NBATCH = 4, SEQ = 2048, DEPTH = 4, MTOK = NBATCH * SEQ;
constexpr int INW = 13328;
constexpr int NP = 13568;
constexpr int PC_SSM = 0, PC_GQ = 1024, PC_GK = 1536, PC_GV = 2048, PC_GR = 3072, PC_MQ = 4096, PC_MK = 5120, PC_MV = 6144, PC_GS = 7168, PC_GLR = 13312;
constexpr int FFN = 5632, NGU = 2 * FFN;
constexpr int YW = 3072;
constexpr float RMS_EPS = 1e-6f;

constexpr size_t MiB = 1u << 20;
constexpr size_t WS_CTL = 0, CTL_ZERO_BYTES = 1 * MiB;
constexpr size_t SZ_WIN = (size_t)NP * DM * 2, SZ_WGLU = (size_t)1024 * 1024 * 2, SZ_WBR = (size_t)DM * 3072 * 2, SZ_WOUT = (size_t)DM * DM * 2, SZ_WGU = (size_t)NGU * DM * 2, SZ_WDN = (size_t)DM * FFN * 2;
constexpr size_t OFF_WIN = 0, OFF_WGLU = OFF_WIN + SZ_WIN, OFF_WBR = OFF_WGLU + SZ_WGLU, OFF_WOUT = OFF_WBR + SZ_WBR, OFF_WGU = OFF_WOUT + SZ_WOUT, OFF_WDN = OFF_WGU + SZ_WGU, SZ_WLAYER = OFF_WDN + SZ_WDN;
constexpr size_t WS_W = 2 * MiB;
constexpr size_t WS_P = WS_W + ((DEPTH * SZ_WLAYER + MiB - 1) / MiB) * MiB;
constexpr size_t WS_Z = WS_P + (size_t)MTOK * NP * 2;
constexpr size_t WS_Y = WS_Z + (size_t)MTOK * 1024 * 2;
constexpr size_t WS_MG = WS_Y + (size_t)MTOK * YW * 2;
constexpr size_t WS_MB = WS_MG + (size_t)MTOK * DM * 4;
constexpr size_t WS_XR = WS_MB + (size_t)MTOK * DM * 2;
constexpr size_t WS_XB = WS_XR + (size_t)MTOK * DM * 4;
constexpr size_t WS_H = WS_XB + (size_t)MTOK * DM * 2;
constexpr size_t WS_SSQ = WS_H + (size_t)MTOK * FFN * 2;
constexpr size_t WS_EG = WS_SSQ + (size_t)MTOK * 8 * 4;
constexpr size_t WS_OT = WS_EG + (size_t)MTOK * 512 * 4;
constexpr size_t WS_QN = WS_OT + (size_t)4 * MTOK * 1024 * 4;
constexpr size_t WS_KN = WS_QN + (size_t)MTOK * 1024 * 2;
constexpr size_t WS_KM = WS_KN + (size_t)MTOK * 1024 * 2;
constexpr size_t WS_TK = WS_KM + (size_t)4 * 8 * 8 * 128 * 4;
constexpr size_t WS_TW = WS_TK + (size_t)DEPTH * 64 * 64 * 256 * 2;
constexpr size_t WS_TC = WS_TW + (size_t)DEPTH * 64 * 128 * 1024 * 2;
constexpr size_t WS_A64 = WS_TC + (size_t)DEPTH * 64 * 1024 * 128 * 2;
constexpr size_t WS_SL = WS_A64 + (size_t)DEPTH * 64 * 128 * 4;
constexpr size_t WS_QD = WS_SL + (size_t)NBATCH * 32 * 64 * 128 * 4;
constexpr size_t WS_KI = WS_QD + (size_t)512 * 64 * 128 * 2;
constexpr size_t WS_GVT = WS_KI + (size_t)512 * 64 * 128 * 2;
constexpr size_t WS_KV = WS_GVT + (size_t)512 * 256 * 64 * 2;
constexpr size_t WS_DEC = WS_KV + (size_t)512 * 256 * 128 * 4;
constexpr size_t WS_ST = WS_DEC + (size_t)512 * 128 * 4;
constexpr size_t WS_VT = WS_ST + (size_t)512 * 256 * 128 * 2;
constexpr size_t WS_US = WS_VT + (size_t)NBATCH * 8 * 128 * SEQ * 2;
constexpr size_t WS_END = WS_US + (size_t)MTOK * 1024 * 2;
constexpr int CW_BAR = 4096;
constexpr int CW_QUEUE = 16384;

constexpr int RING_BYTES = 135168;
constexpr int LDSCTL_OFF = RING_BYTES, MISC_OFF = LDSCTL_OFF + 320;
constexpr int TAB_OFF = RING_BYTES + 1024;
constexpr int LDS_BYTES = 147456;

#define GAS __attribute__((address_space(1)))
#define LAS __attribute__((address_space(3)))
typedef unsigned short bf16;
typedef unsigned v4u __attribute__((ext_vector_type(4)));
typedef unsigned v2u __attribute__((ext_vector_type(2)));
typedef float f32x4 __attribute__((ext_vector_type(4)));
typedef float f32x2 __attribute__((ext_vector_type(2)));
#define LDS_WAIT() asm volatile("s_waitcnt lgkmcnt(0)" ::: "memory")
#define VM_WAIT() asm volatile("s_waitcnt vmcnt(0)" ::: "memory")
__device__ __forceinline__ unsigned f2bf(float f) { unsigned u = __builtin_bit_cast(unsigned, f); return (u + 0x7fffu + ((u >> 16) & 1u)) >> 16; }
__device__ __forceinline__ unsigned pk2(float lo, float hi) { return f2bf(lo) | (f2bf(hi) << 16); }
__device__ __forceinline__ float bflo(unsigned u) { return __builtin_bit_cast(float, u << 16); }
__device__ __forceinline__ float bfhi(unsigned u) { return __builtin_bit_cast(float, u & 0xffff0000u); }
__device__ __forceinline__ float bf1(bf16 b) { return __builtin_bit_cast(float, ((unsigned)b) << 16); }
__device__ __forceinline__ float sigmoidf_(float x) { return __builtin_amdgcn_rcpf(1.0f + __expf(-x)); }
__device__ __forceinline__ float gelu_tanh(float x) { const float u = 0.7978845608028654f * (x + 0.044715f * x * x * x); return x * sigmoidf_(2.0f * u); }
__device__ __forceinline__ float wave_sum(float v) {
#pragma unroll
    for (int o = 1; o < 64; o <<= 1) v += __shfl_xor(v, o);
    return v;
}
__device__ __forceinline__ float wave_max(float v) {
#pragma unroll
    for (int o = 1; o < 64; o <<= 1) v = fmaxf(v, __shfl_xor(v, o));
    return v;
}

#define XB_TMO      128
#define XB_XCNT(j)  (256  + 64 * (j))
#define XB_XSUB(j)  (1280 + 64 * (j))
#define XB_XGEN(j)  (2304 + 64 * (j))
#define XB_TOP      3328
#define XB_TOPGEN   3392
#define XCD_BAR_WORDS 3456
#define XB_SPIN_CAP (1u << 18)
__device__ __forceinline__ unsigned xb_ld(unsigned* p)              { return __hip_atomic_load(p, __ATOMIC_RELAXED, __HIP_MEMORY_SCOPE_AGENT); }
__device__ __forceinline__ unsigned xb_add(unsigned* p, unsigned v) { return __hip_atomic_fetch_add(p, v, __ATOMIC_RELAXED, __HIP_MEMORY_SCOPE_AGENT); }
__device__ __forceinline__ unsigned xb_xcc_id() { return (unsigned)__builtin_amdgcn_s_getreg((3 << 11) | 20) & 0xFu; }
#define XB_SPIN(cond, bar) do { unsigned _sp = 0; while (cond) { __builtin_amdgcn_s_sleep(1); \
    if ((++_sp & 255u) == 0u) { if (xb_ld(&(bar)[XB_TMO])) break; if (_sp > XB_SPIN_CAP) { atomicAdd(&(bar)[XB_TMO], 1u); break; } } } } while (0)
struct XcdBarrier { unsigned* bar; unsigned x; volatile LAS unsigned* st; };
__device__ __forceinline__ XcdBarrier xcd_barrier_post(unsigned* bar, volatile LAS unsigned* st) {
    XcdBarrier b; b.bar = bar; b.x = xb_xcc_id(); b.st = st;
    if (threadIdx.x == 0) (void)xb_add(&bar[XB_XCNT(b.x)], 1u);
    return b;
}
__device__ __forceinline__ void xcd_barrier_complete(unsigned* bar, unsigned x, unsigned& nloc, unsigned& nx) {
    const unsigned G = gridDim.x * gridDim.y * gridDim.z;
    unsigned sum, cnt, mine, sp = 0u;
    for (;;) {
        sum = 0u; cnt = 0u; mine = 0u;
#pragma unroll
        for (unsigned j = 0; j < 16; ++j) { const unsigned c = xb_ld(&bar[XB_XCNT(j)]); sum += c; cnt += (c > 0u) ? 1u : 0u; mine = (j == x) ? c : mine; }
        if (sum == G) break;
        __builtin_amdgcn_s_sleep(1);
        if ((++sp & 255u) == 0u) { if (xb_ld(&bar[XB_TMO])) break; if (sp > XB_SPIN_CAP) { atomicAdd(&bar[XB_TMO], 1u); break; } }
    }
    nloc = mine > 0u ? mine : 1u; nx = cnt > 0u ? cnt : 1u;
}
__device__ __forceinline__ void xcd_barrier(const XcdBarrier& b, int tid) {
    asm volatile("s_waitcnt vmcnt(0)" ::: "memory");
    __syncthreads();
    if (tid == 0) {
        unsigned* bar = b.bar;
        __builtin_amdgcn_s_waitcnt(0);
        unsigned nloc = b.st[0], nx = b.st[1];
        if (nloc == 0u) { xcd_barrier_complete(bar, b.x, nloc, nx); b.st[0] = nloc; b.st[1] = nx; }
        const unsigned old = xb_add(&bar[XB_XSUB(b.x)], 1u);
        const unsigned gen = old / nloc;
        if (old + 1u == (gen + 1u) * nloc) {
            __builtin_amdgcn_fence(__ATOMIC_RELEASE, "agent");
            asm volatile("s_waitcnt vmcnt(0)" ::: "memory");
            const unsigned og = xb_add(&bar[XB_TOP], 1u);
            const unsigned tg = og / nx;
            if (og + 1u == (tg + 1u) * nx) xb_add(&bar[XB_TOPGEN], 1u);
            else XB_SPIN(xb_ld(&bar[XB_TOPGEN]) == tg, bar);
            __builtin_amdgcn_fence(__ATOMIC_ACQUIRE, "agent");
            xb_add(&bar[XB_XGEN(b.x)], 1u);
            asm volatile("s_waitcnt vmcnt(0)" ::: "memory");
        } else {
            XB_SPIN(xb_ld(&bar[XB_XGEN(b.x)]) == gen, bar);
            __builtin_amdgcn_fence(__ATOMIC_ACQUIRE, "agent");
            asm volatile("s_waitcnt vmcnt(0)" ::: "memory");
        }
    }
    __syncthreads();
}

struct Args {
    const float* in[26];
    float* out; unsigned char* ws;
    int l_lo, l_hi, ph_lo, ph_hi;
    int fused, pad;
};
enum { I_X = 0, I_N1G, I_WIN, I_LRE, I_LIM, I_LDT, I_BRE, I_BIM, I_CRE, I_CIM, I_SD, I_WGLU, I_BGLU, I_GW2, I_GB2, I_GNG, I_MQG, I_MKG, I_WBS, I_WBG, I_WBM, I_WOUT, I_N2G, I_FWG, I_FWU, I_FWD };

namespace pg8 {
#define EPI_FENCE() asm volatile("" ::: "memory")
__device__ __forceinline__ void load_rstd(const GAS float* ssq, int pm, int wr, int fr, int fq, float (&rs)[2][4]) {
    f32x2 p[2][4];
#pragma unroll
    for (int ai = 0; ai < 2; ++ai)
#pragma unroll
        for (int m = 0; m < 4; ++m) { const int row = pm * BM + ai * HALF + wr * 64 + m * 16 + fr; p[ai][m] = *(const GAS f32x2*)(ssq + (size_t)row * 8 + 2 * fq); }
#pragma unroll
    for (int ai = 0; ai < 2; ++ai)
#pragma unroll
        for (int m = 0; m < 4; ++m) { float s = p[ai][m][0] + p[ai][m][1]; s += __shfl_xor(s, 16); s += __shfl_xor(s, 32); rs[ai][m] = 1.0f / sqrtf(s * (1.0f / DM) + RMS_EPS); }
    EPI_FENCE();
}
struct EpiInProj {
    static constexpr bool CHAIN = false;
    GAS bf16_t* P; const GAS float* ssq; GAS bf16_t* US;
    __device__ __forceinline__ void operator()(const f32x4 (&acc)[2][2][4][2], const Unit& u, int wr, int wc, int fr, int fq, PG8_LAS unsigned char*) const {
        float rs[2][4]; load_rstd(ssq, u.pm, wr, fr, fq, rs);
        const int row0 = u.pm * BM + wr * 64 + fr, col0 = u.pn * BM + wc * 32 + 8 * fq;
        const bool ssm = u.pn < 4;
#pragma unroll
        for (int ai = 0; ai < 2; ++ai)
#pragma unroll
            for (int m = 0; m < 4; ++m) { const int row = row0 + ai * HALF + m * 16; GAS bf16_t* rowp = P + (size_t)row * NP + col0; const float r = rs[ai][m];
#pragma unroll
                for (int bj = 0; bj < 2; ++bj) { const f32x4 v0 = acc[ai][bj][m][0] * r, v1 = acc[ai][bj][m][1] * r;
                    u32x4 w; w.x = cvt_pk_bf16(v0[0], v0[1]); w.y = cvt_pk_bf16(v0[2], v0[3]); w.z = cvt_pk_bf16(v1[0], v1[1]); w.w = cvt_pk_bf16(v1[2], v1[3]);
                    if (ssm) { const int col = col0 + bj * HALF; *(GAS u32x4*)(US + ((size_t)((row >> 11) * 64 + (col >> 4)) * SEQ + (row & (SEQ - 1))) * 16 + (col & 8)) = w; }
                    else *(GAS u32x4*)(rowp + bj * HALF) = w; } }
    }
};
struct EpiGLU {
    static constexpr bool CHAIN = false;
    const GAS bf16_t* Z; GAS bf16_t* Y; const GAS float* bias;
    __device__ __forceinline__ void operator()(const f32x4 (&acc)[2][2][4][2], const Unit& u, int wr, int wc, int fr, int fq, PG8_LAS unsigned char*) const {
        const int row0 = u.pm * BM + wr * 64 + fr, col0 = u.pn * BM + wc * 32 + 8 * fq;
        f32x4 bv[2][2];
#pragma unroll
        for (int bj = 0; bj < 2; ++bj)
#pragma unroll
            for (int n = 0; n < 2; ++n) bv[bj][n] = *(const GAS f32x4*)(bias + col0 + bj * HALF + 4 * n);
        u32x4 zb[4][2];
#pragma unroll
        for (int bt = 0; bt < 2; ++bt) {
#pragma unroll
            for (int i4 = 0; i4 < 4; ++i4) { const int idx = 4 * bt + i4; const size_t row = (size_t)(row0 + (idx >> 2) * HALF + (idx & 3) * 16);
#pragma unroll
                for (int bj = 0; bj < 2; ++bj) zb[i4][bj] = *(const GAS u32x4*)(Z + row * 1024 + col0 + bj * HALF); }
#pragma unroll
            for (int i4 = 0; i4 < 4; ++i4) { const int idx = 4 * bt + i4, ai = idx >> 2, m = idx & 3; const size_t row = (size_t)(row0 + ai * HALF + m * 16);
#pragma unroll
                for (int bj = 0; bj < 2; ++bj) { const u32x4 zz = zb[i4][bj];
                    const f32x4 g0 = acc[ai][bj][m][0] + bv[bj][0], g1 = acc[ai][bj][m][1] + bv[bj][1];
                    u32x4 w;
                    w.x = cvt_pk_bf16(bflo(zz.x) * sigmoidf_(g0[0]), bfhi(zz.x) * sigmoidf_(g0[1])); w.y = cvt_pk_bf16(bflo(zz.y) * sigmoidf_(g0[2]), bfhi(zz.y) * sigmoidf_(g0[3]));
                    w.z = cvt_pk_bf16(bflo(zz.z) * sigmoidf_(g1[0]), bfhi(zz.z) * sigmoidf_(g1[1])); w.w = cvt_pk_bf16(bflo(zz.w) * sigmoidf_(g1[2]), bfhi(zz.w) * sigmoidf_(g1[3]));
                    *(GAS u32x4*)(Y + row * YW + col0 + bj * HALF) = w; } }
            EPI_FENCE();
        }
    }
};
struct EpiBranch {
    static constexpr bool CHAIN = true;
    const GAS bf16_t* P; GAS bf16_t* MB;
    __device__ __forceinline__ void operator()(f32x4 (&acc)[2][2][4][2], const Unit& u, int wr, int wc, int fr, int fq, PG8_LAS unsigned char*) const {
        const int row0 = u.pm * BM + wr * 64 + fr, col0 = u.pn * BM + wc * 32 + 8 * fq;
        const int br = u.br;
        u32x4 ga[2][2], gb[2][2];
#pragma unroll
        for (int bt = 0; bt < 4; ++bt) {
#pragma unroll
            for (int i4 = 0; i4 < 2; ++i4) { const int idx = 2 * bt + i4; const size_t row = (size_t)(row0 + (idx >> 2) * HALF + (idx & 3) * 16);
#pragma unroll
                for (int bj = 0; bj < 2; ++bj) { const GAS bf16_t* gp = P + row * NP + PC_GS + br * DM + col0 + bj * HALF; ga[i4][bj] = *(const GAS u32x4*)gp; if (br != 2) gb[i4][bj] = *(const GAS u32x4*)(gp + DM); } }
#pragma unroll
            for (int i4 = 0; i4 < 2; ++i4) { const int idx = 2 * bt + i4, ai = idx >> 2, m = idx & 3; const size_t row = (size_t)(row0 + ai * HALF + m * 16);
#pragma unroll
                for (int bj = 0; bj < 2; ++bj) { const u32x4 g0 = ga[i4][bj]; const unsigned g0w[4] = {g0.x, g0.y, g0.z, g0.w}; float f[8];
                    if (br != 2) { const u32x4 g1 = gb[i4][bj]; const unsigned g1w[4] = {g1.x, g1.y, g1.z, g1.w};
#pragma unroll
                        for (int e = 0; e < 4; ++e) { f[2 * e] = (1.0f + __expf(-bflo(g1w[e]))) * __builtin_amdgcn_rcpf(1.0f + __expf(-bflo(g0w[e]))); f[2 * e + 1] = (1.0f + __expf(-bfhi(g1w[e]))) * __builtin_amdgcn_rcpf(1.0f + __expf(-bfhi(g0w[e]))); } }
                    else {
#pragma unroll
                        for (int e = 0; e < 4; ++e) { f[2 * e] = sigmoidf_(bflo(g0w[e])); f[2 * e + 1] = sigmoidf_(bfhi(g0w[e])); } }
                    f32x4 v0 = acc[ai][bj][m][0], v1 = acc[ai][bj][m][1];
                    v0[0] *= f[0]; v0[1] *= f[1]; v0[2] *= f[2]; v0[3] *= f[3]; v1[0] *= f[4]; v1[1] *= f[5]; v1[2] *= f[6]; v1[3] *= f[7];
                    if (br != 2) { acc[ai][bj][m][0] = v0; acc[ai][bj][m][1] = v1; }
                    else { u32x4 w; w.x = cvt_pk_bf16(v0[0], v0[1]); w.y = cvt_pk_bf16(v0[2], v0[3]); w.z = cvt_pk_bf16(v1[0], v1[1]); w.w = cvt_pk_bf16(v1[2], v1[3]); *(GAS u32x4*)(MB + row * DM + col0 + bj * HALF) = w; } } }
            EPI_FENCE();
        }
    }
};
template <bool FIRST, bool LAST> struct EpiResid {
    static constexpr bool CHAIN = false;
    const GAS float* xin; GAS float* xout; GAS bf16_t* XB; GAS float* ssq;
    __device__ __forceinline__ void operator()(const f32x4 (&acc)[2][2][4][2], const Unit& u, int wr, int wc, int fr, int fq, PG8_LAS unsigned char* lds) const {
        const int row0 = u.pm * BM + wr * 64 + fr, col0 = u.pn * BM + wc * 32 + 8 * fq;
        PG8_LAS float* T = (PG8_LAS float*)(lds + TAB_OFF);
        f32x4 xf[FIRST ? 4 : 1][2][2]; u32x4 xh[FIRST ? 1 : 8][2];
#pragma unroll
        for (int bt = 0; bt < (FIRST ? 2 : 1); ++bt) {
#pragma unroll
            for (int i4 = 0; i4 < (FIRST ? 4 : 8); ++i4) { const int idx = (FIRST ? 4 * bt : 0) + i4; const size_t row = (size_t)(row0 + (idx >> 2) * HALF + (idx & 3) * 16);
#pragma unroll
                for (int bj = 0; bj < 2; ++bj) { const size_t o = row * DM + col0 + bj * HALF;
                    if (FIRST) { xf[i4 & 3][bj][0] = *(const GAS f32x4*)(xin + o); xf[i4 & 3][bj][1] = *(const GAS f32x4*)(xin + o + 4); } else xh[FIRST ? 0 : i4][bj] = *(const GAS u32x4*)(XB + o); } }
#pragma unroll
            for (int i4 = 0; i4 < (FIRST ? 4 : 8); ++i4) { const int idx = (FIRST ? 4 * bt : 0) + i4, ai = idx >> 2, m = idx & 3; const size_t row = (size_t)(row0 + ai * HALF + m * 16); float s = 0.f;
#pragma unroll
                for (int bj = 0; bj < 2; ++bj) { const size_t o = row * DM + col0 + bj * HALF; f32x4 v0, v1;
                    if (FIRST) { v0 = acc[ai][bj][m][0] + xf[i4 & 3][bj][0]; v1 = acc[ai][bj][m][1] + xf[i4 & 3][bj][1]; }
                    else { const u32x4 h = xh[FIRST ? 0 : i4][bj]; v0 = acc[ai][bj][m][0] + (f32x4){bflo(h.x), bfhi(h.x), bflo(h.y), bfhi(h.y)}; v1 = acc[ai][bj][m][1] + (f32x4){bflo(h.z), bfhi(h.z), bflo(h.w), bfhi(h.w)}; }
                    if (LAST) { *(GAS f32x4*)(xout + o) = v0; *(GAS f32x4*)(xout + o + 4) = v1; }
                    else { u32x4 w; w.x = cvt_pk_bf16(v0[0], v0[1]); w.y = cvt_pk_bf16(v0[2], v0[3]); w.z = cvt_pk_bf16(v1[0], v1[1]); w.w = cvt_pk_bf16(v1[2], v1[3]); *(GAS u32x4*)(XB + o) = w;
                        v0 = (f32x4){bflo(w.x), bfhi(w.x), bflo(w.y), bfhi(w.y)}; v1 = (f32x4){bflo(w.z), bfhi(w.z), bflo(w.w), bfhi(w.w)}; }
                    s += (v0[0] * v0[0] + v0[1] * v0[1]) + (v0[2] * v0[2] + v0[3] * v0[3]) + (v1[0] * v1[0] + v1[1] * v1[1]) + (v1[2] * v1[2] + v1[3] * v1[3]); }
                if (!LAST) { s += __shfl_xor(s, 16); s += __shfl_xor(s, 32);
                    if (fq == 0) T[(ai * HALF + wr * 64 + m * 16 + fr) * 4 + wc] = s; } }
            EPI_FENCE();
        }
        if (!LAST) {
            asm volatile("s_waitcnt lgkmcnt(0)" ::: "memory"); __builtin_amdgcn_s_barrier(); asm volatile("" ::: "memory");
            const int t = (wr * 4 + wc) * 64 + fq * 16 + fr;
            if (t < 256) { const f32x4 p = *(const PG8_LAS f32x4*)(T + t * 4); ssq[(size_t)(u.pm * BM + t) * 8 + u.pn] = (p[0] + p[1]) + (p[2] + p[3]); }
        }
    }
};
struct EpiFFNUp {
    static constexpr bool CHAIN = false;
    GAS bf16_t* H; const GAS float* ssq;
    __device__ __forceinline__ void operator()(const f32x4 (&acc)[2][2][4][2], const Unit& u, int wr, int wc, int fr, int fq, PG8_LAS unsigned char*) const {
        float rs[2][4]; load_rstd(ssq, u.pm, wr, fr, fq, rs);
        const int row0 = u.pm * BM + wr * 64 + fr, col0 = u.pn * HALF + wc * 32 + 8 * fq;
#pragma unroll
        for (int ai = 0; ai < 2; ++ai)
#pragma unroll
            for (int m = 0; m < 4; ++m) { const float r = rs[ai][m]; float h[8];
#pragma unroll
                for (int n = 0; n < 2; ++n)
#pragma unroll
                    for (int e = 0; e < 4; ++e) { const float gv = acc[ai][0][m][n][e] * r, uv = acc[ai][1][m][n][e] * r; h[n * 4 + e] = gv * sigmoidf_(gv) * uv; }
                u32x4 w; w.x = cvt_pk_bf16(h[0], h[1]); w.y = cvt_pk_bf16(h[2], h[3]); w.z = cvt_pk_bf16(h[4], h[5]); w.w = cvt_pk_bf16(h[6], h[7]);
                *(GAS u32x4*)(H + (size_t)(row0 + ai * HALF + m * 16) * FFN + col0) = w; }
    }
};
}

struct Frame {
    __device__ __forceinline__ void refresh() { ws = (GAS unsigned char*)opaque_ptr(ws0); tid = opaque_tid(wv); lane = tid & 63; wave = __builtin_amdgcn_readfirstlane(tid >> 6); }
    LAS unsigned char* lds;
    volatile LAS unsigned* MISC;
    unsigned* ctl;
    int tid, lane, wave, G, wv;
    const float* const* in;
    GAS unsigned char* ws; unsigned char* ws0;
};

__device__ __forceinline__ void conv_item(const GAS float* W, int ldw, int k0, int src_c0, int nvalid, const GAS float* gk, GAS bf16* WT, int ldt, int dst_r0, int dst_k, LAS float* scr, int lane) {
    const int c4 = 4 * (lane & 15), rq = lane >> 4;
    f32x4 v[16];
#pragma unroll
    for (int i = 0; i < 16; ++i) { const int kk = 4 * i + rq; v[i] = (c4 < nvalid) ? __builtin_nontemporal_load((const GAS f32x4*)(W + (size_t)(k0 + kk) * ldw + src_c0 + c4)) : (f32x4){0.f, 0.f, 0.f, 0.f}; }
    if (gk) {
#pragma unroll
        for (int i = 0; i < 16; ++i) v[i] = v[i] * gk[k0 + 4 * i + rq]; }
#pragma unroll
    for (int i = 0; i < 16; ++i) { LAS float* d = scr + (4 * i + rq) * 65 + c4; d[0] = v[i][0]; d[1] = v[i][1]; d[2] = v[i][2]; d[3] = v[i][3]; }
    LDS_WAIT(); asm volatile("" ::: "memory");
    const int c8 = lane & 7;
#pragma unroll
    for (int j = 0; j < 8; ++j) { const int n = (lane >> 3) + 8 * j; const LAS float* sp = scr + (8 * c8) * 65 + n;
        v4u o; o.x = pk2(sp[0 * 65], sp[1 * 65]); o.y = pk2(sp[2 * 65], sp[3 * 65]); o.z = pk2(sp[4 * 65], sp[5 * 65]); o.w = pk2(sp[6 * 65], sp[7 * 65]);
        *(GAS v4u*)(WT + (size_t)(dst_r0 + n) * ldt + dst_k + 8 * c8) = o; }
    LDS_WAIT(); asm volatile("" ::: "memory");
}
constexpr int CV_NB_IN = NP / 64, CV_NB_FF = FFN / 64;
constexpr int CV_I_IN = 32 * CV_NB_IN, CV_I_GLU = 16 * 16, CV_I_BR = 3 * 16 * 32, CV_I_OUT = 32 * 32, CV_I_GU = 2 * 32 * CV_NB_FF, CV_I_DN = CV_NB_FF * 32;
constexpr int CV_I_LAYER = CV_I_IN + CV_I_GLU + CV_I_BR + CV_I_OUT + CV_I_GU + CV_I_DN;
constexpr int CV_Q1 = 4, CV_Q7 = 4;
__device__ __forceinline__ void conv_layer_item(Frame& F, int l, int r, LAS float* scr, int lane) {
    GAS unsigned char* wl = F.ws + WS_W + (size_t)l * SZ_WLAYER;
    if (r < CV_I_IN) { const int nb = r % CV_NB_IN, kb = r / CV_NB_IN, n0 = 64 * nb; int src, nv;
        if (n0 < 4096) { src = n0; nv = 64; } else if (n0 < PC_GLR) { src = n0 + 16; nv = 64; } else if (n0 == PC_GLR) { src = 4096; nv = 16; } else { src = 0; nv = 0; }
        conv_item(((const GAS float*)F.in[I_WIN]) + (size_t)l * DM * INW, INW, 64 * kb, src, nv, ((const GAS float*)F.in[I_N1G]) + l * DM, (GAS bf16*)(wl + OFF_WIN), DM, n0, 64 * kb, scr, lane); return; } r -= CV_I_IN;
    if (r < CV_I_GLU) { const int nb = r % 16, kb = r / 16;
        conv_item(((const GAS float*)F.in[I_WGLU]) + (size_t)l * 1024 * 1024, 1024, 64 * kb, 64 * nb, 64, nullptr, (GAS bf16*)(wl + OFF_WGLU), 1024, 64 * nb, 64 * kb, scr, lane); return; } r -= CV_I_GLU;
    if (r < CV_I_BR) { const int br = r / (16 * 32), rr = r % (16 * 32), nb = rr % 32, kb = rr / 32;
        conv_item(((const GAS float*)F.in[I_WBS + br]) + (size_t)l * 1024 * DM, DM, 64 * kb, 64 * nb, 64, nullptr, (GAS bf16*)(wl + OFF_WBR), 3072, 64 * nb, br * 1024 + 64 * kb, scr, lane); return; } r -= CV_I_BR;
    if (r < CV_I_OUT) { const int nb = r % 32, kb = r / 32;
        conv_item(((const GAS float*)F.in[I_WOUT]) + (size_t)l * DM * DM, DM, 64 * kb, 64 * nb, 64, nullptr, (GAS bf16*)(wl + OFF_WOUT), DM, 64 * nb, 64 * kb, scr, lane); return; } r -= CV_I_OUT;
    if (r < CV_I_GU) { const int sel = r / (32 * CV_NB_FF), rr = r % (32 * CV_NB_FF), nb = rr % CV_NB_FF, kb = rr / CV_NB_FF, j0 = 64 * nb;
        conv_item(((const GAS float*)F.in[I_FWG + sel]) + (size_t)l * DM * FFN, FFN, 64 * kb, j0, 64, ((const GAS float*)F.in[I_N2G]) + l * DM, (GAS bf16*)(wl + OFF_WGU), DM, (j0 / 128) * 256 + sel * 128 + (j0 % 128), 64 * kb, scr, lane); return; } r -= CV_I_GU;
    { const int nb = r % 32, kb = r / 32;
        conv_item(((const GAS float*)F.in[I_FWD]) + (size_t)l * FFN * DM, DM, 64 * kb, 64 * nb, 64, nullptr, (GAS bf16*)(wl + OFF_WDN), FFN, 64 * nb, 64 * kb, scr, lane); }
}
__device__ __forceinline__ int cv_ntail(int nwg, int G) { const int nr = (nwg + G - 1) / G; return nr * G - nwg; }
__device__ __forceinline__ void cv_split(int G, int& R, int& T1) {
    const int t1 = cv_ntail((MTOK / 256) * (NP / 256), G) * NWAVES * CV_Q1, t7 = cv_ntail((MTOK / 256) * (NGU / 256), G) * NWAVES * CV_Q7;
    int r = CV_I_LAYER - t1 - t7; int tt1 = t1; if (r < 0) { r = 0; tt1 = t1 < CV_I_LAYER ? t1 : CV_I_LAYER; }
    R = r; T1 = tt1;
}
__device__ __forceinline__ void cv_tail(Frame& F, int l, int which) {
    if (l + 1 >= DEPTH) return;
    const int nwg = (MTOK / 256) * ((which ? NGU : NP) / 256), ntail = cv_ntail(nwg, F.G), first = F.G - ntail;
    if ((int)blockIdx.x < first) return;
    int R, T1; cv_split(F.G, R, T1);
    const int lo = which ? R + T1 : R, hi = which ? CV_I_LAYER : R + T1;
    LAS float* scr = (LAS float*)(F.lds + F.wave * 16896);
    for (int r = lo + ((int)blockIdx.x - first) * NWAVES + F.wave; r < hi; r += ntail * NWAVES) conv_layer_item(F, l + 1, r, scr, F.lane);
}
__device__ __forceinline__ void s5_tables_unit(Frame& F, int lg);
__device__ __forceinline__ void p0_prologue(Frame& F) {
    LAS float* scr = (LAS float*)(F.lds + F.wave * 16896);
    const int gw = blockIdx.x * NWAVES + F.wave, NGW = F.G * NWAVES, lane = F.lane;
#if S5_MFMA
    for (int lg = blockIdx.x; lg < DEPTH * 64; lg += F.G) s5_tables_unit(F, lg);
#endif
    int R, T1; cv_split(F.G, R, T1);
    for (int it = gw; it < CV_I_LAYER + (DEPTH - 1) * R; it += NGW) {
        int l, r; if (it < CV_I_LAYER) { l = 0; r = it; } else { const int q = it - CV_I_LAYER; l = 1 + q / R; r = q - (l - 1) * R; }
        conv_layer_item(F, l, r, scr, lane);
    }
    const GAS float* x = ((const GAS float*)F.in[I_X]); GAS bf16* XB = (GAS bf16*)(F.ws + WS_XB); GAS float* ssq = (GAS float*)(F.ws + WS_SSQ);
    for (int m = gw; m < MTOK; m += NGW) {
        const GAS f32x4* xr = (const GAS f32x4*)(x + (size_t)m * DM) + lane; float s = 0.f;
        GAS v2u* o8 = (GAS v2u*)(XB + (size_t)m * DM) + lane;
#pragma unroll
        for (int j = 0; j < 8; ++j) { const f32x4 v = xr[64 * j]; s += (v[0] * v[0] + v[1] * v[1]) + (v[2] * v[2] + v[3] * v[3]); v2u w; w.x = pk2(v[0], v[1]); w.y = pk2(v[2], v[3]); o8[64 * j] = w; }
        s = wave_sum(s);
        if (lane < 8) ssq[(size_t)m * 8 + lane] = (lane == 0) ? s : 0.f;
    }
}

__device__ __forceinline__ void p2a_naive(Frame& F, int l) {
    const GAS bf16* P = (const GAS bf16*)(F.ws + WS_P);
    const int lane = F.lane;
    if (!GLA_MFMA) { GAS float* EG = (GAS float*)(F.ws + WS_EG); const GAS float* w2 = ((const GAS float*)F.in[I_GW2]) + (size_t)l * 16 * 512; const GAS float* b2 = ((const GAS float*)F.in[I_GB2]) + l * 512;
      for (int idx = blockIdx.x * 512 + F.tid; idx < MTOK * 512; idx += F.G * 512) { const int tok = idx >> 9, dk = idx & 511;
          const v4u g0 = *(const GAS v4u*)(P + (size_t)tok * NP + PC_GLR), g1 = *(const GAS v4u*)(P + (size_t)tok * NP + PC_GLR + 8);
          const unsigned gw_[8] = {g0.x, g0.y, g0.z, g0.w, g1.x, g1.y, g1.z, g1.w}; float a = b2[dk];
#pragma unroll
          for (int r = 0; r < 8; ++r) { a += bflo(gw_[r]) * w2[(2 * r) * 512 + dk]; a += bfhi(gw_[r]) * w2[(2 * r + 1) * 512 + dk]; }
          const float ls = fminf(a, 0.f) - log1pf(__expf(-fabsf(a)));
          EG[idx] = __expf(ls * (1.0f / 16.0f)); } }
    if (!MOBA_MFMA) { GAS bf16* QN = (GAS bf16*)(F.ws + WS_QN); GAS bf16* KN = (GAS bf16*)(F.ws + WS_KN); const GAS float* qg = ((const GAS float*)F.in[I_MQG]) + l * 128; const GAS float* kg = ((const GAS float*)F.in[I_MKG]) + l * 128;
      const int gw = blockIdx.x * NWAVES + F.wave, NGW = F.G * NWAVES;
      const float g0q = qg[2 * lane] * 0.08838834764831845f, g1q = qg[2 * lane + 1] * 0.08838834764831845f, g0k = kg[2 * lane], g1k = kg[2 * lane + 1];
      for (int it = gw; it < MTOK * 8 * 2; it += NGW) { const int which = it & 1, th = it >> 1, tok = th >> 3, h = th & 7;
          const unsigned w = *(const GAS unsigned*)(P + (size_t)tok * NP + (which ? PC_MK : PC_MQ) + h * 128 + 2 * lane);
          const float x0 = bflo(w), x1 = bfhi(w); const float ss = wave_sum(x0 * x0 + x1 * x1); const float r = 1.0f / sqrtf(ss * (1.0f / 128.0f) + RMS_EPS);
          *(GAS unsigned*)((which ? KN : QN) + (size_t)tok * 1024 + h * 128 + 2 * lane) = which ? pk2(x0 * r * g0k, x1 * r * g1k) : pk2(x0 * r * g0q, x1 * r * g1q); }
      GAS float* KM = (GAS float*)(F.ws + WS_KM);
      for (int it = gw; it < 4 * 8 * 8; it += NGW) { const int kb = it & 7, h = (it >> 3) & 7, b = it >> 6; float a0 = 0.f, a1 = 0.f;
          for (int j = 0; j < 256; ++j) { const int tok = b * SEQ + kb * 256 + j; const unsigned w = *(const GAS unsigned*)(P + (size_t)tok * NP + PC_MK + h * 128 + 2 * lane);
              const float x0 = bflo(w), x1 = bfhi(w); const float ss = wave_sum(x0 * x0 + x1 * x1); const float r = 1.0f / sqrtf(ss * (1.0f / 128.0f) + RMS_EPS); a0 += x0 * r * g0k; a1 += x1 * r * g1k; }
          *(GAS f32x2*)(KM + (size_t)it * 128 + 2 * lane) = (f32x2){a0 * (1.0f / 256.0f), a1 * (1.0f / 256.0f)}; } }
}

__device__ __forceinline__ void s5_naive_item(Frame& F, int l, int item, LAS float* scr) {
    const int lane = F.lane, b = item >> 6, g = item & 63, lg = l * 64 + g;
    const GAS bf16* P = (const GAS bf16*)(F.ws + WS_P); GAS bf16* Z = (GAS bf16*)(F.ws + WS_Z);
    const float lre = ((const GAS float*)F.in[I_LRE])[lg * 64 + lane], lim = ((const GAS float*)F.in[I_LIM])[lg * 64 + lane], dt = expf(((const GAS float*)F.in[I_LDT])[lg]);
    const float mag = expf(lre * dt), ang = lim * dt, ar = mag * cosf(ang), ai = mag * sinf(ang);
    const float den = lre * lre + lim * lim, nre = ar - 1.0f, nim = ai;
    const float zre = (nre * lre + nim * lim) / den, zim = (nim * lre - nre * lim) / den;
    float bbr[16], bbi[16], cr[16], ci[16];
#pragma unroll
    for (int c = 0; c < 16; ++c) { const float br_ = ((const GAS float*)F.in[I_BRE])[(size_t)(lg * 64 + lane) * 16 + c], bi_ = ((const GAS float*)F.in[I_BIM])[(size_t)(lg * 64 + lane) * 16 + c];
        bbr[c] = zre * br_ - zim * bi_; bbi[c] = zre * bi_ + zim * br_;
        cr[c] = ((const GAS float*)F.in[I_CRE])[(size_t)(lg * 16 + c) * 64 + lane]; ci[c] = ((const GAS float*)F.in[I_CIM])[(size_t)(lg * 16 + c) * 64 + lane]; }
    const float dsk = ((const GAS float*)F.in[I_SD])[l * 1024 + g * 16 + (lane & 15)];
    float xr = 0.f, xi = 0.f;
    const int cc = lane & 15, qq = lane >> 4;
    for (int t0 = 0; t0 < SEQ; t0 += 4) {
        v4u ub[4][2];
#pragma unroll
        for (int s = 0; s < 4; ++s) { const GAS bf16* up = P + (size_t)(b * SEQ + t0 + s) * NP + PC_SSM + g * 16; ub[s][0] = *(const GAS v4u*)up; ub[s][1] = *(const GAS v4u*)(up + 8); }
#pragma unroll
        for (int s = 0; s < 4; ++s) {
            const unsigned uw[8] = {ub[s][0].x, ub[s][0].y, ub[s][0].z, ub[s][0].w, ub[s][1].x, ub[s][1].y, ub[s][1].z, ub[s][1].w};
            float bur = 0.f, bui = 0.f;
#pragma unroll
            for (int c = 0; c < 8; ++c) { const float u0 = bflo(uw[c]), u1 = bfhi(uw[c]); bur += bbr[2 * c] * u0 + bbr[2 * c + 1] * u1; bui += bbi[2 * c] * u0 + bbi[2 * c + 1] * u1; }
            const float nxr = ar * xr - ai * xi + bur, nxi = ar * xi + ai * xr + bui; xr = nxr; xi = nxi;
#pragma unroll
            for (int c = 0; c < 16; ++c) scr[c * 65 + lane] = cr[c] * xr - ci[c] * xi;
            LDS_WAIT();
            float sum = 0.f;
#pragma unroll
            for (int j = 0; j < 16; ++j) sum += scr[cc * 65 + qq * 16 + j];
            LDS_WAIT();
            sum += __shfl_xor(sum, 16); sum += __shfl_xor(sum, 32);
            const size_t row = (size_t)(b * SEQ + t0 + s);
            if (lane < 16) { const float uv = bf1(P[row * NP + PC_SSM + g * 16 + lane]); const float y = sum + dsk * uv; Z[row * 1024 + g * 16 + lane] = (bf16)f2bf(gelu_tanh(y)); }
        }
    }
}
__device__ __forceinline__ void gla_naive_item(Frame& F, int item, LAS float* scr) {
    const int lane = F.lane, hf = item & 3, qt = (item >> 2) & 3, h = (item >> 4) & 3, b = item >> 6;
    const GAS bf16* P = (const GAS bf16*)(F.ws + WS_P); const GAS float* EG = (const GAS float*)(F.ws + WS_EG); GAS float* OT = (GAS float*)(F.ws + WS_OT) + (size_t)hf * MTOK * 1024;
    float S[32];
#pragma unroll
    for (int i = 0; i < 32; ++i) S[i] = 0.f;
    const int l32 = lane & 31;
    const GAS bf16* pq = P + (size_t)(b * SEQ) * NP + PC_GQ + h * 128 + hf * 32 + l32; const GAS bf16* pv = P + (size_t)(b * SEQ) * NP + PC_GV + h * 256 + qt * 64 + lane;
    const GAS float* pe = EG + (size_t)(b * SEQ) * 512 + h * 128 + hf * 32 + l32; GAS float* po = OT + (size_t)(b * SEQ) * 1024 + h * 256 + qt * 64 + lane;
    for (int t0 = 0; t0 < SEQ; t0 += 2) {
        float qw[2], kw[2], ew[2]; bf16 vw[2];
#pragma unroll
        for (int s = 0; s < 2; ++s) { qw[s] = bf1(pq[(size_t)s * NP]); kw[s] = bf1(pq[(size_t)s * NP + (PC_GK - PC_GQ)]); ew[s] = pe[s * 512]; vw[s] = pv[(size_t)s * NP]; }
#pragma unroll
        for (int s = 0; s < 2; ++s) {
            if (lane < 32) { scr[lane] = qw[s]; scr[32 + lane] = kw[s]; scr[64 + lane] = ew[s]; }
            LDS_WAIT();
            const float v = bf1(vw[s]); float o = 0.f;
#pragma unroll
            for (int d = 0; d < 32; d += 4) { const f32x4 q4 = *(const LAS f32x4*)(scr + d), k4 = *(const LAS f32x4*)(scr + 32 + d), e4 = *(const LAS f32x4*)(scr + 64 + d);
#pragma unroll
                for (int e = 0; e < 4; ++e) { S[d + e] = e4[e] * S[d + e] + k4[e] * v; o += q4[e] * S[d + e]; }
                if ((d & 4) != 0) asm volatile("" ::: "memory"); }
            LDS_WAIT();
            po[s * 1024] = o * 0.08838834764831845f;
        }
        pq += 2 * (size_t)NP; pv += 2 * (size_t)NP; pe += 2 * 512; po += 2 * 1024;
    }
}
__device__ __forceinline__ void moba_naive_query(Frame& F, int qi, LAS float* scr) {
    const int lane = F.lane, t = qi & (SEQ - 1), h = (qi >> 11) & 7, b = qi >> 14, qb = t >> 8;
    const GAS bf16* P = (const GAS bf16*)(F.ws + WS_P); const GAS bf16* QN = (const GAS bf16*)(F.ws + WS_QN); const GAS bf16* KN = (const GAS bf16*)(F.ws + WS_KN); const GAS float* KM = (const GAS float*)(F.ws + WS_KM);
    GAS bf16* Y = (GAS bf16*)(F.ws + WS_Y);
    const unsigned qw = *(const GAS unsigned*)(QN + (size_t)(b * SEQ + t) * 1024 + h * 128 + 2 * lane);
    const float q0 = bflo(qw), q1 = bfhi(qw);
    *(LAS f32x2*)(scr + 2 * lane) = (f32x2){q0, q1};
    LDS_WAIT();
    float sc[8]; unsigned selmask = 0u;
#pragma unroll
    for (int kb = 0; kb < 8; ++kb) { const f32x2 km = *(const GAS f32x2*)(KM + (size_t)(((b * 8 + h) * 8 + kb) * 128) + 2 * lane); const float d = wave_sum(q0 * km[0] + q1 * km[1]); sc[kb] = (kb < qb) ? d : -__builtin_inff(); }
#pragma unroll
    for (int kb = 0; kb < 8; ++kb) { int rank = 0;
#pragma unroll
        for (int j = 0; j < 8; ++j) if (j != kb) rank += ((j < qb) && (sc[j] > sc[kb] || (sc[j] == sc[kb] && j < kb))) ? 1 : 0;
        if (kb < qb && rank < 3) selmask |= 1u << kb; }
    selmask |= 1u << qb;
    float m = -__builtin_inff(), lsum = 0.f, o0 = 0.f, o1 = 0.f;
    for (int kb = 0; kb <= qb; ++kb) {
        if (!((selmask >> kb) & 1u)) continue;
        for (int tile = 0; tile < 4; ++tile) {
            const int key0 = kb * 256 + tile * 64; if (key0 > t) break;
            const int key = key0 + lane;
            const GAS v4u* kp = (const GAS v4u*)(KN + (size_t)(b * SEQ + key) * 1024 + h * 128);
            float s = 0.f;
#pragma unroll
            for (int c = 0; c < 16; ++c) { if (c == 8) asm volatile("" ::: "memory"); const v4u kk = kp[c]; const f32x4 qa = *(const LAS f32x4*)(scr + 8 * c), qb4 = *(const LAS f32x4*)(scr + 8 * c + 4);
                s += qa[0] * bflo(kk.x) + qa[1] * bfhi(kk.x) + qa[2] * bflo(kk.y) + qa[3] * bfhi(kk.y) + qb4[0] * bflo(kk.z) + qb4[1] * bfhi(kk.z) + qb4[2] * bflo(kk.w) + qb4[3] * bfhi(kk.w); }
            if (key > t) s = -__builtin_inff();
            const float mnew = fmaxf(m, wave_max(s)); const float p = __expf(s - mnew), corr = __expf(m - mnew);
            lsum = lsum * corr + wave_sum(p); o0 *= corr; o1 *= corr; m = mnew;
            const GAS bf16* vp = P + (size_t)(b * SEQ + key0) * NP + PC_MV + h * 128 + 2 * lane;
#pragma unroll 16
            for (int j = 0; j < 64; ++j) { const float pj = __shfl(p, j); const unsigned vw = *(const GAS unsigned*)(vp + (size_t)j * NP); o0 += pj * bflo(vw); o1 += pj * bfhi(vw); }
        }
    }
    LDS_WAIT();
    const float inv = 1.0f / lsum;
    *(GAS unsigned*)(Y + (size_t)(b * SEQ + t) * YW + 2048 + h * 128 + 2 * lane) = pk2(o0 * inv, o1 * inv);
}
__device__ __forceinline__ void p2b_naive(Frame& F, int l) {
    { F.refresh(); LAS float* scr = (LAS float*)(F.lds + F.wave * 16384);
#if !S5_MFMA
      if (F.wave == 0) for (int it = blockIdx.x; it < 256; it += F.G) s5_naive_item(F, l, it, scr);
#endif
      (void)scr; }
    { F.refresh(); LAS float* scr = (LAS float*)(F.lds + F.wave * 16384);
#if !GLA_MFMA
      if (F.wave == 1) for (int it = blockIdx.x; it < 256; it += F.G) gla_naive_item(F, it, scr);
#endif
      (void)scr; }
    { F.refresh(); LAS float* scr = (LAS float*)(F.lds + F.wave * 16384);
      GAS unsigned* head = (GAS unsigned*)(F.ctl + CW_QUEUE + 64 * l);
      for (;;) {
          unsigned qi = 0; if (F.lane == 0) qi = __hip_atomic_fetch_add(head, 1u, __ATOMIC_RELAXED, __HIP_MEMORY_SCOPE_AGENT);
          qi = __builtin_amdgcn_readfirstlane(qi);
          if (qi >= (unsigned)(NBATCH * 8 * SEQ)) break;
          moba_naive_query(F, (int)qi, scr);
      } }
}

#if PROBE2
#define PR_STAMP(k) do { if (blockIdx.x == 0 && F.tid == 0) { volatile LAS unsigned long long* sl_ = (volatile LAS unsigned long long*)(F.lds + MISC_OFF + 64) + (k); if (*sl_ == 0ull) *sl_ = wall_clock64(); } } while (0)
#else
#define PR_STAMP(k) do { } while (0)
#endif
typedef short bf16x8_t __attribute__((ext_vector_type(8)));
__device__ __forceinline__ f32x4 mma16(bf16x8_t a, bf16x8_t b, f32x4 c) { return __builtin_amdgcn_mfma_f32_16x16x32_bf16(a, b, c, 0, 0, 0); }
constexpr int S5_USTR = 2064;
constexpr int S5_XSTR = 272;
__device__ __forceinline__ void s5_tables_unit(Frame& F, int lg) {
    LAS float* APr = (LAS float*)F.lds; LAS float* APi = APr + 65 * 64; LAS float* BBr = APi + 65 * 64; LAS float* BBi = BBr + 1024; LAS float* CCr = BBi + 1024; LAS float* CCi = CCr + 1024;
    const int tid = F.tid;
    const GAS float* lre_ = ((const GAS float*)F.in[I_LRE]) + lg * 64; const GAS float* lim_ = ((const GAS float*)F.in[I_LIM]) + lg * 64; const double dt = exp((double)((const GAS float*)F.in[I_LDT])[lg]);
    for (int idx = tid; idx < 65 * 64; idx += 512) { const int t = idx >> 6, p = idx & 63;
        const double lr = (double)lre_[p], li = (double)lim_[p]; const double mag = exp(lr * dt * (double)t); double ang = li * dt * (double)t;
        ang -= 6.283185307179586476925 * rint(ang * 0.15915494309189533577);
        APr[idx] = (float)(mag * (double)cosf((float)ang)); APi[idx] = (float)(mag * (double)sinf((float)ang)); }
    for (int idx = tid; idx < 1024; idx += 512) { const int p = idx >> 4, c = idx & 15;
        const double lr = (double)lre_[p], li = (double)lim_[p]; const double mag = exp(lr * dt); double ang = li * dt; ang -= 6.283185307179586476925 * rint(ang * 0.15915494309189533577);
        const double ar = mag * (double)cosf((float)ang), ai = mag * (double)sinf((float)ang), den = lr * lr + li * li, nr = ar - 1.0, ni = ai;
        const double zr = (nr * lr + ni * li) / den, zi = (ni * lr - nr * li) / den;
        const double br = (double)((const GAS float*)F.in[I_BRE])[(size_t)(lg * 64 + p) * 16 + c], bi = (double)((const GAS float*)F.in[I_BIM])[(size_t)(lg * 64 + p) * 16 + c];
        BBr[idx] = (float)(zr * br - zi * bi); BBi[idx] = (float)(zr * bi + zi * br);
        CCr[idx] = ((const GAS float*)F.in[I_CRE])[(size_t)lg * 1024 + idx]; CCi[idx] = ((const GAS float*)F.in[I_CIM])[(size_t)lg * 1024 + idx]; }
    LDS_WAIT(); __syncthreads();
    { const int t = tid >> 3, co0 = 2 * (tid & 7); float acc0[16], acc1[16];
#pragma unroll
      for (int i = 0; i < 16; ++i) { acc0[i] = 0.f; acc1[i] = 0.f; }
      for (int p = 0; p < 64; ++p) { const float ar = APr[t * 64 + p], ai = APi[t * 64 + p];
          const float c0r = CCr[co0 * 64 + p], c0i = CCi[co0 * 64 + p], c1r = CCr[(co0 + 1) * 64 + p], c1i = CCi[(co0 + 1) * 64 + p];
          const float w0r = c0r * ar - c0i * ai, w0i = c0r * ai + c0i * ar, w1r = c1r * ar - c1i * ai, w1i = c1r * ai + c1i * ar;
#pragma unroll
          for (int ci = 0; ci < 16; ++ci) { const float br = BBr[p * 16 + ci], bi = BBi[p * 16 + ci]; acc0[ci] += w0r * br - w0i * bi; acc1[ci] += w1r * br - w1i * bi; } }
      GAS bf16* TK = (GAS bf16*)(F.ws + WS_TK) + (size_t)lg * 64 * 256 + (size_t)(t * 16 + co0) * 16;
      v4u o0, o1, o2, o3; o0.x = pk2(acc0[0], acc0[1]); o0.y = pk2(acc0[2], acc0[3]); o0.z = pk2(acc0[4], acc0[5]); o0.w = pk2(acc0[6], acc0[7]);
      o1.x = pk2(acc0[8], acc0[9]); o1.y = pk2(acc0[10], acc0[11]); o1.z = pk2(acc0[12], acc0[13]); o1.w = pk2(acc0[14], acc0[15]);
      o2.x = pk2(acc1[0], acc1[1]); o2.y = pk2(acc1[2], acc1[3]); o2.z = pk2(acc1[4], acc1[5]); o2.w = pk2(acc1[6], acc1[7]);
      o3.x = pk2(acc1[8], acc1[9]); o3.y = pk2(acc1[10], acc1[11]); o3.z = pk2(acc1[12], acc1[13]); o3.w = pk2(acc1[14], acc1[15]);
      *(GAS v4u*)(TK) = o0; *(GAS v4u*)(TK + 8) = o1; *(GAS v4u*)(TK + 16) = o2; *(GAS v4u*)(TK + 24) = o3; }
    { GAS bf16* TW = (GAS bf16*)(F.ws + WS_TW) + (size_t)lg * 128 * 1024;
      for (int ch = tid; ch < 16384; ch += 512) { const int col = ch >> 7, kc = ch & 127, ri = col >> 6, p = col & 63, j = kc >> 1, c0 = 8 * (kc & 1);
          const float ar = APr[(63 - j) * 64 + p], ai = APi[(63 - j) * 64 + p]; float v[8];
#pragma unroll
          for (int e = 0; e < 8; ++e) { const float br = BBr[p * 16 + c0 + e], bi = BBi[p * 16 + c0 + e]; v[e] = ri ? (ar * bi + ai * br) : (ar * br - ai * bi); }
          v4u o; o.x = pk2(v[0], v[1]); o.y = pk2(v[2], v[3]); o.z = pk2(v[4], v[5]); o.w = pk2(v[6], v[7]);
          *(GAS v4u*)(TW + (size_t)col * 1024 + kc * 8) = o; } }
    { GAS bf16* TC = (GAS bf16*)(F.ws + WS_TC) + (size_t)lg * 1024 * 128;
      for (int ch = tid; ch < 16384; ch += 512) { const int row = ch >> 4, kc = ch & 15, i = row >> 4, co = row & 15, ri = kc >> 3, p0 = 8 * (kc & 7); float v[8];
#pragma unroll
          for (int e = 0; e < 8; ++e) { const int p = p0 + e; const float ar = APr[(i + 1) * 64 + p], ai = APi[(i + 1) * 64 + p], cr = CCr[co * 64 + p], ci = CCi[co * 64 + p];
              v[e] = ri ? -(cr * ai + ci * ar) : (cr * ar - ci * ai); }
          v4u o; o.x = pk2(v[0], v[1]); o.y = pk2(v[2], v[3]); o.z = pk2(v[4], v[5]); o.w = pk2(v[6], v[7]);
          *(GAS v4u*)(TC + (size_t)row * 128 + kc * 8) = o; } }
    if (tid < 128) ((GAS float*)(F.ws + WS_A64))[(size_t)lg * 128 + tid] = (tid < 64) ? APr[64 * 64 + tid] : APi[64 * 64 + tid - 64];
    LDS_WAIT(); __syncthreads();
}
__device__ __forceinline__ void s5_stage_u(Frame& F, int g, int b, LAS unsigned char* U) {
    const GAS v4u* src = (const GAS v4u*)((const GAS bf16*)(F.ws + WS_US) + (size_t)(b * 64 + g) * SEQ * 16);
#pragma unroll
    for (int it = 0; it < 8; ++it) { const int ch = F.tid + 512 * it, t = ch >> 1, hf = ch & 1, n = t >> 6, j = t & 63;
        *(LAS v4u*)(U + n * S5_USTR + (j * 16 + 8 * hf) * 2) = src[ch]; }
}
__device__ __forceinline__ void s5_s1_unit(Frame& F, int l, int unit) {
    const int g = unit & 63, b = unit >> 6, lg = l * 64 + g, lane = F.lane, w = F.wave, fr = lane & 15, fq = lane >> 4;
    LAS unsigned char* U = F.lds;
    s5_stage_u(F, g, b, U);
    LDS_WAIT(); __syncthreads();
    const GAS bf16* TW = (const GAS bf16*)(F.ws + WS_TW) + (size_t)lg * 128 * 1024 + (size_t)(16 * w + fr) * 1024 + 8 * fq;
    f32x4 acc[2] = {(f32x4){0.f, 0.f, 0.f, 0.f}, (f32x4){0.f, 0.f, 0.f, 0.f}};
#pragma unroll 4
    for (int ks = 0; ks < 32; ++ks) {
        const bf16x8_t bfr = *(const GAS bf16x8_t*)(TW + 32 * ks);
        const bf16x8_t a0 = *(const LAS bf16x8_t*)(U + fr * S5_USTR + (32 * ks + 8 * fq) * 2), a1 = *(const LAS bf16x8_t*)(U + (16 + fr) * S5_USTR + (32 * ks + 8 * fq) * 2);
        acc[0] = mma16(a0, bfr, acc[0]); acc[1] = mma16(a1, bfr, acc[1]); }
    GAS float* SL = (GAS float*)(F.ws + WS_SL);
#pragma unroll
    for (int mt = 0; mt < 2; ++mt)
#pragma unroll
        for (int r = 0; r < 4; ++r) { const int n = 16 * mt + 4 * fq + r; SL[((size_t)(b * 32 + n) * 64 + g) * 128 + 16 * w + fr] = acc[mt][r]; }
    __syncthreads();
}
__device__ __forceinline__ void s5_s3_unit(Frame& F, int l, int unit) {
    const int g = unit & 63, b = unit >> 6, lg = l * 64 + g, lane = F.lane, w = F.wave, fr = lane & 15, fq = lane >> 4;
    LAS unsigned char* U = F.lds; LAS unsigned char* TKL = F.lds + 32 * S5_USTR; LAS unsigned char* XP = TKL + 32768;
    PR_STAMP(0);
    float sr[32], si[32]; float a64r = 0.f, a64i = 0.f;
    if (w == 0) { const GAS float* SL = (const GAS float*)(F.ws + WS_SL) + ((size_t)(b * 32) * 64 + g) * 128; const GAS float* A64 = (const GAS float*)(F.ws + WS_A64) + (size_t)lg * 128;
        a64r = A64[lane]; a64i = A64[64 + lane];
#pragma unroll
        for (int e = 0; e < 32; ++e) { sr[e] = SL[(size_t)e * 64 * 128 + lane]; si[e] = SL[(size_t)e * 64 * 128 + 64 + lane]; } }
    s5_stage_u(F, g, b, U);
    { const GAS v4u* src = (const GAS v4u*)((const GAS bf16*)(F.ws + WS_TK) + (size_t)lg * 64 * 256);
#pragma unroll
      for (int it = 0; it < 4; ++it) *(LAS v4u*)(TKL + (F.tid + 512 * it) * 16) = src[F.tid + 512 * it]; }
    const GAS bf16* TC = (const GAS bf16*)(F.ws + WS_TC) + (size_t)lg * 1024 * 128 + (size_t)fr * 128 + 8 * fq;
    bf16x8_t tcf[8];
#pragma unroll
    for (int it = 0; it < 8; ++it) tcf[it] = *(const GAS bf16x8_t*)(TC + (size_t)((w + 8 * it) * 16) * 128);
    if (w == 0) {
        float xr = 0.f, xi = 0.f;
#pragma unroll
        for (int e = 0; e < 32; ++e) { *(LAS bf16*)(XP + e * S5_XSTR + lane * 2) = (bf16)f2bf(xr); *(LAS bf16*)(XP + e * S5_XSTR + (64 + lane) * 2) = (bf16)f2bf(xi);
            const float nr = a64r * xr - a64i * xi + sr[e], ni = a64r * xi + a64i * xr + si[e]; xr = nr; xi = ni; }
    }
    LDS_WAIT(); __syncthreads();
    PR_STAMP(1);
    f32x4 acc[2][8];
#pragma unroll
    for (int mt = 0; mt < 2; ++mt)
#pragma unroll
        for (int it = 0; it < 8; ++it) acc[mt][it] = (f32x4){0.f, 0.f, 0.f, 0.f};
#pragma unroll 1
    for (int c = 0; c < 4; ++c) {
        bf16x8_t bfr[8];
#pragma unroll
        for (int it = 0; it < 8; ++it) { const int lag = w + 8 * it - 2 * c - (fq >> 1); bfr[it] = *(const LAS bf16x8_t*)(TKL + ((lag < 0 ? 0 : lag) * 16 + fr) * 32 + 16 * (fq & 1)); if (lag < 0) bfr[it] = (bf16x8_t){0, 0, 0, 0, 0, 0, 0, 0}; }
        const bool first_ok = (w >= 2 * c);
#pragma unroll
        for (int sgrp = 0; sgrp < 8; ++sgrp) { const int ks = c + 4 * sgrp;
            const bf16x8_t a0 = *(const LAS bf16x8_t*)(U + fr * S5_USTR + (32 * ks + 8 * fq) * 2), a1 = *(const LAS bf16x8_t*)(U + (16 + fr) * S5_USTR + (32 * ks + 8 * fq) * 2);
#pragma unroll
            for (int it = sgrp; it < 8; ++it) { if (it > sgrp || first_ok) { acc[0][it] = mma16(a0, bfr[it - sgrp], acc[0][it]); acc[1][it] = mma16(a1, bfr[it - sgrp], acc[1][it]); } } }
    }
    PR_STAMP(2);
#pragma unroll
    for (int ks = 0; ks < 4; ++ks) {
        if (ks > 0) {
#pragma unroll
            for (int it = 0; it < 8; ++it) tcf[it] = *(const GAS bf16x8_t*)(TC + (size_t)((w + 8 * it) * 16) * 128 + 32 * ks); }
        const bf16x8_t a0 = *(const LAS bf16x8_t*)(XP + fr * S5_XSTR + (32 * ks + 8 * fq) * 2), a1 = *(const LAS bf16x8_t*)(XP + (16 + fr) * S5_XSTR + (32 * ks + 8 * fq) * 2);
#pragma unroll
        for (int it = 0; it < 8; ++it) { acc[0][it] = mma16(a0, tcf[it], acc[0][it]); acc[1][it] = mma16(a1, tcf[it], acc[1][it]); } }
    PR_STAMP(3);
    unsigned zp[2][8][2];
    { const float dsk = ((const GAS float*)F.in[I_SD])[l * 1024 + 16 * g + fr];
#pragma unroll
      for (int mt = 0; mt < 2; ++mt)
#pragma unroll
          for (int it = 0; it < 8; ++it) { float z[4];
#pragma unroll
              for (int r = 0; r < 4; ++r) { const int n = 16 * mt + 4 * fq + r, i = w + 8 * it;
                  const float uv = bf1(*(const LAS bf16*)(U + n * S5_USTR + (i * 16 + fr) * 2)); z[r] = gelu_tanh(acc[mt][it][r] + dsk * uv); }
              zp[mt][it][0] = pg8::cvt_pk_bf16(z[0], z[1]); zp[mt][it][1] = pg8::cvt_pk_bf16(z[2], z[3]); } }
    LDS_WAIT(); __syncthreads();
#pragma unroll
    for (int mt = 0; mt < 2; ++mt)
#pragma unroll
        for (int it = 0; it < 8; ++it)
#pragma unroll
            for (int r = 0; r < 4; ++r) { const int tkn = 64 * (16 * mt + 4 * fq + r) + w + 8 * it; const unsigned v = zp[mt][it][r >> 1];
                *(LAS bf16*)(U + tkn * 32 + fr * 2) = (bf16)((r & 1) ? (v >> 16) : (v & 0xffffu)); }
    LDS_WAIT(); __syncthreads();
    { GAS bf16* Z = (GAS bf16*)(F.ws + WS_Z) + (size_t)b * SEQ * 1024 + 16 * g;
#pragma unroll
      for (int j = 0; j < 8; ++j) { const int c = F.tid + 512 * j; *(GAS v4u*)(Z + (size_t)(c >> 1) * 1024 + 8 * (c & 1)) = *(const LAS v4u*)(U + c * 16); } }
    __syncthreads();
    PR_STAMP(4);
}

constexpr int GL_TSTR = 144;
constexpr int GL_DSTR = 272;
__device__ __forceinline__ void gla_g1_unit(Frame& F, int l, int u) {
    const int n = u & 31, h = (u >> 5) & 3, b = u >> 7, tid = F.tid, lane = F.lane, w = F.wave, fr = lane & 15, fq = lane >> 4;
    const size_t tok0 = (size_t)b * SEQ + 64 * n;
    const GAS bf16* P = (const GAS bf16*)(F.ws + WS_P);
    LAS float* GL = (LAS float*)F.lds; LAS float* W2L = (LAS float*)(F.lds + 32768); LAS float* GLR = (LAS float*)(F.lds + 40960);
    LAS unsigned char* KDt = F.lds + 45056; LAS unsigned char* VTt = F.lds + 63488;
    { const GAS float* w2 = ((const GAS float*)F.in[I_GW2]) + (size_t)l * 16 * 512;
#pragma unroll
      for (int it = 0; it < 4; ++it) { const int idx = tid + 512 * it, r = idx >> 7, dk = idx & 127; W2L[idx] = w2[r * 512 + h * 128 + dk]; }
#pragma unroll
      for (int it = 0; it < 2; ++it) { const int idx = tid + 512 * it, i = idx >> 4, r = idx & 15; GLR[idx] = bf1(P[(tok0 + i) * NP + PC_GLR + r]); } }
    LDS_WAIT(); __syncthreads();
    const int ti = tid >> 3, dq = tid & 7;
    { const GAS float* b2 = ((const GAS float*)F.in[I_GB2]) + l * 512 + h * 128 + 16 * dq; float a[16];
#pragma unroll
      for (int e = 0; e < 16; ++e) a[e] = b2[e];
#pragma unroll
      for (int r = 0; r < 16; ++r) { const float gv = GLR[ti * 16 + r];
#pragma unroll
          for (int e = 0; e < 16; ++e) a[e] += gv * W2L[r * 128 + 16 * dq + e]; }
#pragma unroll
      for (int e = 0; e < 16; ++e) { const float x = a[e]; GL[ti * 128 + 16 * dq + e] = (fminf(x, 0.f) - log1pf(__expf(-fabsf(x)))) * (1.0f / 16.0f); } }
    LDS_WAIT(); __syncthreads();
    if (tid < 128) { float run = 0.f;
        for (int i = 0; i < 64; ++i) { run += GL[i * 128 + tid]; GL[i * 128 + tid] = run; }
        GLR[tid] = run; ((GAS float*)(F.ws + WS_DEC))[(size_t)u * 128 + tid] = __expf(run); }
    LDS_WAIT(); __syncthreads();
    {
      const GAS bf16* qp = P + (tok0 + ti) * NP + PC_GQ + h * 128 + 16 * dq; const GAS bf16* kp = P + (tok0 + ti) * NP + PC_GK + h * 128 + 16 * dq;
      const v4u q0 = *(const GAS v4u*)qp, q1 = *(const GAS v4u*)(qp + 8), k0 = *(const GAS v4u*)kp, k1 = *(const GAS v4u*)(kp + 8);
      const unsigned qw[8] = {q0.x, q0.y, q0.z, q0.w, q1.x, q1.y, q1.z, q1.w}, kw[8] = {k0.x, k0.y, k0.z, k0.w, k1.x, k1.y, k1.z, k1.w};
      float qd[16], ki[16];
#pragma unroll
      for (int e = 0; e < 16; ++e) { const int dk = 16 * dq + e; const float bc = GL[ti * 128 + dk], bl = GLR[dk];
          const float qv = (e & 1) ? bfhi(qw[e >> 1]) : bflo(qw[e >> 1]), kv = (e & 1) ? bfhi(kw[e >> 1]) : bflo(kw[e >> 1]);
          qd[e] = qv * 0.08838834764831845f * __expf(bc); ki[e] = kv * __expf(-bc);
          *(LAS bf16*)(KDt + dk * GL_TSTR + ti * 2) = (bf16)f2bf(kv * __expf(bl - bc)); }
      GAS bf16* QD = (GAS bf16*)(F.ws + WS_QD) + ((size_t)u * 64 + ti) * 128 + 16 * dq; GAS bf16* KI = (GAS bf16*)(F.ws + WS_KI) + ((size_t)u * 64 + ti) * 128 + 16 * dq;
      v4u o; o.x = pk2(qd[0], qd[1]); o.y = pk2(qd[2], qd[3]); o.z = pk2(qd[4], qd[5]); o.w = pk2(qd[6], qd[7]); *(GAS v4u*)QD = o;
      o.x = pk2(qd[8], qd[9]); o.y = pk2(qd[10], qd[11]); o.z = pk2(qd[12], qd[13]); o.w = pk2(qd[14], qd[15]); *(GAS v4u*)(QD + 8) = o;
      o.x = pk2(ki[0], ki[1]); o.y = pk2(ki[2], ki[3]); o.z = pk2(ki[4], ki[5]); o.w = pk2(ki[6], ki[7]); *(GAS v4u*)KI = o;
      o.x = pk2(ki[8], ki[9]); o.y = pk2(ki[10], ki[11]); o.z = pk2(ki[12], ki[13]); o.w = pk2(ki[14], ki[15]); *(GAS v4u*)(KI + 8) = o;
      const GAS bf16* vp = P + (tok0 + ti) * NP + PC_GV + h * 256 + 32 * dq;
#pragma unroll
      for (int c = 0; c < 4; ++c) { const v4u vv = *(const GAS v4u*)(vp + 8 * c); const unsigned vw[4] = {vv.x, vv.y, vv.z, vv.w};
#pragma unroll
          for (int e = 0; e < 4; ++e) { const int dv = 32 * dq + 8 * c + 2 * e;
              *(LAS bf16*)(VTt + dv * GL_TSTR + ti * 2) = (bf16)(vw[e] & 0xffffu); *(LAS bf16*)(VTt + (dv + 1) * GL_TSTR + ti * 2) = (bf16)(vw[e] >> 16); } } }
    LDS_WAIT(); __syncthreads();
    {
      GAS bf16* GVT = (GAS bf16*)(F.ws + WS_GVT) + (size_t)u * 256 * 64; const int row = tid >> 1, hf = tid & 1;
#pragma unroll
      for (int c = 0; c < 4; ++c) *(GAS v4u*)(GVT + row * 64 + 32 * hf + 8 * c) = *(const LAS v4u*)(VTt + row * GL_TSTR + 64 * hf + 16 * c); }
    {
      f32x4 acc[8][2];
#pragma unroll
      for (int mt = 0; mt < 8; ++mt) { acc[mt][0] = (f32x4){0.f, 0.f, 0.f, 0.f}; acc[mt][1] = (f32x4){0.f, 0.f, 0.f, 0.f}; }
#pragma unroll
      for (int ks = 0; ks < 2; ++ks) { bf16x8_t bb[2], aa[8];
#pragma unroll
          for (int nt = 0; nt < 2; ++nt) bb[nt] = *(const LAS bf16x8_t*)(VTt + (16 * (2 * w + nt) + fr) * GL_TSTR + (32 * ks + 8 * fq) * 2);
#pragma unroll
          for (int mt = 0; mt < 8; ++mt) aa[mt] = *(const LAS bf16x8_t*)(KDt + (16 * mt + fr) * GL_TSTR + (32 * ks + 8 * fq) * 2);
#pragma unroll
          for (int mt = 0; mt < 8; ++mt) { acc[mt][0] = mma16(aa[mt], bb[0], acc[mt][0]); acc[mt][1] = mma16(aa[mt], bb[1], acc[mt][1]); } }
      GAS bf16* KV = (GAS bf16*)(F.ws + WS_KV) + (size_t)u * 256 * 128;
#pragma unroll
      for (int nt = 0; nt < 2; ++nt)
#pragma unroll
          for (int mt = 0; mt < 8; ++mt) { v2u o; o.x = pg8::cvt_pk_bf16(acc[mt][nt][0], acc[mt][nt][1]); o.y = pg8::cvt_pk_bf16(acc[mt][nt][2], acc[mt][nt][3]);
              *(GAS v2u*)(KV + (size_t)(16 * (2 * w + nt) + fr) * 128 + 16 * mt + 4 * fq) = o; } }
    __syncthreads();
}
__device__ __forceinline__ void gla_g2_scan(Frame& F) {
    const GAS bf16* KV = (const GAS bf16*)(F.ws + WS_KV); const GAS float* DEC = (const GAS float*)(F.ws + WS_DEC); GAS bf16* ST = (GAS bf16*)(F.ws + WS_ST);
    for (int e8 = blockIdx.x * 512 + F.tid; e8 < 16 * 256 * 16; e8 += F.G * 512) { const int bh = e8 >> 12, dv = (e8 >> 4) & 255, d8 = e8 & 15;
        float s[8];
#pragma unroll
        for (int j = 0; j < 8; ++j) s[j] = 0.f;
        for (int n0 = 0; n0 < 32; n0 += 4) { v4u kv[4]; f32x4 dc[4][2];
#pragma unroll
            for (int e = 0; e < 4; ++e) { const size_t u = (size_t)bh * 32 + n0 + e; kv[e] = *(const GAS v4u*)(KV + (u * 256 + dv) * 128 + 8 * d8); dc[e][0] = *(const GAS f32x4*)(DEC + u * 128 + 8 * d8); dc[e][1] = *(const GAS f32x4*)(DEC + u * 128 + 8 * d8 + 4); }
#pragma unroll
            for (int e = 0; e < 4; ++e) { const size_t u = (size_t)bh * 32 + n0 + e; v4u o; o.x = pk2(s[0], s[1]); o.y = pk2(s[2], s[3]); o.z = pk2(s[4], s[5]); o.w = pk2(s[6], s[7]); *(GAS v4u*)(ST + (u * 256 + dv) * 128 + 8 * d8) = o;
                const unsigned kw[4] = {kv[e].x, kv[e].y, kv[e].z, kv[e].w};
#pragma unroll
                for (int j = 0; j < 4; ++j) { s[2 * j] = dc[e][j >> 1][(2 * j) & 3] * s[2 * j] + bflo(kw[j]); s[2 * j + 1] = dc[e][j >> 1][(2 * j + 1) & 3] * s[2 * j + 1] + bfhi(kw[j]); } } } }
}
__device__ __forceinline__ void gla_g3_unit(Frame& F, int l, int u) {
    const int n = u & 31, h = (u >> 5) & 3, b = u >> 7, tid = F.tid, lane = F.lane, w = F.wave, fr = lane & 15, fq = lane >> 4;
    const size_t tok0 = (size_t)b * SEQ + 64 * n;
    LAS unsigned char* QDL = F.lds; LAS unsigned char* KIL = F.lds + 17408; LAS unsigned char* ATL = F.lds + 34816; LAS float* SSQL = (LAS float*)(F.lds + 44032); LAS float* RSL = (LAS float*)(F.lds + 46080);
    bf16x8_t gvtf[2][2], stf[2][4];
    { const GAS bf16* GVT = (const GAS bf16*)(F.ws + WS_GVT) + (size_t)u * 256 * 64; const GAS bf16* ST = (const GAS bf16*)(F.ws + WS_ST) + (size_t)u * 256 * 128;
#pragma unroll
      for (int mt = 0; mt < 2; ++mt) {
#pragma unroll
          for (int ks = 0; ks < 2; ++ks) gvtf[mt][ks] = *(const GAS bf16x8_t*)(GVT + (size_t)(16 * (2 * w + mt) + fr) * 64 + 32 * ks + 8 * fq);
#pragma unroll
          for (int ks = 0; ks < 4; ++ks) stf[mt][ks] = *(const GAS bf16x8_t*)(ST + (size_t)(16 * (2 * w + mt) + fr) * 128 + 32 * ks + 8 * fq); } }
    { const GAS v4u* qs = (const GAS v4u*)((const GAS bf16*)(F.ws + WS_QD) + (size_t)u * 64 * 128); const GAS v4u* ks_ = (const GAS v4u*)((const GAS bf16*)(F.ws + WS_KI) + (size_t)u * 64 * 128);
#pragma unroll
      for (int it = 0; it < 2; ++it) { const int c = tid + 512 * it, row = c >> 4, c16 = c & 15; *(LAS v4u*)(QDL + row * GL_DSTR + c16 * 16) = qs[c]; *(LAS v4u*)(KIL + row * GL_DSTR + c16 * 16) = ks_[c]; } }
    LDS_WAIT(); __syncthreads();
#pragma unroll
    for (int tt = 0; tt < 2; ++tt) { const int tile = 2 * w + tt, mi = tile >> 2, nj = tile & 3; f32x4 acc = (f32x4){0.f, 0.f, 0.f, 0.f};
        if (nj <= mi) { bf16x8_t fa[4], fb[4];
#pragma unroll
            for (int ks = 0; ks < 4; ++ks) { fa[ks] = *(const LAS bf16x8_t*)(QDL + (16 * mi + fr) * GL_DSTR + (32 * ks + 8 * fq) * 2); fb[ks] = *(const LAS bf16x8_t*)(KIL + (16 * nj + fr) * GL_DSTR + (32 * ks + 8 * fq) * 2); }
#pragma unroll
            for (int ks = 0; ks < 4; ++ks) acc = mma16(fa[ks], fb[ks], acc); }
#pragma unroll
        for (int r = 0; r < 4; ++r) { const int i = 16 * mi + 4 * fq + r, j = 16 * nj + fr; *(LAS bf16*)(ATL + i * GL_TSTR + j * 2) = (bf16)f2bf(j <= i ? acc[r] : 0.f); } }
    LDS_WAIT(); __syncthreads();
    f32x4 acc[2][4];
#pragma unroll
    for (int mt = 0; mt < 2; ++mt)
#pragma unroll
        for (int nt = 0; nt < 4; ++nt) acc[mt][nt] = (f32x4){0.f, 0.f, 0.f, 0.f};
#pragma unroll
    for (int ks = 0; ks < 2; ++ks) { bf16x8_t fb[4];
#pragma unroll
        for (int nt = 0; nt < 4; ++nt) fb[nt] = *(const LAS bf16x8_t*)(ATL + (16 * nt + fr) * GL_TSTR + (32 * ks + 8 * fq) * 2);
#pragma unroll
        for (int nt = 0; nt < 4; ++nt) { acc[0][nt] = mma16(gvtf[0][ks], fb[nt], acc[0][nt]); acc[1][nt] = mma16(gvtf[1][ks], fb[nt], acc[1][nt]); } }
#pragma unroll
    for (int ks = 0; ks < 4; ++ks) { bf16x8_t fb[4];
#pragma unroll
        for (int nt = 0; nt < 4; ++nt) fb[nt] = *(const LAS bf16x8_t*)(QDL + (16 * nt + fr) * GL_DSTR + (32 * ks + 8 * fq) * 2);
#pragma unroll
        for (int nt = 0; nt < 4; ++nt) { acc[0][nt] = mma16(stf[0][ks], fb[nt], acc[0][nt]); acc[1][nt] = mma16(stf[1][ks], fb[nt], acc[1][nt]); } }
#pragma unroll
    for (int nt = 0; nt < 4; ++nt) { float v = 0.f;
#pragma unroll
        for (int mt = 0; mt < 2; ++mt)
#pragma unroll
            for (int r = 0; r < 4; ++r) v += acc[mt][nt][r] * acc[mt][nt][r];
        v += __shfl_xor(v, 16); v += __shfl_xor(v, 32);
        if (fq == 0) SSQL[w * 64 + 16 * nt + fr] = v; }
    LDS_WAIT(); __syncthreads();
    if (tid < 64) { float s = 0.f;
#pragma unroll
        for (int ww = 0; ww < 8; ++ww) s += SSQL[ww * 64 + tid];
        RSL[tid] = 1.0f / sqrtf(s * (1.0f / 256.0f) + RMS_EPS); }
    LDS_WAIT(); __syncthreads();
    { const GAS bf16* P = (const GAS bf16*)(F.ws + WS_P); GAS bf16* Y = (GAS bf16*)(F.ws + WS_Y); const GAS float* gn = (const GAS float*)F.in[I_GNG] + l * 256;
      v2u rr[2][4];
#pragma unroll
      for (int mt = 0; mt < 2; ++mt)
#pragma unroll
          for (int nt = 0; nt < 4; ++nt) rr[mt][nt] = *(const GAS v2u*)(P + (tok0 + 16 * nt + fr) * NP + PC_GR + h * 256 + 16 * (2 * w + mt) + 4 * fq);
#pragma unroll
      for (int mt = 0; mt < 2; ++mt) { const int dv0 = 16 * (2 * w + mt) + 4 * fq; const f32x4 gv = *(const GAS f32x4*)(gn + dv0);
#pragma unroll
          for (int nt = 0; nt < 4; ++nt) { const int i = 16 * nt + fr; const float rs = RSL[i]; const v2u rw = rr[mt][nt];
              const float r0 = bflo(rw.x), r1 = bfhi(rw.x), r2 = bflo(rw.y), r3 = bfhi(rw.y);
              v2u o; o.x = pg8::cvt_pk_bf16(acc[mt][nt][0] * rs * gv[0] * r0 * sigmoidf_(r0), acc[mt][nt][1] * rs * gv[1] * r1 * sigmoidf_(r1));
              o.y = pg8::cvt_pk_bf16(acc[mt][nt][2] * rs * gv[2] * r2 * sigmoidf_(r2), acc[mt][nt][3] * rs * gv[3] * r3 * sigmoidf_(r3));
              *(GAS v2u*)(Y + (tok0 + i) * YW + 1024 + h * 256 + dv0) = o; } } }
    __syncthreads();
}
constexpr int MB_KSTR = 272, MB_VSTR = 144, MB_KBYTES = 64 * MB_KSTR, MB_BUF = MB_KBYTES + 128 * MB_VSTR;
__device__ __forceinline__ void moba_prep_unit(Frame& F, int l, int unit) {
    const int kb = unit & 7, h = (unit >> 3) & 7, b = unit >> 6, tid = F.tid;
    const size_t tok0 = (size_t)b * SEQ + 256 * kb;
    const GAS bf16* P = (const GAS bf16*)(F.ws + WS_P);
    LAS unsigned char* TL = F.lds; LAS float* PART = (LAS float*)(F.lds + 69632);
    const int c16 = tid & 15, tg = tid >> 4;
    v4u xq[8], xk[8], xv[8];
    { const GAS bf16* src = P + (tok0 + tg) * NP + h * 128 + 8 * c16;
#pragma unroll
      for (int j = 0; j < 8; ++j) { xq[j] = *(const GAS v4u*)(src + (size_t)(32 * j) * NP + PC_MQ); xk[j] = *(const GAS v4u*)(src + (size_t)(32 * j) * NP + PC_MK); xv[j] = *(const GAS v4u*)(src + (size_t)(32 * j) * NP + PC_MV); } }
#pragma unroll
    for (int which = 0; which < 2; ++which) {
        const GAS float* gp = (const GAS float*)F.in[which ? I_MKG : I_MQG] + l * 128 + 8 * c16;
        const f32x4 g0 = *(const GAS f32x4*)gp, g1 = *(const GAS f32x4*)(gp + 4);
#pragma unroll
        for (int j = 0; j < 8; ++j) { const v4u xx = which ? xk[j] : xq[j]; const unsigned xw[4] = {xx.x, xx.y, xx.z, xx.w}; float ss = 0.f;
#pragma unroll
            for (int e = 0; e < 4; ++e) { const float a = bflo(xw[e]), bb = bfhi(xw[e]); ss += a * a + bb * bb; }
            ss += __shfl_xor(ss, 1); ss += __shfl_xor(ss, 2); ss += __shfl_xor(ss, 4); ss += __shfl_xor(ss, 8);
            const float r = (1.0f / sqrtf(ss * (1.0f / 128.0f) + RMS_EPS)) * (which ? 1.0f : 0.08838834764831845f * 1.4426950408889634f);
            const int tok = tg + 32 * j;
            v4u o; o.x = pg8::cvt_pk_bf16(bflo(xw[0]) * r * g0[0], bfhi(xw[0]) * r * g0[1]); o.y = pg8::cvt_pk_bf16(bflo(xw[1]) * r * g0[2], bfhi(xw[1]) * r * g0[3]);
            o.z = pg8::cvt_pk_bf16(bflo(xw[2]) * r * g1[0], bfhi(xw[2]) * r * g1[1]); o.w = pg8::cvt_pk_bf16(bflo(xw[3]) * r * g1[2], bfhi(xw[3]) * r * g1[3]);
            *(GAS v4u*)((GAS bf16*)(F.ws + (which ? WS_KN : WS_QN)) + (tok0 + tok) * 1024 + h * 128 + 8 * c16) = o; if (which) *(LAS v4u*)(TL + tok * MB_KSTR + 16 * c16) = o; }
    }
    LDS_WAIT(); __syncthreads();
    { const int d = tid & 127, part = tid >> 7; float a = 0.f;
#pragma unroll 8
      for (int j = 0; j < 64; ++j) a += bf1(*(const LAS bf16*)(TL + (64 * part + j) * MB_KSTR + d * 2));
      PART[part * 128 + d] = a; }
    LDS_WAIT(); __syncthreads();
    if (tid < 128) ((GAS float*)(F.ws + WS_KM))[(size_t)unit * 128 + tid] = ((PART[tid] + PART[128 + tid]) + (PART[256 + tid] + PART[384 + tid])) * (1.0f / 256.0f);
#pragma unroll
    for (int j = 0; j < 8; ++j) *(LAS v4u*)(TL + (tg + 32 * j) * MB_KSTR + 16 * c16) = xv[j];
    LDS_WAIT(); __syncthreads();
    { const int d = tid >> 2, tq = tid & 3; GAS bf16* dst = (GAS bf16*)(F.ws + WS_VT) + ((size_t)(b * 8 + h) * 128 + d) * SEQ + 256 * kb + 64 * tq;
#pragma unroll
      for (int c = 0; c < 8; ++c) { unsigned wv[4];
#pragma unroll
          for (int e = 0; e < 4; ++e) { const unsigned lo = *(const LAS bf16*)(TL + (64 * tq + 8 * c + 2 * e) * MB_KSTR + d * 2), hi = *(const LAS bf16*)(TL + (64 * tq + 8 * c + 2 * e + 1) * MB_KSTR + d * 2); wv[e] = lo | (hi << 16); }
          v4u o; o.x = wv[0]; o.y = wv[1]; o.z = wv[2]; o.w = wv[3]; *(GAS v4u*)(dst + 8 * c) = o; } }
    __syncthreads();
}
constexpr int MB3_TILE = 128 * 256, MB3_BUF = 2 * MB3_TILE;
__device__ __forceinline__ void moba_attn_unit3(Frame& F, int bh, int qt) {
    const int b = bh >> 3, h = bh & 7, tid = F.tid, lane = F.lane, w = F.wave, fr = lane & 15, fq = lane >> 4;
    const int qb = qt >> 1, np = qt + 1, qpos = 128 * qt + 16 * w + fr;
    const GAS bf16* KN = (const GAS bf16*)(F.ws + WS_KN) + (size_t)b * SEQ * 1024 + h * 128; const GAS bf16* VT = (const GAS bf16*)(F.ws + WS_VT) + (size_t)bh * 128 * SEQ;
    LAS float* KML = (LAS float*)(F.lds + 2 * MB3_BUF);
    { const GAS float* km = (const GAS float*)(F.ws + WS_KM) + (size_t)bh * 1024; KML[tid] = km[tid]; KML[512 + tid] = km[512 + tid]; }
    bf16x8_t bq[4];
    { const GAS bf16* qp = (const GAS bf16*)(F.ws + WS_QN) + ((size_t)b * SEQ + qpos) * 1024 + h * 128 + 8 * fq;
#pragma unroll
      for (int ks = 0; ks < 4; ++ks) bq[ks] = *(const GAS bf16x8_t*)(qp + 32 * ks); }
    const int drow = lane >> 4, dslot = lane & 15;
#define MB3_DMA(buf_, p_) do { _Pragma("unroll") for (int j_ = 0; j_ < 4; ++j_) { const int row_ = 4 * (8 * j_ + w) + drow, c_ = dslot ^ (row_ & 15); \
        __builtin_amdgcn_global_load_lds((const GAS unsigned*)(KN + (size_t)(128 * (p_) + row_) * 1024 + 8 * c_), (LAS unsigned*)((buf_) + (8 * j_ + w) * 1024), 16, 0, 0); \
        __builtin_amdgcn_global_load_lds((const GAS unsigned*)(VT + (size_t)row_ * SEQ + 128 * (p_) + 8 * c_), (LAS unsigned*)((buf_) + MB3_TILE + (8 * j_ + w) * 1024), 16, 0, 0); } } while (0)
    MB3_DMA(F.lds, 0);
    VM_WAIT(); LDS_WAIT(); __syncthreads();
    unsigned selmask = 0u;
    { float sc[8];
#pragma unroll
      for (int kb = 0; kb < 8; ++kb) { float a = 0.f;
#pragma unroll
          for (int ks = 0; ks < 4; ++ks) { const LAS float* kp = KML + kb * 128 + 32 * ks + 8 * fq; const f32x4 k0 = *(const LAS f32x4*)kp, k1 = *(const LAS f32x4*)(kp + 4);
              const v4u qv = __builtin_bit_cast(v4u, bq[ks]);
              a += bflo(qv.x) * k0[0] + bfhi(qv.x) * k0[1] + bflo(qv.y) * k0[2] + bfhi(qv.y) * k0[3] + bflo(qv.z) * k1[0] + bfhi(qv.z) * k1[1] + bflo(qv.w) * k1[2] + bfhi(qv.w) * k1[3]; }
          a += __shfl_xor(a, 16); a += __shfl_xor(a, 32); sc[kb] = (kb < qb) ? a : -__builtin_inff(); }
#pragma unroll
      for (int kb = 0; kb < 8; ++kb) { int rank = 0;
#pragma unroll
          for (int j = 0; j < 8; ++j) if (j != kb) rank += ((j < qb) && (sc[j] > sc[kb] || (sc[j] == sc[kb] && j < kb))) ? 1 : 0;
          if (kb < qb && rank < 3) selmask |= 1u << kb; } }
    f32x4 ao[8];
#pragma unroll
    for (int dt = 0; dt < 8; ++dt) ao[dt] = (f32x4){0.f, 0.f, 0.f, 0.f};
    float m = -__builtin_inff(), lsum = 0.f;
#pragma unroll 1
    for (int p = 0; p < np; ++p) {
        LAS unsigned char* KB = F.lds + (p & 1) * MB3_BUF; LAS unsigned char* VB = KB + MB3_TILE;
        if (p + 1 < np) MB3_DMA(F.lds + ((p + 1) & 1) * MB3_BUF, p + 1);
        const int kb = p >> 1; const bool past = kb < qb; const bool mine = past ? (((selmask >> kb) & 1u) != 0u) : true;
        if (__any(mine)) {
            const int lim = (past ? (mine ? 0x7fffffff : -1) : qpos - 128 * p) - 4 * fq;
            f32x4 as[8];
#pragma unroll
            for (int mh = 0; mh < 4; ++mh) { bf16x8_t fragA[2][4];
#pragma unroll
                for (int mt = 0; mt < 2; ++mt)
#pragma unroll
                    for (int ks = 0; ks < 4; ++ks) fragA[mt][ks] = *(const LAS bf16x8_t*)(KB + (16 * (2 * mh + mt) + fr) * 256 + 16 * ((4 * ks + fq) ^ fr));
                __builtin_amdgcn_sched_barrier(0);
#pragma unroll
                for (int mt = 0; mt < 2; ++mt) { as[2 * mh + mt] = (f32x4){0.f, 0.f, 0.f, 0.f};
#pragma unroll
                    for (int ks = 0; ks < 4; ++ks) as[2 * mh + mt] = mma16(fragA[mt][ks], bq[ks], as[2 * mh + mt]); }
                __builtin_amdgcn_sched_barrier(0); }
            float mx = -__builtin_inff();
            if (__all(lim >= 127)) {
#pragma unroll
                for (int mt = 0; mt < 8; ++mt)
#pragma unroll
                    for (int r = 0; r < 4; ++r) mx = fmaxf(mx, as[mt][r]);
            } else {
#pragma unroll
                for (int mt = 0; mt < 8; ++mt)
#pragma unroll
                    for (int r = 0; r < 4; ++r) { const float sv_ = (16 * mt + r <= lim) ? as[mt][r] : -__builtin_inff(); as[mt][r] = sv_; mx = fmaxf(mx, sv_); }
            }
            mx = fmaxf(mx, __shfl_xor(mx, 16)); mx = fmaxf(mx, __shfl_xor(mx, 32));
            const float mnew = fmaxf(m, mx), msafe = (mnew == -__builtin_inff()) ? 0.f : mnew;
            const bool grow = __any(mnew != m);
            const float corr = grow ? __builtin_amdgcn_exp2f(m - msafe) : 1.0f;
            float ps = 0.f;
#pragma unroll
            for (int mt = 0; mt < 8; ++mt)
#pragma unroll
                for (int r = 0; r < 4; ++r) { const float pv = __builtin_amdgcn_exp2f(as[mt][r] - msafe); as[mt][r] = pv; ps += pv; }
            lsum = lsum * corr + ps; m = mnew;
            bf16x8_t pf[4];
#pragma unroll
            for (int k2 = 0; k2 < 4; ++k2) { v4u t; t.x = pg8::cvt_pk_bf16(as[2 * k2][0], as[2 * k2][1]); t.y = pg8::cvt_pk_bf16(as[2 * k2][2], as[2 * k2][3]); t.z = pg8::cvt_pk_bf16(as[2 * k2 + 1][0], as[2 * k2 + 1][1]); t.w = pg8::cvt_pk_bf16(as[2 * k2 + 1][2], as[2 * k2 + 1][3]);
                pf[k2] = __builtin_bit_cast(bf16x8_t, t); }
            if (grow) {
#pragma unroll
                for (int dt = 0; dt < 8; ++dt) ao[dt] = ao[dt] * corr; }
            __builtin_amdgcn_sched_barrier(0);
#pragma unroll
            for (int dh = 0; dh < 4; ++dh) { v2u vlo[2][4], vhi[2][4];
#pragma unroll
                for (int dt = 0; dt < 2; ++dt)
#pragma unroll
                    for (int k2 = 0; k2 < 4; ++k2) { const LAS unsigned char* vr = VB + (16 * (2 * dh + dt) + fr) * 256 + 8 * (fq & 1); const int c0 = 4 * k2 + (fq >> 1);
                        vlo[dt][k2] = *(const LAS v2u*)(vr + 16 * (c0 ^ fr)); vhi[dt][k2] = *(const LAS v2u*)(vr + 16 * ((c0 + 2) ^ fr)); }
                __builtin_amdgcn_sched_barrier(0);
#pragma unroll
                for (int dt = 0; dt < 2; ++dt)
#pragma unroll
                    for (int k2 = 0; k2 < 4; ++k2) { v4u t; t.x = vlo[dt][k2].x; t.y = vlo[dt][k2].y; t.z = vhi[dt][k2].x; t.w = vhi[dt][k2].y; ao[2 * dh + dt] = mma16(__builtin_bit_cast(bf16x8_t, t), pf[k2], ao[2 * dh + dt]); }
                __builtin_amdgcn_sched_barrier(0); }
        }
        VM_WAIT(); LDS_WAIT(); __syncthreads();
    }
#undef MB3_DMA
    lsum += __shfl_xor(lsum, 16); lsum += __shfl_xor(lsum, 32);
    const float inv = 1.0f / lsum;
    GAS bf16* yp = (GAS bf16*)(F.ws + WS_Y) + ((size_t)b * SEQ + qpos) * YW + 2048 + h * 128 + 4 * fq;
#pragma unroll
    for (int dt = 0; dt < 8; ++dt) { v2u o; o.x = pg8::cvt_pk_bf16(ao[dt][0] * inv, ao[dt][1] * inv); o.y = pg8::cvt_pk_bf16(ao[dt][2] * inv, ao[dt][3] * inv); *(GAS v2u*)(yp + 16 * dt) = o; }
}
__device__ __forceinline__ void moba_attn_unit(Frame& F, int bh, int qt) {
    const int b = bh >> 3, h = bh & 7, tid = F.tid, lane = F.lane, w = F.wave, fr = lane & 15, fq = lane >> 4;
    const int qb = qt >> 1, nt = 2 * (qt + 1), qpos = 128 * qt + 16 * w + fr;
    const GAS bf16* KN = (const GAS bf16*)(F.ws + WS_KN) + (size_t)b * SEQ * 1024 + h * 128; const GAS bf16* VT = (const GAS bf16*)(F.ws + WS_VT) + (size_t)bh * 128 * SEQ;
    LAS float* KML = (LAS float*)(F.lds + 2 * MB_BUF);
    { const GAS float* km = (const GAS float*)(F.ws + WS_KM) + (size_t)bh * 1024; KML[tid] = km[tid]; KML[512 + tid] = km[512 + tid]; }
    bf16x8_t bq[4];
    { const GAS bf16* qp = (const GAS bf16*)(F.ws + WS_QN) + ((size_t)b * SEQ + qpos) * 1024 + h * 128 + 8 * fq;
#pragma unroll
      for (int ks = 0; ks < 4; ++ks) bq[ks] = *(const GAS bf16x8_t*)(qp + 32 * ks); }
    v4u sk[2][2], sv[2][2];
#define MB_LOAD(S_, it_) do { _Pragma("unroll") for (int p_ = 0; p_ < 2; ++p_) { const int cc_ = tid + 512 * p_; \
        sk[S_][p_] = *(const GAS v4u*)(KN + (size_t)(64 * (it_) + (cc_ >> 4)) * 1024 + 8 * (cc_ & 15)); sv[S_][p_] = *(const GAS v4u*)(VT + (size_t)(cc_ >> 3) * SEQ + 64 * (it_) + 8 * (cc_ & 7)); } } while (0)
#define MB_STORE(buf_, S_) do { _Pragma("unroll") for (int p_ = 0; p_ < 2; ++p_) { const int cc_ = tid + 512 * p_; \
        *(LAS v4u*)((buf_) + (cc_ >> 4) * MB_KSTR + (cc_ & 15) * 16) = sk[S_][p_]; *(LAS v4u*)((buf_) + MB_KBYTES + (cc_ >> 3) * MB_VSTR + (cc_ & 7) * 16) = sv[S_][p_]; } } while (0)
    MB_LOAD(0, 0); MB_LOAD(1, 1);
    LDS_WAIT(); __syncthreads();
    unsigned selmask = 0u;
    { float sc[8];
#pragma unroll
      for (int kb = 0; kb < 8; ++kb) { float a = 0.f;
#pragma unroll
          for (int ks = 0; ks < 4; ++ks) { const LAS float* kp = KML + kb * 128 + 32 * ks + 8 * fq; const f32x4 k0 = *(const LAS f32x4*)kp, k1 = *(const LAS f32x4*)(kp + 4);
              const unsigned q01 = (unsigned)(unsigned short)bq[ks][0] | ((unsigned)(unsigned short)bq[ks][1] << 16), q23 = (unsigned)(unsigned short)bq[ks][2] | ((unsigned)(unsigned short)bq[ks][3] << 16);
              const unsigned q45 = (unsigned)(unsigned short)bq[ks][4] | ((unsigned)(unsigned short)bq[ks][5] << 16), q67 = (unsigned)(unsigned short)bq[ks][6] | ((unsigned)(unsigned short)bq[ks][7] << 16);
              a += bflo(q01) * k0[0] + bfhi(q01) * k0[1] + bflo(q23) * k0[2] + bfhi(q23) * k0[3] + bflo(q45) * k1[0] + bfhi(q45) * k1[1] + bflo(q67) * k1[2] + bfhi(q67) * k1[3]; }
          a += __shfl_xor(a, 16); a += __shfl_xor(a, 32); sc[kb] = (kb < qb) ? a : -__builtin_inff(); }
#pragma unroll
      for (int kb = 0; kb < 8; ++kb) { int rank = 0;
#pragma unroll
          for (int j = 0; j < 8; ++j) if (j != kb) rank += ((j < qb) && (sc[j] > sc[kb] || (sc[j] == sc[kb] && j < kb))) ? 1 : 0;
          if (kb < qb && rank < 3) selmask |= 1u << kb; } }
    MB_STORE(F.lds, 0);
    LDS_WAIT(); __syncthreads();
    f32x4 ao[8];
#pragma unroll
    for (int dt = 0; dt < 8; ++dt) ao[dt] = (f32x4){0.f, 0.f, 0.f, 0.f};
    float m = -__builtin_inff(), lsum = 0.f;
#pragma unroll 1
    for (int it0 = 0; it0 < nt; it0 += 2) {
#pragma unroll
      for (int hf = 0; hf < 2; ++hf) { const int it = it0 + hf;
        LAS unsigned char* KB = F.lds + hf * MB_BUF; LAS unsigned char* VB = KB + MB_KBYTES;
        if (it + 2 < nt) MB_LOAD(hf, it + 2);
        const int kb = it >> 2; const bool past = kb < qb; const bool mine = past ? (((selmask >> kb) & 1u) != 0u) : true;
        if (__any(mine)) {
            const int lim = (past ? (mine ? 0x7fffffff : -1) : qpos - 64 * it) - 4 * fq;
            f32x4 as[4];
#pragma unroll
            for (int mh = 0; mh < 2; ++mh) { bf16x8_t fragA[2][4];
#pragma unroll
                for (int mt = 0; mt < 2; ++mt)
#pragma unroll
                    for (int ks = 0; ks < 4; ++ks) fragA[mt][ks] = *(const LAS bf16x8_t*)(KB + (16 * (2 * mh + mt) + fr) * MB_KSTR + (32 * ks + 8 * fq) * 2);
                __builtin_amdgcn_sched_barrier(0);
#pragma unroll
                for (int mt = 0; mt < 2; ++mt) { as[2 * mh + mt] = (f32x4){0.f, 0.f, 0.f, 0.f};
#pragma unroll
                    for (int ks = 0; ks < 4; ++ks) as[2 * mh + mt] = mma16(fragA[mt][ks], bq[ks], as[2 * mh + mt]); }
                __builtin_amdgcn_sched_barrier(0); }
            v2u vlo[4][2], vhi[4][2];
#pragma unroll
            for (int dt = 0; dt < 4; ++dt)
#pragma unroll
                for (int k2 = 0; k2 < 2; ++k2) { const LAS unsigned char* vp = VB + (16 * dt + fr) * MB_VSTR + (32 * k2 + 4 * fq) * 2; vlo[dt][k2] = *(const LAS v2u*)vp; vhi[dt][k2] = *(const LAS v2u*)(vp + 32); }
            __builtin_amdgcn_sched_barrier(0);
            float mx = -__builtin_inff();
            if (__all(lim >= 63)) {
#pragma unroll
                for (int mt = 0; mt < 4; ++mt)
#pragma unroll
                    for (int r = 0; r < 4; ++r) mx = fmaxf(mx, as[mt][r]);
            } else {
#pragma unroll
                for (int mt = 0; mt < 4; ++mt)
#pragma unroll
                    for (int r = 0; r < 4; ++r) { const float sv_ = (16 * mt + r <= lim) ? as[mt][r] : -__builtin_inff(); as[mt][r] = sv_; mx = fmaxf(mx, sv_); }
            }
            mx = fmaxf(mx, __shfl_xor(mx, 16)); mx = fmaxf(mx, __shfl_xor(mx, 32));
            const float mnew = fmaxf(m, mx), msafe = (mnew == -__builtin_inff()) ? 0.f : mnew;
            const bool grow = __any(mnew != m);
            const float corr = grow ? __builtin_amdgcn_exp2f(m - msafe) : 1.0f;
            float ps = 0.f;
#pragma unroll
            for (int mt = 0; mt < 4; ++mt)
#pragma unroll
                for (int r = 0; r < 4; ++r) { const float p = __builtin_amdgcn_exp2f(as[mt][r] - msafe); as[mt][r] = p; ps += p; }
            lsum = lsum * corr + ps; m = mnew;
            bf16x8_t pf[2];
#pragma unroll
            for (int k2 = 0; k2 < 2; ++k2) { v4u t; t.x = pg8::cvt_pk_bf16(as[2 * k2][0], as[2 * k2][1]); t.y = pg8::cvt_pk_bf16(as[2 * k2][2], as[2 * k2][3]); t.z = pg8::cvt_pk_bf16(as[2 * k2 + 1][0], as[2 * k2 + 1][1]); t.w = pg8::cvt_pk_bf16(as[2 * k2 + 1][2], as[2 * k2 + 1][3]);
                pf[k2] = __builtin_bit_cast(bf16x8_t, t); }
            if (grow) {
#pragma unroll
                for (int dt = 0; dt < 8; ++dt) ao[dt] = ao[dt] * corr; }
            __builtin_amdgcn_sched_barrier(0);
#pragma unroll
            for (int dh = 0; dh < 2; ++dh) {
                if (dh == 1) {
#pragma unroll
                    for (int dt = 0; dt < 4; ++dt)
#pragma unroll
                        for (int k2 = 0; k2 < 2; ++k2) { const LAS unsigned char* vp = VB + (16 * (4 + dt) + fr) * MB_VSTR + (32 * k2 + 4 * fq) * 2; vlo[dt][k2] = *(const LAS v2u*)vp; vhi[dt][k2] = *(const LAS v2u*)(vp + 32); }
                    __builtin_amdgcn_sched_barrier(0); }
#pragma unroll
                for (int dt = 0; dt < 4; ++dt)
#pragma unroll
                    for (int k2 = 0; k2 < 2; ++k2) { v4u t; t.x = vlo[dt][k2].x; t.y = vlo[dt][k2].y; t.z = vhi[dt][k2].x; t.w = vhi[dt][k2].y; ao[4 * dh + dt] = mma16(__builtin_bit_cast(bf16x8_t, t), pf[k2], ao[4 * dh + dt]); }
                __builtin_amdgcn_sched_barrier(0); }
        }
        if (it + 1 < nt) MB_STORE(F.lds + (hf ^ 1) * MB_BUF, hf ^ 1);
        LDS_WAIT(); __syncthreads();
      }
    }
#undef MB_LOAD
#undef MB_STORE
    lsum += __shfl_xor(lsum, 16); lsum += __shfl_xor(lsum, 32);
    const float inv = 1.0f / lsum;
    GAS bf16* yp = (GAS bf16*)(F.ws + WS_Y) + ((size_t)b * SEQ + qpos) * YW + 2048 + h * 128 + 4 * fq;
#pragma unroll
    for (int dt = 0; dt < 8; ++dt) { v2u o; o.x = pk2(ao[dt][0] * inv, ao[dt][1] * inv); o.y = pk2(ao[dt][2] * inv, ao[dt][3] * inv); *(GAS v2u*)(yp + 16 * dt) = o; }
}

__device__ __forceinline__ void p2c_gla_finish(Frame& F, int l) {
    const GAS bf16* P = (const GAS bf16*)(F.ws + WS_P); const GAS float* OT = (const GAS float*)(F.ws + WS_OT); GAS bf16* Y = (GAS bf16*)(F.ws + WS_Y);
    const int lane = F.lane, gw = blockIdx.x * NWAVES + F.wave, NGW = F.G * NWAVES;
    const f32x4 gn = *(const GAS f32x4*)(((const GAS float*)F.in[I_GNG]) + l * 256 + 4 * lane);
    for (int it = gw; it < MTOK * 4; it += NGW) { const int tok = it >> 2, h = it & 3;
        const f32x4 o = (*(const GAS f32x4*)(OT + (size_t)tok * 1024 + h * 256 + 4 * lane) + *(const GAS f32x4*)(OT + (size_t)(MTOK + tok) * 1024 + h * 256 + 4 * lane)) + (*(const GAS f32x4*)(OT + (size_t)(2 * MTOK + tok) * 1024 + h * 256 + 4 * lane) + *(const GAS f32x4*)(OT + (size_t)(3 * MTOK + tok) * 1024 + h * 256 + 4 * lane));
        const float ss = wave_sum((o[0] * o[0] + o[1] * o[1]) + (o[2] * o[2] + o[3] * o[3])); const float rn = 1.0f / sqrtf(ss * (1.0f / 256.0f) + RMS_EPS);
        const v2u rw = *(const GAS v2u*)(P + (size_t)tok * NP + PC_GR + h * 256 + 4 * lane);
        const float r0 = bflo(rw.x), r1 = bfhi(rw.x), r2 = bflo(rw.y), r3 = bfhi(rw.y);
        v2u w; w.x = pk2(o[0] * rn * gn[0] * r0 * sigmoidf_(r0), o[1] * rn * gn[1] * r1 * sigmoidf_(r1)); w.y = pk2(o[2] * rn * gn[2] * r2 * sigmoidf_(r2), o[3] * rn * gn[3] * r3 * sigmoidf_(r3));
        *(GAS v2u*)(Y + (size_t)tok * YW + 1024 + h * 256 + 4 * lane) = w; }
}

constexpr int NPH = 9;
__global__ void __launch_bounds__(NWAVES * 64, 2) fwd_kernel(Args args) {
    extern __shared__ __attribute__((aligned(16))) unsigned char lds[];
    Frame F;
    F.lds = (LAS unsigned char*)lds;
    F.MISC = (volatile LAS unsigned*)(F.lds + MISC_OFF);
    F.tid = threadIdx.x; F.lane = F.tid & 63; F.wave = __builtin_amdgcn_readfirstlane(F.tid >> 6); F.wv = F.wave;
    F.G = gridDim.x; F.in = args.in; F.ws = (GAS unsigned char*)args.ws; F.ws0 = args.ws; F.ctl = (unsigned*)(args.ws + WS_CTL);
    for (int u = F.tid; u < (LDS_BYTES - LDSCTL_OFF) / 4; u += NWAVES * 64) ((LAS unsigned*)(F.lds + LDSCTL_OFF))[u] = 0u;
    __syncthreads();
    XcdBarrier bar; bar.bar = F.ctl + CW_BAR; bar.x = 0; bar.st = nullptr;
    if (args.fused) bar = xcd_barrier_post(F.ctl + CW_BAR, F.MISC + 8);
#define GRID_BAR() do { if (args.fused) xcd_barrier(bar, opaque_tid(F.wv)); } while (0)
    const int lo = args.ph_lo, hi = args.ph_hi;
#ifndef PH_MASK
#define PH_MASK 0x1ff
#endif
#define IN(k) (((PH_MASK >> (k)) & 1) && lo <= (k) && (k) < hi)
#define WSP(T, off) ((GAS T*)(ws + (off)))

    if (args.l_lo == 0 && IN(0)) for (int rep = 0; rep < NREP(0); ++rep) { F.refresh(); p0_prologue(F); GRID_BAR(); }

    for (int l = args.l_lo; l < args.l_hi; ++l) {
        if (IN(1)) for (int rep = 0; rep < NREP(1); ++rep) {
            GAS unsigned char* ws = (GAS unsigned char*)opaque_ptr(args.ws); const GAS unsigned char* wl = ws + WS_W + (size_t)l * SZ_WLAYER;
            pg8::Gemm g{WSP(pg8::bf16_t, WS_XB), DM, (const GAS pg8::bf16_t*)(wl + OFF_WIN), DM, DM, 0, 0}; pg8::TileOrder S; S.init(MTOK, NP, F.G, (int)blockIdx.x, 1);
            pg8::EpiInProj E{WSP(pg8::bf16_t, WS_P), WSP(float, WS_SSQ), WSP(pg8::bf16_t, WS_US)};
            pg8::gemm_phase(F.lds, g, S, E, F.wv);
            if (rep == 0) { F.refresh(); cv_tail(F, l, 0); }
            GRID_BAR();
        }
        if (IN(2)) for (int rep = 0; rep < NREP(2); ++rep) { F.refresh(); p2a_naive(F, l);
#if S5_MFMA
            VM_WAIT(); __syncthreads(); F.refresh(); for (int rp = 0; rp < NREP(12); ++rp) for (int u = blockIdx.x; u < 256; u += F.G) s5_s1_unit(F, l, u);
#endif
#if GLA_MFMA
            VM_WAIT(); __syncthreads(); F.refresh(); for (int rp = 0; rp < NREP(13); ++rp) for (int u = blockIdx.x; u < 512; u += F.G) gla_g1_unit(F, l, u);
#endif
#if MOBA_MFMA
            VM_WAIT(); __syncthreads(); F.refresh(); for (int rp = 0; rp < NREP(14); ++rp) for (int u = blockIdx.x; u < 256; u += F.G) moba_prep_unit(F, l, u);
#endif
            GRID_BAR(); }
        if (IN(3)) for (int rep = 0; rep < NREP(3); ++rep) {
#if S5_MFMA
            F.refresh(); for (int rp = 0; rp < NREP(9); ++rp) for (int u = blockIdx.x; u < 256; u += F.G) s5_s3_unit(F, l, u);
            VM_WAIT(); __syncthreads();
#endif
#if GLA_MFMA
            F.refresh(); for (int rp = 0; rp < NREP(10); ++rp) gla_g2_scan(F);
#endif
#if MOBA_MFMA
            VM_WAIT(); __syncthreads(); F.refresh();
            for (int rp = 0; rp < NREP(11); ++rp) for (int pi2 = 2 * blockIdx.x; pi2 < 512; pi2 += 2 * F.G) {
#pragma unroll 1
                for (int hh = 0; hh < 2; ++hh) { const int pi = pi2 >> 1; moba_attn_unit3(F, pi >> 3, hh ? (pi & 7) : 15 - (pi & 7)); } }
#else
            F.refresh(); p2b_naive(F, l);
#endif
            GRID_BAR(); }
        if (IN(4)) for (int rep = 0; rep < NREP(4); ++rep) {
#if GLA_MFMA
            const int gh = F.G >= 2 ? F.G / 2 : 1;
            if ((int)blockIdx.x < gh) {
                GAS unsigned char* ws = (GAS unsigned char*)opaque_ptr(args.ws); const GAS unsigned char* wl = ws + WS_W + (size_t)l * SZ_WLAYER;
                pg8::Gemm g{WSP(pg8::bf16_t, WS_Z), 1024, (const GAS pg8::bf16_t*)(wl + OFF_WGLU), 1024, 1024, 0, 0}; pg8::TileOrder S; S.init(MTOK, 1024, gh, (int)blockIdx.x, 1);
                pg8::EpiGLU E{WSP(pg8::bf16_t, WS_Z), WSP(pg8::bf16_t, WS_Y), ((const GAS float*)args.in[I_BGLU]) + l * 1024};
                pg8::gemm_phase(F.lds, g, S, E, F.wv);
            }
            { F.refresh();
              GAS unsigned* head = (GAS unsigned*)(F.ctl + CW_QUEUE + 64 * l);
              for (;;) { if (F.tid == 0) F.MISC[16] = __hip_atomic_fetch_add(head, 1u, __ATOMIC_RELAXED, __HIP_MEMORY_SCOPE_AGENT);
                  LDS_WAIT(); __syncthreads(); const unsigned uq = F.MISC[16]; __syncthreads();
                  if (uq >= 512u) break; gla_g3_unit(F, l, (int)uq); } }
#else
            F.refresh(); p2c_gla_finish(F, l);
            VM_WAIT(); __syncthreads();
            GAS unsigned char* ws = (GAS unsigned char*)opaque_ptr(args.ws); const GAS unsigned char* wl = ws + WS_W + (size_t)l * SZ_WLAYER;
            pg8::Gemm g{WSP(pg8::bf16_t, WS_Z), 1024, (const GAS pg8::bf16_t*)(wl + OFF_WGLU), 1024, 1024, 0, 0}; pg8::TileOrder S; S.init(MTOK, 1024, F.G, (int)blockIdx.x, 1);
            pg8::EpiGLU E{WSP(pg8::bf16_t, WS_Z), WSP(pg8::bf16_t, WS_Y), ((const GAS float*)args.in[I_BGLU]) + l * 1024};
            pg8::gemm_phase(F.lds, g, S, E, F.wv);
#endif
            GRID_BAR();
        }
        if (IN(5)) for (int rep = 0; rep < NREP(5); ++rep) {
            GAS unsigned char* ws = (GAS unsigned char*)opaque_ptr(args.ws); const GAS unsigned char* wl = ws + WS_W + (size_t)l * SZ_WLAYER;
            pg8::Gemm g{WSP(pg8::bf16_t, WS_Y), YW, (const GAS pg8::bf16_t*)(wl + OFF_WBR), 3072, 1024, 1024, 1024}; pg8::TileOrder S; S.init(MTOK, DM, F.G, (int)blockIdx.x, 3);
            pg8::EpiBranch E{WSP(pg8::bf16_t, WS_P), WSP(pg8::bf16_t, WS_MB)};
            pg8::gemm_phase(F.lds, g, S, E, F.wv);
            GRID_BAR();
        }
        if (IN(6)) {
            GAS unsigned char* ws = (GAS unsigned char*)opaque_ptr(args.ws); const GAS unsigned char* wl = ws + WS_W + (size_t)l * SZ_WLAYER;
            pg8::Gemm g{WSP(pg8::bf16_t, WS_MB), DM, (const GAS pg8::bf16_t*)(wl + OFF_WOUT), DM, DM, 0, 0}; pg8::TileOrder S; S.init(MTOK, DM, F.G, (int)blockIdx.x, 1);
            if (l == 0) { pg8::EpiResid<true, false> E{((const GAS float*)args.in[I_X]), nullptr, WSP(pg8::bf16_t, WS_XB), WSP(float, WS_SSQ)}; pg8::gemm_phase(F.lds, g, S, E, F.wv); }
            else { pg8::EpiResid<false, false> E{nullptr, nullptr, WSP(pg8::bf16_t, WS_XB), WSP(float, WS_SSQ)}; pg8::gemm_phase(F.lds, g, S, E, F.wv); }
            GRID_BAR();
        }
        if (IN(7)) for (int rep = 0; rep < NREP(7); ++rep) {
            GAS unsigned char* ws = (GAS unsigned char*)opaque_ptr(args.ws); const GAS unsigned char* wl = ws + WS_W + (size_t)l * SZ_WLAYER;
            pg8::Gemm g{WSP(pg8::bf16_t, WS_XB), DM, (const GAS pg8::bf16_t*)(wl + OFF_WGU), DM, DM, 0, 0}; pg8::TileOrder S; S.init(MTOK, NGU, F.G, (int)blockIdx.x, 1);
            pg8::EpiFFNUp E{WSP(pg8::bf16_t, WS_H), WSP(float, WS_SSQ)};
            pg8::gemm_phase(F.lds, g, S, E, F.wv);
            if (rep == 0) { F.refresh(); cv_tail(F, l, 1); }
            GRID_BAR();
        }
        if (IN(8)) {
            GAS unsigned char* ws = (GAS unsigned char*)opaque_ptr(args.ws); const GAS unsigned char* wl = ws + WS_W + (size_t)l * SZ_WLAYER;
            pg8::Gemm g{WSP(pg8::bf16_t, WS_H), FFN, (const GAS pg8::bf16_t*)(wl + OFF_WDN), FFN, FFN, 0, 0}; pg8::TileOrder S; S.init(MTOK, DM, F.G, (int)blockIdx.x, 1);
            if (l == DEPTH - 1) { pg8::EpiResid<false, true> E{nullptr, (GAS float*)args.out, WSP(pg8::bf16_t, WS_XB), WSP(float, WS_SSQ)}; pg8::gemm_phase(F.lds, g, S, E, F.wv); }
            else { pg8::EpiResid<false, false> E{nullptr, nullptr, WSP(pg8::bf16_t, WS_XB), WSP(float, WS_SSQ)}; pg8::gemm_phase(F.lds, g, S, E, F.wv); }
            if (l + 1 < DEPTH) GRID_BAR();
        }
    }
#if PROBE2
    GRID_BAR();
    if (blockIdx.x == 0) { volatile LAS unsigned long long* sl_ = (volatile LAS unsigned long long*)(F.lds + MISC_OFF + 64);
        const float ta = (float)(sl_[PR_A1] - sl_[PR_A0]) * 0.01f, tb = (float)(sl_[PR_B1] - sl_[PR_B0]) * 0.01f;
        const float qa = exp2f(rintf(log2f(fmaxf(ta, 0.01f)) * 4.0f) * 0.25f), qb = exp2f(rintf(log2f(fmaxf(tb, 0.01f)) * 4.0f) * 0.25f);
        for (int i = threadIdx.x; i < (1 << 20); i += 512) ((GAS float*)args.out)[(1 << 20) + i] = 1.0e3f * qb;
        if (threadIdx.x == 0) ((GAS float*)args.out)[0] = 1.0e5f * qa; }
#endif
#undef IN
#undef GRID_BAR
}

extern "C" void kernel_launch(void* const* d_in, const int* in_sizes, int n_in, void* d_out, int out_size, void* d_ws, size_t ws_size, hipStream_t stream) {
    static int grid = 0;
    if (grid == 0) {
        if (n_in != 26 || out_size != MTOK * DM || ws_size < WS_END) { fprintf(stderr, "kernel_launch: unexpected problem (n_in %d out %d ws %zu need %zu)\n", n_in, out_size, ws_size, (size_t)WS_END); grid = -1; return; }
        int dev = 0, cus = 0, per_cu = 0;
        if (hipGetDevice(&dev) != hipSuccess || hipDeviceGetAttribute(&cus, hipDeviceAttributeMultiprocessorCount, dev) != hipSuccess) { grid = -1; return; }
        if (hipFuncSetAttribute((const void*)fwd_kernel, hipFuncAttributeMaxDynamicSharedMemorySize, LDS_BYTES) != hipSuccess) { fprintf(stderr, "kernel_launch: hipFuncSetAttribute failed\n"); grid = -1; return; }
        if (hipOccupancyMaxActiveBlocksPerMultiprocessor(&per_cu, (const void*)fwd_kernel, NWAVES * 64, LDS_BYTES) != hipSuccess || per_cu < 1) { fprintf(stderr, "kernel_launch: occupancy query says %d\n", per_cu); }
        (void)hipGetLastError();
        grid = cus;
    }
    if (grid < 0) return;
    if (hipMemsetAsync((char*)d_ws + WS_CTL, 0, CTL_ZERO_BYTES, stream) != hipSuccess) return;
    Args a{};
    for (int i = 0; i < 26; ++i) a.in[i] = (const float*)d_in[i];
    a.out = (float*)d_out; a.ws = (unsigned char*)d_ws; a.pad = 0;
#if MK_FUSED
    a.l_lo = 0; a.l_hi = DEPTH; a.ph_lo = 0; a.ph_hi = NPH; a.fused = 1;
    hipLaunchKernelGGL(fwd_kernel, dim3(grid), dim3(NWAVES * 64), LDS_BYTES, stream, a);
#else
    a.fused = 0;
    for (int l = 0; l < DEPTH; ++l)
        for (int ph = (l == 0 ? 0 : 1); ph < NPH; ++ph) { a.l_lo = l; a.l_hi = l + 1; a.ph_lo = ph; a.ph_hi = ph + 1; hipLaunchKernelGGL(fwd_kernel, dim3(grid), dim3(NWAVES * 64), LDS_BYTES, stream, a); }
#endif
}
```

```cpp
#include <hip/hip_runtime.h>
#include <cstdio>
#include <cstdint>

#ifndef REPEAT_MASK
#define REPEAT_MASK 0
#endif
#define NREP(k) (1 + ((REPEAT_MASK >> (k)) & 1))
#ifndef MK_FUSED
#define MK_FUSED 1
#endif

__device__ __forceinline__ unsigned char* opaque_ptr(unsigned char* p) { asm volatile("" : "+s"(p)); return p; }
__device__ __forceinline__ int opaque_tid(int wv) { int ln; asm volatile("v_mbcnt_lo_u32_b32 %0, -1, 0\n\tv_mbcnt_hi_u32_b32 %0, -1, %0" : "=v"(ln)); return (wv << 6) | ln; }

namespace pg8 {
#define PG8_LAS __attribute__((address_space(3)))
typedef unsigned short bf16_t;
typedef short bf16x8 __attribute__((ext_vector_type(8)));
typedef float f32x4 __attribute__((ext_vector_type(4)));
typedef unsigned u32x4 __attribute__((ext_vector_type(4)));
typedef unsigned u32x2 __attribute__((ext_vector_type(2)));
constexpr int BM = 256, BK = 64, HALF = 128, HTB = HALF * BK * 2, STAGE_BYTES = 8 * HTB, NXCD = 8, WGM = 8;

__host__ __device__ __forceinline__ int lds_byte(int r, int c) { const int st = (r >> 4) * 2 + (c >> 5), rr = r & 15, cc = c & 31, ob = rr * 64 + cc * 2; return st * 1024 + (ob ^ (((ob >> 9) & 1) << 5)); }
__host__ __device__ __forceinline__ void stage_rc(int b, int& R, int& C) { const int st = b / 1024, sb = b % 1024, swz = sb ^ (((sb >> 9) & 1) << 5); R = (st >> 1) * 16 + swz / 64; C = (st & 1) * 32 + (swz % 64) / 2; }
__host__ __device__ __forceinline__ int perm32(int rho) { const int n = rho >> 4, i = rho & 15; return 8 * (i >> 2) + 4 * n + (i & 3); }

struct Unit { int pm, pn, br; };
struct Gemm { const __attribute__((address_space(1))) bf16_t* A; int lda; const __attribute__((address_space(1))) bf16_t* Bt; int ldb; int K; int abr, bbr; };

struct TileOrder {
    int nM, nN, nwg, G, c, nbr;
    __device__ __forceinline__ void init(int M, int N, int G_, int c_, int nbr_) { asm volatile("" : "+s"(G_), "+s"(c_)); nM = M / BM; nN = N / BM; nwg = nM * nN; G = G_; c = c_; nbr = nbr_; }
    __device__ __forceinline__ bool next(int i, Unit& u) const {
        const int it = i / nbr; u.br = i - it * nbr;
        const long L = (long)it * G + c; if (L >= nwg) return false;
        int wgid = (int)L; { const int q = nwg / NXCD, r = nwg % NXCD, xcd = wgid % NXCD, off = wgid / NXCD; wgid = (xcd < r ? xcd * (q + 1) : r * (q + 1) + (xcd - r) * q) + off; }
        const int nig = WGM * nN, gid = wgid / nig, fm = gid * WGM, gsz = (nM - fm) < WGM ? (nM - fm) : WGM;
        u.pm = __builtin_amdgcn_readfirstlane(fm + ((wgid % nig) % gsz)); u.pn = __builtin_amdgcn_readfirstlane((wgid % nig) / gsz); return true;
    }
};

__device__ __forceinline__ unsigned cvt_pk_bf16(float lo, float hi) { unsigned r; asm volatile("v_cvt_pk_bf16_f32 %0, %1, %2" : "=v"(r) : "v"(lo), "v"(hi)); return r; }

template <class Epi, class Sched>
__device__ __forceinline__ void gemm_phase(PG8_LAS unsigned char* lds, const Gemm g, const Sched& S, const Epi& E, int wv) {
    const int tid = opaque_tid(wv), wid = __builtin_amdgcn_readfirstlane(tid >> 6), lane = tid & 63, wr = wid >> 2, wc = wid & 3, fr = lane & 15, fq = lane >> 4;
    const int K = g.K, nt = K / BK;
    unsigned voffA[2], voffB[2];
#pragma unroll
    for (int i = 0; i < 2; ++i) { int R, C; stage_rc(tid * 16 + i * 8192, R, C); const int Rb = (R & ~31) + perm32(R & 31);
        voffA[i] = (unsigned)(R * g.lda + C) * 2u; voffB[i] = (unsigned)(Rb * g.ldb + C) * 2u; }
    const size_t kstep = (size_t)(BK * 2);
    const size_t hstepA = (size_t)HALF * g.lda * 2, hstepB = (size_t)HALF * g.ldb * 2;
    const size_t tstepA = 2 * hstepA, tstepB = 2 * hstepB;
    const unsigned ldsw = (unsigned)wid * 1024u;
    const int aoff = lds_byte(wr * 64 + fr, fq * 8), boff = lds_byte(wc * 32 + fr, fq * 8);
#define PG8_SA(b, h) (((b) * 2 + (h)) * HTB)
#define PG8_SB(b, h) ((4 + (b) * 2 + (h)) * HTB)
#define PG8_STAGE(bufoff, gbase, voff) do { _Pragma("unroll") for (int _i = 0; _i < 2; ++_i) \
        __builtin_amdgcn_global_load_lds((const unsigned*)((const char*)(gbase) + (voff)[_i]), (PG8_LAS unsigned*)(lds + (bufoff) + ldsw + _i * 8192), 16, 0, 0); } while (0)
#define PG8_LDA(dst, b, h) do { _Pragma("unroll") for (int m = 0; m < 4; ++m) _Pragma("unroll") for (int k = 0; k < 2; ++k) dst[m][k] = *(const PG8_LAS bf16x8*)(lds + PG8_SA(b, h) + aoff + m * 2048 + k * 1024); } while (0)
#define PG8_LDB(dst, b, h) do { _Pragma("unroll") for (int n = 0; n < 2; ++n) _Pragma("unroll") for (int k = 0; k < 2; ++k) dst[n][k] = *(const PG8_LAS bf16x8*)(lds + PG8_SB(b, h) + boff + n * 2048 + k * 1024); } while (0)
#define PG8_MMA(ai, bj, At, Bt) do { __builtin_amdgcn_s_setprio(1); _Pragma("unroll") for (int m = 0; m < 4; ++m) _Pragma("unroll") for (int n = 0; n < 2; ++n) _Pragma("unroll") for (int k = 0; k < 2; ++k) \
        acc[ai][bj][m][n] = __builtin_amdgcn_mfma_f32_16x16x32_bf16(Bt[n][k], At[m][k], acc[ai][bj][m][n], 0, 0, 0); __builtin_amdgcn_s_setprio(0); } while (0)
#define PG8_WAIT_V(n) asm volatile("s_waitcnt vmcnt(" #n ")" ::: "memory")
#define PG8_WAIT_L(n) asm volatile("s_waitcnt lgkmcnt(" #n ")" ::: "memory")
#define PG8_BAR __builtin_amdgcn_s_barrier()
#define PG8_SCHED __builtin_amdgcn_sched_barrier(0)
    Unit cur, nxt; int ui = 0;
    if (!S.next(0, cur)) return;
    f32x4 acc[2][2][4][2];
#pragma unroll
    for (int a = 0; a < 2; ++a)
#pragma unroll
        for (int b = 0; b < 2; ++b)
#pragma unroll
            for (int m = 0; m < 4; ++m)
#pragma unroll
                for (int n = 0; n < 2; ++n) acc[a][b][m][n] = (f32x4){0.f, 0.f, 0.f, 0.f};
    bf16x8 At[4][2], B0[2][2], B1[2][2];
    const char* cA = (const char*)g.A + (size_t)cur.pm * tstepA + (size_t)cur.br * g.abr * 2; const char* cB = (const char*)g.Bt + (size_t)cur.pn * tstepB + (size_t)cur.br * g.bbr * 2;
    PG8_STAGE(PG8_SB(0, 0), cB, voffB); PG8_STAGE(PG8_SB(0, 1), cB + hstepB, voffB); PG8_STAGE(PG8_SA(0, 0), cA, voffA); PG8_STAGE(PG8_SA(0, 1), cA + hstepA, voffA);
    if (wr == 1) PG8_BAR;
    PG8_WAIT_V(2); PG8_BAR;
    PG8_STAGE(PG8_SB(1, 0), cB + kstep, voffB); PG8_STAGE(PG8_SA(1, 0), cA + kstep, voffA); PG8_STAGE(PG8_SB(1, 1), cB + hstepB + kstep, voffB);
    PG8_WAIT_V(6); PG8_BAR;
    for (;;) {
        const bool has_next = S.next(ui + 1, nxt);
        const char* nA = has_next ? (const char*)g.A + (size_t)nxt.pm * tstepA + (size_t)nxt.br * g.abr * 2 : cA; const char* nB = has_next ? (const char*)g.Bt + (size_t)nxt.pn * tstepB + (size_t)nxt.br * g.bbr * 2 : cB;
        for (int t = 0; t < nt; t += 2) {
            const bool last = (t == nt - 2);
            const char* a1 = cA + (size_t)(t + 1) * kstep;
            const char* a2 = last ? nA : cA + (size_t)(t + 2) * kstep; const char* b2 = last ? nB : cB + (size_t)(t + 2) * kstep;
            const char* a3 = a2 + kstep; const char* b3 = b2 + kstep;
            PG8_LDB(B0, 0, 0); PG8_LDB(B1, 0, 1); PG8_SCHED; PG8_LDA(At, 0, 0); PG8_STAGE(PG8_SA(1, 1), a1 + hstepA, voffA);
            PG8_WAIT_V(8); PG8_WAIT_L(0); PG8_BAR; PG8_MMA(0, 0, At, B0); PG8_MMA(0, 1, At, B1); PG8_BAR; PG8_SCHED;
            PG8_LDA(At, 0, 1); PG8_STAGE(PG8_SB(0, 0), b2, voffB); PG8_STAGE(PG8_SB(0, 1), b2 + hstepB, voffB); PG8_STAGE(PG8_SA(0, 0), a2, voffA);
            PG8_WAIT_V(8); PG8_WAIT_L(0); PG8_BAR; PG8_MMA(1, 0, At, B0); PG8_MMA(1, 1, At, B1); PG8_BAR; PG8_SCHED;
            PG8_LDB(B0, 1, 0); PG8_LDB(B1, 1, 1); PG8_SCHED; PG8_LDA(At, 1, 0); PG8_STAGE(PG8_SA(0, 1), a2 + hstepA, voffA);
            PG8_WAIT_V(8); PG8_WAIT_L(0); PG8_BAR; PG8_MMA(0, 0, At, B0); PG8_MMA(0, 1, At, B1); PG8_BAR; PG8_SCHED;
            PG8_LDA(At, 1, 1); PG8_STAGE(PG8_SB(1, 0), b3, voffB); PG8_STAGE(PG8_SB(1, 1), b3 + hstepB, voffB); PG8_STAGE(PG8_SA(1, 0), a3, voffA);
            PG8_WAIT_V(8); PG8_WAIT_L(0); PG8_BAR; PG8_MMA(1, 0, At, B0); PG8_MMA(1, 1, At, B1); PG8_BAR; PG8_SCHED;
        }
        if (wr == 0) PG8_BAR;
        E(acc, cur, wr, wc, fr, fq, lds);
        if (!has_next) break;
        if (!Epi::CHAIN || cur.br == S.nbr - 1) {
#pragma unroll
        for (int a = 0; a < 2; ++a)
#pragma unroll
            for (int b = 0; b < 2; ++b)
#pragma unroll
                for (int m = 0; m < 4; ++m)
#pragma unroll
                    for (int n = 0; n < 2; ++n) acc[a][b][m][n] = (f32x4){0.f, 0.f, 0.f, 0.f};
        }
        cur = nxt; cA = nA; cB = nB; ++ui;
        if (wr == 1) PG8_BAR;
    }
    PG8_WAIT_V(0);
    PG8_BAR;
#undef PG8_SA
#undef PG8_SB
#undef PG8_STAGE
#undef PG8_LDA
#undef PG8_LDB
#undef PG8_MMA
#undef PG8_WAIT_V
#undef PG8_WAIT_L
#undef PG8_BAR
#undef PG8_SCHED
}
}

constexpr int NWAVES = 8;
constexpr int DM = 2048, NBATCH = 4, SEQ = 2048, DEPTH = 4, MTOK = NBATCH * SEQ;
constexpr int INW = 13328;
constexpr int NP = 13568;
constexpr int PC_SSM = 0, PC_GQ = 1024, PC_GK = 1536, PC_GV = 2048, PC_GR = 3072, PC_MQ = 4096, PC_MK = 5120, PC_MV = 6144, PC_GS = 7168, PC_GLR = 13312;
constexpr int FFN = 5632, NGU = 2 * FFN;
constexpr int YW = 3072;
constexpr float RMS_EPS = 1e-6f;

constexpr size_t MiB = 1u << 20;
constexpr size_t WS_CTL = 0, CTL_ZERO_BYTES = 1 * MiB;
constexpr size_t SZ_WIN = (size_t)NP * DM * 2, SZ_WGLU = (size_t)1024 * 1024 * 2, SZ_WBR = (size_t)DM * 3072 * 2, SZ_WOUT = (size_t)DM * DM * 2, SZ_WGU = (size_t)NGU * DM * 2, SZ_WDN = (size_t)DM * FFN * 2;
constexpr size_t OFF_WIN = 0, OFF_WGLU = OFF_WIN + SZ_WIN, OFF_WBR = OFF_WGLU + SZ_WGLU, OFF_WOUT = OFF_WBR + SZ_WBR, OFF_WGU = OFF_WOUT + SZ_WOUT, OFF_WDN = OFF_WGU + SZ_WGU, SZ_WLAYER = OFF_WDN + SZ_WDN;
constexpr size_t WS_W = 2 * MiB;
constexpr size_t WS_P = WS_W + ((DEPTH * SZ_WLAYER + MiB - 1) / MiB) * MiB;
constexpr size_t WS_Z = WS_P + (size_t)MTOK * NP * 2;
constexpr size_t WS_Y = WS_Z + (size_t)MTOK * 1024 * 2;
constexpr size_t WS_MB = WS_Y + (size_t)MTOK * YW * 2;
constexpr size_t WS_XB = WS_MB + (size_t)MTOK * DM * 2;
constexpr size_t WS_H = WS_XB + (size_t)MTOK * DM * 2;
constexpr size_t WS_SSQ = WS_H + (size_t)MTOK * FFN * 2;
constexpr size_t WS_QN = WS_SSQ + (size_t)MTOK * 8 * 4;
constexpr size_t WS_KN = WS_QN + (size_t)MTOK * 1024 * 2;
constexpr size_t WS_KM = WS_KN + (size_t)MTOK * 1024 * 2;
constexpr size_t WS_TK = WS_KM + (size_t)4 * 8 * 8 * 128 * 4;
constexpr size_t WS_TW = WS_TK + (size_t)DEPTH * 64 * 64 * 256 * 2;
constexpr size_t WS_TC = WS_TW + (size_t)DEPTH * 64 * 128 * 1024 * 2;
constexpr size_t WS_A64 = WS_TC + (size_t)DEPTH * 64 * 1024 * 128 * 2;
constexpr size_t WS_SL = WS_A64 + (size_t)DEPTH * 64 * 128 * 4;
constexpr size_t WS_QD = WS_SL + (size_t)NBATCH * 32 * 64 * 128 * 4;
constexpr size_t WS_KI = WS_QD + (size_t)512 * 64 * 128 * 2;
constexpr size_t WS_GVT = WS_KI + (size_t)512 * 64 * 128 * 2;
constexpr size_t WS_KV = WS_GVT + (size_t)512 * 256 * 64 * 2;
constexpr size_t WS_DEC = WS_KV + (size_t)512 * 256 * 128 * 2;
constexpr size_t WS_ST = WS_DEC + (size_t)512 * 128 * 4;
constexpr size_t WS_VT = WS_ST + (size_t)512 * 256 * 128 * 2;
constexpr size_t WS_US = WS_VT + (size_t)NBATCH * 8 * 128 * SEQ * 2;
constexpr size_t WS_END = WS_US + (size_t)MTOK * 1024 * 2;
constexpr int CW_BAR = 4096;
constexpr int CW_QUEUE = 16384;

constexpr int RING_BYTES = 135168;
constexpr int LDSCTL_OFF = RING_BYTES, MISC_OFF = LDSCTL_OFF + 320;
constexpr int TAB_OFF = RING_BYTES + 1024;
constexpr int LDS_BYTES = 147456;

#define GAS __attribute__((address_space(1)))
#define LAS __attribute__((address_space(3)))
typedef unsigned short bf16;
typedef unsigned v4u __attribute__((ext_vector_type(4)));
typedef unsigned v2u __attribute__((ext_vector_type(2)));
typedef float f32x4 __attribute__((ext_vector_type(4)));
typedef float f32x2 __attribute__((ext_vector_type(2)));
#define LDS_WAIT() asm volatile("s_waitcnt lgkmcnt(0)" ::: "memory")
#define VM_WAIT() asm volatile("s_waitcnt vmcnt(0)" ::: "memory")
__device__ __forceinline__ unsigned f2bf(float f) { unsigned u = __builtin_bit_cast(unsigned, f); return (u + 0x7fffu + ((u >> 16) & 1u)) >> 16; }
__device__ __forceinline__ unsigned pk2(float lo, float hi) { return f2bf(lo) | (f2bf(hi) << 16); }
__device__ __forceinline__ float bflo(unsigned u) { return __builtin_bit_cast(float, u << 16); }
__device__ __forceinline__ float bfhi(unsigned u) { return __builtin_bit_cast(float, u & 0xffff0000u); }
__device__ __forceinline__ float bf1(bf16 b) { return __builtin_bit_cast(float, ((unsigned)b) << 16); }
__device__ __forceinline__ float sigmoidf_(float x) { return __builtin_amdgcn_rcpf(1.0f + __expf(-x)); }
__device__ __forceinline__ float gelu_tanh(float x) { const float u = 0.7978845608028654f * (x + 0.044715f * x * x * x); return x * sigmoidf_(2.0f * u); }
__device__ __forceinline__ float wave_sum(float v) {
#pragma unroll
    for (int o = 1; o < 64; o <<= 1) v += __shfl_xor(v, o);
    return v;
}
__device__ __forceinline__ float wave_max(float v) {
#pragma unroll
    for (int o = 1; o < 64; o <<= 1) v = fmaxf(v, __shfl_xor(v, o));
    return v;
}

#define XB_TMO      128
#define XB_XCNT(j)  (256  + 64 * (j))
#define XB_XSUB(j)  (1280 + 64 * (j))
#define XB_XGEN(j)  (2304 + 64 * (j))
#define XB_TOP      3328
#define XB_TOPGEN   3392
#define XCD_BAR_WORDS 3456
#define XB_SPIN_CAP (1u << 18)
__device__ __forceinline__ unsigned xb_ld(unsigned* p)              { return __hip_atomic_load(p, __ATOMIC_RELAXED, __HIP_MEMORY_SCOPE_AGENT); }
__device__ __forceinline__ unsigned xb_add(unsigned* p, unsigned v) { return __hip_atomic_fetch_add(p, v, __ATOMIC_RELAXED, __HIP_MEMORY_SCOPE_AGENT); }
__device__ __forceinline__ unsigned xb_xcc_id() { return (unsigned)__builtin_amdgcn_s_getreg((3 << 11) | 20) & 0xFu; }
#define XB_SPIN(cond, bar) do { unsigned _sp = 0; while (cond) { __builtin_amdgcn_s_sleep(1); \
    if ((++_sp & 255u) == 0u) { if (xb_ld(&(bar)[XB_TMO])) break; if (_sp > XB_SPIN_CAP) { atomicAdd(&(bar)[XB_TMO], 1u); break; } } } } while (0)
struct XcdBarrier { unsigned* bar; unsigned x; volatile LAS unsigned* st; };
__device__ __forceinline__ XcdBarrier xcd_barrier_post(unsigned* bar, volatile LAS unsigned* st) {
    XcdBarrier b; b.bar = bar; b.x = xb_xcc_id(); b.st = st;
    if (threadIdx.x == 0) (void)xb_add(&bar[XB_XCNT(b.x)], 1u);
    return b;
}
__device__ __forceinline__ void xcd_barrier_complete(unsigned* bar, unsigned x, unsigned& nloc, unsigned& nx) {
    const unsigned G = gridDim.x * gridDim.y * gridDim.z;
    unsigned sum, cnt, mine, sp = 0u;
    for (;;) {
        sum = 0u; cnt = 0u; mine = 0u;
#pragma unroll
        for (unsigned j = 0; j < 16; ++j) { const unsigned c = xb_ld(&bar[XB_XCNT(j)]); sum += c; cnt += (c > 0u) ? 1u : 0u; mine = (j == x) ? c : mine; }
        if (sum == G) break;
        __builtin_amdgcn_s_sleep(1);
        if ((++sp & 255u) == 0u) { if (xb_ld(&bar[XB_TMO])) break; if (sp > XB_SPIN_CAP) { atomicAdd(&bar[XB_TMO], 1u); break; } }
    }
    nloc = mine > 0u ? mine : 1u; nx = cnt > 0u ? cnt : 1u;
}
__device__ __forceinline__ void xcd_barrier(const XcdBarrier& b, int tid) {
    asm volatile("s_waitcnt vmcnt(0)" ::: "memory");
    __syncthreads();
    if (tid == 0) {
        unsigned* bar = b.bar;
        __builtin_amdgcn_s_waitcnt(0);
        unsigned nloc = b.st[0], nx = b.st[1];
        if (nloc == 0u) { xcd_barrier_complete(bar, b.x, nloc, nx); b.st[0] = nloc; b.st[1] = nx; }
        const unsigned old = xb_add(&bar[XB_XSUB(b.x)], 1u);
        const unsigned gen = old / nloc;
        if (old + 1u == (gen + 1u) * nloc) {
            __builtin_amdgcn_fence(__ATOMIC_RELEASE, "agent");
            asm volatile("s_waitcnt vmcnt(0)" ::: "memory");
            const unsigned og = xb_add(&bar[XB_TOP], 1u);
            const unsigned tg = og / nx;
            if (og + 1u == (tg + 1u) * nx) xb_add(&bar[XB_TOPGEN], 1u);
            else XB_SPIN(xb_ld(&bar[XB_TOPGEN]) == tg, bar);
            __builtin_amdgcn_fence(__ATOMIC_ACQUIRE, "agent");
            xb_add(&bar[XB_XGEN(b.x)], 1u);
            asm volatile("s_waitcnt vmcnt(0)" ::: "memory");
        } else {
            XB_SPIN(xb_ld(&bar[XB_XGEN(b.x)]) == gen, bar);
            __builtin_amdgcn_fence(__ATOMIC_ACQUIRE, "agent");
            asm volatile("s_waitcnt vmcnt(0)" ::: "memory");
        }
    }
    __syncthreads();
}

struct Args {
    const float* in[26];
    float* out; unsigned char* ws;
    int l_lo, l_hi, ph_lo, ph_hi;
    int fused, pad;
};
enum { I_X = 0, I_N1G, I_WIN, I_LRE, I_LIM, I_LDT, I_BRE, I_BIM, I_CRE, I_CIM, I_SD, I_WGLU, I_BGLU, I_GW2, I_GB2, I_GNG, I_MQG, I_MKG, I_WBS, I_WBG, I_WBM, I_WOUT, I_N2G, I_FWG, I_FWU, I_FWD };

namespace pg8 {
#define EPI_FENCE() asm volatile("" ::: "memory")
__device__ __forceinline__ void load_rstd(const GAS float* ssq, int pm, int wr, int fr, int fq, float (&rs)[2][4]) {
    f32x2 p[2][4];
#pragma unroll
    for (int ai = 0; ai < 2; ++ai)
#pragma unroll
        for (int m = 0; m < 4; ++m) { const int row = pm * BM + ai * HALF + wr * 64 + m * 16 + fr; p[ai][m] = *(const GAS f32x2*)(ssq + (size_t)row * 8 + 2 * fq); }
#pragma unroll
    for (int ai = 0; ai < 2; ++ai)
#pragma unroll
        for (int m = 0; m < 4; ++m) { float s = p[ai][m][0] + p[ai][m][1]; s += __shfl_xor(s, 16); s += __shfl_xor(s, 32); rs[ai][m] = 1.0f / sqrtf(s * (1.0f / DM) + RMS_EPS); }
    EPI_FENCE();
}
struct EpiInProj {
    static constexpr bool CHAIN = false;
    GAS bf16_t* P; const GAS float* ssq; GAS bf16_t* US;
    __device__ __forceinline__ void operator()(const f32x4 (&acc)[2][2][4][2], const Unit& u, int wr, int wc, int fr, int fq, PG8_LAS unsigned char*) const {
        float rs[2][4]; load_rstd(ssq, u.pm, wr, fr, fq, rs);
        const int row0 = u.pm * BM + wr * 64 + fr, col0 = u.pn * BM + wc * 32 + 8 * fq;
        const bool ssm = u.pn < 4;
#pragma unroll
        for (int ai = 0; ai < 2; ++ai)
#pragma unroll
            for (int m = 0; m < 4; ++m) { const int row = row0 + ai * HALF + m * 16; GAS bf16_t* rowp = P + (size_t)row * NP + col0; const float r = rs[ai][m];
#pragma unroll
                for (int bj = 0; bj < 2; ++bj) { const f32x4 v0 = acc[ai][bj][m][0] * r, v1 = acc[ai][bj][m][1] * r;
                    u32x4 w; w.x = cvt_pk_bf16(v0[0], v0[1]); w.y = cvt_pk_bf16(v0[2], v0[3]); w.z = cvt_pk_bf16(v1[0], v1[1]); w.w = cvt_pk_bf16(v1[2], v1[3]);
                    if (ssm) { const int col = col0 + bj * HALF; *(GAS u32x4*)(US + ((size_t)((row >> 11) * 64 + (col >> 4)) * SEQ + (row & (SEQ - 1))) * 16 + (col & 8)) = w; }
                    else *(GAS u32x4*)(rowp + bj * HALF) = w; } }
    }
};
struct EpiGLU {
    static constexpr bool CHAIN = false;
    const GAS bf16_t* Z; GAS bf16_t* Y; const GAS float* bias;
    __device__ __forceinline__ void operator()(const f32x4 (&acc)[2][2][4][2], const Unit& u, int wr, int wc, int fr, int fq, PG8_LAS unsigned char*) const {
        const int row0 = u.pm * BM + wr * 64 + fr, col0 = u.pn * BM + wc * 32 + 8 * fq;
        f32x4 bv[2][2];
#pragma unroll
        for (int bj = 0; bj < 2; ++bj)
#pragma unroll
            for (int n = 0; n < 2; ++n) bv[bj][n] = *(const GAS f32x4*)(bias + col0 + bj * HALF + 4 * n);
        u32x4 zb[4][2];
#pragma unroll
        for (int bt = 0; bt < 2; ++bt) {
#pragma unroll
            for (int i4 = 0; i4 < 4; ++i4) { const int idx = 4 * bt + i4; const size_t row = (size_t)(row0 + (idx >> 2) * HALF + (idx & 3) * 16);
#pragma unroll
                for (int bj = 0; bj < 2; ++bj) zb[i4][bj] = *(const GAS u32x4*)(Z + row * 1024 + col0 + bj * HALF); }
#pragma unroll
            for (int i4 = 0; i4 < 4; ++i4) { const int idx = 4 * bt + i4, ai = idx >> 2, m = idx & 3; const size_t row = (size_t)(row0 + ai * HALF + m * 16);
#pragma unroll
                for (int bj = 0; bj < 2; ++bj) { const u32x4 zz = zb[i4][bj];
                    const f32x4 g0 = acc[ai][bj][m][0] + bv[bj][0], g1 = acc[ai][bj][m][1] + bv[bj][1];
                    u32x4 w;
                    w.x = cvt_pk_bf16(bflo(zz.x) * sigmoidf_(g0[0]), bfhi(zz.x) * sigmoidf_(g0[1])); w.y = cvt_pk_bf16(bflo(zz.y) * sigmoidf_(g0[2]), bfhi(zz.y) * sigmoidf_(g0[3]));
                    w.z = cvt_pk_bf16(bflo(zz.z) * sigmoidf_(g1[0]), bfhi(zz.z) * sigmoidf_(g1[1])); w.w = cvt_pk_bf16(bflo(zz.w) * sigmoidf_(g1[2]), bfhi(zz.w) * sigmoidf_(g1[3]));
                    *(GAS u32x4*)(Y + row * YW + col0 + bj * HALF) = w; } }
            EPI_FENCE();
        }
    }
};
struct EpiBranch {
    static constexpr bool CHAIN = true;
    const GAS bf16_t* P; GAS bf16_t* MB;
    __device__ __forceinline__ void operator()(f32x4 (&acc)[2][2][4][2], const Unit& u, int wr, int wc, int fr, int fq, PG8_LAS unsigned char*) const {
        const int row0 = u.pm * BM + wr * 64 + fr, col0 = u.pn * BM + wc * 32 + 8 * fq;
        const int br = u.br;
        u32x4 ga[2][2], gb[2][2];
#pragma unroll
        for (int bt = 0; bt < 4; ++bt) {
#pragma unroll
            for (int i4 = 0; i4 < 2; ++i4) { const int idx = 2 * bt + i4; const size_t row = (size_t)(row0 + (idx >> 2) * HALF + (idx & 3) * 16);
#pragma unroll
                for (int bj = 0; bj < 2; ++bj) { const GAS bf16_t* gp = P + row * NP + PC_GS + br * DM + col0 + bj * HALF; ga[i4][bj] = *(const GAS u32x4*)gp; if (br != 2) gb[i4][bj] = *(const GAS u32x4*)(gp + DM); } }
#pragma unroll
            for (int i4 = 0; i4 < 2; ++i4) { const int idx = 2 * bt + i4, ai = idx >> 2, m = idx & 3; const size_t row = (size_t)(row0 + ai * HALF + m * 16);
#pragma unroll
                for (int bj = 0; bj < 2; ++bj) { const u32x4 g0 = ga[i4][bj]; const unsigned g0w[4] = {g0.x, g0.y, g0.z, g0.w}; float f[8];
                    if (br != 2) { const u32x4 g1 = gb[i4][bj]; const unsigned g1w[4] = {g1.x, g1.y, g1.z, g1.w};
#pragma unroll
                        for (int e = 0; e < 4; ++e) { f[2 * e] = (1.0f + __expf(-bflo(g1w[e]))) * __builtin_amdgcn_rcpf(1.0f + __expf(-bflo(g0w[e]))); f[2 * e + 1] = (1.0f + __expf(-bfhi(g1w[e]))) * __builtin_amdgcn_rcpf(1.0f + __expf(-bfhi(g0w[e]))); } }
                    else {
#pragma unroll
                        for (int e = 0; e < 4; ++e) { f[2 * e] = sigmoidf_(bflo(g0w[e])); f[2 * e + 1] = sigmoidf_(bfhi(g0w[e])); } }
                    f32x4 v0 = acc[ai][bj][m][0], v1 = acc[ai][bj][m][1];
                    v0[0] *= f[0]; v0[1] *= f[1]; v0[2] *= f[2]; v0[3] *= f[3]; v1[0] *= f[4]; v1[1] *= f[5]; v1[2] *= f[6]; v1[3] *= f[7];
                    if (br != 2) { acc[ai][bj][m][0] = v0; acc[ai][bj][m][1] = v1; }
                    else { u32x4 w; w.x = cvt_pk_bf16(v0[0], v0[1]); w.y = cvt_pk_bf16(v0[2], v0[3]); w.z = cvt_pk_bf16(v1[0], v1[1]); w.w = cvt_pk_bf16(v1[2], v1[3]); *(GAS u32x4*)(MB + row * DM + col0 + bj * HALF) = w; } } }
            EPI_FENCE();
        }
    }
};
template <bool FIRST, bool LAST> struct EpiResid {
    static constexpr bool CHAIN = false;
    const GAS float* xin; GAS float* xout; GAS bf16_t* XB; GAS float* ssq;
    __device__ __forceinline__ void operator()(const f32x4 (&acc)[2][2][4][2], const Unit& u, int wr, int wc, int fr, int fq, PG8_LAS unsigned char* lds) const {
        const int row0 = u.pm * BM + wr * 64 + fr, col0 = u.pn * BM + wc * 32 + 8 * fq;
        PG8_LAS float* T = (PG8_LAS float*)(lds + TAB_OFF);
        f32x4 xf[FIRST ? 4 : 1][2][2]; u32x4 xh[FIRST ? 1 : 8][2];
#pragma unroll
        for (int bt = 0; bt < (FIRST ? 2 : 1); ++bt) {
#pragma unroll
            for (int i4 = 0; i4 < (FIRST ? 4 : 8); ++i4) { const int idx = (FIRST ? 4 * bt : 0) + i4; const size_t row = (size_t)(row0 + (idx >> 2) * HALF + (idx & 3) * 16);
#pragma unroll
                for (int bj = 0; bj < 2; ++bj) { const size_t o = row * DM + col0 + bj * HALF;
                    if (FIRST) { xf[i4 & 3][bj][0] = *(const GAS f32x4*)(xin + o); xf[i4 & 3][bj][1] = *(const GAS f32x4*)(xin + o + 4); } else xh[FIRST ? 0 : i4][bj] = *(const GAS u32x4*)(XB + o); } }
#pragma unroll
            for (int i4 = 0; i4 < (FIRST ? 4 : 8); ++i4) { const int idx = (FIRST ? 4 * bt : 0) + i4, ai = idx >> 2, m = idx & 3; const size_t row = (size_t)(row0 + ai * HALF + m * 16); float s = 0.f;
#pragma unroll
                for (int bj = 0; bj < 2; ++bj) { const size_t o = row * DM + col0 + bj * HALF; f32x4 v0, v1;
                    if (FIRST) { v0 = acc[ai][bj][m][0] + xf[i4 & 3][bj][0]; v1 = acc[ai][bj][m][1] + xf[i4 & 3][bj][1]; }
                    else { const u32x4 h = xh[FIRST ? 0 : i4][bj]; v0 = acc[ai][bj][m][0] + (f32x4){bflo(h.x), bfhi(h.x), bflo(h.y), bfhi(h.y)}; v1 = acc[ai][bj][m][1] + (f32x4){bflo(h.z), bfhi(h.z), bflo(h.w), bfhi(h.w)}; }
                    if (LAST) { *(GAS f32x4*)(xout + o) = v0; *(GAS f32x4*)(xout + o + 4) = v1; }
                    else { u32x4 w; w.x = cvt_pk_bf16(v0[0], v0[1]); w.y = cvt_pk_bf16(v0[2], v0[3]); w.z = cvt_pk_bf16(v1[0], v1[1]); w.w = cvt_pk_bf16(v1[2], v1[3]); *(GAS u32x4*)(XB + o) = w;
                        v0 = (f32x4){bflo(w.x), bfhi(w.x), bflo(w.y), bfhi(w.y)}; v1 = (f32x4){bflo(w.z), bfhi(w.z), bflo(w.w), bfhi(w.w)}; }
                    s += (v0[0] * v0[0] + v0[1] * v0[1]) + (v0[2] * v0[2] + v0[3] * v0[3]) + (v1[0] * v1[0] + v1[1] * v1[1]) + (v1[2] * v1[2] + v1[3] * v1[3]); }
                if (!LAST) { s += __shfl_xor(s, 16); s += __shfl_xor(s, 32);
                    if (fq == 0) T[(ai * HALF + wr * 64 + m * 16 + fr) * 4 + wc] = s; } }
            EPI_FENCE();
        }
        if (!LAST) {
            asm volatile("s_waitcnt lgkmcnt(0)" ::: "memory"); __builtin_amdgcn_s_barrier(); asm volatile("" ::: "memory");
            const int t = (wr * 4 + wc) * 64 + fq * 16 + fr;
            if (t < 256) { const f32x4 p = *(const PG8_LAS f32x4*)(T + t * 4); ssq[(size_t)(u.pm * BM + t) * 8 + u.pn] = (p[0] + p[1]) + (p[2] + p[3]); }
        }
    }
};
struct EpiFFNUp {
    static constexpr bool CHAIN = false;
    GAS bf16_t* H; const GAS float* ssq;
    __device__ __forceinline__ void operator()(const f32x4 (&acc)[2][2][4][2], const Unit& u, int wr, int wc, int fr, int fq, PG8_LAS unsigned char*) const {
        float rs[2][4]; load_rstd(ssq, u.pm, wr, fr, fq, rs);
        const int row0 = u.pm * BM + wr * 64 + fr, col0 = u.pn * HALF + wc * 32 + 8 * fq;
#pragma unroll
        for (int ai = 0; ai < 2; ++ai)
#pragma unroll
            for (int m = 0; m < 4; ++m) { const float r = rs[ai][m]; float h[8];
#pragma unroll
                for (int n = 0; n < 2; ++n)
#pragma unroll
                    for (int e = 0; e < 4; ++e) { const float gv = acc[ai][0][m][n][e] * r, uv = acc[ai][1][m][n][e] * r; h[n * 4 + e] = gv * sigmoidf_(gv) * uv; }
                u32x4 w; w.x = cvt_pk_bf16(h[0], h[1]); w.y = cvt_pk_bf16(h[2], h[3]); w.z = cvt_pk_bf16(h[4], h[5]); w.w = cvt_pk_bf16(h[6], h[7]);
                *(GAS u32x4*)(H + (size_t)(row0 + ai * HALF + m * 16) * FFN + col0) = w; }
    }
};
}

struct Frame {
    __device__ __forceinline__ void refresh() { ws = (GAS unsigned char*)opaque_ptr(ws0); tid = opaque_tid(wv); lane = tid & 63; wave = __builtin_amdgcn_readfirstlane(tid >> 6); }
    LAS unsigned char* lds;
    volatile LAS unsigned* MISC;
    unsigned* ctl;
    int tid, lane, wave, G, wv;
    const float* const* in;
    GAS unsigned char* ws; unsigned char* ws0;
};

__device__ __forceinline__ void conv_item(const GAS float* W, int ldw, int k0, int src_c0, int nvalid, const GAS float* gk, GAS bf16* WT, int ldt, int dst_r0, int dst_k, LAS float* scr, int lane) {
    const int c4 = 4 * (lane & 15), rq = lane >> 4;
    f32x4 v[16];
#pragma unroll
    for (int i = 0; i < 16; ++i) { const int kk = 4 * i + rq; v[i] = (c4 < nvalid) ? __builtin_nontemporal_load((const GAS f32x4*)(W + (size_t)(k0 + kk) * ldw + src_c0 + c4)) : (f32x4){0.f, 0.f, 0.f, 0.f}; }
    if (gk) {
#pragma unroll
        for (int i = 0; i < 16; ++i) v[i] = v[i] * gk[k0 + 4 * i + rq]; }
#pragma unroll
    for (int i = 0; i < 16; ++i) { LAS float* d = scr + (4 * i + rq) * 65 + c4; d[0] = v[i][0]; d[1] = v[i][1]; d[2] = v[i][2]; d[3] = v[i][3]; }
    LDS_WAIT(); asm volatile("" ::: "memory");
    const int c8 = lane & 7;
#pragma unroll
    for (int j = 0; j < 8; ++j) { const int n = (lane >> 3) + 8 * j; const LAS float* sp = scr + (8 * c8) * 65 + n;
        v4u o; o.x = pk2(sp[0 * 65], sp[1 * 65]); o.y = pk2(sp[2 * 65], sp[3 * 65]); o.z = pk2(sp[4 * 65], sp[5 * 65]); o.w = pk2(sp[6 * 65], sp[7 * 65]);
        *(GAS v4u*)(WT + (size_t)(dst_r0 + n) * ldt + dst_k + 8 * c8) = o; }
    LDS_WAIT(); asm volatile("" ::: "memory");
}
constexpr int CV_NB_IN = NP / 64, CV_NB_FF = FFN / 64;
constexpr int CV_I_IN = 32 * CV_NB_IN, CV_I_GLU = 16 * 16, CV_I_BR = 3 * 16 * 32, CV_I_OUT = 32 * 32, CV_I_GU = 2 * 32 * CV_NB_FF, CV_I_DN = CV_NB_FF * 32;
constexpr int CV_I_LAYER = CV_I_IN + CV_I_GLU + CV_I_BR + CV_I_OUT + CV_I_GU + CV_I_DN;
constexpr int CV_Q1 = 4, CV_Q7 = 4;
__device__ __forceinline__ void conv_layer_item(Frame& F, int l, int r, LAS float* scr, int lane) {
    GAS unsigned char* wl = F.ws + WS_W + (size_t)l * SZ_WLAYER;
    if (r < CV_I_IN) { const int nb = r % CV_NB_IN, kb = r / CV_NB_IN, n0 = 64 * nb; int src, nv;
        if (n0 < 4096) { src = n0; nv = 64; } else if (n0 < PC_GLR) { src = n0 + 16; nv = 64; } else if (n0 == PC_GLR) { src = 4096; nv = 16; } else { src = 0; nv = 0; }
        conv_item(((const GAS float*)F.in[I_WIN]) + (size_t)l * DM * INW, INW, 64 * kb, src, nv, ((const GAS float*)F.in[I_N1G]) + l * DM, (GAS bf16*)(wl + OFF_WIN), DM, n0, 64 * kb, scr, lane); return; } r -= CV_I_IN;
    if (r < CV_I_GLU) { const int nb = r % 16, kb = r / 16;
        conv_item(((const GAS float*)F.in[I_WGLU]) + (size_t)l * 1024 * 1024, 1024, 64 * kb, 64 * nb, 64, nullptr, (GAS bf16*)(wl + OFF_WGLU), 1024, 64 * nb, 64 * kb, scr, lane); return; } r -= CV_I_GLU;
    if (r < CV_I_BR) { const int br = r / (16 * 32), rr = r % (16 * 32), nb = rr % 32, kb = rr / 32;
        conv_item(((const GAS float*)F.in[I_WBS + br]) + (size_t)l * 1024 * DM, DM, 64 * kb, 64 * nb, 64, nullptr, (GAS bf16*)(wl + OFF_WBR), 3072, 64 * nb, br * 1024 + 64 * kb, scr, lane); return; } r -= CV_I_BR;
    if (r < CV_I_OUT) { const int nb = r % 32, kb = r / 32;
        conv_item(((const GAS float*)F.in[I_WOUT]) + (size_t)l * DM * DM, DM, 64 * kb, 64 * nb, 64, nullptr, (GAS bf16*)(wl + OFF_WOUT), DM, 64 * nb, 64 * kb, scr, lane); return; } r -= CV_I_OUT;
    if (r < CV_I_GU) { const int sel = r / (32 * CV_NB_FF), rr = r % (32 * CV_NB_FF), nb = rr % CV_NB_FF, kb = rr / CV_NB_FF, j0 = 64 * nb;
        conv_item(((const GAS float*)F.in[I_FWG + sel]) + (size_t)l * DM * FFN, FFN, 64 * kb, j0, 64, ((const GAS float*)F.in[I_N2G]) + l * DM, (GAS bf16*)(wl + OFF_WGU), DM, (j0 / 128) * 256 + sel * 128 + (j0 % 128), 64 * kb, scr, lane); return; } r -= CV_I_GU;
    { const int nb = r % 32, kb = r / 32;
        conv_item(((const GAS float*)F.in[I_FWD]) + (size_t)l * FFN * DM, DM, 64 * kb, 64 * nb, 64, nullptr, (GAS bf16*)(wl + OFF_WDN), FFN, 64 * nb, 64 * kb, scr, lane); }
}
__device__ __forceinline__ int cv_ntail(int nwg, int G) { const int nr = (nwg + G - 1) / G; return nr * G - nwg; }
__device__ __forceinline__ void cv_split(int G, int& R, int& T1) {
    const int t1 = cv_ntail((MTOK / 256) * (NP / 256), G) * NWAVES * CV_Q1, t7 = cv_ntail((MTOK / 256) * (NGU / 256), G) * NWAVES * CV_Q7;
    int r = CV_I_LAYER - t1 - t7; int tt1 = t1; if (r < 0) { r = 0; tt1 = t1 < CV_I_LAYER ? t1 : CV_I_LAYER; }
    R = r; T1 = tt1;
}
__device__ __forceinline__ void cv_tail(Frame& F, int l, int which) {
    if (l + 1 >= DEPTH) return;
    const int nwg = (MTOK / 256) * ((which ? NGU : NP) / 256), ntail = cv_ntail(nwg, F.G), first = F.G - ntail;
    if ((int)blockIdx.x < first) return;
    int R, T1; cv_split(F.G, R, T1);
    const int lo = which ? R + T1 : R, hi = which ? CV_I_LAYER : R + T1;
    LAS float* scr = (LAS float*)(F.lds + F.wave * 16896);
    for (int r = lo + ((int)blockIdx.x - first) * NWAVES + F.wave; r < hi; r += ntail * NWAVES) conv_layer_item(F, l + 1, r, scr, F.lane);
}
__device__ __forceinline__ void s5_tables_unit(Frame& F, int lg);
__device__ __forceinline__ void p0_prologue(Frame& F) {
    LAS float* scr = (LAS float*)(F.lds + F.wave * 16896);
    const int gw = blockIdx.x * NWAVES + F.wave, NGW = F.G * NWAVES, lane = F.lane;
    for (int lg = blockIdx.x; lg < DEPTH * 64; lg += F.G) s5_tables_unit(F, lg);
    int R, T1; cv_split(F.G, R, T1);
    for (int it = gw; it < CV_I_LAYER + (DEPTH - 1) * R; it += NGW) {
        int l, r; if (it < CV_I_LAYER) { l = 0; r = it; } else { const int q = it - CV_I_LAYER; l = 1 + q / R; r = q - (l - 1) * R; }
        conv_layer_item(F, l, r, scr, lane);
    }
    const GAS float* x = ((const GAS float*)F.in[I_X]); GAS bf16* XB = (GAS bf16*)(F.ws + WS_XB); GAS float* ssq = (GAS float*)(F.ws + WS_SSQ);
    for (int m = gw; m < MTOK; m += NGW) {
        const GAS f32x4* xr = (const GAS f32x4*)(x + (size_t)m * DM) + lane; float s = 0.f;
        GAS v2u* o8 = (GAS v2u*)(XB + (size_t)m * DM) + lane;
#pragma unroll
        for (int j = 0; j < 8; ++j) { const f32x4 v = xr[64 * j]; s += (v[0] * v[0] + v[1] * v[1]) + (v[2] * v[2] + v[3] * v[3]); v2u w; w.x = pk2(v[0], v[1]); w.y = pk2(v[2], v[3]); o8[64 * j] = w; }
        s = wave_sum(s);
        if (lane < 8) ssq[(size_t)m * 8 + lane] = (lane == 0) ? s : 0.f;
    }
}

typedef short bf16x8_t __attribute__((ext_vector_type(8)));
__device__ __forceinline__ f32x4 mma16(bf16x8_t a, bf16x8_t b, f32x4 c) { return __builtin_amdgcn_mfma_f32_16x16x32_bf16(a, b, c, 0, 0, 0); }
constexpr int S5_USTR = 2064;
constexpr int S5_XSTR = 272;
__device__ __forceinline__ void s5_tables_unit(Frame& F, int lg) {
    LAS float* APr = (LAS float*)F.lds; LAS float* APi = APr + 65 * 64; LAS float* BBr = APi + 65 * 64; LAS float* BBi = BBr + 1024; LAS float* CCr = BBi + 1024; LAS float* CCi = CCr + 1024;
    const int tid = F.tid;
    const GAS float* lre_ = ((const GAS float*)F.in[I_LRE]) + lg * 64; const GAS float* lim_ = ((const GAS float*)F.in[I_LIM]) + lg * 64; const double dt = exp((double)((const GAS float*)F.in[I_LDT])[lg]);
    for (int idx = tid; idx < 65 * 64; idx += 512) { const int t = idx >> 6, p = idx & 63;
        const double lr = (double)lre_[p], li = (double)lim_[p]; const double mag = exp(lr * dt * (double)t); double ang = li * dt * (double)t;
        ang -= 6.283185307179586476925 * rint(ang * 0.15915494309189533577);
        APr[idx] = (float)(mag * (double)cosf((float)ang)); APi[idx] = (float)(mag * (double)sinf((float)ang)); }
    for (int idx = tid; idx < 1024; idx += 512) { const int p = idx >> 4, c = idx & 15;
        const double lr = (double)lre_[p], li = (double)lim_[p]; const double mag = exp(lr * dt); double ang = li * dt; ang -= 6.283185307179586476925 * rint(ang * 0.15915494309189533577);
        const double ar = mag * (double)cosf((float)ang), ai = mag * (double)sinf((float)ang), den = lr * lr + li * li, nr = ar - 1.0, ni = ai;
        const double zr = (nr * lr + ni * li) / den, zi = (ni * lr - nr * li) / den;
        const double br = (double)((const GAS float*)F.in[I_BRE])[(size_t)(lg * 64 + p) * 16 + c], bi = (double)((const GAS float*)F.in[I_BIM])[(size_t)(lg * 64 + p) * 16 + c];
        BBr[idx] = (float)(zr * br - zi * bi); BBi[idx] = (float)(zr * bi + zi * br);
        CCr[idx] = ((const GAS float*)F.in[I_CRE])[(size_t)lg * 1024 + idx]; CCi[idx] = ((const GAS float*)F.in[I_CIM])[(size_t)lg * 1024 + idx]; }
    LDS_WAIT(); __syncthreads();
    { const int t = tid >> 3, co0 = 2 * (tid & 7); float acc0[16], acc1[16];
#pragma unroll
      for (int i = 0; i < 16; ++i) { acc0[i] = 0.f; acc1[i] = 0.f; }
      for (int p = 0; p < 64; ++p) { const float ar = APr[t * 64 + p], ai = APi[t * 64 + p];
          const float c0r = CCr[co0 * 64 + p], c0i = CCi[co0 * 64 + p], c1r = CCr[(co0 + 1) * 64 + p], c1i = CCi[(co0 + 1) * 64 + p];
          const float w0r = c0r * ar - c0i * ai, w0i = c0r * ai + c0i * ar, w1r = c1r * ar - c1i * ai, w1i = c1r * ai + c1i * ar;
#pragma unroll
          for (int ci = 0; ci < 16; ++ci) { const float br = BBr[p * 16 + ci], bi = BBi[p * 16 + ci]; acc0[ci] += w0r * br - w0i * bi; acc1[ci] += w1r * br - w1i * bi; } }
      GAS bf16* TK = (GAS bf16*)(F.ws + WS_TK) + (size_t)lg * 64 * 256 + (size_t)(t * 16 + co0) * 16;
      v4u o0, o1, o2, o3; o0.x = pk2(acc0[0], acc0[1]); o0.y = pk2(acc0[2], acc0[3]); o0.z = pk2(acc0[4], acc0[5]); o0.w = pk2(acc0[6], acc0[7]);
      o1.x = pk2(acc0[8], acc0[9]); o1.y = pk2(acc0[10], acc0[11]); o1.z = pk2(acc0[12], acc0[13]); o1.w = pk2(acc0[14], acc0[15]);
      o2.x = pk2(acc1[0], acc1[1]); o2.y = pk2(acc1[2], acc1[3]); o2.z = pk2(acc1[4], acc1[5]); o2.w = pk2(acc1[6], acc1[7]);
      o3.x = pk2(acc1[8], acc1[9]); o3.y = pk2(acc1[10], acc1[11]); o3.z = pk2(acc1[12], acc1[13]); o3.w = pk2(acc1[14], acc1[15]);
      *(GAS v4u*)(TK) = o0; *(GAS v4u*)(TK + 8) = o1; *(GAS v4u*)(TK + 16) = o2; *(GAS v4u*)(TK + 24) = o3; }
    { GAS bf16* TW = (GAS bf16*)(F.ws + WS_TW) + (size_t)lg * 128 * 1024;
      for (int ch = tid; ch < 16384; ch += 512) { const int col = ch >> 7, kc = ch & 127, ri = col >> 6, p = col & 63, j = kc >> 1, c0 = 8 * (kc & 1);
          const float ar = APr[(63 - j) * 64 + p], ai = APi[(63 - j) * 64 + p]; float v[8];
#pragma unroll
          for (int e = 0; e < 8; ++e) { const float br = BBr[p * 16 + c0 + e], bi = BBi[p * 16 + c0 + e]; v[e] = ri ? (ar * bi + ai * br) : (ar * br - ai * bi); }
          v4u o; o.x = pk2(v[0], v[1]); o.y = pk2(v[2], v[3]); o.z = pk2(v[4], v[5]); o.w = pk2(v[6], v[7]);
          *(GAS v4u*)(TW + (size_t)col * 1024 + kc * 8) = o; } }
    { GAS bf16* TC = (GAS bf16*)(F.ws + WS_TC) + (size_t)lg * 1024 * 128;
      for (int ch = tid; ch < 16384; ch += 512) { const int row = ch >> 4, kc = ch & 15, i = row >> 4, co = row & 15, ri = kc >> 3, p0 = 8 * (kc & 7); float v[8];
#pragma unroll
          for (int e = 0; e < 8; ++e) { const int p = p0 + e; const float ar = APr[(i + 1) * 64 + p], ai = APi[(i + 1) * 64 + p], cr = CCr[co * 64 + p], ci = CCi[co * 64 + p];
              v[e] = ri ? -(cr * ai + ci * ar) : (cr * ar - ci * ai); }
          v4u o; o.x = pk2(v[0], v[1]); o.y = pk2(v[2], v[3]); o.z = pk2(v[4], v[5]); o.w = pk2(v[6], v[7]);
          *(GAS v4u*)(TC + (size_t)row * 128 + kc * 8) = o; } }
    if (tid < 128) ((GAS float*)(F.ws + WS_A64))[(size_t)lg * 128 + tid] = (tid < 64) ? APr[64 * 64 + tid] : APi[64 * 64 + tid - 64];
    LDS_WAIT(); __syncthreads();
}
__device__ __forceinline__ void s5_stage_u(Frame& F, int g, int b, LAS unsigned char* U) {
    const GAS v4u* src = (const GAS v4u*)((const GAS bf16*)(F.ws + WS_US) + (size_t)(b * 64 + g) * SEQ * 16);
#pragma unroll
    for (int it = 0; it < 8; ++it) { const int ch = F.tid + 512 * it, t = ch >> 1, hf = ch & 1, n = t >> 6, j = t & 63;
        *(LAS v4u*)(U + n * S5_USTR + (j * 16 + 8 * hf) * 2) = src[ch]; }
}
__device__ __forceinline__ void s5_s1_unit(Frame& F, int l, int unit) {
    const int g = unit & 63, b = unit >> 6, lg = l * 64 + g, lane = F.lane, w = F.wave, fr = lane & 15, fq = lane >> 4;
    LAS unsigned char* U = F.lds;
    s5_stage_u(F, g, b, U);
    LDS_WAIT(); __syncthreads();
    const GAS bf16* TW = (const GAS bf16*)(F.ws + WS_TW) + (size_t)lg * 128 * 1024 + (size_t)(16 * w + fr) * 1024 + 8 * fq;
    f32x4 acc[2] = {(f32x4){0.f, 0.f, 0.f, 0.f}, (f32x4){0.f, 0.f, 0.f, 0.f}};
#pragma unroll 4
    for (int ks = 0; ks < 32; ++ks) {
        const bf16x8_t bfr = *(const GAS bf16x8_t*)(TW + 32 * ks);
        const bf16x8_t a0 = *(const LAS bf16x8_t*)(U + fr * S5_USTR + (32 * ks + 8 * fq) * 2), a1 = *(const LAS bf16x8_t*)(U + (16 + fr) * S5_USTR + (32 * ks + 8 * fq) * 2);
        acc[0] = mma16(a0, bfr, acc[0]); acc[1] = mma16(a1, bfr, acc[1]); }
    GAS float* SL = (GAS float*)(F.ws + WS_SL);
#pragma unroll
    for (int mt = 0; mt < 2; ++mt)
#pragma unroll
        for (int r = 0; r < 4; ++r) { const int n = 16 * mt + 4 * fq + r; SL[((size_t)(b * 32 + n) * 64 + g) * 128 + 16 * w + fr] = acc[mt][r]; }
    __syncthreads();
}
__device__ __forceinline__ void s5_s3_unit(Frame& F, int l, int unit) {
    const int g = unit & 63, b = unit >> 6, lg = l * 64 + g, lane = F.lane, w = F.wave, fr = lane & 15, fq = lane >> 4;
    LAS unsigned char* U = F.lds; LAS unsigned char* TKL = F.lds + 32 * S5_USTR; LAS unsigned char* XP = TKL + 32768;
    float sr[32], si[32]; float a64r = 0.f, a64i = 0.f;
    if (w == 0) { const GAS float* SL = (const GAS float*)(F.ws + WS_SL) + ((size_t)(b * 32) * 64 + g) * 128; const GAS float* A64 = (const GAS float*)(F.ws + WS_A64) + (size_t)lg * 128;
        a64r = A64[lane]; a64i = A64[64 + lane];
#pragma unroll
        for (int e = 0; e < 32; ++e) { sr[e] = SL[(size_t)e * 64 * 128 + lane]; si[e] = SL[(size_t)e * 64 * 128 + 64 + lane]; } }
    s5_stage_u(F, g, b, U);
    { const GAS v4u* src = (const GAS v4u*)((const GAS bf16*)(F.ws + WS_TK) + (size_t)lg * 64 * 256);
#pragma unroll
      for (int it = 0; it < 4; ++it) *(LAS v4u*)(TKL + (F.tid + 512 * it) * 16) = src[F.tid + 512 * it]; }
    const GAS bf16* TC = (const GAS bf16*)(F.ws + WS_TC) + (size_t)lg * 1024 * 128 + (size_t)fr * 128 + 8 * fq;
    bf16x8_t tcf[8];
#pragma unroll
    for (int it = 0; it < 8; ++it) tcf[it] = *(const GAS bf16x8_t*)(TC + (size_t)((w + 8 * it) * 16) * 128);
    if (w == 0) {
        float xr = 0.f, xi = 0.f;
#pragma unroll
        for (int e = 0; e < 32; ++e) { *(LAS bf16*)(XP + e * S5_XSTR + lane * 2) = (bf16)f2bf(xr); *(LAS bf16*)(XP + e * S5_XSTR + (64 + lane) * 2) = (bf16)f2bf(xi);
            const float nr = a64r * xr - a64i * xi + sr[e], ni = a64r * xi + a64i * xr + si[e]; xr = nr; xi = ni; }
    }
    LDS_WAIT(); __syncthreads();
    f32x4 acc[2][8];
#pragma unroll
    for (int mt = 0; mt < 2; ++mt)
#pragma unroll
        for (int it = 0; it < 8; ++it) acc[mt][it] = (f32x4){0.f, 0.f, 0.f, 0.f};
#pragma unroll 1
    for (int c = 0; c < 4; ++c) {
        bf16x8_t bfr[8];
#pragma unroll
        for (int it = 0; it < 8; ++it) { const int lag = w + 8 * it - 2 * c - (fq >> 1); bfr[it] = *(const LAS bf16x8_t*)(TKL + ((lag < 0 ? 0 : lag) * 16 + fr) * 32 + 16 * (fq & 1)); if (lag < 0) bfr[it] = (bf16x8_t){0, 0, 0, 0, 0, 0, 0, 0}; }
        const bool first_ok = (w >= 2 * c);
#pragma unroll
        for (int sgrp = 0; sgrp < 8; ++sgrp) { const int ks = c + 4 * sgrp;
            const bf16x8_t a0 = *(const LAS bf16x8_t*)(U + fr * S5_USTR + (32 * ks + 8 * fq) * 2), a1 = *(const LAS bf16x8_t*)(U + (16 + fr) * S5_USTR + (32 * ks + 8 * fq) * 2);
#pragma unroll
            for (int it = sgrp; it < 8; ++it) { if (it > sgrp || first_ok) { acc[0][it] = mma16(a0, bfr[it - sgrp], acc[0][it]); acc[1][it] = mma16(a1, bfr[it - sgrp], acc[1][it]); } } }
    }
#pragma unroll
    for (int ks = 0; ks < 4; ++ks) {
        if (ks > 0) {
#pragma unroll
            for (int it = 0; it < 8; ++it) tcf[it] = *(const GAS bf16x8_t*)(TC + (size_t)((w + 8 * it) * 16) * 128 + 32 * ks); }
        const bf16x8_t a0 = *(const LAS bf16x8_t*)(XP + fr * S5_XSTR + (32 * ks + 8 * fq) * 2), a1 = *(const LAS bf16x8_t*)(XP + (16 + fr) * S5_XSTR + (32 * ks + 8 * fq) * 2);
#pragma unroll
        for (int it = 0; it < 8; ++it) { acc[0][it] = mma16(a0, tcf[it], acc[0][it]); acc[1][it] = mma16(a1, tcf[it], acc[1][it]); } }
    unsigned zp[2][8][2];
    { const float dsk = ((const GAS float*)F.in[I_SD])[l * 1024 + 16 * g + fr];
#pragma unroll
      for (int mt = 0; mt < 2; ++mt)
#pragma unroll
          for (int it = 0; it < 8; ++it) { float z[4];
#pragma unroll
              for (int r = 0; r < 4; ++r) { const int n = 16 * mt + 4 * fq + r, i = w + 8 * it;
                  const float uv = bf1(*(const LAS bf16*)(U + n * S5_USTR + (i * 16 + fr) * 2)); z[r] = gelu_tanh(acc[mt][it][r] + dsk * uv); }
              zp[mt][it][0] = pg8::cvt_pk_bf16(z[0], z[1]); zp[mt][it][1] = pg8::cvt_pk_bf16(z[2], z[3]); } }
    LDS_WAIT(); __syncthreads();
#pragma unroll
    for (int mt = 0; mt < 2; ++mt)
#pragma unroll
        for (int it = 0; it < 8; ++it)
#pragma unroll
            for (int r = 0; r < 4; ++r) { const int tkn = 64 * (16 * mt + 4 * fq + r) + w + 8 * it; const unsigned v = zp[mt][it][r >> 1];
                *(LAS bf16*)(U + tkn * 32 + fr * 2) = (bf16)((r & 1) ? (v >> 16) : (v & 0xffffu)); }
    LDS_WAIT(); __syncthreads();
    { GAS bf16* Z = (GAS bf16*)(F.ws + WS_Z) + (size_t)b * SEQ * 1024 + 16 * g;
#pragma unroll
      for (int j = 0; j < 8; ++j) { const int c = F.tid + 512 * j; *(GAS v4u*)(Z + (size_t)(c >> 1) * 1024 + 8 * (c & 1)) = *(const LAS v4u*)(U + c * 16); } }
    __syncthreads();
}

constexpr int GL_TSTR = 144;
constexpr int GL_DSTR = 272;
__device__ __forceinline__ void gla_g1_unit(Frame& F, int l, int u) {
    const int n = u & 31, h = (u >> 5) & 3, b = u >> 7, tid = F.tid, lane = F.lane, w = F.wave, fr = lane & 15, fq = lane >> 4;
    const size_t tok0 = (size_t)b * SEQ + 64 * n;
    const GAS bf16* P = (const GAS bf16*)(F.ws + WS_P);
    LAS float* GL = (LAS float*)F.lds; LAS float* W2L = (LAS float*)(F.lds + 32768); LAS float* GLR = (LAS float*)(F.lds + 40960);
    LAS unsigned char* KDt = F.lds + 45056; LAS unsigned char* VTt = F.lds + 63488;
    { const GAS float* w2 = ((const GAS float*)F.in[I_GW2]) + (size_t)l * 16 * 512;
#pragma unroll
      for (int it = 0; it < 4; ++it) { const int idx = tid + 512 * it, r = idx >> 7, dk = idx & 127; W2L[idx] = w2[r * 512 + h * 128 + dk]; }
#pragma unroll
      for (int it = 0; it < 2; ++it) { const int idx = tid + 512 * it, i = idx >> 4, r = idx & 15; GLR[idx] = bf1(P[(tok0 + i) * NP + PC_GLR + r]); } }
    LDS_WAIT(); __syncthreads();
    const int ti = tid >> 3, dq = tid & 7;
    { const GAS float* b2 = ((const GAS float*)F.in[I_GB2]) + l * 512 + h * 128 + 16 * dq; float a[16];
#pragma unroll
      for (int e = 0; e < 16; ++e) a[e] = b2[e];
#pragma unroll
      for (int r = 0; r < 16; ++r) { const float gv = GLR[ti * 16 + r];
#pragma unroll
          for (int e = 0; e < 16; ++e) a[e] += gv * W2L[r * 128 + 16 * dq + e]; }
#pragma unroll
      for (int e = 0; e < 16; ++e) { const float x = a[e]; GL[ti * 128 + 16 * dq + e] = (fminf(x, 0.f) - log1pf(__expf(-fabsf(x)))) * (1.0f / 16.0f); } }
    LDS_WAIT(); __syncthreads();
    if (tid < 128) { float run = 0.f;
        for (int i = 0; i < 64; ++i) { run += GL[i * 128 + tid]; GL[i * 128 + tid] = run; }
        GLR[tid] = run; ((GAS float*)(F.ws + WS_DEC))[(size_t)u * 128 + tid] = __expf(run); }
    LDS_WAIT(); __syncthreads();
    {
      const GAS bf16* qp = P + (tok0 + ti) * NP + PC_GQ + h * 128 + 16 * dq; const GAS bf16* kp = P + (tok0 + ti) * NP + PC_GK + h * 128 + 16 * dq;
      const v4u q0 = *(const GAS v4u*)qp, q1 = *(const GAS v4u*)(qp + 8), k0 = *(const GAS v4u*)kp, k1 = *(const GAS v4u*)(kp + 8);
      const unsigned qw[8] = {q0.x, q0.y, q0.z, q0.w, q1.x, q1.y, q1.z, q1.w}, kw[8] = {k0.x, k0.y, k0.z, k0.w, k1.x, k1.y, k1.z, k1.w};
      float qd[16], ki[16];
#pragma unroll
      for (int e = 0; e < 16; ++e) { const int dk = 16 * dq + e; const float bc = GL[ti * 128 + dk], bl = GLR[dk];
          const float qv = (e & 1) ? bfhi(qw[e >> 1]) : bflo(qw[e >> 1]), kv = (e & 1) ? bfhi(kw[e >> 1]) : bflo(kw[e >> 1]);
          qd[e] = qv * 0.08838834764831845f * __expf(bc); ki[e] = kv * __expf(-bc);
          *(LAS bf16*)(KDt + dk * GL_TSTR + ti * 2) = (bf16)f2bf(kv * __expf(bl - bc)); }
      GAS bf16* QD = (GAS bf16*)(F.ws + WS_QD) + ((size_t)u * 64 + ti) * 128 + 16 * dq; GAS bf16* KI = (GAS bf16*)(F.ws + WS_KI) + ((size_t)u * 64 + ti) * 128 + 16 * dq;
      v4u o; o.x = pk2(qd[0], qd[1]); o.y = pk2(qd[2], qd[3]); o.z = pk2(qd[4], qd[5]); o.w = pk2(qd[6], qd[7]); *(GAS v4u*)QD = o;
      o.x = pk2(qd[8], qd[9]); o.y = pk2(qd[10], qd[11]); o.z = pk2(qd[12], qd[13]); o.w = pk2(qd[14], qd[15]); *(GAS v4u*)(QD + 8) = o;
      o.x = pk2(ki[0], ki[1]); o.y = pk2(ki[2], ki[3]); o.z = pk2(ki[4], ki[5]); o.w = pk2(ki[6], ki[7]); *(GAS v4u*)KI = o;
      o.x = pk2(ki[8], ki[9]); o.y = pk2(ki[10], ki[11]); o.z = pk2(ki[12], ki[13]); o.w = pk2(ki[14], ki[15]); *(GAS v4u*)(KI + 8) = o;
      const GAS bf16* vp = P + (tok0 + ti) * NP + PC_GV + h * 256 + 32 * dq;
#pragma unroll
      for (int c = 0; c < 4; ++c) { const v4u vv = *(const GAS v4u*)(vp + 8 * c); const unsigned vw[4] = {vv.x, vv.y, vv.z, vv.w};
#pragma unroll
          for (int e = 0; e < 4; ++e) { const int dv = 32 * dq + 8 * c + 2 * e;
              *(LAS bf16*)(VTt + dv * GL_TSTR + ti * 2) = (bf16)(vw[e] & 0xffffu); *(LAS bf16*)(VTt + (dv + 1) * GL_TSTR + ti * 2) = (bf16)(vw[e] >> 16); } } }
    LDS_WAIT(); __syncthreads();
    {
      GAS bf16* GVT = (GAS bf16*)(F.ws + WS_GVT) + (size_t)u * 256 * 64; const int row = tid >> 1, hf = tid & 1;
#pragma unroll
      for (int c = 0; c < 4; ++c) *(GAS v4u*)(GVT + row * 64 + 32 * hf + 8 * c) = *(const LAS v4u*)(VTt + row * GL_TSTR + 64 * hf + 16 * c); }
    {
      f32x4 acc[8][2];
#pragma unroll
      for (int mt = 0; mt < 8; ++mt) { acc[mt][0] = (f32x4){0.f, 0.f, 0.f, 0.f}; acc[mt][1] = (f32x4){0.f, 0.f, 0.f, 0.f}; }
#pragma unroll
      for (int ks = 0; ks < 2; ++ks) { bf16x8_t bb[2], aa[8];
#pragma unroll
          for (int nt = 0; nt < 2; ++nt) bb[nt] = *(const LAS bf16x8_t*)(VTt + (16 * (2 * w + nt) + fr) * GL_TSTR + (32 * ks + 8 * fq) * 2);
#pragma unroll
          for (int mt = 0; mt < 8; ++mt) aa[mt] = *(const LAS bf16x8_t*)(KDt + (16 * mt + fr) * GL_TSTR + (32 * ks + 8 * fq) * 2);
#pragma unroll
          for (int mt = 0; mt < 8; ++mt) { acc[mt][0] = mma16(aa[mt], bb[0], acc[mt][0]); acc[mt][1] = mma16(aa[mt], bb[1], acc[mt][1]); } }
      GAS bf16* KV = (GAS bf16*)(F.ws + WS_KV) + (size_t)u * 256 * 128;
#pragma unroll
      for (int nt = 0; nt < 2; ++nt)
#pragma unroll
          for (int mt = 0; mt < 8; ++mt) { v2u o; o.x = pg8::cvt_pk_bf16(acc[mt][nt][0], acc[mt][nt][1]); o.y = pg8::cvt_pk_bf16(acc[mt][nt][2], acc[mt][nt][3]);
              *(GAS v2u*)(KV + (size_t)(16 * (2 * w + nt) + fr) * 128 + 16 * mt + 4 * fq) = o; } }
    __syncthreads();
}
__device__ __forceinline__ void gla_g2_scan(Frame& F) {
    const GAS bf16* KV = (const GAS bf16*)(F.ws + WS_KV); const GAS float* DEC = (const GAS float*)(F.ws + WS_DEC); GAS bf16* ST = (GAS bf16*)(F.ws + WS_ST);
    for (int e8 = blockIdx.x * 512 + F.tid; e8 < 16 * 256 * 16; e8 += F.G * 512) { const int bh = e8 >> 12, dv = (e8 >> 4) & 255, d8 = e8 & 15;
        float s[8];
#pragma unroll
        for (int j = 0; j < 8; ++j) s[j] = 0.f;
        for (int n0 = 0; n0 < 32; n0 += 4) { v4u kv[4]; f32x4 dc[4][2];
#pragma unroll
            for (int e = 0; e < 4; ++e) { const size_t u = (size_t)bh * 32 + n0 + e; kv[e] = *(const GAS v4u*)(KV + (u * 256 + dv) * 128 + 8 * d8); dc[e][0] = *(const GAS f32x4*)(DEC + u * 128 + 8 * d8); dc[e][1] = *(const GAS f32x4*)(DEC + u * 128 + 8 * d8 + 4); }
#pragma unroll
            for (int e = 0; e < 4; ++e) { const size_t u = (size_t)bh * 32 + n0 + e; v4u o; o.x = pk2(s[0], s[1]); o.y = pk2(s[2], s[3]); o.z = pk2(s[4], s[5]); o.w = pk2(s[6], s[7]); *(GAS v4u*)(ST + (u * 256 + dv) * 128 + 8 * d8) = o;
                const unsigned kw[4] = {kv[e].x, kv[e].y, kv[e].z, kv[e].w};
#pragma unroll
                for (int j = 0; j < 4; ++j) { s[2 * j] = dc[e][j >> 1][(2 * j) & 3] * s[2 * j] + bflo(kw[j]); s[2 * j + 1] = dc[e][j >> 1][(2 * j + 1) & 3] * s[2 * j + 1] + bfhi(kw[j]); } } } }
}
__device__ __forceinline__ void gla_g3_unit(Frame& F, int l, int u) {
    const int n = u & 31, h = (u >> 5) & 3, b = u >> 7, tid = F.tid, lane = F.lane, w = F.wave, fr = lane & 15, fq = lane >> 4;
    const size_t tok0 = (size_t)b * SEQ + 64 * n;
    LAS unsigned char* QDL = F.lds; LAS unsigned char* KIL = F.lds + 17408; LAS unsigned char* ATL = F.lds + 34816; LAS float* SSQL = (LAS float*)(F.lds + 44032); LAS float* RSL = (LAS float*)(F.lds + 46080);
    bf16x8_t gvtf[2][2], stf[2][4];
    { const GAS bf16* GVT = (const GAS bf16*)(F.ws + WS_GVT) + (size_t)u * 256 * 64; const GAS bf16* ST = (const GAS bf16*)(F.ws + WS_ST) + (size_t)u * 256 * 128;
#pragma unroll
      for (int mt = 0; mt < 2; ++mt) {
#pragma unroll
          for (int ks = 0; ks < 2; ++ks) gvtf[mt][ks] = *(const GAS bf16x8_t*)(GVT + (size_t)(16 * (2 * w + mt) + fr) * 64 + 32 * ks + 8 * fq);
#pragma unroll
          for (int ks = 0; ks < 4; ++ks) stf[mt][ks] = *(const GAS bf16x8_t*)(ST + (size_t)(16 * (2 * w + mt) + fr) * 128 + 32 * ks + 8 * fq); } }
    { const GAS v4u* qs = (const GAS v4u*)((const GAS bf16*)(F.ws + WS_QD) + (size_t)u * 64 * 128); const GAS v4u* ks_ = (const GAS v4u*)((const GAS bf16*)(F.ws + WS_KI) + (size_t)u * 64 * 128);
#pragma unroll
      for (int it = 0; it < 2; ++it) { const int c = tid + 512 * it, row = c >> 4, c16 = c & 15; *(LAS v4u*)(QDL + row * GL_DSTR + c16 * 16) = qs[c]; *(LAS v4u*)(KIL + row * GL_DSTR + c16 * 16) = ks_[c]; } }
    LDS_WAIT(); __syncthreads();
#pragma unroll
    for (int tt = 0; tt < 2; ++tt) { const int tile = 2 * w + tt, mi = tile >> 2, nj = tile & 3; f32x4 acc = (f32x4){0.f, 0.f, 0.f, 0.f};
        if (nj <= mi) { bf16x8_t fa[4], fb[4];
#pragma unroll
            for (int ks = 0; ks < 4; ++ks) { fa[ks] = *(const LAS bf16x8_t*)(QDL + (16 * mi + fr) * GL_DSTR + (32 * ks + 8 * fq) * 2); fb[ks] = *(const LAS bf16x8_t*)(KIL + (16 * nj + fr) * GL_DSTR + (32 * ks + 8 * fq) * 2); }
#pragma unroll
            for (int ks = 0; ks < 4; ++ks) acc = mma16(fa[ks], fb[ks], acc); }
#pragma unroll
        for (int r = 0; r < 4; ++r) { const int i = 16 * mi + 4 * fq + r, j = 16 * nj + fr; *(LAS bf16*)(ATL + i * GL_TSTR + j * 2) = (bf16)f2bf(j <= i ? acc[r] : 0.f); } }
    LDS_WAIT(); __syncthreads();
    f32x4 acc[2][4];
#pragma unroll
    for (int mt = 0; mt < 2; ++mt)
#pragma unroll
        for (int nt = 0; nt < 4; ++nt) acc[mt][nt] = (f32x4){0.f, 0.f, 0.f, 0.f};
#pragma unroll
    for (int ks = 0; ks < 2; ++ks) { bf16x8_t fb[4];
#pragma unroll
        for (int nt = 0; nt < 4; ++nt) fb[nt] = *(const LAS bf16x8_t*)(ATL + (16 * nt + fr) * GL_TSTR + (32 * ks + 8 * fq) * 2);
#pragma unroll
        for (int nt = 0; nt < 4; ++nt) { acc[0][nt] = mma16(gvtf[0][ks], fb[nt], acc[0][nt]); acc[1][nt] = mma16(gvtf[1][ks], fb[nt], acc[1][nt]); } }
#pragma unroll
    for (int ks = 0; ks < 4; ++ks) { bf16x8_t fb[4];
#pragma unroll
        for (int nt = 0; nt < 4; ++nt) fb[nt] = *(const LAS bf16x8_t*)(QDL + (16 * nt + fr) * GL_DSTR + (32 * ks + 8 * fq) * 2);
#pragma unroll
        for (int nt = 0; nt < 4; ++nt) { acc[0][nt] = mma16(stf[0][ks], fb[nt], acc[0][nt]); acc[1][nt] = mma16(stf[1][ks], fb[nt], acc[1][nt]); } }
#pragma unroll
    for (int nt = 0; nt < 4; ++nt) { float v = 0.f;
#pragma unroll
        for (int mt = 0; mt < 2; ++mt)
#pragma unroll
            for (int r = 0; r < 4; ++r) v += acc[mt][nt][r] * acc[mt][nt][r];
        v += __shfl_xor(v, 16); v += __shfl_xor(v, 32);
        if (fq == 0) SSQL[w * 64 + 16 * nt + fr] = v; }
    LDS_WAIT(); __syncthreads();
    if (tid < 64) { float s = 0.f;
#pragma unroll
        for (int ww = 0; ww < 8; ++ww) s += SSQL[ww * 64 + tid];
        RSL[tid] = 1.0f / sqrtf(s * (1.0f / 256.0f) + RMS_EPS); }
    LDS_WAIT(); __syncthreads();
    { const GAS bf16* P = (const GAS bf16*)(F.ws + WS_P); GAS bf16* Y = (GAS bf16*)(F.ws + WS_Y); const GAS float* gn = (const GAS float*)F.in[I_GNG] + l * 256;
      v2u rr[2][4];
#pragma unroll
      for (int mt = 0; mt < 2; ++mt)
#pragma unroll
          for (int nt = 0; nt < 4; ++nt) rr[mt][nt] = *(const GAS v2u*)(P + (tok0 + 16 * nt + fr) * NP + PC_GR + h * 256 + 16 * (2 * w + mt) + 4 * fq);
#pragma unroll
      for (int mt = 0; mt < 2; ++mt) { const int dv0 = 16 * (2 * w + mt) + 4 * fq; const f32x4 gv = *(const GAS f32x4*)(gn + dv0);
#pragma unroll
          for (int nt = 0; nt < 4; ++nt) { const int i = 16 * nt + fr; const float rs = RSL[i]; const v2u rw = rr[mt][nt];
              const float r0 = bflo(rw.x), r1 = bfhi(rw.x), r2 = bflo(rw.y), r3 = bfhi(rw.y);
              v2u o; o.x = pg8::cvt_pk_bf16(acc[mt][nt][0] * rs * gv[0] * r0 * sigmoidf_(r0), acc[mt][nt][1] * rs * gv[1] * r1 * sigmoidf_(r1));
              o.y = pg8::cvt_pk_bf16(acc[mt][nt][2] * rs * gv[2] * r2 * sigmoidf_(r2), acc[mt][nt][3] * rs * gv[3] * r3 * sigmoidf_(r3));
              *(GAS v2u*)(Y + (tok0 + i) * YW + 1024 + h * 256 + dv0) = o; } } }
    __syncthreads();
}
constexpr int MB_KSTR = 272, MB_VSTR = 144, MB_KBYTES = 64 * MB_KSTR, MB_BUF = MB_KBYTES + 128 * MB_VSTR;
__device__ __forceinline__ void moba_prep_unit(Frame& F, int l, int unit) {
    const int kb = unit & 7, h = (unit >> 3) & 7, b = unit >> 6, tid = F.tid;
    const size_t tok0 = (size_t)b * SEQ + 256 * kb;
    const GAS bf16* P = (const GAS bf16*)(F.ws + WS_P);
    LAS unsigned char* TL = F.lds; LAS float* PART = (LAS float*)(F.lds + 69632);
    const int c16 = tid & 15, tg = tid >> 4;
    v4u xq[8], xk[8], xv[8];
    { const GAS bf16* src = P + (tok0 + tg) * NP + h * 128 + 8 * c16;
#pragma unroll
      for (int j = 0; j < 8; ++j) { xq[j] = *(const GAS v4u*)(src + (size_t)(32 * j) * NP + PC_MQ); xk[j] = *(const GAS v4u*)(src + (size_t)(32 * j) * NP + PC_MK); xv[j] = *(const GAS v4u*)(src + (size_t)(32 * j) * NP + PC_MV); } }
#pragma unroll
    for (int which = 0; which < 2; ++which) {
        const GAS float* gp = (const GAS float*)F.in[which ? I_MKG : I_MQG] + l * 128 + 8 * c16;
        const f32x4 g0 = *(const GAS f32x4*)gp, g1 = *(const GAS f32x4*)(gp + 4);
#pragma unroll
        for (int j = 0; j < 8; ++j) { const v4u xx = which ? xk[j] : xq[j]; const unsigned xw[4] = {xx.x, xx.y, xx.z, xx.w}; float ss = 0.f;
#pragma unroll
            for (int e = 0; e < 4; ++e) { const float a = bflo(xw[e]), bb = bfhi(xw[e]); ss += a * a + bb * bb; }
            ss += __shfl_xor(ss, 1); ss += __shfl_xor(ss, 2); ss += __shfl_xor(ss, 4); ss += __shfl_xor(ss, 8);
            const float r = (1.0f / sqrtf(ss * (1.0f / 128.0f) + RMS_EPS)) * (which ? 1.0f : 0.08838834764831845f * 1.4426950408889634f);
            const int tok = tg + 32 * j;
            v4u o; o.x = pg8::cvt_pk_bf16(bflo(xw[0]) * r * g0[0], bfhi(xw[0]) * r * g0[1]); o.y = pg8::cvt_pk_bf16(bflo(xw[1]) * r * g0[2], bfhi(xw[1]) * r * g0[3]);
            o.z = pg8::cvt_pk_bf16(bflo(xw[2]) * r * g1[0], bfhi(xw[2]) * r * g1[1]); o.w = pg8::cvt_pk_bf16(bflo(xw[3]) * r * g1[2], bfhi(xw[3]) * r * g1[3]);
            *(GAS v4u*)((GAS bf16*)(F.ws + (which ? WS_KN : WS_QN)) + (tok0 + tok) * 1024 + h * 128 + 8 * c16) = o; if (which) *(LAS v4u*)(TL + tok * MB_KSTR + 16 * c16) = o; }
    }
    LDS_WAIT(); __syncthreads();
    { const int d = tid & 127, part = tid >> 7; float a = 0.f;
#pragma unroll 8
      for (int j = 0; j < 64; ++j) a += bf1(*(const LAS bf16*)(TL + (64 * part + j) * MB_KSTR + d * 2));
      PART[part * 128 + d] = a; }
    LDS_WAIT(); __syncthreads();
    if (tid < 128) ((GAS float*)(F.ws + WS_KM))[(size_t)unit * 128 + tid] = ((PART[tid] + PART[128 + tid]) + (PART[256 + tid] + PART[384 + tid])) * (1.0f / 256.0f);
#pragma unroll
    for (int j = 0; j < 8; ++j) *(LAS v4u*)(TL + (tg + 32 * j) * MB_KSTR + 16 * c16) = xv[j];
    LDS_WAIT(); __syncthreads();
    { const int d = tid >> 2, tq = tid & 3; GAS bf16* dst = (GAS bf16*)(F.ws + WS_VT) + ((size_t)(b * 8 + h) * 128 + d) * SEQ + 256 * kb + 64 * tq;
#pragma unroll
      for (int c = 0; c < 8; ++c) { unsigned wv[4];
#pragma unroll
          for (int e = 0; e < 4; ++e) { const unsigned lo = *(const LAS bf16*)(TL + (64 * tq + 8 * c + 2 * e) * MB_KSTR + d * 2), hi = *(const LAS bf16*)(TL + (64 * tq + 8 * c + 2 * e + 1) * MB_KSTR + d * 2); wv[e] = lo | (hi << 16); }
          v4u o; o.x = wv[0]; o.y = wv[1]; o.z = wv[2]; o.w = wv[3]; *(GAS v4u*)(dst + 8 * c) = o; } }
    __syncthreads();
}
constexpr int MB3_TILE = 128 * 256, MB3_BUF = 2 * MB3_TILE;
__device__ __forceinline__ void moba_attn_unit3(Frame& F, int bh, int qt) {
    const int b = bh >> 3, h = bh & 7, tid = F.tid, lane = F.lane, w = F.wave, fr = lane & 15, fq = lane >> 4;
    const int qb = qt >> 1, np = qt + 1, qpos = 128 * qt + 16 * w + fr;
    const GAS bf16* KN = (const GAS bf16*)(F.ws + WS_KN) + (size_t)b * SEQ * 1024 + h * 128; const GAS bf16* VT = (const GAS bf16*)(F.ws + WS_VT) + (size_t)bh * 128 * SEQ;
    LAS float* KML = (LAS float*)(F.lds + 2 * MB3_BUF);
    { const GAS float* km = (const GAS float*)(F.ws + WS_KM) + (size_t)bh * 1024; KML[tid] = km[tid]; KML[512 + tid] = km[512 + tid]; }
    bf16x8_t bq[4];
    { const GAS bf16* qp = (const GAS bf16*)(F.ws + WS_QN) + ((size_t)b * SEQ + qpos) * 1024 + h * 128 + 8 * fq;
#pragma unroll
      for (int ks = 0; ks < 4; ++ks) bq[ks] = *(const GAS bf16x8_t*)(qp + 32 * ks); }
    const int drow = lane >> 4, dslot = lane & 15;
#define MB3_DMA(buf_, p_) do { _Pragma("unroll") for (int j_ = 0; j_ < 4; ++j_) { const int row_ = 4 * (8 * j_ + w) + drow, c_ = dslot ^ (row_ & 15); \
        __builtin_amdgcn_global_load_lds((const GAS unsigned*)(KN + (size_t)(128 * (p_) + row_) * 1024 + 8 * c_), (LAS unsigned*)((buf_) + (8 * j_ + w) * 1024), 16, 0, 0); \
        __builtin_amdgcn_global_load_lds((const GAS unsigned*)(VT + (size_t)row_ * SEQ + 128 * (p_) + 8 * c_), (LAS unsigned*)((buf_) + MB3_TILE + (8 * j_ + w) * 1024), 16, 0, 0); } } while (0)
    MB3_DMA(F.lds, 0);
    VM_WAIT(); LDS_WAIT(); __syncthreads();
    unsigned selmask = 0u;
    { float sc[8];
#pragma unroll
      for (int kb = 0; kb < 8; ++kb) { float a = 0.f;
#pragma unroll
          for (int ks = 0; ks < 4; ++ks) { const LAS float* kp = KML + kb * 128 + 32 * ks + 8 * fq; const f32x4 k0 = *(const LAS f32x4*)kp, k1 = *(const LAS f32x4*)(kp + 4);
              const v4u qv = __builtin_bit_cast(v4u, bq[ks]);
              a += bflo(qv.x) * k0[0] + bfhi(qv.x) * k0[1] + bflo(qv.y) * k0[2] + bfhi(qv.y) * k0[3] + bflo(qv.z) * k1[0] + bfhi(qv.z) * k1[1] + bflo(qv.w) * k1[2] + bfhi(qv.w) * k1[3]; }
          a += __shfl_xor(a, 16); a += __shfl_xor(a, 32); sc[kb] = (kb < qb) ? a : -__builtin_inff(); }
#pragma unroll
      for (int kb = 0; kb < 8; ++kb) { int rank = 0;
#pragma unroll
          for (int j = 0; j < 8; ++j) if (j != kb) rank += ((j < qb) && (sc[j] > sc[kb] || (sc[j] == sc[kb] && j < kb))) ? 1 : 0;
          if (kb < qb && rank < 3) selmask |= 1u << kb; } }
    f32x4 ao[8];
#pragma unroll
    for (int dt = 0; dt < 8; ++dt) ao[dt] = (f32x4){0.f, 0.f, 0.f, 0.f};
    float m = -__builtin_inff(), lsum = 0.f;
#pragma unroll 1
    for (int p = 0; p < np; ++p) {
        LAS unsigned char* KB = F.lds + (p & 1) * MB3_BUF; LAS unsigned char* VB = KB + MB3_TILE;
        if (p + 1 < np) MB3_DMA(F.lds + ((p + 1) & 1) * MB3_BUF, p + 1);
        const int kb = p >> 1; const bool past = kb < qb; const bool mine = past ? (((selmask >> kb) & 1u) != 0u) : true;
        if (__any(mine)) {
            const int lim = (past ? (mine ? 0x7fffffff : -1) : qpos - 128 * p) - 4 * fq;
            f32x4 as[8];
#pragma unroll
            for (int mh = 0; mh < 4; ++mh) { bf16x8_t fragA[2][4];
#pragma unroll
                for (int mt = 0; mt < 2; ++mt)
#pragma unroll
                    for (int ks = 0; ks < 4; ++ks) fragA[mt][ks] = *(const LAS bf16x8_t*)(KB + (16 * (2 * mh + mt) + fr) * 256 + 16 * ((4 * ks + fq) ^ fr));
                __builtin_amdgcn_sched_barrier(0);
#pragma unroll
                for (int mt = 0; mt < 2; ++mt) { as[2 * mh + mt] = (f32x4){0.f, 0.f, 0.f, 0.f};
#pragma unroll
                    for (int ks = 0; ks < 4; ++ks) as[2 * mh + mt] = mma16(fragA[mt][ks], bq[ks], as[2 * mh + mt]); }
                __builtin_amdgcn_sched_barrier(0); }
            float mx = -__builtin_inff();
            if (__all(lim >= 127)) {
#pragma unroll
                for (int mt = 0; mt < 8; ++mt)
#pragma unroll
                    for (int r = 0; r < 4; ++r) mx = fmaxf(mx, as[mt][r]);
            } else {
#pragma unroll
                for (int mt = 0; mt < 8; ++mt)
#pragma unroll
                    for (int r = 0; r < 4; ++r) { const float sv_ = (16 * mt + r <= lim) ? as[mt][r] : -__builtin_inff(); as[mt][r] = sv_; mx = fmaxf(mx, sv_); }
            }
            mx = fmaxf(mx, __shfl_xor(mx, 16)); mx = fmaxf(mx, __shfl_xor(mx, 32));
            const float mnew = fmaxf(m, mx), msafe = (mnew == -__builtin_inff()) ? 0.f : mnew;
            const bool grow = __any(mnew != m);
            const float corr = grow ? __builtin_amdgcn_exp2f(m - msafe) : 1.0f;
            float ps = 0.f;
#pragma unroll
            for (int mt = 0; mt < 8; ++mt)
#pragma unroll
                for (int r = 0; r < 4; ++r) { const float pv = __builtin_amdgcn_exp2f(as[mt][r] - msafe); as[mt][r] = pv; ps += pv; }
            lsum = lsum * corr + ps; m = mnew;
            bf16x8_t pf[4];
#pragma unroll
            for (int k2 = 0; k2 < 4; ++k2) { v4u t; t.x = pg8::cvt_pk_bf16(as[2 * k2][0], as[2 * k2][1]); t.y = pg8::cvt_pk_bf16(as[2 * k2][2], as[2 * k2][3]); t.z = pg8::cvt_pk_bf16(as[2 * k2 + 1][0], as[2 * k2 + 1][1]); t.w = pg8::cvt_pk_bf16(as[2 * k2 + 1][2], as[2 * k2 + 1][3]);
                pf[k2] = __builtin_bit_cast(bf16x8_t, t); }
            if (grow) {
#pragma unroll
                for (int dt = 0; dt < 8; ++dt) ao[dt] = ao[dt] * corr; }
            __builtin_amdgcn_sched_barrier(0);
#pragma unroll
            for (int dh = 0; dh < 4; ++dh) { v2u vlo[2][4], vhi[2][4];
#pragma unroll
                for (int dt = 0; dt < 2; ++dt)
#pragma unroll
                    for (int k2 = 0; k2 < 4; ++k2) { const LAS unsigned char* vr = VB + (16 * (2 * dh + dt) + fr) * 256 + 8 * (fq & 1); const int c0 = 4 * k2 + (fq >> 1);
                        vlo[dt][k2] = *(const LAS v2u*)(vr + 16 * (c0 ^ fr)); vhi[dt][k2] = *(const LAS v2u*)(vr + 16 * ((c0 + 2) ^ fr)); }
                __builtin_amdgcn_sched_barrier(0);
#pragma unroll
                for (int dt = 0; dt < 2; ++dt)
#pragma unroll
                    for (int k2 = 0; k2 < 4; ++k2) { v4u t; t.x = vlo[dt][k2].x; t.y = vlo[dt][k2].y; t.z = vhi[dt][k2].x; t.w = vhi[dt][k2].y; ao[2 * dh + dt] = mma16(__builtin_bit_cast(bf16x8_t, t), pf[k2], ao[2 * dh + dt]); }
                __builtin_amdgcn_sched_barrier(0); }
        }
        VM_WAIT(); LDS_WAIT(); __syncthreads();
    }
#undef MB3_DMA
    lsum += __shfl_xor(lsum, 16); lsum += __shfl_xor(lsum, 32);
    const float inv = 1.0f / lsum;
    GAS bf16* yp = (GAS bf16*)(F.ws + WS_Y) + ((size_t)b * SEQ + qpos) * YW + 2048 + h * 128 + 4 * fq;
#pragma unroll
    for (int dt = 0; dt < 8; ++dt) { v2u o; o.x = pg8::cvt_pk_bf16(ao[dt][0] * inv, ao[dt][1] * inv); o.y = pg8::cvt_pk_bf16(ao[dt][2] * inv, ao[dt][3] * inv); *(GAS v2u*)(yp + 16 * dt) = o; }
}
constexpr int NPH = 9;
__global__ void __launch_bounds__(NWAVES * 64, 2) fwd_kernel(Args args) {
    extern __shared__ __attribute__((aligned(16))) unsigned char lds[];
    Frame F;
    F.lds = (LAS unsigned char*)lds;
    F.MISC = (volatile LAS unsigned*)(F.lds + MISC_OFF);
    F.tid = threadIdx.x; F.lane = F.tid & 63; F.wave = __builtin_amdgcn_readfirstlane(F.tid >> 6); F.wv = F.wave;
    F.G = gridDim.x; F.in = args.in; F.ws = (GAS unsigned char*)args.ws; F.ws0 = args.ws; F.ctl = (unsigned*)(args.ws + WS_CTL);
    for (int u = F.tid; u < (LDS_BYTES - LDSCTL_OFF) / 4; u += NWAVES * 64) ((LAS unsigned*)(F.lds + LDSCTL_OFF))[u] = 0u;
    __syncthreads();
    XcdBarrier bar; bar.bar = F.ctl + CW_BAR; bar.x = 0; bar.st = nullptr;
    if (args.fused) bar = xcd_barrier_post(F.ctl + CW_BAR, F.MISC + 8);
#define GRID_BAR() do { if (args.fused) xcd_barrier(bar, opaque_tid(F.wv)); } while (0)
    const int lo = args.ph_lo, hi = args.ph_hi;
#ifndef PH_MASK
#define PH_MASK 0x1ff
#endif
#define IN(k) (((PH_MASK >> (k)) & 1) && lo <= (k) && (k) < hi)
#define WSP(T, off) ((GAS T*)(ws + (off)))

    if (args.l_lo == 0 && IN(0)) for (int rep = 0; rep < NREP(0); ++rep) { F.refresh(); p0_prologue(F); GRID_BAR(); }

    for (int l = args.l_lo; l < args.l_hi; ++l) {
        if (IN(1)) for (int rep = 0; rep < NREP(1); ++rep) {
            GAS unsigned char* ws = (GAS unsigned char*)opaque_ptr(args.ws); const GAS unsigned char* wl = ws + WS_W + (size_t)l * SZ_WLAYER;
            pg8::Gemm g{WSP(pg8::bf16_t, WS_XB), DM, (const GAS pg8::bf16_t*)(wl + OFF_WIN), DM, DM, 0, 0}; pg8::TileOrder S; S.init(MTOK, NP, F.G, (int)blockIdx.x, 1);
            pg8::EpiInProj E{WSP(pg8::bf16_t, WS_P), WSP(float, WS_SSQ), WSP(pg8::bf16_t, WS_US)};
            pg8::gemm_phase(F.lds, g, S, E, F.wv);
            if (rep == 0) { F.refresh(); cv_tail(F, l, 0); }
            GRID_BAR();
        }
        if (IN(2)) for (int rep = 0; rep < NREP(2); ++rep) {
            F.refresh(); for (int rp = 0; rp < NREP(12); ++rp) for (int u = blockIdx.x; u < 256; u += F.G) s5_s1_unit(F, l, u);
            VM_WAIT(); __syncthreads(); F.refresh(); for (int rp = 0; rp < NREP(13); ++rp) for (int u = blockIdx.x; u < 512; u += F.G) gla_g1_unit(F, l, u);
            VM_WAIT(); __syncthreads(); F.refresh(); for (int rp = 0; rp < NREP(14); ++rp) for (int u = blockIdx.x; u < 256; u += F.G) moba_prep_unit(F, l, u);
            GRID_BAR(); }
        if (IN(3)) for (int rep = 0; rep < NREP(3); ++rep) {
            F.refresh(); for (int rp = 0; rp < NREP(9); ++rp) for (int u = blockIdx.x; u < 256; u += F.G) s5_s3_unit(F, l, u);
            VM_WAIT(); __syncthreads();
            F.refresh(); for (int rp = 0; rp < NREP(10); ++rp) gla_g2_scan(F);
            VM_WAIT(); __syncthreads(); F.refresh();
            for (int rp = 0; rp < NREP(11); ++rp) for (int pi2 = 2 * blockIdx.x; pi2 < 512; pi2 += 2 * F.G) {
#pragma unroll 1
                for (int hh = 0; hh < 2; ++hh) { const int pi = pi2 >> 1; moba_attn_unit3(F, pi >> 3, hh ? (pi & 7) : 15 - (pi & 7)); } }
            GRID_BAR(); }
        if (IN(4)) for (int rep = 0; rep < NREP(4); ++rep) {
            const int gh = F.G >= 2 ? F.G / 2 : 1;
            if ((int)blockIdx.x < gh) {
                GAS unsigned char* ws = (GAS unsigned char*)opaque_ptr(args.ws); const GAS unsigned char* wl = ws + WS_W + (size_t)l * SZ_WLAYER;
                pg8::Gemm g{WSP(pg8::bf16_t, WS_Z), 1024, (const GAS pg8::bf16_t*)(wl + OFF_WGLU), 1024, 1024, 0, 0}; pg8::TileOrder S; S.init(MTOK, 1024, gh, (int)blockIdx.x, 1);
                pg8::EpiGLU E{WSP(pg8::bf16_t, WS_Z), WSP(pg8::bf16_t, WS_Y), ((const GAS float*)args.in[I_BGLU]) + l * 1024};
                pg8::gemm_phase(F.lds, g, S, E, F.wv);
            }
            { F.refresh();
              GAS unsigned* head = (GAS unsigned*)(F.ctl + CW_QUEUE + 64 * l);
              for (;;) { if (F.tid == 0) F.MISC[16] = __hip_atomic_fetch_add(head, 1u, __ATOMIC_RELAXED, __HIP_MEMORY_SCOPE_AGENT);
                  LDS_WAIT(); __syncthreads(); const unsigned uq = F.MISC[16]; __syncthreads();
                  if (uq >= 512u) break; gla_g3_unit(F, l, (int)uq); } }
            GRID_BAR();
        }
        if (IN(5)) for (int rep = 0; rep < NREP(5); ++rep) {
            GAS unsigned char* ws = (GAS unsigned char*)opaque_ptr(args.ws); const GAS unsigned char* wl = ws + WS_W + (size_t)l * SZ_WLAYER;
            pg8::Gemm g{WSP(pg8::bf16_t, WS_Y), YW, (const GAS pg8::bf16_t*)(wl + OFF_WBR), 3072, 1024, 1024, 1024}; pg8::TileOrder S; S.init(MTOK, DM, F.G, (int)blockIdx.x, 3);
            pg8::EpiBranch E{WSP(pg8::bf16_t, WS_P), WSP(pg8::bf16_t, WS_MB)};
            pg8::gemm_phase(F.lds, g, S, E, F.wv);
            GRID_BAR();
        }
        if (IN(6)) {
            GAS unsigned char* ws = (GAS unsigned char*)opaque_ptr(args.ws); const GAS unsigned char* wl = ws + WS_W + (size_t)l * SZ_WLAYER;
            pg8::Gemm g{WSP(pg8::bf16_t, WS_MB), DM, (const GAS pg8::bf16_t*)(wl + OFF_WOUT), DM, DM, 0, 0}; pg8::TileOrder S; S.init(MTOK, DM, F.G, (int)blockIdx.x, 1);
            if (l == 0) { pg8::EpiResid<true, false> E{((const GAS float*)args.in[I_X]), nullptr, WSP(pg8::bf16_t, WS_XB), WSP(float, WS_SSQ)}; pg8::gemm_phase(F.lds, g, S, E, F.wv); }
            else { pg8::EpiResid<false, false> E{nullptr, nullptr, WSP(pg8::bf16_t, WS_XB), WSP(float, WS_SSQ)}; pg8::gemm_phase(F.lds, g, S, E, F.wv); }
            GRID_BAR();
        }
        if (IN(7)) for (int rep = 0; rep < NREP(7); ++rep) {
            GAS unsigned char* ws = (GAS unsigned char*)opaque_ptr(args.ws); const GAS unsigned char* wl = ws + WS_W + (size_t)l * SZ_WLAYER;
            pg8::Gemm g{WSP(pg8::bf16_t, WS_XB), DM, (const GAS pg8::bf16_t*)(wl + OFF_WGU), DM, DM, 0, 0}; pg8::TileOrder S; S.init(MTOK, NGU, F.G, (int)blockIdx.x, 1);
            pg8::EpiFFNUp E{WSP(pg8::bf16_t, WS_H), WSP(float, WS_SSQ)};
            pg8::gemm_phase(F.lds, g, S, E, F.wv);
            if (rep == 0) { F.refresh(); cv_tail(F, l, 1); }
            GRID_BAR();
        }
        if (IN(8)) {
            GAS unsigned char* ws = (GAS unsigned char*)opaque_ptr(args.ws); const GAS unsigned char* wl = ws + WS_W + (size_t)l * SZ_WLAYER;
            pg8::Gemm g{WSP(pg8::bf16_t, WS_H), FFN, (const GAS pg8::bf16_t*)(wl + OFF_WDN), FFN, FFN, 0, 0}; pg8::TileOrder S; S.init(MTOK, DM, F.G, (int)blockIdx.x, 1);
            if (l == DEPTH - 1) { pg8::EpiResid<false, true> E{nullptr, (GAS float*)args.out, WSP(pg8::bf16_t, WS_XB), WSP(float, WS_SSQ)}; pg8::gemm_phase(F.lds, g, S, E, F.wv); }
            else { pg8::EpiResid<false, false> E{nullptr, nullptr, WSP(pg8::bf16_t, WS_XB), WSP(float, WS_SSQ)}; pg8::gemm_phase(F.lds, g, S, E, F.wv); }
            if (l + 1 < DEPTH) GRID_BAR();
        }
    }
#undef IN
#undef GRID_BAR
}

extern "C" void kernel_launch(void* const* d_in, const int* in_sizes, int n_in, void* d_out, int out_size, void* d_ws, size_t ws_size, hipStream_t stream) {
    static int grid = 0;
    if (grid == 0) {
        if (n_in != 26 || out_size != MTOK * DM || ws_size < WS_END) { fprintf(stderr, "kernel_launch: unexpected problem (n_in %d out %d ws %zu need %zu)\n", n_in, out_size, ws_size, (size_t)WS_END); grid = -1; return; }
        int dev = 0, cus = 0, per_cu = 0;
        if (hipGetDevice(&dev) != hipSuccess || hipDeviceGetAttribute(&cus, hipDeviceAttributeMultiprocessorCount, dev) != hipSuccess) { grid = -1; return; }
        if (hipFuncSetAttribute((const void*)fwd_kernel, hipFuncAttributeMaxDynamicSharedMemorySize, LDS_BYTES) != hipSuccess) { fprintf(stderr, "kernel_launch: hipFuncSetAttribute failed\n"); grid = -1; return; }
        if (hipOccupancyMaxActiveBlocksPerMultiprocessor(&per_cu, (const void*)fwd_kernel, NWAVES * 64, LDS_BYTES) != hipSuccess || per_cu < 1) { fprintf(stderr, "kernel_launch: occupancy query says %d\n", per_cu); }
        (void)hipGetLastError();
        grid = cus;
    }
    if (grid < 0) return;
    if (hipMemsetAsync((char*)d_ws + WS_CTL, 0, CTL_ZERO_BYTES, stream) != hipSuccess) return;
    Args a{};
    for (int i = 0; i < 26; ++i) a.in[i] = (const float*)d_in[i];
    a.out = (float*)d_out; a.ws = (unsigned char*)d_ws; a.pad = 0;
#if MK_FUSED
    a.l_lo = 0; a.l_hi = DEPTH; a.ph_lo = 0; a.ph_hi = NPH; a.fused = 1;
    hipLaunchKernelGGL(fwd_kernel, dim3(grid), dim3(NWAVES * 64), LDS_BYTES, stream, a);
#else
    a.fused = 0;
    for (int l = 0; l < DEPTH; ++l)
        for (int ph = (l == 0 ? 0 : 1); ph < NPH; ++ph) { a.l_lo = l; a.l_hi = l + 1; a.ph_lo = ph; a.ph_hi = ph + 1; hipLaunchKernelGGL(fwd_kernel, dim3(grid), dim3(NWAVES * 64), LDS_BYTES, stream, a); }
#endif
}
```

```cpp
#include <hip/hip_runtime.h>
#include <cstdio>
#include <cstdint>

#ifndef REPEAT_MASK
#define REPEAT_MASK 0
#endif
#define NREP(k) (1 + ((REPEAT_MASK >> (k)) & 1))
#ifndef MK_FUSED
#define MK_FUSED 1
#endif

__device__ __forceinline__ unsigned char* opaque_ptr(unsigned char* p) { asm volatile("" : "+s"(p)); return p; }
__device__ __forceinline__ int opaque_tid(int wv) { int ln; asm volatile("v_mbcnt_lo_u32_b32 %0, -1, 0\n\tv_mbcnt_hi_u32_b32 %0, -1, %0" : "=v"(ln)); return (wv << 6) | ln; }

namespace pg8 {
#define PG8_LAS __attribute__((address_space(3)))
typedef unsigned short bf16_t;
typedef short bf16x8 __attribute__((ext_vector_type(8)));
typedef float f32x4 __attribute__((ext_vector_type(4)));
typedef unsigned u32x4 __attribute__((ext_vector_type(4)));
typedef unsigned u32x2 __attribute__((ext_vector_type(2)));
constexpr int BM = 256, BK = 64, HALF = 128, HTB = HALF * BK * 2, STAGE_BYTES = 8 * HTB, NXCD = 8, WGM = 8;

__host__ __device__ __forceinline__ int lds_byte(int r, int c) { const int st = (r >> 4) * 2 + (c >> 5), rr = r & 15, cc = c & 31, ob = rr * 64 + cc * 2; return st * 1024 + (ob ^ (((ob >> 9) & 1) << 5)); }
__host__ __device__ __forceinline__ void stage_rc(int b, int& R, int& C) { const int st = b / 1024, sb = b % 1024, swz = sb ^ (((sb >> 9) & 1) << 5); R = (st >> 1) * 16 + swz / 64; C = (st & 1) * 32 + (swz % 64) / 2; }
__host__ __device__ __forceinline__ int perm32(int rho) { const int n = rho >> 4, i = rho & 15; return 8 * (i >> 2) + 4 * n + (i & 3); }

struct Unit { int pm, pn, br; };
struct Gemm { const __attribute__((address_space(1))) bf16_t* A; int lda; const __attribute__((address_space(1))) bf16_t* Bt; int ldb; int K; int abr, bbr; };

struct TileOrder {
    int nM, nN, nwg, G, c, nbr;
    __device__ __forceinline__ void init(int M, int N, int G_, int c_, int nbr_) { asm volatile("" : "+s"(G_), "+s"(c_)); nM = M / BM; nN = N / BM; nwg = nM * nN; G = G_; c = c_; nbr = nbr_; }
    __device__ __forceinline__ bool next(int i, Unit& u) const {
        const int it = i / nbr; u.br = i - it * nbr;
        const long L = (long)it * G + c; if (L >= nwg) return false;
        int wgid = (int)L; { const int q = nwg / NXCD, r = nwg % NXCD, xcd = wgid % NXCD, off = wgid / NXCD; wgid = (xcd < r ? xcd * (q + 1) : r * (q + 1) + (xcd - r) * q) + off; }
        const int nig = WGM * nN, gid = wgid / nig, fm = gid * WGM, gsz = (nM - fm) < WGM ? (nM - fm) : WGM;
        u.pm = __builtin_amdgcn_readfirstlane(fm + ((wgid % nig) % gsz)); u.pn = __builtin_amdgcn_readfirstlane((wgid % nig) / gsz); return true;
    }
};

__device__ __forceinline__ unsigned cvt_pk_bf16(float lo, float hi) { unsigned r; asm volatile("v_cvt_pk_bf16_f32 %0, %1, %2" : "=v"(r) : "v"(lo), "v"(hi)); return r; }

template <class Epi, class Sched>
__device__ __forceinline__ void gemm_phase(PG8_LAS unsigned char* lds, const Gemm g, const Sched& S, const Epi& E, int wv) {
    const int tid = opaque_tid(wv), wid = __builtin_amdgcn_readfirstlane(tid >> 6), lane = tid & 63, wr = wid >> 2, wc = wid & 3, fr = lane & 15, fq = lane >> 4;
    const int K = g.K, nt = K / BK;
    unsigned voffA[2], voffB[2];
#pragma unroll
    for (int i = 0; i < 2; ++i) { int R, C; stage_rc(tid * 16 + i * 8192, R, C); const int Rb = (R & ~31) + perm32(R & 31);
        voffA[i] = (unsigned)(R * g.lda + C) * 2u; voffB[i] = (unsigned)(Rb * g.ldb + C) * 2u; }
    const size_t kstep = (size_t)(BK * 2);
    const size_t hstepA = (size_t)HALF * g.lda * 2, hstepB = (size_t)HALF * g.ldb * 2;
    const size_t tstepA = 2 * hstepA, tstepB = 2 * hstepB;
    const unsigned ldsw = (unsigned)wid * 1024u;
    const int aoff = lds_byte(wr * 64 + fr, fq * 8), boff = lds_byte(wc * 32 + fr, fq * 8);
#define PG8_SA(b, h) (((b) * 2 + (h)) * HTB)
#define PG8_SB(b, h) ((4 + (b) * 2 + (h)) * HTB)
#define PG8_STAGE(bufoff, gbase, voff) do { _Pragma("unroll") for (int _i = 0; _i < 2; ++_i) \
        __builtin_amdgcn_global_load_lds((const unsigned*)((const char*)(gbase) + (voff)[_i]), (PG8_LAS unsigned*)(lds + (bufoff) + ldsw + _i * 8192), 16, 0, 0); } while (0)
#define PG8_LDA(dst, b, h) do { _Pragma("unroll") for (int m = 0; m < 4; ++m) _Pragma("unroll") for (int k = 0; k < 2; ++k) dst[m][k] = *(const PG8_LAS bf16x8*)(lds + PG8_SA(b, h) + aoff + m * 2048 + k * 1024); } while (0)
#define PG8_LDB(dst, b, h) do { _Pragma("unroll") for (int n = 0; n < 2; ++n) _Pragma("unroll") for (int k = 0; k < 2; ++k) dst[n][k] = *(const PG8_LAS bf16x8*)(lds + PG8_SB(b, h) + boff + n * 2048 + k * 1024); } while (0)
#define PG8_MMA(ai, bj, At, Bt) do { __builtin_amdgcn_s_setprio(1); _Pragma("unroll") for (int m = 0; m < 4; ++m) _Pragma("unroll") for (int n = 0; n < 2; ++n) _Pragma("unroll") for (int k = 0; k < 2; ++k) \
        acc[ai][bj][m][n] = __builtin_amdgcn_mfma_f32_16x16x32_bf16(Bt[n][k], At[m][k], acc[ai][bj][m][n], 0, 0, 0); __builtin_amdgcn_s_setprio(0); } while (0)
#define PG8_WAIT_V(n) asm volatile("s_waitcnt vmcnt(" #n ")" ::: "memory")
#define PG8_WAIT_L(n) asm volatile("s_waitcnt lgkmcnt(" #n ")" ::: "memory")
#define PG8_BAR __builtin_amdgcn_s_barrier()
#define PG8_SCHED __builtin_amdgcn_sched_barrier(0)
    Unit cur, nxt; int ui = 0;
    if (!S.next(0, cur)) return;
    f32x4 acc[2][2][4][2];
#pragma unroll
    for (int a = 0; a < 2; ++a)
#pragma unroll
        for (int b = 0; b < 2; ++b)
#pragma unroll
            for (int m = 0; m < 4; ++m)
#pragma unroll
                for (int n = 0; n < 2; ++n) acc[a][b][m][n] = (f32x4){0.f, 0.f, 0.f, 0.f};
    bf16x8 At[4][2], B0[2][2], B1[2][2];
    const char* cA = (const char*)g.A + (size_t)cur.pm * tstepA + (size_t)cur.br * g.abr * 2; const char* cB = (const char*)g.Bt + (size_t)cur.pn * tstepB + (size_t)cur.br * g.bbr * 2;
    PG8_STAGE(PG8_SB(0, 0), cB, voffB); PG8_STAGE(PG8_SB(0, 1), cB + hstepB, voffB); PG8_STAGE(PG8_SA(0, 0), cA, voffA); PG8_STAGE(PG8_SA(0, 1), cA + hstepA, voffA);
    if (wr == 1) PG8_BAR;
    PG8_WAIT_V(2); PG8_BAR;
    PG8_STAGE(PG8_SB(1, 0), cB + kstep, voffB); PG8_STAGE(PG8_SA(1, 0), cA + kstep, voffA); PG8_STAGE(PG8_SB(1, 1), cB + hstepB + kstep, voffB);
    PG8_WAIT_V(6); PG8_BAR;
    for (;;) {
        const bool has_next = S.next(ui + 1, nxt);
        const char* nA = has_next ? (const char*)g.A + (size_t)nxt.pm * tstepA + (size_t)nxt.br * g.abr * 2 : cA; const char* nB = has_next ? (const char*)g.Bt + (size_t)nxt.pn * tstepB + (size_t)nxt.br * g.bbr * 2 : cB;
        for (int t = 0; t < nt; t += 2) {
            const bool last = (t == nt - 2);
            const char* a1 = cA + (size_t)(t + 1) * kstep;
            const char* a2 = last ? nA : cA + (size_t)(t + 2) * kstep; const char* b2 = last ? nB : cB + (size_t)(t + 2) * kstep;
            const char* a3 = a2 + kstep; const char* b3 = b2 + kstep;
            PG8_LDB(B0, 0, 0); PG8_LDB(B1, 0, 1); PG8_SCHED; PG8_LDA(At, 0, 0); PG8_STAGE(PG8_SA(1, 1), a1 + hstepA, voffA);
            PG8_WAIT_V(8); PG8_WAIT_L(0); PG8_BAR; PG8_MMA(0, 0, At, B0); PG8_MMA(0, 1, At, B1); PG8_BAR; PG8_SCHED;
            PG8_LDA(At, 0, 1); PG8_STAGE(PG8_SB(0, 0), b2, voffB); PG8_STAGE(PG8_SB(0, 1), b2 + hstepB, voffB); PG8_STAGE(PG8_SA(0, 0), a2, voffA);
            PG8_WAIT_V(8); PG8_WAIT_L(0); PG8_BAR; PG8_MMA(1, 0, At, B0); PG8_MMA(1, 1, At, B1); PG8_BAR; PG8_SCHED;
            PG8_LDB(B0, 1, 0); PG8_LDB(B1, 1, 1); PG8_SCHED; PG8_LDA(At, 1, 0); PG8_STAGE(PG8_SA(0, 1), a2 + hstepA, voffA);
            PG8_WAIT_V(8); PG8_WAIT_L(0); PG8_BAR; PG8_MMA(0, 0, At, B0); PG8_MMA(0, 1, At, B1); PG8_BAR; PG8_SCHED;
            PG8_LDA(At, 1, 1); PG8_STAGE(PG8_SB(1, 0), b3, voffB); PG8_STAGE(PG8_SB(1, 1), b3 + hstepB, voffB); PG8_STAGE(PG8_SA(1, 0), a3, voffA);
            PG8_WAIT_V(8); PG8_WAIT_L(0); PG8_BAR; PG8_MMA(1, 0, At, B0); PG8_MMA(1, 1, At, B1); PG8_BAR; PG8_SCHED;
        }
        if (wr == 0) PG8_BAR;
        E(acc, cur, wr, wc, fr, fq, lds);
        if (!has_next) break;
        if (!Epi::CHAIN || cur.br == S.nbr - 1) {
#pragma unroll
        for (int a = 0; a < 2; ++a)
#pragma unroll
            for (int b = 0; b < 2; ++b)
#pragma unroll
                for (int m = 0; m < 4; ++m)
#pragma unroll
                    for (int n = 0; n < 2; ++n) acc[a][b][m][n] = (f32x4){0.f, 0.f, 0.f, 0.f};
        }
        cur = nxt; cA = nA; cB = nB; ++ui;
        if (wr == 1) PG8_BAR;
    }
    PG8_WAIT_V(0);
    PG8_BAR;
#undef PG8_SA
#undef PG8_SB
#undef PG8_STAGE
#undef PG8_LDA
#undef PG8_LDB
#undef PG8_MMA
#undef PG8_WAIT_V
#undef PG8_WAIT_L
#undef PG8_BAR
#undef PG8_SCHED
}
}

constexpr int NWAVES = 8;
constexpr int DM = 2048, NBATCH = 4, SEQ = 2048, DEPTH = 4, MTOK = NBATCH * SEQ;
constexpr int INW = 13328;
constexpr int NP = 13568;
constexpr int PC_SSM = 0, PC_GQ = 1024, PC_GK = 1536, PC_GV = 2048, PC_GR = 3072, PC_MQ = 4096, PC_MK = 5120, PC_MV = 6144, PC_GS = 7168, PC_GLR = 13312;
constexpr int FFN = 5632, NGU = 2 * FFN;
constexpr int YW = 3072;
constexpr float RMS_EPS = 1e-6f;

constexpr size_t MiB = 1u << 20;
constexpr size_t WS_CTL = 0, CTL_ZERO_BYTES = 1 * MiB;
constexpr size_t SZ_WIN = (size_t)NP * DM * 2, SZ_WGLU = (size_t)1024 * 1024 * 2, SZ_WBR = (size_t)DM * 3072 * 2, SZ_WOUT = (size_t)DM * DM * 2, SZ_WGU = (size_t)NGU * DM * 2, SZ_WDN = (size_t)DM * FFN * 2;
constexpr size_t OFF_WIN = 0, OFF_WGLU = OFF_WIN + SZ_WIN, OFF_WBR = OFF_WGLU + SZ_WGLU, OFF_WOUT = OFF_WBR + SZ_WBR, OFF_WGU = OFF_WOUT + SZ_WOUT, OFF_WDN = OFF_WGU + SZ_WGU, SZ_WLAYER = OFF_WDN + SZ_WDN;
constexpr size_t WS_W = 2 * MiB;
constexpr size_t WS_P = WS_W + ((DEPTH * SZ_WLAYER + MiB - 1) / MiB) * MiB;
constexpr size_t WS_Z = WS_P + (size_t)MTOK * NP * 2;
constexpr size_t WS_Y = WS_Z + (size_t)MTOK * 1024 * 2;
constexpr size_t WS_MB = WS_Y + (size_t)MTOK * YW * 2;
constexpr size_t WS_XB = WS_MB + (size_t)MTOK * DM * 2;
constexpr size_t WS_H = WS_XB + (size_t)MTOK * DM * 2;
constexpr size_t WS_SSQ = WS_H + (size_t)MTOK * FFN * 2;
constexpr size_t WS_QN = WS_SSQ + (size_t)MTOK * 8 * 4;
constexpr size_t WS_KN = WS_QN + (size_t)MTOK * 1024 * 2;
constexpr size_t WS_KM = WS_KN + (size_t)MTOK * 1024 * 2;
constexpr size_t WS_TK = WS_KM + (size_t)4 * 8 * 8 * 128 * 4;
constexpr size_t WS_TW = WS_TK + (size_t)DEPTH * 64 * 64 * 256 * 2;
constexpr size_t WS_TC = WS_TW + (size_t)DEPTH * 64 * 128 * 1024 * 2;
constexpr size_t WS_A64 = WS_TC + (size_t)DEPTH * 64 * 1024 * 128 * 2;
constexpr size_t WS_SL = WS_A64 + (size_t)DEPTH * 64 * 128 * 4;
constexpr size_t WS_QD = WS_SL + (size_t)NBATCH * 32 * 64 * 128 * 4;
constexpr size_t WS_KI = WS_QD + (size_t)512 * 64 * 128 * 2;
constexpr size_t WS_GVT = WS_KI + (size_t)512 * 64 * 128 * 2;
constexpr size_t WS_KV = WS_GVT + (size_t)512 * 256 * 64 * 2;
constexpr size_t WS_DEC = WS_KV + (size_t)512 * 256 * 128 * 2;
constexpr size_t WS_ST = WS_DEC + (size_t)512 * 128 * 4;
constexpr size_t WS_VT = WS_ST + (size_t)512 * 256 * 128 * 2;
constexpr size_t WS_US = WS_VT + (size_t)NBATCH * 8 * 128 * SEQ * 2;
constexpr size_t WS_END = WS_US + (size_t)MTOK * 1024 * 2;
constexpr int CW_BAR = 4096;
constexpr int CW_QUEUE = 16384;

constexpr int RING_BYTES = 135168;
constexpr int LDSCTL_OFF = RING_BYTES, MISC_OFF = LDSCTL_OFF + 320;
constexpr int TAB_OFF = RING_BYTES + 1024;
constexpr int LDS_BYTES = 147456;

#define GAS __attribute__((address_space(1)))
#define LAS __attribute__((address_space(3)))
typedef unsigned short bf16;
typedef unsigned v4u __attribute__((ext_vector_type(4)));
typedef unsigned v2u __attribute__((ext_vector_type(2)));
typedef float f32x4 __attribute__((ext_vector_type(4)));
typedef float f32x2 __attribute__((ext_vector_type(2)));
#define LDS_WAIT() asm volatile("s_waitcnt lgkmcnt(0)" ::: "memory")
#define VM_WAIT() asm volatile("s_waitcnt vmcnt(0)" ::: "memory")
__device__ __forceinline__ unsigned f2bf(float f) { unsigned u = __builtin_bit_cast(unsigned, f); return (u + 0x7fffu + ((u >> 16) & 1u)) >> 16; }
__device__ __forceinline__ unsigned pk2(float lo, float hi) { return f2bf(lo) | (f2bf(hi) << 16); }
__device__ __forceinline__ float bflo(unsigned u) { return __builtin_bit_cast(float, u << 16); }
__device__ __forceinline__ float bfhi(unsigned u) { return __builtin_bit_cast(float, u & 0xffff0000u); }
__device__ __forceinline__ float bf1(bf16 b) { return __builtin_bit_cast(float, ((unsigned)b) << 16); }
__device__ __forceinline__ float sigmoidf_(float x) { return __builtin_amdgcn_rcpf(1.0f + __expf(-x)); }
__device__ __forceinline__ float gelu_tanh(float x) { const float u = 0.7978845608028654f * (x + 0.044715f * x * x * x); return x * sigmoidf_(2.0f * u); }
__device__ __forceinline__ float wave_sum(float v) {
#pragma unroll
    for (int o = 1; o < 64; o <<= 1) v += __shfl_xor(v, o);
    return v;
}
__device__ __forceinline__ float wave_max(float v) {
#pragma unroll
    for (int o = 1; o < 64; o <<= 1) v = fmaxf(v, __shfl_xor(v, o));
    return v;
}

#define XB_TMO      128
#define XB_XCNT(j)  (256  + 64 * (j))
#define XB_XSUB(j)  (1280 + 64 * (j))
#define XB_XGEN(j)  (2304 + 64 * (j))
#define XB_TOP      3328
#define XB_TOPGEN   3392
#define XCD_BAR_WORDS 3456
#define XB_SPIN_CAP (1u << 18)
__device__ __forceinline__ unsigned xb_ld(unsigned* p)              { return __hip_atomic_load(p, __ATOMIC_RELAXED, __HIP_MEMORY_SCOPE_AGENT); }
__device__ __forceinline__ unsigned xb_add(unsigned* p, unsigned v) { return __hip_atomic_fetch_add(p, v, __ATOMIC_RELAXED, __HIP_MEMORY_SCOPE_AGENT); }
__device__ __forceinline__ unsigned xb_xcc_id() { return (unsigned)__builtin_amdgcn_s_getreg((3 << 11) | 20) & 0xFu; }
#define XB_SPIN(cond, bar) do { unsigned _sp = 0; while (cond) { __builtin_amdgcn_s_sleep(1); \
    if ((++_sp & 255u) == 0u) { if (xb_ld(&(bar)[XB_TMO])) break; if (_sp > XB_SPIN_CAP) { atomicAdd(&(bar)[XB_TMO], 1u); break; } } } } while (0)
struct XcdBarrier { unsigned* bar; unsigned x; volatile LAS unsigned* st; };
__device__ __forceinline__ XcdBarrier xcd_barrier_post(unsigned* bar, volatile LAS unsigned* st) {
    XcdBarrier b; b.bar = bar; b.x = xb_xcc_id(); b.st = st;
    if (threadIdx.x == 0) (void)xb_add(&bar[XB_XCNT(b.x)], 1u);
    return b;
}
__device__ __forceinline__ void xcd_barrier_complete(unsigned* bar, unsigned x, unsigned& nloc, unsigned& nx) {
    const unsigned G = gridDim.x * gridDim.y * gridDim.z;
    unsigned sum, cnt, mine, sp = 0u;
    for (;;) {
        sum = 0u; cnt = 0u; mine = 0u;
#pragma unroll
        for (unsigned j = 0; j < 16; ++j) { const unsigned c = xb_ld(&bar[XB_XCNT(j)]); sum += c; cnt += (c > 0u) ? 1u : 0u; mine = (j == x) ? c : mine; }
        if (sum == G) break;
        __builtin_amdgcn_s_sleep(1);
        if ((++sp & 255u) == 0u) { if (xb_ld(&bar[XB_TMO])) break; if (sp > XB_SPIN_CAP) { atomicAdd(&bar[XB_TMO], 1u); break; } }
    }
    nloc = mine > 0u ? mine : 1u; nx = cnt > 0u ? cnt : 1u;
}
__device__ __forceinline__ void xcd_barrier(const XcdBarrier& b, int tid) {
    asm volatile("s_waitcnt vmcnt(0)" ::: "memory");
    __syncthreads();
    if (tid == 0) {
        unsigned* bar = b.bar;
        __builtin_amdgcn_s_waitcnt(0);
        unsigned nloc = b.st[0], nx = b.st[1];
        if (nloc == 0u) { xcd_barrier_complete(bar, b.x, nloc, nx); b.st[0] = nloc; b.st[1] = nx; }
        const unsigned old = xb_add(&bar[XB_XSUB(b.x)], 1u);
        const unsigned gen = old / nloc;
        if (old + 1u == (gen + 1u) * nloc) {
            __builtin_amdgcn_fence(__ATOMIC_RELEASE, "agent");
            asm volatile("s_waitcnt vmcnt(0)" ::: "memory");
            const unsigned og = xb_add(&bar[XB_TOP], 1u);
            const unsigned tg = og / nx;
            if (og + 1u == (tg + 1u) * nx) xb_add(&bar[XB_TOPGEN], 1u);
            else XB_SPIN(xb_ld(&bar[XB_TOPGEN]) == tg, bar);
            __builtin_amdgcn_fence(__ATOMIC_ACQUIRE, "agent");
            xb_add(&bar[XB_XGEN(b.x)], 1u);
            asm volatile("s_waitcnt vmcnt(0)" ::: "memory");
        } else {
            XB_SPIN(xb_ld(&bar[XB_XGEN(b.x)]) == gen, bar);
            __builtin_amdgcn_fence(__ATOMIC_ACQUIRE, "agent");
            asm volatile("s_waitcnt vmcnt(0)" ::: "memory");
        }
    }
    __syncthreads();
}

struct Args {
    const float* in[26];
    float* out; unsigned char* ws;
    int l_lo, l_hi, ph_lo, ph_hi;
    int fused, pad;
};
enum { I_X = 0, I_N1G, I_WIN, I_LRE, I_LIM, I_LDT, I_BRE, I_BIM, I_CRE, I_CIM, I_SD, I_WGLU, I_BGLU, I_GW2, I_GB2, I_GNG, I_MQG, I_MKG, I_WBS, I_WBG, I_WBM, I_WOUT, I_N2G, I_FWG, I_FWU, I_FWD };

namespace pg8 {
#define EPI_FENCE() asm volatile("" ::: "memory")
__device__ __forceinline__ void load_rstd(const GAS float* ssq, int pm, int wr, int fr, int fq, float (&rs)[2][4]) {
    f32x2 p[2][4];
#pragma unroll
    for (int ai = 0; ai < 2; ++ai)
#pragma unroll
        for (int m = 0; m < 4; ++m) { const int row = pm * BM + ai * HALF + wr * 64 + m * 16 + fr; p[ai][m] = *(const GAS f32x2*)(ssq + (size_t)row * 8 + 2 * fq); }
#pragma unroll
    for (int ai = 0; ai < 2; ++ai)
#pragma unroll
        for (int m = 0; m < 4; ++m) { float s = p[ai][m][0] + p[ai][m][1]; s += __shfl_xor(s, 16); s += __shfl_xor(s, 32); rs[ai][m] = 1.0f / sqrtf(s * (1.0f / DM) + RMS_EPS); }
    EPI_FENCE();
}
struct EpiInProj {
    static constexpr bool CHAIN = false;
    GAS bf16_t* P; const GAS float* ssq; GAS bf16_t* US;
    __device__ __forceinline__ void operator()(const f32x4 (&acc)[2][2][4][2], const Unit& u, int wr, int wc, int fr, int fq, PG8_LAS unsigned char*) const {
        float rs[2][4]; load_rstd(ssq, u.pm, wr, fr, fq, rs);
        const int row0 = u.pm * BM + wr * 64 + fr, col0 = u.pn * BM + wc * 32 + 8 * fq;
        const bool ssm = u.pn < 4;
#pragma unroll
        for (int ai = 0; ai < 2; ++ai)
#pragma unroll
            for (int m = 0; m < 4; ++m) { const int row = row0 + ai * HALF + m * 16; GAS bf16_t* rowp = P + (size_t)row * NP + col0; const float r = rs[ai][m];
#pragma unroll
                for (int bj = 0; bj < 2; ++bj) { const f32x4 v0 = acc[ai][bj][m][0] * r, v1 = acc[ai][bj][m][1] * r;
                    u32x4 w; w.x = cvt_pk_bf16(v0[0], v0[1]); w.y = cvt_pk_bf16(v0[2], v0[3]); w.z = cvt_pk_bf16(v1[0], v1[1]); w.w = cvt_pk_bf16(v1[2], v1[3]);
                    if (ssm) { const int col = col0 + bj * HALF; *(GAS u32x4*)(US + ((size_t)((row >> 11) * 64 + (col >> 4)) * SEQ + (row & (SEQ - 1))) * 16 + (col & 8)) = w; }
                    else *(GAS u32x4*)(rowp + bj * HALF) = w; } }
    }
};
struct EpiGLU {
    static constexpr bool CHAIN = false;
    const GAS bf16_t* Z; GAS bf16_t* Y; const GAS float* bias;
    __device__ __forceinline__ void operator()(const f32x4 (&acc)[2][2][4][2], const Unit& u, int wr, int wc, int fr, int fq, PG8_LAS unsigned char*) const {
        const int row0 = u.pm * BM + wr * 64 + fr, col0 = u.pn * BM + wc * 32 + 8 * fq;
        f32x4 bv[2][2];
#pragma unroll
        for (int bj = 0; bj < 2; ++bj)
#pragma unroll
            for (int n = 0; n < 2; ++n) bv[bj][n] = *(const GAS f32x4*)(bias + col0 + bj * HALF + 4 * n);
        u32x4 zb[4][2];
#pragma unroll
        for (int bt = 0; bt < 2; ++bt) {
#pragma unroll
            for (int i4 = 0; i4 < 4; ++i4) { const int idx = 4 * bt + i4; const size_t row = (size_t)(row0 + (idx >> 2) * HALF + (idx & 3) * 16);
#pragma unroll
                for (int bj = 0; bj < 2; ++bj) zb[i4][bj] = *(const GAS u32x4*)(Z + row * 1024 + col0 + bj * HALF); }
#pragma unroll
            for (int i4 = 0; i4 < 4; ++i4) { const int idx = 4 * bt + i4, ai = idx >> 2, m = idx & 3; const size_t row = (size_t)(row0 + ai * HALF + m * 16);
#pragma unroll
                for (int bj = 0; bj < 2; ++bj) { const u32x4 zz = zb[i4][bj];
                    const f32x4 g0 = acc[ai][bj][m][0] + bv[bj][0], g1 = acc[ai][bj][m][1] + bv[bj][1];
                    u32x4 w;
                    w.x = cvt_pk_bf16(bflo(zz.x) * sigmoidf_(g0[0]), bfhi(zz.x) * sigmoidf_(g0[1])); w.y = cvt_pk_bf16(bflo(zz.y) * sigmoidf_(g0[2]), bfhi(zz.y) * sigmoidf_(g0[3]));
                    w.z = cvt_pk_bf16(bflo(zz.z) * sigmoidf_(g1[0]), bfhi(zz.z) * sigmoidf_(g1[1])); w.w = cvt_pk_bf16(bflo(zz.w) * sigmoidf_(g1[2]), bfhi(zz.w) * sigmoidf_(g1[3]));
                    *(GAS u32x4*)(Y + row * YW + col0 + bj * HALF) = w; } }
            EPI_FENCE();
        }
    }
};
struct EpiBranch {
    static constexpr bool CHAIN = true;
    const GAS bf16_t* P; GAS bf16_t* MB;
    __device__ __forceinline__ void operator()(f32x4 (&acc)[2][2][4][2], const Unit& u, int wr, int wc, int fr, int fq, PG8_LAS unsigned char*) const {
        const int row0 = u.pm * BM + wr * 64 + fr, col0 = u.pn * BM + wc * 32 + 8 * fq;
        const int br = u.br;
        u32x4 ga[2][2], gb[2][2];
#pragma unroll
        for (int bt = 0; bt < 4; ++bt) {
#pragma unroll
            for (int i4 = 0; i4 < 2; ++i4) { const int idx = 2 * bt + i4; const size_t row = (size_t)(row0 + (idx >> 2) * HALF + (idx & 3) * 16);
#pragma unroll
                for (int bj = 0; bj < 2; ++bj) { const GAS bf16_t* gp = P + row * NP + PC_GS + br * DM + col0 + bj * HALF; ga[i4][bj] = *(const GAS u32x4*)gp; if (br != 2) gb[i4][bj] = *(const GAS u32x4*)(gp + DM); } }
#pragma unroll
            for (int i4 = 0; i4 < 2; ++i4) { const int idx = 2 * bt + i4, ai = idx >> 2, m = idx & 3; const size_t row = (size_t)(row0 + ai * HALF + m * 16);
#pragma unroll
                for (int bj = 0; bj < 2; ++bj) { const u32x4 g0 = ga[i4][bj]; const unsigned g0w[4] = {g0.x, g0.y, g0.z, g0.w}; float f[8];
                    if (br != 2) { const u32x4 g1 = gb[i4][bj]; const unsigned g1w[4] = {g1.x, g1.y, g1.z, g1.w};
#pragma unroll
                        for (int e = 0; e < 4; ++e) { f[2 * e] = (1.0f + __expf(-bflo(g1w[e]))) * __builtin_amdgcn_rcpf(1.0f + __expf(-bflo(g0w[e]))); f[2 * e + 1] = (1.0f + __expf(-bfhi(g1w[e]))) * __builtin_amdgcn_rcpf(1.0f + __expf(-bfhi(g0w[e]))); } }
                    else {
#pragma unroll
                        for (int e = 0; e < 4; ++e) { f[2 * e] = sigmoidf_(bflo(g0w[e])); f[2 * e + 1] = sigmoidf_(bfhi(g0w[e])); } }
                    f32x4 v0 = acc[ai][bj][m][0], v1 = acc[ai][bj][m][1];
                    v0[0] *= f[0]; v0[1] *= f[1]; v0[2] *= f[2]; v0[3] *= f[3]; v1[0] *= f[4]; v1[1] *= f[5]; v1[2] *= f[6]; v1[3] *= f[7];
                    if (br != 2) { acc[ai][bj][m][0] = v0; acc[ai][bj][m][1] = v1; }
                    else { u32x4 w; w.x = cvt_pk_bf16(v0[0], v0[1]); w.y = cvt_pk_bf16(v0[2], v0[3]); w.z = cvt_pk_bf16(v1[0], v1[1]); w.w = cvt_pk_bf16(v1[2], v1[3]); *(GAS u32x4*)(MB + row * DM + col0 + bj * HALF) = w; } } }
            EPI_FENCE();
        }
    }
};
template <bool FIRST, bool LAST> struct EpiResid {
    static constexpr bool CHAIN = false;
    const GAS float* xin; GAS float* xout; GAS bf16_t* XB; GAS float* ssq;
    __device__ __forceinline__ void operator()(const f32x4 (&acc)[2][2][4][2], const Unit& u, int wr, int wc, int fr, int fq, PG8_LAS unsigned char* lds) const {
        const int row0 = u.pm * BM + wr * 64 + fr, col0 = u.pn * BM + wc * 32 + 8 * fq;
        PG8_LAS float* T = (PG8_LAS float*)(lds + TAB_OFF);
        f32x4 xf[FIRST ? 4 : 1][2][2]; u32x4 xh[FIRST ? 1 : 8][2];
#pragma unroll
        for (int bt = 0; bt < (FIRST ? 2 : 1); ++bt) {
#pragma unroll
            for (int i4 = 0; i4 < (FIRST ? 4 : 8); ++i4) { const int idx = (FIRST ? 4 * bt : 0) + i4; const size_t row = (size_t)(row0 + (idx >> 2) * HALF + (idx & 3) * 16);
#pragma unroll
                for (int bj = 0; bj < 2; ++bj) { const size_t o = row * DM + col0 + bj * HALF;
                    if (FIRST) { xf[i4 & 3][bj][0] = *(const GAS f32x4*)(xin + o); xf[i4 & 3][bj][1] = *(const GAS f32x4*)(xin + o + 4); } else xh[FIRST ? 0 : i4][bj] = *(const GAS u32x4*)(XB + o); } }
#pragma unroll
            for (int i4 = 0; i4 < (FIRST ? 4 : 8); ++i4) { const int idx = (FIRST ? 4 * bt : 0) + i4, ai = idx >> 2, m = idx & 3; const size_t row = (size_t)(row0 + ai * HALF + m * 16); float s = 0.f;
#pragma unroll
                for (int bj = 0; bj < 2; ++bj) { const size_t o = row * DM + col0 + bj * HALF; f32x4 v0, v1;
                    if (FIRST) { v0 = acc[ai][bj][m][0] + xf[i4 & 3][bj][0]; v1 = acc[ai][bj][m][1] + xf[i4 & 3][bj][1]; }
                    else { const u32x4 h = xh[FIRST ? 0 : i4][bj]; v0 = acc[ai][bj][m][0] + (f32x4){bflo(h.x), bfhi(h.x), bflo(h.y), bfhi(h.y)}; v1 = acc[ai][bj][m][1] + (f32x4){bflo(h.z), bfhi(h.z), bflo(h.w), bfhi(h.w)}; }
                    if (LAST) { *(GAS f32x4*)(xout + o) = v0; *(GAS f32x4*)(xout + o + 4) = v1; }
                    else { u32x4 w; w.x = cvt_pk_bf16(v0[0], v0[1]); w.y = cvt_pk_bf16(v0[2], v0[3]); w.z = cvt_pk_bf16(v1[0], v1[1]); w.w = cvt_pk_bf16(v1[2], v1[3]); *(GAS u32x4*)(XB + o) = w;
                        v0 = (f32x4){bflo(w.x), bfhi(w.x), bflo(w.y), bfhi(w.y)}; v1 = (f32x4){bflo(w.z), bfhi(w.z), bflo(w.w), bfhi(w.w)}; }
                    s += (v0[0] * v0[0] + v0[1] * v0[1]) + (v0[2] * v0[2] + v0[3] * v0[3]) + (v1[0] * v1[0] + v1[1] * v1[1]) + (v1[2] * v1[2] + v1[3] * v1[3]); }
                if (!LAST) { s += __shfl_xor(s, 16); s += __shfl_xor(s, 32);
                    if (fq == 0) T[(ai * HALF + wr * 64 + m * 16 + fr) * 4 + wc] = s; } }
            EPI_FENCE();
        }
        if (!LAST) {
            asm volatile("s_waitcnt lgkmcnt(0)" ::: "memory"); __builtin_amdgcn_s_barrier(); asm volatile("" ::: "memory");
            const int t = (wr * 4 + wc) * 64 + fq * 16 + fr;
            if (t < 256) { const f32x4 p = *(const PG8_LAS f32x4*)(T + t * 4); ssq[(size_t)(u.pm * BM + t) * 8 + u.pn] = (p[0] + p[1]) + (p[2] + p[3]); }
        }
    }
};
struct EpiFFNUp {
    static constexpr bool CHAIN = false;
    GAS bf16_t* H; const GAS float* ssq;
    __device__ __forceinline__ void operator()(const f32x4 (&acc)[2][2][4][2], const Unit& u, int wr, int wc, int fr, int fq, PG8_LAS unsigned char*) const {
        float rs[2][4]; load_rstd(ssq, u.pm, wr, fr, fq, rs);
        const int row0 = u.pm * BM + wr * 64 + fr, col0 = u.pn * HALF + wc * 32 + 8 * fq;
#pragma unroll
        for (int ai = 0; ai < 2; ++ai)
#pragma unroll
            for (int m = 0; m < 4; ++m) { const float r = rs[ai][m]; float h[8];
#pragma unroll
                for (int n = 0; n < 2; ++n)
#pragma unroll
                    for (int e = 0; e < 4; ++e) { const float gv = acc[ai][0][m][n][e] * r, uv = acc[ai][1][m][n][e] * r; h[n * 4 + e] = gv * sigmoidf_(gv) * uv; }
                u32x4 w; w.x = cvt_pk_bf16(h[0], h[1]); w.y = cvt_pk_bf16(h[2], h[3]); w.z = cvt_pk_bf16(h[4], h[5]); w.w = cvt_pk_bf16(h[6], h[7]);
                *(GAS u32x4*)(H + (size_t)(row0 + ai * HALF + m * 16) * FFN + col0) = w; }
    }
};
}

struct Frame {
    __device__ __forceinline__ void refresh() { ws = (GAS unsigned char*)opaque_ptr(ws0); tid = opaque_tid(wv); lane = tid & 63; wave = __builtin_amdgcn_readfirstlane(tid >> 6); }
    LAS unsigned char* lds;
    volatile LAS unsigned* MISC;
    unsigned* ctl;
    int tid, lane, wave, G, wv;
    const float* const* in;
    GAS unsigned char* ws; unsigned char* ws0;
};

__device__ __forceinline__ void conv_item(const GAS float* W, int ldw, int k0, int src_c0, int nvalid, const GAS float* gk, GAS bf16* WT, int ldt, int dst_r0, int dst_k, LAS float* scr, int lane) {
    const int c4 = 4 * (lane & 15), rq = lane >> 4;
    f32x4 v[16];
#pragma unroll
    for (int i = 0; i < 16; ++i) { const int kk = 4 * i + rq; v[i] = (c4 < nvalid) ? __builtin_nontemporal_load((const GAS f32x4*)(W + (size_t)(k0 + kk) * ldw + src_c0 + c4)) : (f32x4){0.f, 0.f, 0.f, 0.f}; }
    if (gk) {
#pragma unroll
        for (int i = 0; i < 16; ++i) v[i] = v[i] * gk[k0 + 4 * i + rq]; }
#pragma unroll
    for (int i = 0; i < 16; ++i) { LAS float* d = scr + (4 * i + rq) * 65 + c4; d[0] = v[i][0]; d[1] = v[i][1]; d[2] = v[i][2]; d[3] = v[i][3]; }
    LDS_WAIT(); asm volatile("" ::: "memory");
    const int c8 = lane & 7;
#pragma unroll
    for (int j = 0; j < 8; ++j) { const int n = (lane >> 3) + 8 * j; const LAS float* sp = scr + (8 * c8) * 65 + n;
        v4u o; o.x = pk2(sp[0 * 65], sp[1 * 65]); o.y = pk2(sp[2 * 65], sp[3 * 65]); o.z = pk2(sp[4 * 65], sp[5 * 65]); o.w = pk2(sp[6 * 65], sp[7 * 65]);
        *(GAS v4u*)(WT + (size_t)(dst_r0 + n) * ldt + dst_k + 8 * c8) = o; }
    LDS_WAIT(); asm volatile("" ::: "memory");
}
constexpr int CV_NB_IN = NP / 64, CV_NB_FF = FFN / 64;
constexpr int CV_I_IN = 32 * CV_NB_IN, CV_I_GLU = 16 * 16, CV_I_BR = 3 * 16 * 32, CV_I_OUT = 32 * 32, CV_I_GU = 2 * 32 * CV_NB_FF, CV_I_DN = CV_NB_FF * 32;
constexpr int CV_I_LAYER = CV_I_IN + CV_I_GLU + CV_I_BR + CV_I_OUT + CV_I_GU + CV_I_DN;
constexpr int CV_Q1 = 4, CV_Q7 = 4;
__device__ __forceinline__ void conv_layer_item(Frame& F, int l, int r, LAS float* scr, int lane) {
    GAS unsigned char* wl = F.ws + WS_W + (size_t)l * SZ_WLAYER;
    if (r < CV_I_IN) { const int nb = r % CV_NB_IN, kb = r / CV_NB_IN, n0 = 64 * nb; int src, nv;
        if (n0 < 4096) { src = n0; nv = 64; } else if (n0 < PC_GLR) { src = n0 + 16; nv = 64; } else if (n0 == PC_GLR) { src = 4096; nv = 16; } else { src = 0; nv = 0; }
        conv_item(((const GAS float*)F.in[I_WIN]) + (size_t)l * DM * INW, INW, 64 * kb, src, nv, ((const GAS float*)F.in[I_N1G]) + l * DM, (GAS bf16*)(wl + OFF_WIN), DM, n0, 64 * kb, scr, lane); return; } r -= CV_I_IN;
    if (r < CV_I_GLU) { const int nb = r % 16, kb = r / 16;
        conv_item(((const GAS float*)F.in[I_WGLU]) + (size_t)l * 1024 * 1024, 1024, 64 * kb, 64 * nb, 64, nullptr, (GAS bf16*)(wl + OFF_WGLU), 1024, 64 * nb, 64 * kb, scr, lane); return; } r -= CV_I_GLU;
    if (r < CV_I_BR) { const int br = r / (16 * 32), rr = r % (16 * 32), nb = rr % 32, kb = rr / 32;
        conv_item(((const GAS float*)F.in[I_WBS + br]) + (size_t)l * 1024 * DM, DM, 64 * kb, 64 * nb, 64, nullptr, (GAS bf16*)(wl + OFF_WBR), 3072, 64 * nb, br * 1024 + 64 * kb, scr, lane); return; } r -= CV_I_BR;
    if (r < CV_I_OUT) { const int nb = r % 32, kb = r / 32;
        conv_item(((const GAS float*)F.in[I_WOUT]) + (size_t)l * DM * DM, DM, 64 * kb, 64 * nb, 64, nullptr, (GAS bf16*)(wl + OFF_WOUT), DM, 64 * nb, 64 * kb, scr, lane); return; } r -= CV_I_OUT;
    if (r < CV_I_GU) { const int sel = r / (32 * CV_NB_FF), rr = r % (32 * CV_NB_FF), nb = rr % CV_NB_FF, kb = rr / CV_NB_FF, j0 = 64 * nb;
        conv_item(((const GAS float*)F.in[I_FWG + sel]) + (size_t)l * DM * FFN, FFN, 64 * kb, j0, 64, ((const GAS float*)F.in[I_N2G]) + l * DM, (GAS bf16*)(wl + OFF_WGU), DM, (j0 / 128) * 256 + sel * 128 + (j0 % 128), 64 * kb, scr, lane); return; } r -= CV_I_GU;
    { const int nb = r % 32, kb = r / 32;
        conv_item(((const GAS float*)F.in[I_FWD]) + (size_t)l * FFN * DM, DM, 64 * kb, 64 * nb, 64, nullptr, (GAS bf16*)(wl + OFF_WDN), FFN, 64 * nb, 64 * kb, scr, lane); }
}
__device__ __forceinline__ int cv_ntail(int nwg, int G) { const int nr = (nwg + G - 1) / G; return nr * G - nwg; }
__device__ __forceinline__ void cv_split(int G, int& R, int& T1) {
    const int t1 = cv_ntail((MTOK / 256) * (NP / 256), G) * NWAVES * CV_Q1, t7 = cv_ntail((MTOK / 256) * (NGU / 256), G) * NWAVES * CV_Q7;
    int r = CV_I_LAYER - t1 - t7; int tt1 = t1; if (r < 0) { r = 0; tt1 = t1 < CV_I_LAYER ? t1 : CV_I_LAYER; }
    R = r; T1 = tt1;
}
__device__ __forceinline__ void cv_tail(Frame& F, int l, int which) {
    if (l + 1 >= DEPTH) return;
    const int nwg = (MTOK / 256) * ((which ? NGU : NP) / 256), ntail = cv_ntail(nwg, F.G), first = F.G - ntail;
    if ((int)blockIdx.x < first) return;
    int R, T1; cv_split(F.G, R, T1);
    const int lo = which ? R + T1 : R, hi = which ? CV_I_LAYER : R + T1;
    LAS float* scr = (LAS float*)(F.lds + F.wave * 16896);
    for (int r = lo + ((int)blockIdx.x - first) * NWAVES + F.wave; r < hi; r += ntail * NWAVES) conv_layer_item(F, l + 1, r, scr, F.lane);
}
__device__ __forceinline__ void s5_tables_unit(Frame& F, int lg);
__device__ __forceinline__ void p0_prologue(Frame& F) {
    LAS float* scr = (LAS float*)(F.lds + F.wave * 16896);
    const int gw = blockIdx.x * NWAVES + F.wave, NGW = F.G * NWAVES, lane = F.lane;
    for (int lg = blockIdx.x; lg < DEPTH * 64; lg += F.G) s5_tables_unit(F, lg);
    int R, T1; cv_split(F.G, R, T1);
    for (int it = gw; it < CV_I_LAYER + (DEPTH - 1) * R; it += NGW) {
        int l, r; if (it < CV_I_LAYER) { l = 0; r = it; } else { const int q = it - CV_I_LAYER; l = 1 + q / R; r = q - (l - 1) * R; }
        conv_layer_item(F, l, r, scr, lane);
    }
    const GAS float* x = ((const GAS float*)F.in[I_X]); GAS bf16* XB = (GAS bf16*)(F.ws + WS_XB); GAS float* ssq = (GAS float*)(F.ws + WS_SSQ);
    for (int m = gw; m < MTOK; m += NGW) {
        const GAS f32x4* xr = (const GAS f32x4*)(x + (size_t)m * DM) + lane; float s = 0.f;
        GAS v2u* o8 = (GAS v2u*)(XB + (size_t)m * DM) + lane;
#pragma unroll
        for (int j = 0; j < 8; ++j) { const f32x4 v = xr[64 * j]; s += (v[0] * v[0] + v[1] * v[1]) + (v[2] * v[2] + v[3] * v[3]); v2u w; w.x = pk2(v[0], v[1]); w.y = pk2(v[2], v[3]); o8[64 * j] = w; }
        s = wave_sum(s);
        if (lane < 8) ssq[(size_t)m * 8 + lane] = (lane == 0) ? s : 0.f;
    }
}

typedef short bf16x8_t __attribute__((ext_vector_type(8)));
__device__ __forceinline__ f32x4 mma16(bf16x8_t a, bf16x8_t b, f32x4 c) { return __builtin_amdgcn_mfma_f32_16x16x32_bf16(a, b, c, 0, 0, 0); }
constexpr int S5_USTR = 2064;
constexpr int S5_XSTR = 272;
__device__ __forceinline__ void s5_tables_unit(Frame& F, int lg) {
    LAS float* APr = (LAS float*)F.lds; LAS float* APi = APr + 65 * 64; LAS float* BBr = APi + 65 * 64; LAS float* BBi = BBr + 1024; LAS float* CCr = BBi + 1024; LAS float* CCi = CCr + 1024;
    const int tid = F.tid;
    const GAS float* lre_ = ((const GAS float*)F.in[I_LRE]) + lg * 64; const GAS float* lim_ = ((const GAS float*)F.in[I_LIM]) + lg * 64; const double dt = exp((double)((const GAS float*)F.in[I_LDT])[lg]);
    for (int idx = tid; idx < 65 * 64; idx += 512) { const int t = idx >> 6, p = idx & 63;
        const double lr = (double)lre_[p], li = (double)lim_[p]; const double mag = exp(lr * dt * (double)t); double ang = li * dt * (double)t;
        ang -= 6.283185307179586476925 * rint(ang * 0.15915494309189533577);
        APr[idx] = (float)(mag * (double)cosf((float)ang)); APi[idx] = (float)(mag * (double)sinf((float)ang)); }
    for (int idx = tid; idx < 1024; idx += 512) { const int p = idx >> 4, c = idx & 15;
        const double lr = (double)lre_[p], li = (double)lim_[p]; const double mag = exp(lr * dt); double ang = li * dt; ang -= 6.283185307179586476925 * rint(ang * 0.15915494309189533577);
        const double ar = mag * (double)cosf((float)ang), ai = mag * (double)sinf((float)ang), den = lr * lr + li * li, nr = ar - 1.0, ni = ai;
        const double zr = (nr * lr + ni * li) / den, zi = (ni * lr - nr * li) / den;
        const double br = (double)((const GAS float*)F.in[I_BRE])[(size_t)(lg * 64 + p) * 16 + c], bi = (double)((const GAS float*)F.in[I_BIM])[(size_t)(lg * 64 + p) * 16 + c];
        BBr[idx] = (float)(zr * br - zi * bi); BBi[idx] = (float)(zr * bi + zi * br);
        CCr[idx] = ((const GAS float*)F.in[I_CRE])[(size_t)lg * 1024 + idx]; CCi[idx] = ((const GAS float*)F.in[I_CIM])[(size_t)lg * 1024 + idx]; }
    LDS_WAIT(); __syncthreads();
    { const int t = tid >> 3, co0 = 2 * (tid & 7); float acc0[16], acc1[16];
#pragma unroll
      for (int i = 0; i < 16; ++i) { acc0[i] = 0.f; acc1[i] = 0.f; }
      for (int p = 0; p < 64; ++p) { const float ar = APr[t * 64 + p], ai = APi[t * 64 + p];
          const float c0r = CCr[co0 * 64 + p], c0i = CCi[co0 * 64 + p], c1r = CCr[(co0 + 1) * 64 + p], c1i = CCi[(co0 + 1) * 64 + p];
          const float w0r = c0r * ar - c0i * ai, w0i = c0r * ai + c0i * ar, w1r = c1r * ar - c1i * ai, w1i = c1r * ai + c1i * ar;
#pragma unroll
          for (int ci = 0; ci < 16; ++ci) { const float br = BBr[p * 16 + ci], bi = BBi[p * 16 + ci]; acc0[ci] += w0r * br - w0i * bi; acc1[ci] += w1r * br - w1i * bi; } }
      GAS bf16* TK = (GAS bf16*)(F.ws + WS_TK) + (size_t)lg * 64 * 256 + (size_t)(t * 16 + co0) * 16;
      v4u o0, o1, o2, o3; o0.x = pk2(acc0[0], acc0[1]); o0.y = pk2(acc0[2], acc0[3]); o0.z = pk2(acc0[4], acc0[5]); o0.w = pk2(acc0[6], acc0[7]);
      o1.x = pk2(acc0[8], acc0[9]); o1.y = pk2(acc0[10], acc0[11]); o1.z = pk2(acc0[12], acc0[13]); o1.w = pk2(acc0[14], acc0[15]);
      o2.x = pk2(acc1[0], acc1[1]); o2.y = pk2(acc1[2], acc1[3]); o2.z = pk2(acc1[4], acc1[5]); o2.w = pk2(acc1[6], acc1[7]);
      o3.x = pk2(acc1[8], acc1[9]); o3.y = pk2(acc1[10], acc1[11]); o3.z = pk2(acc1[12], acc1[13]); o3.w = pk2(acc1[14], acc1[15]);
      *(GAS v4u*)(TK) = o0; *(GAS v4u*)(TK + 8) = o1; *(GAS v4u*)(TK + 16) = o2; *(GAS v4u*)(TK + 24) = o3; }
    { GAS bf16* TW = (GAS bf16*)(F.ws + WS_TW) + (size_t)lg * 128 * 1024;
      for (int ch = tid; ch < 16384; ch += 512) { const int col = ch >> 7, kc = ch & 127, ri = col >> 6, p = col & 63, j = kc >> 1, c0 = 8 * (kc & 1);
          const float ar = APr[(63 - j) * 64 + p], ai = APi[(63 - j) * 64 + p]; float v[8];
#pragma unroll
          for (int e = 0; e < 8; ++e) { const float br = BBr[p * 16 + c0 + e], bi = BBi[p * 16 + c0 + e]; v[e] = ri ? (ar * bi + ai * br) : (ar * br - ai * bi); }
          v4u o; o.x = pk2(v[0], v[1]); o.y = pk2(v[2], v[3]); o.z = pk2(v[4], v[5]); o.w = pk2(v[6], v[7]);
          *(GAS v4u*)(TW + (size_t)col * 1024 + kc * 8) = o; } }
    { GAS bf16* TC = (GAS bf16*)(F.ws + WS_TC) + (size_t)lg * 1024 * 128;
      for (int ch = tid; ch < 16384; ch += 512) { const int row = ch >> 4, kc = ch & 15, i = row >> 4, co = row & 15, ri = kc >> 3, p0 = 8 * (kc & 7); float v[8];
#pragma unroll
          for (int e = 0; e < 8; ++e) { const int p = p0 + e; const float ar = APr[(i + 1) * 64 + p], ai = APi[(i + 1) * 64 + p], cr = CCr[co * 64 + p], ci = CCi[co * 64 + p];
              v[e] = ri ? -(cr * ai + ci * ar) : (cr * ar - ci * ai); }
          v4u o; o.x = pk2(v[0], v[1]); o.y = pk2(v[2], v[3]); o.z = pk2(v[4], v[5]); o.w = pk2(v[6], v[7]);
          *(GAS v4u*)(TC + (size_t)row * 128 + kc * 8) = o; } }
    if (tid < 128) ((GAS float*)(F.ws + WS_A64))[(size_t)lg * 128 + tid] = (tid < 64) ? APr[64 * 64 + tid] : APi[64 * 64 + tid - 64];
    LDS_WAIT(); __syncthreads();
}
__device__ __forceinline__ void s5_stage_u(Frame& F, int g, int b, LAS unsigned char* U) {
    const GAS v4u* src = (const GAS v4u*)((const GAS bf16*)(F.ws + WS_US) + (size_t)(b * 64 + g) * SEQ * 16);
#pragma unroll
    for (int it = 0; it < 8; ++it) { const int ch = F.tid + 512 * it, t = ch >> 1, hf = ch & 1, n = t >> 6, j = t & 63;
        *(LAS v4u*)(U + n * S5_USTR + (j * 16 + 8 * hf) * 2) = src[ch]; }
}
__device__ __forceinline__ void s5_s1_unit(Frame& F, int l, int unit) {
    const int g = unit & 63, b = unit >> 6, lg = l * 64 + g, lane = F.lane, w = F.wave, fr = lane & 15, fq = lane >> 4;
    LAS unsigned char* U = F.lds;
    s5_stage_u(F, g, b, U);
    LDS_WAIT(); __syncthreads();
    const GAS bf16* TW = (const GAS bf16*)(F.ws + WS_TW) + (size_t)lg * 128 * 1024 + (size_t)(16 * w + fr) * 1024 + 8 * fq;
    f32x4 acc[2] = {(f32x4){0.f, 0.f, 0.f, 0.f}, (f32x4){0.f, 0.f, 0.f, 0.f}};
#pragma unroll 4
    for (int ks = 0; ks < 32; ++ks) {
        const bf16x8_t bfr = *(const GAS bf16x8_t*)(TW + 32 * ks);
        const bf16x8_t a0 = *(const LAS bf16x8_t*)(U + fr * S5_USTR + (32 * ks + 8 * fq) * 2), a1 = *(const LAS bf16x8_t*)(U + (16 + fr) * S5_USTR + (32 * ks + 8 * fq) * 2);
        acc[0] = mma16(a0, bfr, acc[0]); acc[1] = mma16(a1, bfr, acc[1]); }
    GAS float* SL = (GAS float*)(F.ws + WS_SL);
#pragma unroll
    for (int mt = 0; mt < 2; ++mt)
#pragma unroll
        for (int r = 0; r < 4; ++r) { const int n = 16 * mt + 4 * fq + r; SL[((size_t)(b * 32 + n) * 64 + g) * 128 + 16 * w + fr] = acc[mt][r]; }
    __syncthreads();
}
__device__ __forceinline__ void s5_s3_unit(Frame& F, int l, int unit) {
    const int g = unit & 63, b = unit >> 6, lg = l * 64 + g, lane = F.lane, w = F.wave, fr = lane & 15, fq = lane >> 4;
    LAS unsigned char* U = F.lds; LAS unsigned char* TKL = F.lds + 32 * S5_USTR; LAS unsigned char* XP = TKL + 32768;
    float sr[32], si[32]; float a64r = 0.f, a64i = 0.f;
    if (w == 0) { const GAS float* SL = (const GAS float*)(F.ws + WS_SL) + ((size_t)(b * 32) * 64 + g) * 128; const GAS float* A64 = (const GAS float*)(F.ws + WS_A64) + (size_t)lg * 128;
        a64r = A64[lane]; a64i = A64[64 + lane];
#pragma unroll
        for (int e = 0; e < 32; ++e) { sr[e] = SL[(size_t)e * 64 * 128 + lane]; si[e] = SL[(size_t)e * 64 * 128 + 64 + lane]; } }
    s5_stage_u(F, g, b, U);
    { const GAS v4u* src = (const GAS v4u*)((const GAS bf16*)(F.ws + WS_TK) + (size_t)lg * 64 * 256);
#pragma unroll
      for (int it = 0; it < 4; ++it) *(LAS v4u*)(TKL + (F.tid + 512 * it) * 16) = src[F.tid + 512 * it]; }
    const GAS bf16* TC = (const GAS bf16*)(F.ws + WS_TC) + (size_t)lg * 1024 * 128 + (size_t)fr * 128 + 8 * fq;
    bf16x8_t tcf[8];
#pragma unroll
    for (int it = 0; it < 8; ++it) tcf[it] = *(const GAS bf16x8_t*)(TC + (size_t)((w + 8 * it) * 16) * 128);
    if (w == 0) {
        float xr = 0.f, xi = 0.f;
#pragma unroll
        for (int e = 0; e < 32; ++e) { *(LAS bf16*)(XP + e * S5_XSTR + lane * 2) = (bf16)f2bf(xr); *(LAS bf16*)(XP + e * S5_XSTR + (64 + lane) * 2) = (bf16)f2bf(xi);
            const float nr = a64r * xr - a64i * xi + sr[e], ni = a64r * xi + a64i * xr + si[e]; xr = nr; xi = ni; }
    }
    LDS_WAIT(); __syncthreads();
    f32x4 acc[2][8];
#pragma unroll
    for (int mt = 0; mt < 2; ++mt)
#pragma unroll
        for (int it = 0; it < 8; ++it) acc[mt][it] = (f32x4){0.f, 0.f, 0.f, 0.f};
#pragma unroll 1
    for (int c = 0; c < 4; ++c) {
        bf16x8_t bfr[8];
#pragma unroll
        for (int it = 0; it < 8; ++it) { const int lag = w + 8 * it - 2 * c - (fq >> 1); bfr[it] = *(const LAS bf16x8_t*)(TKL + ((lag < 0 ? 0 : lag) * 16 + fr) * 32 + 16 * (fq & 1)); if (lag < 0) bfr[it] = (bf16x8_t){0, 0, 0, 0, 0, 0, 0, 0}; }
        const bool first_ok = (w >= 2 * c);
#pragma unroll
        for (int sgrp = 0; sgrp < 8; ++sgrp) { const int ks = c + 4 * sgrp;
            const bf16x8_t a0 = *(const LAS bf16x8_t*)(U + fr * S5_USTR + (32 * ks + 8 * fq) * 2), a1 = *(const LAS bf16x8_t*)(U + (16 + fr) * S5_USTR + (32 * ks + 8 * fq) * 2);
#pragma unroll
            for (int it = sgrp; it < 8; ++it) { if (it > sgrp || first_ok) { acc[0][it] = mma16(a0, bfr[it - sgrp], acc[0][it]); acc[1][it] = mma16(a1, bfr[it - sgrp], acc[1][it]); } } }
    }
#pragma unroll
    for (int ks = 0; ks < 4; ++ks) {
        if (ks > 0) {
#pragma unroll
            for (int it = 0; it < 8; ++it) tcf[it] = *(const GAS bf16x8_t*)(TC + (size_t)((w + 8 * it) * 16) * 128 + 32 * ks); }
        const bf16x8_t a0 = *(const LAS bf16x8_t*)(XP + fr * S5_XSTR + (32 * ks + 8 * fq) * 2), a1 = *(const LAS bf16x8_t*)(XP + (16 + fr) * S5_XSTR + (32 * ks + 8 * fq) * 2);
#pragma unroll
        for (int it = 0; it < 8; ++it) { acc[0][it] = mma16(a0, tcf[it], acc[0][it]); acc[1][it] = mma16(a1, tcf[it], acc[1][it]); } }
    unsigned zp[2][8][2];
    { const float dsk = ((const GAS float*)F.in[I_SD])[l * 1024 + 16 * g + fr];
#pragma unroll
      for (int mt = 0; mt < 2; ++mt)
#pragma unroll
          for (int it = 0; it < 8; ++it) { float z[4];
#pragma unroll
              for (int r = 0; r < 4; ++r) { const int n = 16 * mt + 4 * fq + r, i = w + 8 * it;
                  const float uv = bf1(*(const LAS bf16*)(U + n * S5_USTR + (i * 16 + fr) * 2)); z[r] = gelu_tanh(acc[mt][it][r] + dsk * uv); }
              zp[mt][it][0] = pg8::cvt_pk_bf16(z[0], z[1]); zp[mt][it][1] = pg8::cvt_pk_bf16(z[2], z[3]); } }
    LDS_WAIT(); __syncthreads();
#pragma unroll
    for (int mt = 0; mt < 2; ++mt)
#pragma unroll
        for (int it = 0; it < 8; ++it)
#pragma unroll
            for (int r = 0; r < 4; ++r) { const int tkn = 64 * (16 * mt + 4 * fq + r) + w + 8 * it; const unsigned v = zp[mt][it][r >> 1];
                *(LAS bf16*)(U + tkn * 32 + fr * 2) = (bf16)((r & 1) ? (v >> 16) : (v & 0xffffu)); }
    LDS_WAIT(); __syncthreads();
    { GAS bf16* Z = (GAS bf16*)(F.ws + WS_Z) + (size_t)b * SEQ * 1024 + 16 * g;
#pragma unroll
      for (int j = 0; j < 8; ++j) { const int c = F.tid + 512 * j; *(GAS v4u*)(Z + (size_t)(c >> 1) * 1024 + 8 * (c & 1)) = *(const LAS v4u*)(U + c * 16); } }
    __syncthreads();
}

constexpr int GL_TSTR = 144;
constexpr int GL_DSTR = 272;
__device__ __forceinline__ void gla_g1_unit(Frame& F, int l, int u) {
    const int n = u & 31, h = (u >> 5) & 3, b = u >> 7, tid = F.tid, lane = F.lane, w = F.wave, fr = lane & 15, fq = lane >> 4;
    const size_t tok0 = (size_t)b * SEQ + 64 * n;
    const GAS bf16* P = (const GAS bf16*)(F.ws + WS_P);
    LAS float* GL = (LAS float*)F.lds; LAS float* W2L = (LAS float*)(F.lds + 32768); LAS float* GLR = (LAS float*)(F.lds + 40960);
    LAS unsigned char* KDt = F.lds + 45056; LAS unsigned char* VTt = F.lds + 63488;
    { const GAS float* w2 = ((const GAS float*)F.in[I_GW2]) + (size_t)l * 16 * 512;
#pragma unroll
      for (int it = 0; it < 4; ++it) { const int idx = tid + 512 * it, r = idx >> 7, dk = idx & 127; W2L[idx] = w2[r * 512 + h * 128 + dk]; }
#pragma unroll
      for (int it = 0; it < 2; ++it) { const int idx = tid + 512 * it, i = idx >> 4, r = idx & 15; GLR[idx] = bf1(P[(tok0 + i) * NP + PC_GLR + r]); } }
    LDS_WAIT(); __syncthreads();
    const int ti = tid >> 3, dq = tid & 7;
    { const GAS float* b2 = ((const GAS float*)F.in[I_GB2]) + l * 512 + h * 128 + 16 * dq; float a[16];
#pragma unroll
      for (int e = 0; e < 16; ++e) a[e] = b2[e];
#pragma unroll
      for (int r = 0; r < 16; ++r) { const float gv = GLR[ti * 16 + r];
#pragma unroll
          for (int e = 0; e < 16; ++e) a[e] += gv * W2L[r * 128 + 16 * dq + e]; }
#pragma unroll
      for (int e = 0; e < 16; ++e) { const float x = a[e]; GL[ti * 128 + 16 * dq + e] = (fminf(x, 0.f) - log1pf(__expf(-fabsf(x)))) * (1.0f / 16.0f); } }
    LDS_WAIT(); __syncthreads();
    if (tid < 128) { float run = 0.f;
        for (int i = 0; i < 64; ++i) { run += GL[i * 128 + tid]; GL[i * 128 + tid] = run; }
        GLR[tid] = run; ((GAS float*)(F.ws + WS_DEC))[(size_t)u * 128 + tid] = __expf(run); }
    LDS_WAIT(); __syncthreads();
    {
      const GAS bf16* qp = P + (tok0 + ti) * NP + PC_GQ + h * 128 + 16 * dq; const GAS bf16* kp = P + (tok0 + ti) * NP + PC_GK + h * 128 + 16 * dq;
      const v4u q0 = *(const GAS v4u*)qp, q1 = *(const GAS v4u*)(qp + 8), k0 = *(const GAS v4u*)kp, k1 = *(const GAS v4u*)(kp + 8);
      const unsigned qw[8] = {q0.x, q0.y, q0.z, q0.w, q1.x, q1.y, q1.z, q1.w}, kw[8] = {k0.x, k0.y, k0.z, k0.w, k1.x, k1.y, k1.z, k1.w};
      float qd[16], ki[16];
#pragma unroll
      for (int e = 0; e < 16; ++e) { const int dk = 16 * dq + e; const float bc = GL[ti * 128 + dk], bl = GLR[dk];
          const float qv = (e & 1) ? bfhi(qw[e >> 1]) : bflo(qw[e >> 1]), kv = (e & 1) ? bfhi(kw[e >> 1]) : bflo(kw[e >> 1]);
          qd[e] = qv * 0.08838834764831845f * __expf(bc); ki[e] = kv * __expf(-bc);
          *(LAS bf16*)(KDt + dk * GL_TSTR + ti * 2) = (bf16)f2bf(kv * __expf(bl - bc)); }
      GAS bf16* QD = (GAS bf16*)(F.ws + WS_QD) + ((size_t)u * 64 + ti) * 128 + 16 * dq; GAS bf16* KI = (GAS bf16*)(F.ws + WS_KI) + ((size_t)u * 64 + ti) * 128 + 16 * dq;
      v4u o; o.x = pk2(qd[0], qd[1]); o.y = pk2(qd[2], qd[3]); o.z = pk2(qd[4], qd[5]); o.w = pk2(qd[6], qd[7]); *(GAS v4u*)QD = o;
      o.x = pk2(qd[8], qd[9]); o.y = pk2(qd[10], qd[11]); o.z = pk2(qd[12], qd[13]); o.w = pk2(qd[14], qd[15]); *(GAS v4u*)(QD + 8) = o;
      o.x = pk2(ki[0], ki[1]); o.y = pk2(ki[2], ki[3]); o.z = pk2(ki[4], ki[5]); o.w = pk2(ki[6], ki[7]); *(GAS v4u*)KI = o;
      o.x = pk2(ki[8], ki[9]); o.y = pk2(ki[10], ki[11]); o.z = pk2(ki[12], ki[13]); o.w = pk2(ki[14], ki[15]); *(GAS v4u*)(KI + 8) = o;
      const GAS bf16* vp = P + (tok0 + ti) * NP + PC_GV + h * 256 + 32 * dq;
#pragma unroll
      for (int c = 0; c < 4; ++c) { const v4u vv = *(const GAS v4u*)(vp + 8 * c); const unsigned vw[4] = {vv.x, vv.y, vv.z, vv.w};
#pragma unroll
          for (int e = 0; e < 4; ++e) { const int dv = 32 * dq + 8 * c + 2 * e;
              *(LAS bf16*)(VTt + dv * GL_TSTR + ti * 2) = (bf16)(vw[e] & 0xffffu); *(LAS bf16*)(VTt + (dv + 1) * GL_TSTR + ti * 2) = (bf16)(vw[e] >> 16); } } }
    LDS_WAIT(); __syncthreads();
    {
      GAS bf16* GVT = (GAS bf16*)(F.ws + WS_GVT) + (size_t)u * 256 * 64; const int row = tid >> 1, hf = tid & 1;
#pragma unroll
      for (int c = 0; c < 4; ++c) *(GAS v4u*)(GVT + row * 64 + 32 * hf + 8 * c) = *(const LAS v4u*)(VTt + row * GL_TSTR + 64 * hf + 16 * c); }
    {
      f32x4 acc[8][2];
#pragma unroll
      for (int mt = 0; mt < 8; ++mt) { acc[mt][0] = (f32x4){0.f, 0.f, 0.f, 0.f}; acc[mt][1] = (f32x4){0.f, 0.f, 0.f, 0.f}; }
#pragma unroll
      for (int ks = 0; ks < 2; ++ks) { bf16x8_t bb[2], aa[8];
#pragma unroll
          for (int nt = 0; nt < 2; ++nt) bb[nt] = *(const LAS bf16x8_t*)(VTt + (16 * (2 * w + nt) + fr) * GL_TSTR + (32 * ks + 8 * fq) * 2);
#pragma unroll
          for (int mt = 0; mt < 8; ++mt) aa[mt] = *(const LAS bf16x8_t*)(KDt + (16 * mt + fr) * GL_TSTR + (32 * ks + 8 * fq) * 2);
#pragma unroll
          for (int mt = 0; mt < 8; ++mt) { acc[mt][0] = mma16(aa[mt], bb[0], acc[mt][0]); acc[mt][1] = mma16(aa[mt], bb[1], acc[mt][1]); } }
      GAS bf16* KV = (GAS bf16*)(F.ws + WS_KV) + (size_t)u * 256 * 128;
#pragma unroll
      for (int nt = 0; nt < 2; ++nt)
#pragma unroll
          for (int mt = 0; mt < 8; ++mt) { v2u o; o.x = pg8::cvt_pk_bf16(acc[mt][nt][0], acc[mt][nt][1]); o.y = pg8::cvt_pk_bf16(acc[mt][nt][2], acc[mt][nt][3]);
              *(GAS v2u*)(KV + (size_t)(16 * (2 * w + nt) + fr) * 128 + 16 * mt + 4 * fq) = o; } }
    __syncthreads();
}
__device__ __forceinline__ void gla_g2_scan(Frame& F) {
    const GAS bf16* KV = (const GAS bf16*)(F.ws + WS_KV); const GAS float* DEC = (const GAS float*)(F.ws + WS_DEC); GAS bf16* ST = (GAS bf16*)(F.ws + WS_ST);
    for (int e8 = blockIdx.x * 512 + F.tid; e8 < 16 * 256 * 16; e8 += F.G * 512) { const int bh = e8 >> 12, dv = (e8 >> 4) & 255, d8 = e8 & 15;
        float s[8];
#pragma unroll
        for (int j = 0; j < 8; ++j) s[j] = 0.f;
        for (int n0 = 0; n0 < 32; n0 += 4) { v4u kv[4]; f32x4 dc[4][2];
#pragma unroll
            for (int e = 0; e < 4; ++e) { const size_t u = (size_t)bh * 32 + n0 + e; kv[e] = *(const GAS v4u*)(KV + (u * 256 + dv) * 128 + 8 * d8); dc[e][0] = *(const GAS f32x4*)(DEC + u * 128 + 8 * d8); dc[e][1] = *(const GAS f32x4*)(DEC + u * 128 + 8 * d8 + 4); }
#pragma unroll
            for (int e = 0; e < 4; ++e) { const size_t u = (size_t)bh * 32 + n0 + e; v4u o; o.x = pk2(s[0], s[1]); o.y = pk2(s[2], s[3]); o.z = pk2(s[4], s[5]); o.w = pk2(s[6], s[7]); *(GAS v4u*)(ST + (u * 256 + dv) * 128 + 8 * d8) = o;
                const unsigned kw[4] = {kv[e].x, kv[e].y, kv[e].z, kv[e].w};
#pragma unroll
                for (int j = 0; j < 4; ++j) { s[2 * j] = dc[e][j >> 1][(2 * j) & 3] * s[2 * j] + bflo(kw[j]); s[2 * j + 1] = dc[e][j >> 1][(2 * j + 1) & 3] * s[2 * j + 1] + bfhi(kw[j]); } } } }
}
__device__ __forceinline__ void gla_g3_unit(Frame& F, int l, int u) {
    const int n = u & 31, h = (u >> 5) & 3, b = u >> 7, tid = F.tid, lane = F.lane, w = F.wave, fr = lane & 15, fq = lane >> 4;
    const size_t tok0 = (size_t)b * SEQ + 64 * n;
    LAS unsigned char* QDL = F.lds; LAS unsigned char* KIL = F.lds + 17408; LAS unsigned char* ATL = F.lds + 34816; LAS float* SSQL = (LAS float*)(F.lds + 44032); LAS float* RSL = (LAS float*)(F.lds + 46080);
    bf16x8_t gvtf[2][2], stf[2][4];
    { const GAS bf16* GVT = (const GAS bf16*)(F.ws + WS_GVT) + (size_t)u * 256 * 64; const GAS bf16* ST = (const GAS bf16*)(F.ws + WS_ST) + (size_t)u * 256 * 128;
#pragma unroll
      for (int mt = 0; mt < 2; ++mt) {
#pragma unroll
          for (int ks = 0; ks < 2; ++ks) gvtf[mt][ks] = *(const GAS bf16x8_t*)(GVT + (size_t)(16 * (2 * w + mt) + fr) * 64 + 32 * ks + 8 * fq);
#pragma unroll
          for (int ks = 0; ks < 4; ++ks) stf[mt][ks] = *(const GAS bf16x8_t*)(ST + (size_t)(16 * (2 * w + mt) + fr) * 128 + 32 * ks + 8 * fq); } }
    { const GAS v4u* qs = (const GAS v4u*)((const GAS bf16*)(F.ws + WS_QD) + (size_t)u * 64 * 128); const GAS v4u* ks_ = (const GAS v4u*)((const GAS bf16*)(F.ws + WS_KI) + (size_t)u * 64 * 128);
#pragma unroll
      for (int it = 0; it < 2; ++it) { const int c = tid + 512 * it, row = c >> 4, c16 = c & 15; *(LAS v4u*)(QDL + row * GL_DSTR + c16 * 16) = qs[c]; *(LAS v4u*)(KIL + row * GL_DSTR + c16 * 16) = ks_[c]; } }
    LDS_WAIT(); __syncthreads();
#pragma unroll
    for (int tt = 0; tt < 2; ++tt) { const int tile = 2 * w + tt, mi = tile >> 2, nj = tile & 3; f32x4 acc = (f32x4){0.f, 0.f, 0.f, 0.f};
        if (nj <= mi) { bf16x8_t fa[4], fb[4];
#pragma unroll
            for (int ks = 0; ks < 4; ++ks) { fa[ks] = *(const LAS bf16x8_t*)(QDL + (16 * mi + fr) * GL_DSTR + (32 * ks + 8 * fq) * 2); fb[ks] = *(const LAS bf16x8_t*)(KIL + (16 * nj + fr) * GL_DSTR + (32 * ks + 8 * fq) * 2); }
#pragma unroll
            for (int ks = 0; ks < 4; ++ks) acc = mma16(fa[ks], fb[ks], acc); }
#pragma unroll
        for (int r = 0; r < 4; ++r) { const int i = 16 * mi + 4 * fq + r, j = 16 * nj + fr; *(LAS bf16*)(ATL + i * GL_TSTR + j * 2) = (bf16)f2bf(j <= i ? acc[r] : 0.f); } }
    LDS_WAIT(); __syncthreads();
    f32x4 acc[2][4];
#pragma unroll
    for (int mt = 0; mt < 2; ++mt)
#pragma unroll
        for (int nt = 0; nt < 4; ++nt) acc[mt][nt] = (f32x4){0.f, 0.f, 0.f, 0.f};
#pragma unroll
    for (int ks = 0; ks < 2; ++ks) { bf16x8_t fb[4];
#pragma unroll
        for (int nt = 0; nt < 4; ++nt) fb[nt] = *(const LAS bf16x8_t*)(ATL + (16 * nt + fr) * GL_TSTR + (32 * ks + 8 * fq) * 2);
#pragma unroll
        for (int nt = 0; nt < 4; ++nt) { acc[0][nt] = mma16(gvtf[0][ks], fb[nt], acc[0][nt]); acc[1][nt] = mma16(gvtf[1][ks], fb[nt], acc[1][nt]); } }
#pragma unroll
    for (int ks = 0; ks < 4; ++ks) { bf16x8_t fb[4];
#pragma unroll
        for (int nt = 0; nt < 4; ++nt) fb[nt] = *(const LAS bf16x8_t*)(QDL + (16 * nt + fr) * GL_DSTR + (32 * ks + 8 * fq) * 2);
#pragma unroll
        for (int nt = 0; nt < 4; ++nt) { acc[0][nt] = mma16(stf[0][ks], fb[nt], acc[0][nt]); acc[1][nt] = mma16(stf[1][ks], fb[nt], acc[1][nt]); } }
#pragma unroll
    for (int nt = 0; nt < 4; ++nt) { float v = 0.f;
#pragma unroll
        for (int mt = 0; mt < 2; ++mt)
#pragma unroll
            for (int r = 0; r < 4; ++r) v += acc[mt][nt][r] * acc[mt][nt][r];
        v += __shfl_xor(v, 16); v += __shfl_xor(v, 32);
        if (fq == 0) SSQL[w * 64 + 16 * nt + fr] = v; }
    LDS_WAIT(); __syncthreads();
    if (tid < 64) { float s = 0.f;
#pragma unroll
        for (int ww = 0; ww < 8; ++ww) s += SSQL[ww * 64 + tid];
        RSL[tid] = 1.0f / sqrtf(s * (1.0f / 256.0f) + RMS_EPS); }
    LDS_WAIT(); __syncthreads();
    { const GAS bf16* P = (const GAS bf16*)(F.ws + WS_P); GAS bf16* Y = (GAS bf16*)(F.ws + WS_Y); const GAS float* gn = (const GAS float*)F.in[I_GNG] + l * 256;
      v2u rr[2][4];
#pragma unroll
      for (int mt = 0; mt < 2; ++mt)
#pragma unroll
          for (int nt = 0; nt < 4; ++nt) rr[mt][nt] = *(const GAS v2u*)(P + (tok0 + 16 * nt + fr) * NP + PC_GR + h * 256 + 16 * (2 * w + mt) + 4 * fq);
#pragma unroll
      for (int mt = 0; mt < 2; ++mt) { const int dv0 = 16 * (2 * w + mt) + 4 * fq; const f32x4 gv = *(const GAS f32x4*)(gn + dv0);
#pragma unroll
          for (int nt = 0; nt < 4; ++nt) { const int i = 16 * nt + fr; const float rs = RSL[i]; const v2u rw = rr[mt][nt];
              const float r0 = bflo(rw.x), r1 = bfhi(rw.x), r2 = bflo(rw.y), r3 = bfhi(rw.y);
              v2u o; o.x = pg8::cvt_pk_bf16(acc[mt][nt][0] * rs * gv[0] * r0 * sigmoidf_(r0), acc[mt][nt][1] * rs * gv[1] * r1 * sigmoidf_(r1));
              o.y = pg8::cvt_pk_bf16(acc[mt][nt][2] * rs * gv[2] * r2 * sigmoidf_(r2), acc[mt][nt][3] * rs * gv[3] * r3 * sigmoidf_(r3));
              *(GAS v2u*)(Y + (tok0 + i) * YW + 1024 + h * 256 + dv0) = o; } } }
    __syncthreads();
}
constexpr int MB_KSTR = 272, MB_VSTR = 144, MB_KBYTES = 64 * MB_KSTR, MB_BUF = MB_KBYTES + 128 * MB_VSTR;
__device__ __forceinline__ void moba_prep_unit(Frame& F, int l, int unit) {
    const int kb = unit & 7, h = (unit >> 3) & 7, b = unit >> 6, tid = F.tid;
    const size_t tok0 = (size_t)b * SEQ + 256 * kb;
    const GAS bf16* P = (const GAS bf16*)(F.ws + WS_P);
    LAS unsigned char* TL = F.lds; LAS float* PART = (LAS float*)(F.lds + 69632);
    const int c16 = tid & 15, tg = tid >> 4;
    v4u xq[8], xk[8], xv[8];
    { const GAS bf16* src = P + (tok0 + tg) * NP + h * 128 + 8 * c16;
#pragma unroll
      for (int j = 0; j < 8; ++j) { xq[j] = *(const GAS v4u*)(src + (size_t)(32 * j) * NP + PC_MQ); xk[j] = *(const GAS v4u*)(src + (size_t)(32 * j) * NP + PC_MK); xv[j] = *(const GAS v4u*)(src + (size_t)(32 * j) * NP + PC_MV); } }
#pragma unroll
    for (int which = 0; which < 2; ++which) {
        const GAS float* gp = (const GAS float*)F.in[which ? I_MKG : I_MQG] + l * 128 + 8 * c16;
        const f32x4 g0 = *(const GAS f32x4*)gp, g1 = *(const GAS f32x4*)(gp + 4);
#pragma unroll
        for (int j = 0; j < 8; ++j) { const v4u xx = which ? xk[j] : xq[j]; const unsigned xw[4] = {xx.x, xx.y, xx.z, xx.w}; float ss = 0.f;
#pragma unroll
            for (int e = 0; e < 4; ++e) { const float a = bflo(xw[e]), bb = bfhi(xw[e]); ss += a * a + bb * bb; }
            ss += __shfl_xor(ss, 1); ss += __shfl_xor(ss, 2); ss += __shfl_xor(ss, 4); ss += __shfl_xor(ss, 8);
            const float r = (1.0f / sqrtf(ss * (1.0f / 128.0f) + RMS_EPS)) * (which ? 1.0f : 0.08838834764831845f * 1.4426950408889634f);
            const int tok = tg + 32 * j;
            v4u o; o.x = pg8::cvt_pk_bf16(bflo(xw[0]) * r * g0[0], bfhi(xw[0]) * r * g0[1]); o.y = pg8::cvt_pk_bf16(bflo(xw[1]) * r * g0[2], bfhi(xw[1]) * r * g0[3]);
            o.z = pg8::cvt_pk_bf16(bflo(xw[2]) * r * g1[0], bfhi(xw[2]) * r * g1[1]); o.w = pg8::cvt_pk_bf16(bflo(xw[3]) * r * g1[2], bfhi(xw[3]) * r * g1[3]);
            *(GAS v4u*)((GAS bf16*)(F.ws + (which ? WS_KN : WS_QN)) + (tok0 + tok) * 1024 + h * 128 + 8 * c16) = o; if (which) *(LAS v4u*)(TL + tok * MB_KSTR + 16 * c16) = o; }
    }
    LDS_WAIT(); __syncthreads();
    { const int d = tid & 127, part = tid >> 7; float a = 0.f;
#pragma unroll 8
      for (int j = 0; j < 64; ++j) a += bf1(*(const LAS bf16*)(TL + (64 * part + j) * MB_KSTR + d * 2));
      PART[part * 128 + d] = a; }
    LDS_WAIT(); __syncthreads();
    if (tid < 128) ((GAS float*)(F.ws + WS_KM))[(size_t)unit * 128 + tid] = ((PART[tid] + PART[128 + tid]) + (PART[256 + tid] + PART[384 + tid])) * (1.0f / 256.0f);
#pragma unroll
    for (int j = 0; j < 8; ++j) *(LAS v4u*)(TL + (tg + 32 * j) * MB_KSTR + 16 * c16) = xv[j];
    LDS_WAIT(); __syncthreads();
    { const int d = tid >> 2, tq = tid & 3; GAS bf16* dst = (GAS bf16*)(F.ws + WS_VT) + ((size_t)(b * 8 + h) * 128 + d) * SEQ + 256 * kb + 64 * tq;
#pragma unroll
      for (int c = 0; c < 8; ++c) { unsigned wv[4];
#pragma unroll
          for (int e = 0; e < 4; ++e) { const unsigned lo = *(const LAS bf16*)(TL + (64 * tq + 8 * c + 2 * e) * MB_KSTR + d * 2), hi = *(const LAS bf16*)(TL + (64 * tq + 8 * c + 2 * e + 1) * MB_KSTR + d * 2); wv[e] = lo | (hi << 16); }
          v4u o; o.x = wv[0]; o.y = wv[1]; o.z = wv[2]; o.w = wv[3]; *(GAS v4u*)(dst + 8 * c) = o; } }
    __syncthreads();
}
constexpr int MB3_TILE = 128 * 256, MB3_BUF = 2 * MB3_TILE;
__device__ __forceinline__ void moba_attn_unit3(Frame& F, int bh, int qt) {
    const int b = bh >> 3, h = bh & 7, tid = F.tid, lane = F.lane, w = F.wave, fr = lane & 15, fq = lane >> 4;
    const int qb = qt >> 1, np = qt + 1, qpos = 128 * qt + 16 * w + fr;
    const GAS bf16* KN = (const GAS bf16*)(F.ws + WS_KN) + (size_t)b * SEQ * 1024 + h * 128; const GAS bf16* VT = (const GAS bf16*)(F.ws + WS_VT) + (size_t)bh * 128 * SEQ;
    LAS float* KML = (LAS float*)(F.lds + 2 * MB3_BUF);
    { const GAS float* km = (const GAS float*)(F.ws + WS_KM) + (size_t)bh * 1024; KML[tid] = km[tid]; KML[512 + tid] = km[512 + tid]; }
    bf16x8_t bq[4];
    { const GAS bf16* qp = (const GAS bf16*)(F.ws + WS_QN) + ((size_t)b * SEQ + qpos) * 1024 + h * 128 + 8 * fq;
#pragma unroll
      for (int ks = 0; ks < 4; ++ks) bq[ks] = *(const GAS bf16x8_t*)(qp + 32 * ks); }
    const int drow = lane >> 4, dslot = lane & 15;
#define MB3_DMA(buf_, p_) do { _Pragma("unroll") for (int j_ = 0; j_ < 4; ++j_) { const int row_ = 4 * (8 * j_ + w) + drow, c_ = dslot ^ (row_ & 15); \
        __builtin_amdgcn_global_load_lds((const GAS unsigned*)(KN + (size_t)(128 * (p_) + row_) * 1024 + 8 * c_), (LAS unsigned*)((buf_) + (8 * j_ + w) * 1024), 16, 0, 0); \
        __builtin_amdgcn_global_load_lds((const GAS unsigned*)(VT + (size_t)row_ * SEQ + 128 * (p_) + 8 * c_), (LAS unsigned*)((buf_) + MB3_TILE + (8 * j_ + w) * 1024), 16, 0, 0); } } while (0)
    MB3_DMA(F.lds, 0);
    VM_WAIT(); LDS_WAIT(); __syncthreads();
    unsigned selmask = 0u;
    { float sc[8];
#pragma unroll
      for (int kb = 0; kb < 8; ++kb) { float a = 0.f;
#pragma unroll
          for (int ks = 0; ks < 4; ++ks) { const LAS float* kp = KML + kb * 128 + 32 * ks + 8 * fq; const f32x4 k0 = *(const LAS f32x4*)kp, k1 = *(const LAS f32x4*)(kp + 4);
              const v4u qv = __builtin_bit_cast(v4u, bq[ks]);
              a += bflo(qv.x) * k0[0] + bfhi(qv.x) * k0[1] + bflo(qv.y) * k0[2] + bfhi(qv.y) * k0[3] + bflo(qv.z) * k1[0] + bfhi(qv.z) * k1[1] + bflo(qv.w) * k1[2] + bfhi(qv.w) * k1[3]; }
          a += __shfl_xor(a, 16); a += __shfl_xor(a, 32); sc[kb] = (kb < qb) ? a : -__builtin_inff(); }
#pragma unroll
      for (int kb = 0; kb < 8; ++kb) { int rank = 0;
#pragma unroll
          for (int j = 0; j < 8; ++j) if (j != kb) rank += ((j < qb) && (sc[j] > sc[kb] || (sc[j] == sc[kb] && j < kb))) ? 1 : 0;
          if (kb < qb && rank < 3) selmask |= 1u << kb; } }
    f32x4 ao[8];
#pragma unroll
    for (int dt = 0; dt < 8; ++dt) ao[dt] = (f32x4){0.f, 0.f, 0.f, 0.f};
    float m = -__builtin_inff(), lsum = 0.f;
#pragma unroll 1
    for (int p = 0; p < np; ++p) {
        LAS unsigned char* KB = F.lds + (p & 1) * MB3_BUF; LAS unsigned char* VB = KB + MB3_TILE;
        if (p + 1 < np) MB3_DMA(F.lds + ((p + 1) & 1) * MB3_BUF, p + 1);
        const int kb = p >> 1; const bool past = kb < qb; const bool mine = past ? (((selmask >> kb) & 1u) != 0u) : true;
        if (__any(mine)) {
            const int lim = (past ? (mine ? 0x7fffffff : -1) : qpos - 128 * p) - 4 * fq;
            f32x4 as[8];
#pragma unroll
            for (int mh = 0; mh < 4; ++mh) { bf16x8_t fragA[2][4];
#pragma unroll
                for (int mt = 0; mt < 2; ++mt)
#pragma unroll
                    for (int ks = 0; ks < 4; ++ks) fragA[mt][ks] = *(const LAS bf16x8_t*)(KB + (16 * (2 * mh + mt) + fr) * 256 + 16 * ((4 * ks + fq) ^ fr));
                __builtin_amdgcn_sched_barrier(0);
#pragma unroll
                for (int mt = 0; mt < 2; ++mt) { as[2 * mh + mt] = (f32x4){0.f, 0.f, 0.f, 0.f};
#pragma unroll
                    for (int ks = 0; ks < 4; ++ks) as[2 * mh + mt] = mma16(fragA[mt][ks], bq[ks], as[2 * mh + mt]); }
                __builtin_amdgcn_sched_barrier(0); }
            float mx = -__builtin_inff();
            if (__all(lim >= 127)) {
#pragma unroll
                for (int mt = 0; mt < 8; ++mt)
#pragma unroll
                    for (int r = 0; r < 4; ++r) mx = fmaxf(mx, as[mt][r]);
            } else {
#pragma unroll
                for (int mt = 0; mt < 8; ++mt)
#pragma unroll
                    for (int r = 0; r < 4; ++r) { const float sv_ = (16 * mt + r <= lim) ? as[mt][r] : -__builtin_inff(); as[mt][r] = sv_; mx = fmaxf(mx, sv_); }
            }
            mx = fmaxf(mx, __shfl_xor(mx, 16)); mx = fmaxf(mx, __shfl_xor(mx, 32));
            const float mnew = fmaxf(m, mx), msafe = (mnew == -__builtin_inff()) ? 0.f : mnew;
            const bool grow = __any(mnew != m);
            const float corr = grow ? __builtin_amdgcn_exp2f(m - msafe) : 1.0f;
            float ps = 0.f;
#pragma unroll
            for (int mt = 0; mt < 8; ++mt)
#pragma unroll
                for (int r = 0; r < 4; ++r) { const float pv = __builtin_amdgcn_exp2f(as[mt][r] - msafe); as[mt][r] = pv; ps += pv; }
            lsum = lsum * corr + ps; m = mnew;
            bf16x8_t pf[4];
#pragma unroll
            for (int k2 = 0; k2 < 4; ++k2) { v4u t; t.x = pg8::cvt_pk_bf16(as[2 * k2][0], as[2 * k2][1]); t.y = pg8::cvt_pk_bf16(as[2 * k2][2], as[2 * k2][3]); t.z = pg8::cvt_pk_bf16(as[2 * k2 + 1][0], as[2 * k2 + 1][1]); t.w = pg8::cvt_pk_bf16(as[2 * k2 + 1][2], as[2 * k2 + 1][3]);
                pf[k2] = __builtin_bit_cast(bf16x8_t, t); }
            if (grow) {
#pragma unroll
                for (int dt = 0; dt < 8; ++dt) ao[dt] = ao[dt] * corr; }
            __builtin_amdgcn_sched_barrier(0);
#pragma unroll
            for (int dh = 0; dh < 4; ++dh) { v2u vlo[2][4], vhi[2][4];
#pragma unroll
                for (int dt = 0; dt < 2; ++dt)
#pragma unroll
                    for (int k2 = 0; k2 < 4; ++k2) { const LAS unsigned char* vr = VB + (16 * (2 * dh + dt) + fr) * 256 + 8 * (fq & 1); const int c0 = 4 * k2 + (fq >> 1);
                        vlo[dt][k2] = *(const LAS v2u*)(vr + 16 * (c0 ^ fr)); vhi[dt][k2] = *(const LAS v2u*)(vr + 16 * ((c0 + 2) ^ fr)); }
                __builtin_amdgcn_sched_barrier(0);
#pragma unroll
                for (int dt = 0; dt < 2; ++dt)
#pragma unroll
                    for (int k2 = 0; k2 < 4; ++k2) { v4u t; t.x = vlo[dt][k2].x; t.y = vlo[dt][k2].y; t.z = vhi[dt][k2].x; t.w = vhi[dt][k2].y; ao[2 * dh + dt] = mma16(__builtin_bit_cast(bf16x8_t, t), pf[k2], ao[2 * dh + dt]); }
                __builtin_amdgcn_sched_barrier(0); }
        }
        VM_WAIT(); LDS_WAIT(); __syncthreads();
    }
#undef MB3_DMA
    lsum += __shfl_xor(lsum, 16); lsum += __shfl_xor(lsum, 32);
    const float inv = 1.0f / lsum;
    GAS bf16* yp = (GAS bf16*)(F.ws + WS_Y) + ((size_t)b * SEQ + qpos) * YW + 2048 + h * 128 + 4 * fq;
#pragma unroll
    for (int dt = 0; dt < 8; ++dt) { v2u o; o.x = pg8::cvt_pk_bf16(ao[dt][0] * inv, ao[dt][1] * inv); o.y = pg8::cvt_pk_bf16(ao[dt][2] * inv, ao[dt][3] * inv); *(GAS v2u*)(yp + 16 * dt) = o; }
}
constexpr int NPH = 9;
__global__ void __launch_bounds__(NWAVES * 64, 2) fwd_kernel(Args args) {
    extern __shared__ __attribute__((aligned(16))) unsigned char lds[];
    Frame F;
    F.lds = (LAS unsigned char*)lds;
    F.MISC = (volatile LAS unsigned*)(F.lds + MISC_OFF);
    F.tid = threadIdx.x; F.lane = F.tid & 63; F.wave = __builtin_amdgcn_readfirstlane(F.tid >> 6); F.wv = F.wave;
    F.G = gridDim.x; F.in = args.in; F.ws = (GAS unsigned char*)args.ws; F.ws0 = args.ws; F.ctl = (unsigned*)(args.ws + WS_CTL);
    for (int u = F.tid; u < (LDS_BYTES - LDSCTL_OFF) / 4; u += NWAVES * 64) ((LAS unsigned*)(F.lds + LDSCTL_OFF))[u] = 0u;
    __syncthreads();
    XcdBarrier bar; bar.bar = F.ctl + CW_BAR; bar.x = 0; bar.st = nullptr;
    if (args.fused) bar = xcd_barrier_post(F.ctl + CW_BAR, F.MISC + 8);
#define GRID_BAR() do { if (args.fused) xcd_barrier(bar, opaque_tid(F.wv)); } while (0)
    const int lo = args.ph_lo, hi = args.ph_hi;
#ifndef PH_MASK
#define PH_MASK 0x1ff
#endif
#define IN(k) (((PH_MASK >> (k)) & 1) && lo <= (k) && (k) < hi)
#define WSP(T, off) ((GAS T*)(ws + (off)))

    if (args.l_lo == 0 && IN(0)) for (int rep = 0; rep < NREP(0); ++rep) { F.refresh(); p0_prologue(F); GRID_BAR(); }

    for (int l = args.l_lo; l < args.l_hi; ++l) {
        if (IN(1)) for (int rep = 0; rep < NREP(1); ++rep) {
            GAS unsigned char* ws = (GAS unsigned char*)opaque_ptr(args.ws); const GAS unsigned char* wl = ws + WS_W + (size_t)l * SZ_WLAYER;
            pg8::Gemm g{WSP(pg8::bf16_t, WS_XB), DM, (const GAS pg8::bf16_t*)(wl + OFF_WIN), DM, DM, 0, 0}; pg8::TileOrder S; S.init(MTOK, NP, F.G, (int)blockIdx.x, 1);
            pg8::EpiInProj E{WSP(pg8::bf16_t, WS_P), WSP(float, WS_SSQ), WSP(pg8::bf16_t, WS_US)};
            pg8::gemm_phase(F.lds, g, S, E, F.wv);
            if (rep == 0) { F.refresh(); cv_tail(F, l, 0); }
            GRID_BAR();
        }
        if (IN(2)) for (int rep = 0; rep < NREP(2); ++rep) {
            F.refresh(); for (int rp = 0; rp < NREP(12); ++rp) for (int u = blockIdx.x; u < 256; u += F.G) s5_s1_unit(F, l, u);
            VM_WAIT(); __syncthreads(); F.refresh(); for (int rp = 0; rp < NREP(13); ++rp) for (int u = blockIdx.x; u < 512; u += F.G) gla_g1_unit(F, l, u);
            VM_WAIT(); __syncthreads(); F.refresh(); for (int rp = 0; rp < NREP(14); ++rp) for (int u = blockIdx.x; u < 256; u += F.G) moba_prep_unit(F, l, u);
            GRID_BAR(); }
        if (IN(3)) for (int rep = 0; rep < NREP(3); ++rep) {
            F.refresh(); for (int rp = 0; rp < NREP(9); ++rp) for (int u = blockIdx.x; u < 256; u += F.G) s5_s3_unit(F, l, u);
            VM_WAIT(); __syncthreads();
            F.refresh(); for (int rp = 0; rp < NREP(10); ++rp) gla_g2_scan(F);
            VM_WAIT(); __syncthreads(); F.refresh();
            for (int rp = 0; rp < NREP(11); ++rp) for (int pi2 = 2 * blockIdx.x; pi2 < 512; pi2 += 2 * F.G) {
#pragma unroll 1
                for (int hh = 0; hh < 2; ++hh) { const int pi = pi2 >> 1;
                    const int bh = (pi & 7) + 8 * ((pi >> 6) & 3), xp = (pi >> 3) & 7; moba_attn_unit3(F, bh, hh ? xp : 15 - xp); } }
            GRID_BAR(); }
        if (IN(4)) for (int rep = 0; rep < NREP(4); ++rep) {
            const int gh = F.G >= 2 ? F.G / 2 : 1;
            if ((int)blockIdx.x < gh) {
                GAS unsigned char* ws = (GAS unsigned char*)opaque_ptr(args.ws); const GAS unsigned char* wl = ws + WS_W + (size_t)l * SZ_WLAYER;
                pg8::Gemm g{WSP(pg8::bf16_t, WS_Z), 1024, (const GAS pg8::bf16_t*)(wl + OFF_WGLU), 1024, 1024, 0, 0}; pg8::TileOrder S; S.init(MTOK, 1024, gh, (int)blockIdx.x, 1);
                pg8::EpiGLU E{WSP(pg8::bf16_t, WS_Z), WSP(pg8::bf16_t, WS_Y), ((const GAS float*)args.in[I_BGLU]) + l * 1024};
                pg8::gemm_phase(F.lds, g, S, E, F.wv);
            }
            { F.refresh();
              GAS unsigned* head = (GAS unsigned*)(F.ctl + CW_QUEUE + 64 * l);
              for (;;) { if (F.tid == 0) F.MISC[16] = __hip_atomic_fetch_add(head, 1u, __ATOMIC_RELAXED, __HIP_MEMORY_SCOPE_AGENT);
                  LDS_WAIT(); __syncthreads(); const unsigned uq = F.MISC[16]; __syncthreads();
                  if (uq >= 512u) break; gla_g3_unit(F, l, (int)uq); } }
            GRID_BAR();
        }
        if (IN(5)) for (int rep = 0; rep < NREP(5); ++rep) {
            GAS unsigned char* ws = (GAS unsigned char*)opaque_ptr(args.ws); const GAS unsigned char* wl = ws + WS_W + (size_t)l * SZ_WLAYER;
            pg8::Gemm g{WSP(pg8::bf16_t, WS_Y), YW, (const GAS pg8::bf16_t*)(wl + OFF_WBR), 3072, 1024, 1024, 1024}; pg8::TileOrder S; S.init(MTOK, DM, F.G, (int)blockIdx.x, 3);
            pg8::EpiBranch E{WSP(pg8::bf16_t, WS_P), WSP(pg8::bf16_t, WS_MB)};
            pg8::gemm_phase(F.lds, g, S, E, F.wv);
            GRID_BAR();
        }
        if (IN(6)) {
            GAS unsigned char* ws = (GAS unsigned char*)opaque_ptr(args.ws); const GAS unsigned char* wl = ws + WS_W + (size_t)l * SZ_WLAYER;
            pg8::Gemm g{WSP(pg8::bf16_t, WS_MB), DM, (const GAS pg8::bf16_t*)(wl + OFF_WOUT), DM, DM, 0, 0}; pg8::TileOrder S; S.init(MTOK, DM, F.G, (int)blockIdx.x, 1);
            if (l == 0) { pg8::EpiResid<true, false> E{((const GAS float*)args.in[I_X]), nullptr, WSP(pg8::bf16_t, WS_XB), WSP(float, WS_SSQ)}; pg8::gemm_phase(F.lds, g, S, E, F.wv); }
            else { pg8::EpiResid<false, false> E{nullptr, nullptr, WSP(pg8::bf16_t, WS_XB), WSP(float, WS_SSQ)}; pg8::gemm_phase(F.lds, g, S, E, F.wv); }
            GRID_BAR();
        }
        if (IN(7)) for (int rep = 0; rep < NREP(7); ++rep) {
            GAS unsigned char* ws = (GAS unsigned char*)opaque_ptr(args.ws); const GAS unsigned char* wl = ws + WS_W + (size_t)l * SZ_WLAYER;
            pg8::Gemm g{WSP(pg8::bf16_t, WS_XB), DM, (const GAS pg8::bf16_t*)(wl + OFF_WGU), DM, DM, 0, 0}; pg8::TileOrder S; S.init(MTOK, NGU, F.G, (int)blockIdx.x, 1);
            pg8::EpiFFNUp E{WSP(pg8::bf16_t, WS_H), WSP(float, WS_SSQ)};
            pg8::gemm_phase(F.lds, g, S, E, F.wv);
            if (rep == 0) { F.refresh(); cv_tail(F, l, 1); }
            GRID_BAR();
        }
        if (IN(8)) {
            GAS unsigned char* ws = (GAS unsigned char*)opaque_ptr(args.ws); const GAS unsigned char* wl = ws + WS_W + (size_t)l * SZ_WLAYER;
            pg8::Gemm g{WSP(pg8::bf16_t, WS_H), FFN, (const GAS pg8::bf16_t*)(wl + OFF_WDN), FFN, FFN, 0, 0}; pg8::TileOrder S; S.init(MTOK, DM, F.G, (int)blockIdx.x, 1);
            if (l == DEPTH - 1) { pg8::EpiResid<false, true> E{nullptr, (GAS float*)args.out, WSP(pg8::bf16_t, WS_XB), WSP(float, WS_SSQ)}; pg8::gemm_phase(F.lds, g, S, E, F.wv); }
            else { pg8::EpiResid<false, false> E{nullptr, nullptr, WSP(pg8::bf16_t, WS_XB), WSP(float, WS_SSQ)}; pg8::gemm_phase(F.lds, g, S, E, F.wv); }
            if (l + 1 < DEPTH) GRID_BAR();
        }
    }
#undef IN
#undef GRID_BAR
}

extern "C" void kernel_launch(void* const* d_in, const int* in_sizes, int n_in, void* d_out, int out_size, void* d_ws, size_t ws_size, hipStream_t stream) {
    static int grid = 0;
    if (grid == 0) {
        if (n_in != 26 || out_size != MTOK * DM || ws_size < WS_END) { fprintf(stderr, "kernel_launch: unexpected problem (n_in %d out %d ws %zu need %zu)\n", n_in, out_size, ws_size, (size_t)WS_END); grid = -1; return; }
        int dev = 0, cus = 0, per_cu = 0;
        if (hipGetDevice(&dev) != hipSuccess || hipDeviceGetAttribute(&cus, hipDeviceAttributeMultiprocessorCount, dev) != hipSuccess) { grid = -1; return; }
        if (hipFuncSetAttribute((const void*)fwd_kernel, hipFuncAttributeMaxDynamicSharedMemorySize, LDS_BYTES) != hipSuccess) { fprintf(stderr, "kernel_launch: hipFuncSetAttribute failed\n"); grid = -1; return; }
        if (hipOccupancyMaxActiveBlocksPerMultiprocessor(&per_cu, (const void*)fwd_kernel, NWAVES * 64, LDS_BYTES) != hipSuccess || per_cu < 1) { fprintf(stderr, "kernel_launch: occupancy query says %d\n", per_cu); }
        (void)hipGetLastError();
        grid = cus;
    }
    if (grid < 0) return;
    if (hipMemsetAsync((char*)d_ws + WS_CTL, 0, CTL_ZERO_BYTES, stream) != hipSuccess) return;
    Args a{};
    for (int i = 0; i < 26; ++i) a.in[i] = (const float*)d_in[i];
    a.out = (float*)d_out; a.ws = (unsigned char*)d_ws; a.pad = 0;
#if MK_FUSED
    a.l_lo = 0; a.l_hi = DEPTH; a.ph_lo = 0; a.ph_hi = NPH; a.fused = 1;
    hipLaunchKernelGGL(fwd_kernel, dim3(grid), dim3(NWAVES * 64), LDS_BYTES, stream, a);
#else
    a.fused = 0;
    for (int l = 0; l < DEPTH; ++l)
        for (int ph = (l == 0 ? 0 : 1); ph < NPH; ++ph) { a.l_lo = l; a.l_hi = l + 1; a.ph_lo = ph; a.ph_hi = ph + 1; hipLaunchKernelGGL(fwd_kernel, dim3(grid), dim3(NWAVES * 64), LDS_BYTES, stream, a); }
#endif
}
```

```cpp
#include <hip/hip_runtime.h>
#include <cstdio>
#include <cstdint>

#ifndef REPEAT_MASK
#define REPEAT_MASK 0
#endif
#ifndef REPF
#define REPF 1
#endif
#define NREP(k) (1 + REPF * ((REPEAT_MASK >> (k)) & 1))
#ifndef ATT_REP
#define ATT_REP 1
#endif
#ifndef MK_FUSED
#define MK_FUSED 1
#endif

__device__ __forceinline__ unsigned char* opaque_ptr(unsigned char* p) { asm volatile("" : "+s"(p)); return p; }
__device__ __forceinline__ int opaque_tid(int wv) { int ln; asm volatile("v_mbcnt_lo_u32_b32 %0, -1, 0\n\tv_mbcnt_hi_u32_b32 %0, -1, %0" : "=v"(ln)); return (wv << 6) | ln; }

namespace pg8 {
#define PG8_LAS __attribute__((address_space(3)))
typedef unsigned short bf16_t;
typedef short bf16x8 __attribute__((ext_vector_type(8)));
typedef float f32x4 __attribute__((ext_vector_type(4)));
typedef unsigned u32x4 __attribute__((ext_vector_type(4)));
typedef unsigned u32x2 __attribute__((ext_vector_type(2)));
constexpr int BM = 256, BK = 64, HALF = 128, HTB = HALF * BK * 2, STAGE_BYTES = 8 * HTB, NXCD = 8, WGM = 8;

__host__ __device__ __forceinline__ int lds_byte(int r, int c) { const int st = (r >> 4) * 2 + (c >> 5), rr = r & 15, cc = c & 31, ob = rr * 64 + cc * 2; return st * 1024 + (ob ^ (((ob >> 9) & 1) << 5)); }
__host__ __device__ __forceinline__ void stage_rc(int b, int& R, int& C) { const int st = b / 1024, sb = b % 1024, swz = sb ^ (((sb >> 9) & 1) << 5); R = (st >> 1) * 16 + swz / 64; C = (st & 1) * 32 + (swz % 64) / 2; }
__host__ __device__ __forceinline__ int perm32(int rho) { const int n = rho >> 4, i = rho & 15; return 8 * (i >> 2) + 4 * n + (i & 3); }

struct Unit { int pm, pn, br; };
struct Gemm { const __attribute__((address_space(1))) bf16_t* A; int lda; const __attribute__((address_space(1))) bf16_t* Bt; int ldb; int K; int abr, bbr; };

struct TileOrder {
    int nM, nN, nwg, G, c, nbr;
    __device__ __forceinline__ void init(int M, int N, int G_, int c_, int nbr_) { asm volatile("" : "+s"(G_), "+s"(c_)); nM = M / BM; nN = N / BM; nwg = nM * nN; G = G_; c = c_; nbr = nbr_; }
    __device__ __forceinline__ bool next(int i, Unit& u) const {
        const int it = i / nbr; u.br = i - it * nbr;
        const long L = (long)it * G + c; if (L >= nwg) return false;
        int wgid = (int)L; { const int q = nwg / NXCD, r = nwg % NXCD, xcd = wgid % NXCD, off = wgid / NXCD; wgid = (xcd < r ? xcd * (q + 1) : r * (q + 1) + (xcd - r) * q) + off; }
        const int nig = WGM * nN, gid = wgid / nig, fm = gid * WGM, gsz = (nM - fm) < WGM ? (nM - fm) : WGM;
        u.pm = __builtin_amdgcn_readfirstlane(fm + ((wgid % nig) % gsz)); u.pn = __builtin_amdgcn_readfirstlane((wgid % nig) / gsz); return true;
    }
};

__device__ __forceinline__ unsigned cvt_pk_bf16(float lo, float hi) { unsigned r; asm volatile("v_cvt_pk_bf16_f32 %0, %1, %2" : "=v"(r) : "v"(lo), "v"(hi)); return r; }

template <class Epi, class Sched>
__device__ __forceinline__ void gemm_phase(PG8_LAS unsigned char* lds, const Gemm g, const Sched& S, const Epi& E, int wv) {
    const int tid = opaque_tid(wv), wid = __builtin_amdgcn_readfirstlane(tid >> 6), lane = tid & 63, wr = wid >> 2, wc = wid & 3, fr = lane & 15, fq = lane >> 4;
    const int K = g.K, nt = K / BK;
    unsigned voffA[2], voffB[2];
#pragma unroll
    for (int i = 0; i < 2; ++i) { int R, C; stage_rc(tid * 16 + i * 8192, R, C); const int Rb = (R & ~31) + perm32(R & 31);
        voffA[i] = (unsigned)(R * g.lda + C) * 2u; voffB[i] = (unsigned)(Rb * g.ldb + C) * 2u; }
    const size_t kstep = (size_t)(BK * 2);
    const size_t hstepA = (size_t)HALF * g.lda * 2, hstepB = (size_t)HALF * g.ldb * 2;
    const size_t tstepA = 2 * hstepA, tstepB = 2 * hstepB;
    const unsigned ldsw = (unsigned)wid * 1024u;
    const int aoff = lds_byte(wr * 64 + fr, fq * 8), boff = lds_byte(wc * 32 + fr, fq * 8);
#define PG8_SA(b, h) (((b) * 2 + (h)) * HTB)
#define PG8_SB(b, h) ((4 + (b) * 2 + (h)) * HTB)
#define PG8_STAGE(bufoff, gbase, voff) do { _Pragma("unroll") for (int _i = 0; _i < 2; ++_i) \
        __builtin_amdgcn_global_load_lds((const unsigned*)((const char*)(gbase) + (voff)[_i]), (PG8_LAS unsigned*)(lds + (bufoff) + ldsw + _i * 8192), 16, 0, 0); } while (0)
#define PG8_LDA(dst, b, h) do { _Pragma("unroll") for (int m = 0; m < 4; ++m) _Pragma("unroll") for (int k = 0; k < 2; ++k) dst[m][k] = *(const PG8_LAS bf16x8*)(lds + PG8_SA(b, h) + aoff + m * 2048 + k * 1024); } while (0)
#define PG8_LDB(dst, b, h) do { _Pragma("unroll") for (int n = 0; n < 2; ++n) _Pragma("unroll") for (int k = 0; k < 2; ++k) dst[n][k] = *(const PG8_LAS bf16x8*)(lds + PG8_SB(b, h) + boff + n * 2048 + k * 1024); } while (0)
#define PG8_MMA(ai, bj, At, Bt) do { __builtin_amdgcn_s_setprio(1); _Pragma("unroll") for (int m = 0; m < 4; ++m) _Pragma("unroll") for (int n = 0; n < 2; ++n) _Pragma("unroll") for (int k = 0; k < 2; ++k) \
        acc[ai][bj][m][n] = __builtin_amdgcn_mfma_f32_16x16x32_bf16(Bt[n][k], At[m][k], acc[ai][bj][m][n], 0, 0, 0); __builtin_amdgcn_s_setprio(0); } while (0)
#define PG8_WAIT_V(n) asm volatile("s_waitcnt vmcnt(" #n ")" ::: "memory")
#define PG8_WAIT_L(n) asm volatile("s_waitcnt lgkmcnt(" #n ")" ::: "memory")
#define PG8_BAR __builtin_amdgcn_s_barrier()
#define PG8_SCHED __builtin_amdgcn_sched_barrier(0)
    Unit cur, nxt; int ui = 0;
    if (!S.next(0, cur)) return;
    f32x4 acc[2][2][4][2];
#pragma unroll
    for (int a = 0; a < 2; ++a)
#pragma unroll
        for (int b = 0; b < 2; ++b)
#pragma unroll
            for (int m = 0; m < 4; ++m)
#pragma unroll
                for (int n = 0; n < 2; ++n) acc[a][b][m][n] = (f32x4){0.f, 0.f, 0.f, 0.f};
    bf16x8 At[4][2], B0[2][2], B1[2][2];
    const char* cA = (const char*)g.A + (size_t)cur.pm * tstepA + (size_t)cur.br * g.abr * 2; const char* cB = (const char*)g.Bt + (size_t)cur.pn * tstepB + (size_t)cur.br * g.bbr * 2;
    PG8_STAGE(PG8_SB(0, 0), cB, voffB); PG8_STAGE(PG8_SB(0, 1), cB + hstepB, voffB); PG8_STAGE(PG8_SA(0, 0), cA, voffA); PG8_STAGE(PG8_SA(0, 1), cA + hstepA, voffA);
    if (wr == 1) PG8_BAR;
    PG8_WAIT_V(2); PG8_BAR;
    PG8_STAGE(PG8_SB(1, 0), cB + kstep, voffB); PG8_STAGE(PG8_SA(1, 0), cA + kstep, voffA); PG8_STAGE(PG8_SB(1, 1), cB + hstepB + kstep, voffB);
    PG8_WAIT_V(6); PG8_BAR;
    for (;;) {
        const bool has_next = S.next(ui + 1, nxt);
        const char* nA = has_next ? (const char*)g.A + (size_t)nxt.pm * tstepA + (size_t)nxt.br * g.abr * 2 : cA; const char* nB = has_next ? (const char*)g.Bt + (size_t)nxt.pn * tstepB + (size_t)nxt.br * g.bbr * 2 : cB;
        for (int t = 0; t < nt; t += 2) {
            const bool last = (t == nt - 2);
            const char* a1 = cA + (size_t)(t + 1) * kstep;
            const char* a2 = last ? nA : cA + (size_t)(t + 2) * kstep; const char* b2 = last ? nB : cB + (size_t)(t + 2) * kstep;
            const char* a3 = a2 + kstep; const char* b3 = b2 + kstep;
            PG8_LDB(B0, 0, 0); PG8_LDB(B1, 0, 1); PG8_SCHED; PG8_LDA(At, 0, 0); PG8_STAGE(PG8_SA(1, 1), a1 + hstepA, voffA);
            PG8_WAIT_V(8); PG8_WAIT_L(0); PG8_BAR; PG8_MMA(0, 0, At, B0); PG8_MMA(0, 1, At, B1); PG8_BAR; PG8_SCHED;
            PG8_LDA(At, 0, 1); PG8_STAGE(PG8_SB(0, 0), b2, voffB); PG8_STAGE(PG8_SB(0, 1), b2 + hstepB, voffB); PG8_STAGE(PG8_SA(0, 0), a2, voffA);
            PG8_WAIT_V(8); PG8_WAIT_L(0); PG8_BAR; PG8_MMA(1, 0, At, B0); PG8_MMA(1, 1, At, B1); PG8_BAR; PG8_SCHED;
            PG8_LDB(B0, 1, 0); PG8_LDB(B1, 1, 1); PG8_SCHED; PG8_LDA(At, 1, 0); PG8_STAGE(PG8_SA(0, 1), a2 + hstepA, voffA);
            PG8_WAIT_V(8); PG8_WAIT_L(0); PG8_BAR; PG8_MMA(0, 0, At, B0); PG8_MMA(0, 1, At, B1); PG8_BAR; PG8_SCHED;
            PG8_LDA(At, 1, 1); PG8_STAGE(PG8_SB(1, 0), b3, voffB); PG8_STAGE(PG8_SB(1, 1), b3 + hstepB, voffB); PG8_STAGE(PG8_SA(1, 0), a3, voffA);
            PG8_WAIT_V(8); PG8_WAIT_L(0); PG8_BAR; PG8_MMA(1, 0, At, B0); PG8_MMA(1, 1, At, B1); PG8_BAR; PG8_SCHED;
        }
        if (wr == 0) PG8_BAR;
        E(acc, cur, wr, wc, fr, fq, lds);
        if (!has_next) break;
        if (!Epi::CHAIN || cur.br == S.nbr - 1) {
#pragma unroll
        for (int a = 0; a < 2; ++a)
#pragma unroll
            for (int b = 0; b < 2; ++b)
#pragma unroll
                for (int m = 0; m < 4; ++m)
#pragma unroll
                    for (int n = 0; n < 2; ++n) acc[a][b][m][n] = (f32x4){0.f, 0.f, 0.f, 0.f};
        }
        cur = nxt; cA = nA; cB = nB; ++ui;
        if (wr == 1) PG8_BAR;
    }
    PG8_WAIT_V(0);
    PG8_BAR;
#undef PG8_SA
#undef PG8_SB
#undef PG8_STAGE
#undef PG8_LDA
#undef PG8_LDB
#undef PG8_MMA
#undef PG8_WAIT_V
#undef PG8_WAIT_L
#undef PG8_BAR
#undef PG8_SCHED
}
}

constexpr int NWAVES = 8;
constexpr int DM = 2048, NBATCH = 4, SEQ = 2048, DEPTH = 4, MTOK = NBATCH * SEQ;
constexpr int INW = 13328;
constexpr int NP = 13568;
constexpr int PC_SSM = 0, PC_GQ = 1024, PC_GK = 1536, PC_GV = 2048, PC_GR = 3072, PC_MQ = 4096, PC_MK = 5120, PC_MV = 6144, PC_GS = 7168, PC_GLR = 13312;
constexpr int FFN = 5632, NGU = 2 * FFN;
constexpr int YW = 3072;
constexpr float RMS_EPS = 1e-6f;

constexpr size_t MiB = 1u << 20;
constexpr size_t WS_CTL = 0, CTL_ZERO_BYTES = 1 * MiB;
constexpr size_t SZ_WIN = (size_t)NP * DM * 2, SZ_WGLU = (size_t)1024 * 1024 * 2, SZ_WBR = (size_t)DM * 3072 * 2, SZ_WOUT = (size_t)DM * DM * 2, SZ_WGU = (size_t)NGU * DM * 2, SZ_WDN = (size_t)DM * FFN * 2;
constexpr size_t OFF_WIN = 0, OFF_WGLU = OFF_WIN + SZ_WIN, OFF_WBR = OFF_WGLU + SZ_WGLU, OFF_WOUT = OFF_WBR + SZ_WBR, OFF_WGU = OFF_WOUT + SZ_WOUT, OFF_WDN = OFF_WGU + SZ_WGU, SZ_WLAYER = OFF_WDN + SZ_WDN;
constexpr size_t WS_W = 2 * MiB;
constexpr size_t WS_P = WS_W + ((DEPTH * SZ_WLAYER + MiB - 1) / MiB) * MiB;
constexpr size_t WS_Z = WS_P + (size_t)MTOK * NP * 2;
constexpr size_t WS_Y = WS_Z + (size_t)MTOK * 1024 * 2;
constexpr size_t WS_MB = WS_Y + (size_t)MTOK * YW * 2;
constexpr size_t WS_XB = WS_MB + (size_t)MTOK * DM * 2;
constexpr size_t WS_H = WS_XB + (size_t)MTOK * DM * 2;
constexpr size_t WS_SSQ = WS_H + (size_t)MTOK * FFN * 2;
constexpr size_t WS_QN = WS_SSQ + (size_t)MTOK * 8 * 4;
constexpr size_t WS_KN = WS_QN + (size_t)MTOK * 1024 * 2;
constexpr size_t WS_KM = WS_KN + (size_t)MTOK * 1024 * 2;
constexpr size_t WS_TK = WS_KM + (size_t)4 * 8 * 8 * 128 * 4;
constexpr size_t WS_TW = WS_TK + (size_t)DEPTH * 64 * 64 * 256 * 2;
constexpr size_t WS_TC = WS_TW + (size_t)DEPTH * 64 * 128 * 1024 * 2;
constexpr size_t WS_A64 = WS_TC + (size_t)DEPTH * 64 * 1024 * 128 * 2;
constexpr size_t WS_SL = WS_A64 + (size_t)DEPTH * 64 * 128 * 4;
constexpr size_t WS_QD = WS_SL + (size_t)NBATCH * 32 * 64 * 128 * 4;
constexpr size_t WS_KI = WS_QD + (size_t)512 * 64 * 128 * 2;
constexpr size_t WS_GVT = WS_KI + (size_t)512 * 64 * 128 * 2;
constexpr size_t WS_KV = WS_GVT + (size_t)512 * 256 * 64 * 2;
constexpr size_t WS_DEC = WS_KV + (size_t)512 * 256 * 128 * 2;
constexpr size_t WS_ST = WS_DEC + (size_t)512 * 128 * 4;
constexpr size_t WS_VT = WS_ST + (size_t)512 * 256 * 128 * 2;
constexpr size_t WS_US = WS_VT + (size_t)NBATCH * 8 * 128 * SEQ * 2;
constexpr size_t WS_END = WS_US + (size_t)MTOK * 1024 * 2;
constexpr int CW_BAR = 4096;
constexpr int CW_QUEUE = 16384;

constexpr int RING_BYTES = 135168;
constexpr int LDSCTL_OFF = RING_BYTES, MISC_OFF = LDSCTL_OFF + 320;
constexpr int TAB_OFF = RING_BYTES + 1024;
constexpr int LDS_BYTES = 147456;

#define GAS __attribute__((address_space(1)))
#define LAS __attribute__((address_space(3)))
typedef unsigned short bf16;
typedef unsigned v4u __attribute__((ext_vector_type(4)));
typedef unsigned v2u __attribute__((ext_vector_type(2)));
typedef float f32x4 __attribute__((ext_vector_type(4)));
typedef float f32x2 __attribute__((ext_vector_type(2)));
#define LDS_WAIT() asm volatile("s_waitcnt lgkmcnt(0)" ::: "memory")
#define VM_WAIT() asm volatile("s_waitcnt vmcnt(0)" ::: "memory")
__device__ __forceinline__ unsigned f2bf(float f) { unsigned u = __builtin_bit_cast(unsigned, f); return (u + 0x7fffu + ((u >> 16) & 1u)) >> 16; }
__device__ __forceinline__ unsigned pk2(float lo, float hi) { return f2bf(lo) | (f2bf(hi) << 16); }
__device__ __forceinline__ float bflo(unsigned u) { return __builtin_bit_cast(float, u << 16); }
__device__ __forceinline__ float bfhi(unsigned u) { return __builtin_bit_cast(float, u & 0xffff0000u); }
__device__ __forceinline__ float bf1(bf16 b) { return __builtin_bit_cast(float, ((unsigned)b) << 16); }
__device__ __forceinline__ float sigmoidf_(float x) { return __builtin_amdgcn_rcpf(1.0f + __expf(-x)); }
__device__ __forceinline__ float gelu_tanh(float x) { const float u = 0.7978845608028654f * (x + 0.044715f * x * x * x); return x * sigmoidf_(2.0f * u); }
__device__ __forceinline__ float wave_sum(float v) {
#pragma unroll
    for (int o = 1; o < 64; o <<= 1) v += __shfl_xor(v, o);
    return v;
}
__device__ __forceinline__ float wave_max(float v) {
#pragma unroll
    for (int o = 1; o < 64; o <<= 1) v = fmaxf(v, __shfl_xor(v, o));
    return v;
}

#define XB_TMO      128
#define XB_XCNT(j)  (256  + 64 * (j))
#define XB_XSUB(j)  (1280 + 64 * (j))
#define XB_XGEN(j)  (2304 + 64 * (j))
#define XB_TOP      3328
#define XB_TOPGEN   3392
#define XCD_BAR_WORDS 3456
#define XB_SPIN_CAP (1u << 18)
__device__ __forceinline__ unsigned xb_ld(unsigned* p)              { return __hip_atomic_load(p, __ATOMIC_RELAXED, __HIP_MEMORY_SCOPE_AGENT); }
__device__ __forceinline__ unsigned xb_add(unsigned* p, unsigned v) { return __hip_atomic_fetch_add(p, v, __ATOMIC_RELAXED, __HIP_MEMORY_SCOPE_AGENT); }
__device__ __forceinline__ unsigned xb_xcc_id() { return (unsigned)__builtin_amdgcn_s_getreg((3 << 11) | 20) & 0xFu; }
#define XB_SPIN(cond, bar) do { unsigned _sp = 0; while (cond) { __builtin_amdgcn_s_sleep(1); \
    if ((++_sp & 255u) == 0u) { if (xb_ld(&(bar)[XB_TMO])) break; if (_sp > XB_SPIN_CAP) { atomicAdd(&(bar)[XB_TMO], 1u); break; } } } } while (0)
struct XcdBarrier { unsigned* bar; unsigned x; volatile LAS unsigned* st; };
__device__ __forceinline__ XcdBarrier xcd_barrier_post(unsigned* bar, volatile LAS unsigned* st) {
    XcdBarrier b; b.bar = bar; b.x = xb_xcc_id(); b.st = st;
    if (threadIdx.x == 0) (void)xb_add(&bar[XB_XCNT(b.x)], 1u);
    return b;
}
__device__ __forceinline__ void xcd_barrier_complete(unsigned* bar, unsigned x, unsigned& nloc, unsigned& nx) {
    const unsigned G = gridDim.x * gridDim.y * gridDim.z;
    unsigned sum, cnt, mine, sp = 0u;
    for (;;) {
        sum = 0u; cnt = 0u; mine = 0u;
#pragma unroll
        for (unsigned j = 0; j < 16; ++j) { const unsigned c = xb_ld(&bar[XB_XCNT(j)]); sum += c; cnt += (c > 0u) ? 1u : 0u; mine = (j == x) ? c : mine; }
        if (sum == G) break;
        __builtin_amdgcn_s_sleep(1);
        if ((++sp & 255u) == 0u) { if (xb_ld(&bar[XB_TMO])) break; if (sp > XB_SPIN_CAP) { atomicAdd(&bar[XB_TMO], 1u); break; } }
    }
    nloc = mine > 0u ? mine : 1u; nx = cnt > 0u ? cnt : 1u;
}
__device__ __forceinline__ void xcd_barrier(const XcdBarrier& b, int tid) {
    asm volatile("s_waitcnt vmcnt(0)" ::: "memory");
    __syncthreads();
    if (tid == 0) {
        unsigned* bar = b.bar;
        __builtin_amdgcn_s_waitcnt(0);
        unsigned nloc = b.st[0], nx = b.st[1];
        if (nloc == 0u) { xcd_barrier_complete(bar, b.x, nloc, nx); b.st[0] = nloc; b.st[1] = nx; }
        const unsigned old = xb_add(&bar[XB_XSUB(b.x)], 1u);
        const unsigned gen = old / nloc;
        if (old + 1u == (gen + 1u) * nloc) {
            __builtin_amdgcn_fence(__ATOMIC_RELEASE, "agent");
            asm volatile("s_waitcnt vmcnt(0)" ::: "memory");
            const unsigned og = xb_add(&bar[XB_TOP], 1u);
            const unsigned tg = og / nx;
            if (og + 1u == (tg + 1u) * nx) xb_add(&bar[XB_TOPGEN], 1u);
            else XB_SPIN(xb_ld(&bar[XB_TOPGEN]) == tg, bar);
            __builtin_amdgcn_fence(__ATOMIC_ACQUIRE, "agent");
            xb_add(&bar[XB_XGEN(b.x)], 1u);
            asm volatile("s_waitcnt vmcnt(0)" ::: "memory");
        } else {
            XB_SPIN(xb_ld(&bar[XB_XGEN(b.x)]) == gen, bar);
            __builtin_amdgcn_fence(__ATOMIC_ACQUIRE, "agent");
            asm volatile("s_waitcnt vmcnt(0)" ::: "memory");
        }
    }
    __syncthreads();
}

struct Args {
    const float* in[26];
    float* out; unsigned char* ws;
    int l_lo, l_hi, ph_lo, ph_hi;
    int fused, pad;
};
enum { I_X = 0, I_N1G, I_WIN, I_LRE, I_LIM, I_LDT, I_BRE, I_BIM, I_CRE, I_CIM, I_SD, I_WGLU, I_BGLU, I_GW2, I_GB2, I_GNG, I_MQG, I_MKG, I_WBS, I_WBG, I_WBM, I_WOUT, I_N2G, I_FWG, I_FWU, I_FWD };

namespace pg8 {
#define EPI_FENCE() asm volatile("" ::: "memory")
__device__ __forceinline__ void load_rstd(const GAS float* ssq, int pm, int wr, int fr, int fq, float (&rs)[2][4]) {
    f32x2 p[2][4];
#pragma unroll
    for (int ai = 0; ai < 2; ++ai)
#pragma unroll
        for (int m = 0; m < 4; ++m) { const int row = pm * BM + ai * HALF + wr * 64 + m * 16 + fr; p[ai][m] = *(const GAS f32x2*)(ssq + (size_t)row * 8 + 2 * fq); }
#pragma unroll
    for (int ai = 0; ai < 2; ++ai)
#pragma unroll
        for (int m = 0; m < 4; ++m) { float s = p[ai][m][0] + p[ai][m][1]; s += __shfl_xor(s, 16); s += __shfl_xor(s, 32); rs[ai][m] = __builtin_amdgcn_rsqf(s * (1.0f / DM) + RMS_EPS); }
    EPI_FENCE();
}
struct EpiInProj {
    static constexpr bool CHAIN = false;
    GAS bf16_t* P; const GAS float* ssq; GAS bf16_t* US; GAS bf16_t* QN; GAS bf16_t* KN; GAS float* KM; const GAS float* qg; const GAS float* kg;
    __device__ __forceinline__ void operator()(const f32x4 (&acc)[2][2][4][2], const Unit& u, int wr, int wc, int fr, int fq, PG8_LAS unsigned char* lds) const {
        float rs[2][4]; load_rstd(ssq, u.pm, wr, fr, fq, rs);
        const int row0 = u.pm * BM + wr * 64 + fr, col0 = u.pn * BM + wc * 32 + 8 * fq;
        if (u.pn >= 16 && u.pn < 24) {
            const bool isk = u.pn >= 20;
            PG8_LAS float* T0 = (PG8_LAS float*)(lds + TAB_OFF); PG8_LAS float* CS = T0 + 2048;
#pragma unroll
            for (int ai = 0; ai < 2; ++ai)
#pragma unroll
                for (int m = 0; m < 4; ++m) { const float r = rs[ai][m];
#pragma unroll
                    for (int bj = 0; bj < 2; ++bj) { const f32x4 v0 = acc[ai][bj][m][0] * r, v1 = acc[ai][bj][m][1] * r;
                        float s = (v0[0] * v0[0] + v0[1] * v0[1]) + (v0[2] * v0[2] + v0[3] * v0[3]) + (v1[0] * v1[0] + v1[1] * v1[1]) + (v1[2] * v1[2] + v1[3] * v1[3]);
                        s += __shfl_xor(s, 16); s += __shfl_xor(s, 32);
                        if (fq == 0) T0[bj * 1024 + (ai * HALF + wr * 64 + m * 16 + fr) * 4 + wc] = s; } }
            asm volatile("s_waitcnt lgkmcnt(0)" ::: "memory"); __builtin_amdgcn_s_barrier(); asm volatile("" ::: "memory");
            const GAS float* gp = (isk ? kg : qg) + wc * 32 + 8 * fq; const f32x4 g0 = *(const GAS f32x4*)gp, g1 = *(const GAS f32x4*)(gp + 4);
            const float hs = isk ? 1.0f : 0.08838834764831845f * 1.4426950408889634f;
            GAS bf16_t* dst = (isk ? KN : QN) + (size_t)row0 * 1024 + (u.pn & 3) * 256 + wc * 32 + 8 * fq;
            float cs[2][8];
#pragma unroll
            for (int bj = 0; bj < 2; ++bj)
#pragma unroll
                for (int e = 0; e < 8; ++e) cs[bj][e] = 0.f;
#pragma unroll
            for (int ai = 0; ai < 2; ++ai)
#pragma unroll
                for (int m = 0; m < 4; ++m) { const float r = rs[ai][m];
#pragma unroll
                    for (int bj = 0; bj < 2; ++bj) { const f32x4 p4 = *(const PG8_LAS f32x4*)(T0 + bj * 1024 + (ai * HALF + wr * 64 + m * 16 + fr) * 4);
                        const float sc = r * hs * __builtin_amdgcn_rsqf(((p4[0] + p4[1]) + (p4[2] + p4[3])) * (1.0f / 128.0f) + RMS_EPS);
                        const f32x4 v0 = acc[ai][bj][m][0] * sc * g0, v1 = acc[ai][bj][m][1] * sc * g1;
                        u32x4 w; w.x = cvt_pk_bf16(v0[0], v0[1]); w.y = cvt_pk_bf16(v0[2], v0[3]); w.z = cvt_pk_bf16(v1[0], v1[1]); w.w = cvt_pk_bf16(v1[2], v1[3]);
                        *(GAS u32x4*)(dst + (size_t)(ai * HALF + m * 16) * 1024 + bj * HALF) = w;
                        if (isk) { cs[bj][0] += bflo(w.x); cs[bj][1] += bfhi(w.x); cs[bj][2] += bflo(w.y); cs[bj][3] += bfhi(w.y); cs[bj][4] += bflo(w.z); cs[bj][5] += bfhi(w.z); cs[bj][6] += bflo(w.w); cs[bj][7] += bfhi(w.w); } } }
            if (isk) {
#pragma unroll
                for (int bj = 0; bj < 2; ++bj)
#pragma unroll
                    for (int e = 0; e < 8; ++e) { float c = cs[bj][e]; c += __shfl_xor(c, 1); c += __shfl_xor(c, 2); c += __shfl_xor(c, 4); c += __shfl_xor(c, 8); cs[bj][e] = c; }
                if (fr == 0) {
#pragma unroll
                    for (int bj = 0; bj < 2; ++bj) { PG8_LAS float* cp = CS + wr * 256 + bj * HALF + wc * 32 + 8 * fq;
                        *(PG8_LAS f32x4*)cp = (f32x4){cs[bj][0], cs[bj][1], cs[bj][2], cs[bj][3]}; *(PG8_LAS f32x4*)(cp + 4) = (f32x4){cs[bj][4], cs[bj][5], cs[bj][6], cs[bj][7]}; } }
                asm volatile("s_waitcnt lgkmcnt(0)" ::: "memory"); __builtin_amdgcn_s_barrier(); asm volatile("" ::: "memory");
                const int t = (wr * 4 + wc) * 64 + fq * 16 + fr;
                if (t < 256) { const int hd = 2 * (u.pn & 3) + (t >> 7);
                    KM[((size_t)((u.pm >> 3) * 8 + hd) * 8 + (u.pm & 7)) * 128 + (t & 127)] = (CS[t] + CS[256 + t]) * (1.0f / 256.0f); }
            }
            return;
        }
        const bool ssm = u.pn < 4;
#pragma unroll
        for (int ai = 0; ai < 2; ++ai)
#pragma unroll
            for (int m = 0; m < 4; ++m) { const int row = row0 + ai * HALF + m * 16; GAS bf16_t* rowp = P + (size_t)row * NP + col0; const float r = rs[ai][m];
#pragma unroll
                for (int bj = 0; bj < 2; ++bj) { const f32x4 v0 = acc[ai][bj][m][0] * r, v1 = acc[ai][bj][m][1] * r;
                    u32x4 w; w.x = cvt_pk_bf16(v0[0], v0[1]); w.y = cvt_pk_bf16(v0[2], v0[3]); w.z = cvt_pk_bf16(v1[0], v1[1]); w.w = cvt_pk_bf16(v1[2], v1[3]);
                    if (ssm) { const int col = col0 + bj * HALF; *(GAS u32x4*)(US + ((size_t)((row >> 11) * 64 + (col >> 4)) * SEQ + (row & (SEQ - 1))) * 16 + (col & 8)) = w; }
                    else *(GAS u32x4*)(rowp + bj * HALF) = w; } }
    }
};
struct EpiGLU {
    static constexpr bool CHAIN = false;
    const GAS bf16_t* Z; GAS bf16_t* Y; const GAS float* bias;
    __device__ __forceinline__ void operator()(const f32x4 (&acc)[2][2][4][2], const Unit& u, int wr, int wc, int fr, int fq, PG8_LAS unsigned char*) const {
        const int row0 = u.pm * BM + wr * 64 + fr, col0 = u.pn * BM + wc * 32 + 8 * fq;
        f32x4 bv[2][2];
#pragma unroll
        for (int bj = 0; bj < 2; ++bj)
#pragma unroll
            for (int n = 0; n < 2; ++n) bv[bj][n] = *(const GAS f32x4*)(bias + col0 + bj * HALF + 4 * n);
        u32x4 zb[4][2];
#pragma unroll
        for (int bt = 0; bt < 2; ++bt) {
#pragma unroll
            for (int i4 = 0; i4 < 4; ++i4) { const int idx = 4 * bt + i4; const size_t row = (size_t)(row0 + (idx >> 2) * HALF + (idx & 3) * 16);
#pragma unroll
                for (int bj = 0; bj < 2; ++bj) zb[i4][bj] = *(const GAS u32x4*)(Z + row * 1024 + col0 + bj * HALF); }
#pragma unroll
            for (int i4 = 0; i4 < 4; ++i4) { const int idx = 4 * bt + i4, ai = idx >> 2, m = idx & 3; const size_t row = (size_t)(row0 + ai * HALF + m * 16);
#pragma unroll
                for (int bj = 0; bj < 2; ++bj) { const u32x4 zz = zb[i4][bj];
                    const f32x4 g0 = acc[ai][bj][m][0] + bv[bj][0], g1 = acc[ai][bj][m][1] + bv[bj][1];
                    u32x4 w;
                    w.x = cvt_pk_bf16(bflo(zz.x) * sigmoidf_(g0[0]), bfhi(zz.x) * sigmoidf_(g0[1])); w.y = cvt_pk_bf16(bflo(zz.y) * sigmoidf_(g0[2]), bfhi(zz.y) * sigmoidf_(g0[3]));
                    w.z = cvt_pk_bf16(bflo(zz.z) * sigmoidf_(g1[0]), bfhi(zz.z) * sigmoidf_(g1[1])); w.w = cvt_pk_bf16(bflo(zz.w) * sigmoidf_(g1[2]), bfhi(zz.w) * sigmoidf_(g1[3]));
                    *(GAS u32x4*)(Y + row * YW + col0 + bj * HALF) = w; } }
            EPI_FENCE();
        }
    }
};
struct EpiBranch {
    static constexpr bool CHAIN = true;
    const GAS bf16_t* P; GAS bf16_t* MB;
    __device__ __forceinline__ void operator()(f32x4 (&acc)[2][2][4][2], const Unit& u, int wr, int wc, int fr, int fq, PG8_LAS unsigned char*) const {
        const int row0 = u.pm * BM + wr * 64 + fr, col0 = u.pn * BM + wc * 32 + 8 * fq;
        const int br = u.br;
        u32x4 ga[2][2], gb[2][2];
#pragma unroll
        for (int bt = 0; bt < 4; ++bt) {
#pragma unroll
            for (int i4 = 0; i4 < 2; ++i4) { const int idx = 2 * bt + i4; const size_t row = (size_t)(row0 + (idx >> 2) * HALF + (idx & 3) * 16);
#pragma unroll
                for (int bj = 0; bj < 2; ++bj) { const GAS bf16_t* gp = P + row * NP + PC_GS + br * DM + col0 + bj * HALF; ga[i4][bj] = *(const GAS u32x4*)gp; if (br != 2) gb[i4][bj] = *(const GAS u32x4*)(gp + DM); } }
#pragma unroll
            for (int i4 = 0; i4 < 2; ++i4) { const int idx = 2 * bt + i4, ai = idx >> 2, m = idx & 3; const size_t row = (size_t)(row0 + ai * HALF + m * 16);
#pragma unroll
                for (int bj = 0; bj < 2; ++bj) { const u32x4 g0 = ga[i4][bj]; const unsigned g0w[4] = {g0.x, g0.y, g0.z, g0.w}; float f[8];
                    if (br != 2) { const u32x4 g1 = gb[i4][bj]; const unsigned g1w[4] = {g1.x, g1.y, g1.z, g1.w};
#pragma unroll
                        for (int e = 0; e < 4; ++e) {
                            const float a0 = __builtin_amdgcn_fmed3f(bflo(g0w[e]), -30.f, 30.f), a1 = __builtin_amdgcn_fmed3f(bfhi(g0w[e]), -30.f, 30.f), b0 = __builtin_amdgcn_fmed3f(bflo(g1w[e]), -30.f, 30.f), b1 = __builtin_amdgcn_fmed3f(bfhi(g1w[e]), -30.f, 30.f);
                            f[2 * e] = (1.0f + __expf(-b0)) * __builtin_amdgcn_rcpf(1.0f + __expf(-a0)); f[2 * e + 1] = (1.0f + __expf(-b1)) * __builtin_amdgcn_rcpf(1.0f + __expf(-a1)); } }
                    else {
#pragma unroll
                        for (int e = 0; e < 4; ++e) { f[2 * e] = sigmoidf_(__builtin_amdgcn_fmed3f(bflo(g0w[e]), -30.f, 30.f)); f[2 * e + 1] = sigmoidf_(__builtin_amdgcn_fmed3f(bfhi(g0w[e]), -30.f, 30.f)); } }
                    f32x4 v0 = acc[ai][bj][m][0], v1 = acc[ai][bj][m][1];
                    v0[0] *= f[0]; v0[1] *= f[1]; v0[2] *= f[2]; v0[3] *= f[3]; v1[0] *= f[4]; v1[1] *= f[5]; v1[2] *= f[6]; v1[3] *= f[7];
                    if (br != 2) { acc[ai][bj][m][0] = v0; acc[ai][bj][m][1] = v1; }
                    else { u32x4 w; w.x = cvt_pk_bf16(v0[0], v0[1]); w.y = cvt_pk_bf16(v0[2], v0[3]); w.z = cvt_pk_bf16(v1[0], v1[1]); w.w = cvt_pk_bf16(v1[2], v1[3]); *(GAS u32x4*)(MB + row * DM + col0 + bj * HALF) = w; } } }
            EPI_FENCE();
        }
    }
};
template <bool FIRST, bool LAST> struct EpiResid {
    static constexpr bool CHAIN = false;
    const GAS float* xin; GAS float* xout; GAS bf16_t* XB; GAS float* ssq;
    __device__ __forceinline__ void operator()(const f32x4 (&acc)[2][2][4][2], const Unit& u, int wr, int wc, int fr, int fq, PG8_LAS unsigned char* lds) const {
        const int row0 = u.pm * BM + wr * 64 + fr, col0 = u.pn * BM + wc * 32 + 8 * fq;
        PG8_LAS float* T = (PG8_LAS float*)(lds + TAB_OFF);
        f32x4 xf[FIRST ? 4 : 1][2][2]; u32x4 xh[FIRST ? 1 : 8][2];
#pragma unroll
        for (int bt = 0; bt < (FIRST ? 2 : 1); ++bt) {
#pragma unroll
            for (int i4 = 0; i4 < (FIRST ? 4 : 8); ++i4) { const int idx = (FIRST ? 4 * bt : 0) + i4; const size_t row = (size_t)(row0 + (idx >> 2) * HALF + (idx & 3) * 16);
#pragma unroll
                for (int bj = 0; bj < 2; ++bj) { const size_t o = row * DM + col0 + bj * HALF;
                    if (FIRST) { xf[i4 & 3][bj][0] = *(const GAS f32x4*)(xin + o); xf[i4 & 3][bj][1] = *(const GAS f32x4*)(xin + o + 4); } else xh[FIRST ? 0 : i4][bj] = *(const GAS u32x4*)(XB + o); } }
#pragma unroll
            for (int i4 = 0; i4 < (FIRST ? 4 : 8); ++i4) { const int idx = (FIRST ? 4 * bt : 0) + i4, ai = idx >> 2, m = idx & 3; const size_t row = (size_t)(row0 + ai * HALF + m * 16); float s = 0.f;
#pragma unroll
                for (int bj = 0; bj < 2; ++bj) { const size_t o = row * DM + col0 + bj * HALF; f32x4 v0, v1;
                    if (FIRST) { v0 = acc[ai][bj][m][0] + xf[i4 & 3][bj][0]; v1 = acc[ai][bj][m][1] + xf[i4 & 3][bj][1]; }
                    else { const u32x4 h = xh[FIRST ? 0 : i4][bj]; v0 = acc[ai][bj][m][0] + (f32x4){bflo(h.x), bfhi(h.x), bflo(h.y), bfhi(h.y)}; v1 = acc[ai][bj][m][1] + (f32x4){bflo(h.z), bfhi(h.z), bflo(h.w), bfhi(h.w)}; }
                    if (LAST) { *(GAS f32x4*)(xout + o) = v0; *(GAS f32x4*)(xout + o + 4) = v1; }
                    else { u32x4 w; w.x = cvt_pk_bf16(v0[0], v0[1]); w.y = cvt_pk_bf16(v0[2], v0[3]); w.z = cvt_pk_bf16(v1[0], v1[1]); w.w = cvt_pk_bf16(v1[2], v1[3]); *(GAS u32x4*)(XB + o) = w;
                        v0 = (f32x4){bflo(w.x), bfhi(w.x), bflo(w.y), bfhi(w.y)}; v1 = (f32x4){bflo(w.z), bfhi(w.z), bflo(w.w), bfhi(w.w)}; }
                    s += (v0[0] * v0[0] + v0[1] * v0[1]) + (v0[2] * v0[2] + v0[3] * v0[3]) + (v1[0] * v1[0] + v1[1] * v1[1]) + (v1[2] * v1[2] + v1[3] * v1[3]); }
                if (!LAST) { s += __shfl_xor(s, 16); s += __shfl_xor(s, 32);
                    if (fq == 0) T[(ai * HALF + wr * 64 + m * 16 + fr) * 4 + wc] = s; } }
            EPI_FENCE();
        }
        if (!LAST) {
            asm volatile("s_waitcnt lgkmcnt(0)" ::: "memory"); __builtin_amdgcn_s_barrier(); asm volatile("" ::: "memory");
            const int t = (wr * 4 + wc) * 64 + fq * 16 + fr;
            if (t < 256) { const f32x4 p = *(const PG8_LAS f32x4*)(T + t * 4); ssq[(size_t)(u.pm * BM + t) * 8 + u.pn] = (p[0] + p[1]) + (p[2] + p[3]); }
        }
    }
};
struct EpiFFNUp {
    static constexpr bool CHAIN = false;
    GAS bf16_t* H; const GAS float* ssq;
    __device__ __forceinline__ void operator()(const f32x4 (&acc)[2][2][4][2], const Unit& u, int wr, int wc, int fr, int fq, PG8_LAS unsigned char*) const {
        float rs[2][4]; load_rstd(ssq, u.pm, wr, fr, fq, rs);
        const int row0 = u.pm * BM + wr * 64 + fr, col0 = u.pn * HALF + wc * 32 + 8 * fq;
#pragma unroll
        for (int ai = 0; ai < 2; ++ai)
#pragma unroll
            for (int m = 0; m < 4; ++m) { const float r = rs[ai][m]; float h[8];
#pragma unroll
                for (int n = 0; n < 2; ++n)
#pragma unroll
                    for (int e = 0; e < 4; ++e) { const float gv = acc[ai][0][m][n][e] * r, uv = acc[ai][1][m][n][e] * r; h[n * 4 + e] = gv * sigmoidf_(gv) * uv; }
                u32x4 w; w.x = cvt_pk_bf16(h[0], h[1]); w.y = cvt_pk_bf16(h[2], h[3]); w.z = cvt_pk_bf16(h[4], h[5]); w.w = cvt_pk_bf16(h[6], h[7]);
                *(GAS u32x4*)(H + (size_t)(row0 + ai * HALF + m * 16) * FFN + col0) = w; }
    }
};
}

struct Frame {
    __device__ __forceinline__ void refresh() { ws = (GAS unsigned char*)opaque_ptr(ws0); tid = opaque_tid(wv); lane = tid & 63; wave = __builtin_amdgcn_readfirstlane(tid >> 6); }
    LAS unsigned char* lds;
    volatile LAS unsigned* MISC;
    unsigned* ctl;
    int tid, lane, wave, G, wv;
    const float* const* in;
    GAS unsigned char* ws; unsigned char* ws0;
};

struct ConvDesc { const GAS float* W; const GAS float* gk; GAS bf16* WT; int ldw, k0, src_c0, nvalid, ldt, dst_r0, dst_k; };
struct ConvRegs { f32x4 v[16]; f32x4 g0, g1; };
__device__ __forceinline__ void conv_load(const ConvDesc& d, ConvRegs& R, int lane) {
    const int c4 = 4 * (lane & 15), rq = lane >> 4, c8 = lane & 7;
#pragma unroll
    for (int i = 0; i < 16; ++i) { const int kk = 4 * i + rq; R.v[i] = (c4 < d.nvalid) ? __builtin_nontemporal_load((const GAS f32x4*)(d.W + (size_t)(d.k0 + kk) * d.ldw + d.src_c0 + c4)) : (f32x4){0.f, 0.f, 0.f, 0.f}; }
    if (d.gk) { R.g0 = *(const GAS f32x4*)(d.gk + d.k0 + 8 * c8); R.g1 = *(const GAS f32x4*)(d.gk + d.k0 + 8 * c8 + 4); }
}
__device__ __forceinline__ void conv_finish(const ConvDesc& d, const ConvRegs& R, LAS float* scr, int lane) {
    const int c4 = 4 * (lane & 15), rq = lane >> 4, c8 = lane & 7;
#pragma unroll
    for (int i = 0; i < 16; ++i) { LAS float* p = scr + (4 * i + rq) * 65 + c4; p[0] = R.v[i][0]; p[1] = R.v[i][1]; p[2] = R.v[i][2]; p[3] = R.v[i][3]; }
    LDS_WAIT(); asm volatile("" ::: "memory");
#pragma unroll
    for (int j = 0; j < 8; ++j) { const int n = (lane >> 3) + 8 * j; const LAS float* sp = scr + (8 * c8) * 65 + n;
        v4u o;
        if (d.gk) { o.x = pk2(sp[0 * 65] * R.g0[0], sp[1 * 65] * R.g0[1]); o.y = pk2(sp[2 * 65] * R.g0[2], sp[3 * 65] * R.g0[3]); o.z = pk2(sp[4 * 65] * R.g1[0], sp[5 * 65] * R.g1[1]); o.w = pk2(sp[6 * 65] * R.g1[2], sp[7 * 65] * R.g1[3]); }
        else { o.x = pk2(sp[0 * 65], sp[1 * 65]); o.y = pk2(sp[2 * 65], sp[3 * 65]); o.z = pk2(sp[4 * 65], sp[5 * 65]); o.w = pk2(sp[6 * 65], sp[7 * 65]); }
        *(GAS v4u*)(d.WT + (size_t)(d.dst_r0 + n) * d.ldt + d.dst_k + 8 * c8) = o; }
    LDS_WAIT(); asm volatile("" ::: "memory");
}
constexpr int CV_NB_IN = NP / 64, CV_NB_FF = FFN / 64;
constexpr int CV_I_IN = 32 * CV_NB_IN, CV_I_GLU = 16 * 16, CV_I_BR = 3 * 16 * 32, CV_I_OUT = 32 * 32, CV_I_GU = 2 * 32 * CV_NB_FF, CV_I_DN = CV_NB_FF * 32;
constexpr int CV_I_LAYER = CV_I_IN + CV_I_GLU + CV_I_BR + CV_I_OUT + CV_I_GU + CV_I_DN;
#ifndef CVQ1
#define CVQ1 6
#endif
#ifndef CVQ7
#define CVQ7 7
#endif
constexpr int CV_Q1 = CVQ1, CV_Q7 = CVQ7;
__device__ __forceinline__ ConvDesc conv_layer_desc(Frame& F, int l, int r) {
    GAS unsigned char* wl = F.ws + WS_W + (size_t)l * SZ_WLAYER; ConvDesc d;
    if (r < CV_I_IN) { const int nb = r % CV_NB_IN, kb = r / CV_NB_IN, n0 = 64 * nb; int src, nv;
        if (n0 < 4096) { src = n0; nv = 64; } else if (n0 < PC_GLR) { src = n0 + 16; nv = 64; } else if (n0 == PC_GLR) { src = 4096; nv = 16; } else { src = 0; nv = 0; }
        d.W = ((const GAS float*)F.in[I_WIN]) + (size_t)l * DM * INW; d.ldw = INW; d.k0 = 64 * kb; d.src_c0 = src; d.nvalid = nv; d.gk = ((const GAS float*)F.in[I_N1G]) + l * DM; d.WT = (GAS bf16*)(wl + OFF_WIN); d.ldt = DM; d.dst_r0 = n0; d.dst_k = 64 * kb; return d; } r -= CV_I_IN;
    if (r < CV_I_GLU) { const int nb = r % 16, kb = r / 16;
        d.W = ((const GAS float*)F.in[I_WGLU]) + (size_t)l * 1024 * 1024; d.ldw = 1024; d.k0 = 64 * kb; d.src_c0 = 64 * nb; d.nvalid = 64; d.gk = nullptr; d.WT = (GAS bf16*)(wl + OFF_WGLU); d.ldt = 1024; d.dst_r0 = 64 * nb; d.dst_k = 64 * kb; return d; } r -= CV_I_GLU;
    if (r < CV_I_BR) { const int br = r / (16 * 32), rr = r % (16 * 32), nb = rr % 32, kb = rr / 32;
        d.W = ((const GAS float*)F.in[I_WBS + br]) + (size_t)l * 1024 * DM; d.ldw = DM; d.k0 = 64 * kb; d.src_c0 = 64 * nb; d.nvalid = 64; d.gk = nullptr; d.WT = (GAS bf16*)(wl + OFF_WBR); d.ldt = 3072; d.dst_r0 = 64 * nb; d.dst_k = br * 1024 + 64 * kb; return d; } r -= CV_I_BR;
    if (r < CV_I_OUT) { const int nb = r % 32, kb = r / 32;
        d.W = ((const GAS float*)F.in[I_WOUT]) + (size_t)l * DM * DM; d.ldw = DM; d.k0 = 64 * kb; d.src_c0 = 64 * nb; d.nvalid = 64; d.gk = nullptr; d.WT = (GAS bf16*)(wl + OFF_WOUT); d.ldt = DM; d.dst_r0 = 64 * nb; d.dst_k = 64 * kb; return d; } r -= CV_I_OUT;
    if (r < CV_I_GU) { const int sel = r / (32 * CV_NB_FF), rr = r % (32 * CV_NB_FF), nb = rr % CV_NB_FF, kb = rr / CV_NB_FF, j0 = 64 * nb;
        d.W = ((const GAS float*)F.in[I_FWG + sel]) + (size_t)l * DM * FFN; d.ldw = FFN; d.k0 = 64 * kb; d.src_c0 = j0; d.nvalid = 64; d.gk = ((const GAS float*)F.in[I_N2G]) + l * DM; d.WT = (GAS bf16*)(wl + OFF_WGU); d.ldt = DM; d.dst_r0 = (j0 / 128) * 256 + sel * 128 + (j0 % 128); d.dst_k = 64 * kb; return d; } r -= CV_I_GU;
    { const int nb = r % 32, kb = r / 32;
        d.W = ((const GAS float*)F.in[I_FWD]) + (size_t)l * FFN * DM; d.ldw = DM; d.k0 = 64 * kb; d.src_c0 = 64 * nb; d.nvalid = 64; d.gk = nullptr; d.WT = (GAS bf16*)(wl + OFF_WDN); d.ldt = FFN; d.dst_r0 = 64 * nb; d.dst_k = 64 * kb; return d; }
}
template <class Dec> __device__ __forceinline__ void conv_stream(int first, int limit, int stride, LAS float* scr, int lane, const Dec& dec) {
    int it = first; if (it >= limit) return;
    ConvDesc dA, dB; ConvRegs rA, rB;
    dA = dec(it); conv_load(dA, rA, lane);
    for (;;) {
        it += stride; const bool hb = it < limit;
        if (hb) { dB = dec(it); conv_load(dB, rB, lane); }
        conv_finish(dA, rA, scr, lane);
        if (!hb) break;
        it += stride; const bool ha = it < limit;
        if (ha) { dA = dec(it); conv_load(dA, rA, lane); }
        conv_finish(dB, rB, scr, lane);
        if (!ha) break;
    }
}
__device__ __forceinline__ int cv_ntail(int nwg, int G) { const int nr = (nwg + G - 1) / G; return nr * G - nwg; }
__device__ __forceinline__ void cv_slot(int G, int s, int& lo, int& hi) {
    const int cap1 = cv_ntail((MTOK / 256) * (NP / 256), G) * NWAVES * CV_Q1, cap7 = cv_ntail((MTOK / 256) * (NGU / 256), G) * NWAVES * CV_Q7;
    int Bn = DEPTH * CV_I_LAYER, B = Bn;
    for (int t = 2 * DEPTH; t >= 1; --t) { const int l = (t - 1) >> 1, odd = t & 1, D = l * CV_I_LAYER + (odd ? CV_I_IN : CV_I_LAYER - CV_I_DN), cap = odd ? cap1 : cap7;
        Bn = B; B = (Bn - cap > D) ? Bn - cap : D; if (t == s) { lo = B; hi = Bn; return; } if (t == 1 && s == 0) { lo = 0; hi = B; return; } }
    lo = 0; hi = 0;
}
__device__ __forceinline__ void cv_tail(Frame& F, int l, int which) {
    const int nwg = (MTOK / 256) * ((which ? NGU : NP) / 256), ntail = cv_ntail(nwg, F.G), first = F.G - ntail;
    if ((int)blockIdx.x < first) return;
    int lo, hi; cv_slot(F.G, 2 * l + 1 + which, lo, hi);
    LAS float* scr = (LAS float*)(F.lds + F.wave * 16896);
    conv_stream(lo + ((int)blockIdx.x - first) * NWAVES + F.wave, hi, ntail * NWAVES, scr, F.lane, [&](int g) { const int ll = g / CV_I_LAYER; return conv_layer_desc(F, ll, g - ll * CV_I_LAYER); });
}
__device__ __forceinline__ void s5_tables_unit(Frame& F, int lg);
__device__ __forceinline__ void p0_prologue(Frame& F) {
    int npass = 2, tf = (((int)blockIdx.x >> 3) & 1); asm volatile("" : "+s"(npass), "+s"(tf));
#pragma unroll 1
    for (int pass = 0; pass < npass; ++pass) {
        if (pass == tf) { F.refresh(); __syncthreads(); for (int lg = blockIdx.x; lg < DEPTH * 64; lg += F.G) s5_tables_unit(F, lg); }
        if (pass == 0) { F.refresh(); int lo0, hi0; cv_slot(F.G, 0, lo0, hi0);
            conv_stream((int)blockIdx.x * NWAVES + F.wave, hi0, F.G * NWAVES, (LAS float*)(F.lds + F.wave * 16896), F.lane, [&](int g) { const int ll = g / CV_I_LAYER; return conv_layer_desc(F, ll, g - ll * CV_I_LAYER); }); }
    }
    F.refresh();
    const int gw = blockIdx.x * NWAVES + F.wave, NGW = F.G * NWAVES, lane = F.lane;
    const GAS float* x = ((const GAS float*)F.in[I_X]); GAS bf16* XB = (GAS bf16*)(F.ws + WS_XB); GAS float* ssq = (GAS float*)(F.ws + WS_SSQ);
    for (int m = gw; m < MTOK; m += NGW) {
        const GAS f32x4* xr = (const GAS f32x4*)(x + (size_t)m * DM) + lane; float s = 0.f;
        GAS v2u* o8 = (GAS v2u*)(XB + (size_t)m * DM) + lane;
#pragma unroll
        for (int j = 0; j < 8; ++j) { const f32x4 v = xr[64 * j]; s += (v[0] * v[0] + v[1] * v[1]) + (v[2] * v[2] + v[3] * v[3]); v2u w; w.x = pk2(v[0], v[1]); w.y = pk2(v[2], v[3]); o8[64 * j] = w; }
        s = wave_sum(s);
        if (lane < 8) ssq[(size_t)m * 8 + lane] = (lane == 0) ? s : 0.f;
    }
}

typedef short bf16x8_t __attribute__((ext_vector_type(8)));
__device__ __forceinline__ f32x4 mma16(bf16x8_t a, bf16x8_t b, f32x4 c) { return __builtin_amdgcn_mfma_f32_16x16x32_bf16(a, b, c, 0, 0, 0); }
constexpr int S5_USTR = 2064;
constexpr int S5_XSTR = 272;
__device__ __forceinline__ void s5_tables_unit(Frame& F, int lg) {
    LAS float* APr = (LAS float*)F.lds; LAS float* APi = APr + 65 * 64; LAS float* BBr = APi + 65 * 64; LAS float* BBi = BBr + 1024; LAS float* CCr = BBi + 1024; LAS float* CCi = CCr + 1024;
    const int tid = F.tid;
    const GAS float* lre_ = ((const GAS float*)F.in[I_LRE]) + lg * 64; const GAS float* lim_ = ((const GAS float*)F.in[I_LIM]) + lg * 64; const double dt = exp((double)((const GAS float*)F.in[I_LDT])[lg]);
    for (int idx = tid; idx < 65 * 64; idx += 512) { const int t = idx >> 6, p = idx & 63;
        const double lr = (double)lre_[p], li = (double)lim_[p]; const double mag = exp(lr * dt * (double)t); double ang = li * dt * (double)t;
        ang -= 6.283185307179586476925 * rint(ang * 0.15915494309189533577);
        APr[idx] = (float)(mag * (double)cosf((float)ang)); APi[idx] = (float)(mag * (double)sinf((float)ang)); }
    for (int idx = tid; idx < 1024; idx += 512) { const int p = idx >> 4, c = idx & 15;
        const double lr = (double)lre_[p], li = (double)lim_[p]; const double mag = exp(lr * dt); double ang = li * dt; ang -= 6.283185307179586476925 * rint(ang * 0.15915494309189533577);
        const double ar = mag * (double)cosf((float)ang), ai = mag * (double)sinf((float)ang), den = lr * lr + li * li, nr = ar - 1.0, ni = ai;
        const double zr = (nr * lr + ni * li) / den, zi = (ni * lr - nr * li) / den;
        const double br = (double)((const GAS float*)F.in[I_BRE])[(size_t)(lg * 64 + p) * 16 + c], bi = (double)((const GAS float*)F.in[I_BIM])[(size_t)(lg * 64 + p) * 16 + c];
        BBr[idx] = (float)(zr * br - zi * bi); BBi[idx] = (float)(zr * bi + zi * br);
        CCr[idx] = ((const GAS float*)F.in[I_CRE])[(size_t)lg * 1024 + idx]; CCi[idx] = ((const GAS float*)F.in[I_CIM])[(size_t)lg * 1024 + idx]; }
    LDS_WAIT(); __syncthreads();
    { const int t = tid >> 3, co0 = 2 * (tid & 7); float acc0[16], acc1[16];
#pragma unroll
      for (int i = 0; i < 16; ++i) { acc0[i] = 0.f; acc1[i] = 0.f; }
      for (int p = 0; p < 64; ++p) { const float ar = APr[t * 64 + p], ai = APi[t * 64 + p];
          const float c0r = CCr[co0 * 64 + p], c0i = CCi[co0 * 64 + p], c1r = CCr[(co0 + 1) * 64 + p], c1i = CCi[(co0 + 1) * 64 + p];
          const float w0r = c0r * ar - c0i * ai, w0i = c0r * ai + c0i * ar, w1r = c1r * ar - c1i * ai, w1i = c1r * ai + c1i * ar;
#pragma unroll
          for (int ci = 0; ci < 16; ++ci) { const float br = BBr[p * 16 + ci], bi = BBi[p * 16 + ci]; acc0[ci] += w0r * br - w0i * bi; acc1[ci] += w1r * br - w1i * bi; } }
      GAS bf16* TK = (GAS bf16*)(F.ws + WS_TK) + (size_t)lg * 64 * 256 + (size_t)(t * 16 + co0) * 16;
      v4u o0, o1, o2, o3; o0.x = pk2(acc0[0], acc0[1]); o0.y = pk2(acc0[2], acc0[3]); o0.z = pk2(acc0[4], acc0[5]); o0.w = pk2(acc0[6], acc0[7]);
      o1.x = pk2(acc0[8], acc0[9]); o1.y = pk2(acc0[10], acc0[11]); o1.z = pk2(acc0[12], acc0[13]); o1.w = pk2(acc0[14], acc0[15]);
      o2.x = pk2(acc1[0], acc1[1]); o2.y = pk2(acc1[2], acc1[3]); o2.z = pk2(acc1[4], acc1[5]); o2.w = pk2(acc1[6], acc1[7]);
      o3.x = pk2(acc1[8], acc1[9]); o3.y = pk2(acc1[10], acc1[11]); o3.z = pk2(acc1[12], acc1[13]); o3.w = pk2(acc1[14], acc1[15]);
      *(GAS v4u*)(TK) = o0; *(GAS v4u*)(TK + 8) = o1; *(GAS v4u*)(TK + 16) = o2; *(GAS v4u*)(TK + 24) = o3; }
    { GAS bf16* TW = (GAS bf16*)(F.ws + WS_TW) + (size_t)lg * 128 * 1024;
      for (int ch = tid; ch < 16384; ch += 512) { const int col = ch >> 7, kc = ch & 127, ri = col >> 6, p = col & 63, j = kc >> 1, c0 = 8 * (kc & 1);
          const float ar = APr[(63 - j) * 64 + p], ai = APi[(63 - j) * 64 + p]; float v[8];
#pragma unroll
          for (int e = 0; e < 8; ++e) { const float br = BBr[p * 16 + c0 + e], bi = BBi[p * 16 + c0 + e]; v[e] = ri ? (ar * bi + ai * br) : (ar * br - ai * bi); }
          v4u o; o.x = pk2(v[0], v[1]); o.y = pk2(v[2], v[3]); o.z = pk2(v[4], v[5]); o.w = pk2(v[6], v[7]);
          *(GAS v4u*)(TW + (size_t)col * 1024 + kc * 8) = o; } }
    { GAS bf16* TC = (GAS bf16*)(F.ws + WS_TC) + (size_t)lg * 1024 * 128;
      for (int ch = tid; ch < 16384; ch += 512) { const int row = ch >> 4, kc = ch & 15, i = row >> 4, co = row & 15, ri = kc >> 3, p0 = 8 * (kc & 7); float v[8];
#pragma unroll
          for (int e = 0; e < 8; ++e) { const int p = p0 + e; const float ar = APr[(i + 1) * 64 + p], ai = APi[(i + 1) * 64 + p], cr = CCr[co * 64 + p], ci = CCi[co * 64 + p];
              v[e] = ri ? -(cr * ai + ci * ar) : (cr * ar - ci * ai); }
          v4u o; o.x = pk2(v[0], v[1]); o.y = pk2(v[2], v[3]); o.z = pk2(v[4], v[5]); o.w = pk2(v[6], v[7]);
          *(GAS v4u*)(TC + (size_t)row * 128 + kc * 8) = o; } }
    if (tid < 128) ((GAS float*)(F.ws + WS_A64))[(size_t)lg * 128 + tid] = (tid < 64) ? APr[64 * 64 + tid] : APi[64 * 64 + tid - 64];
    LDS_WAIT(); __syncthreads();
}
__device__ __forceinline__ void s5_stage_u(Frame& F, int g, int b, LAS unsigned char* U) {
    const GAS v4u* src = (const GAS v4u*)((const GAS bf16*)(F.ws + WS_US) + (size_t)(b * 64 + g) * SEQ * 16);
#pragma unroll
    for (int it = 0; it < 8; ++it) { const int ch = F.tid + 512 * it, t = ch >> 1, hf = ch & 1, n = t >> 6, j = t & 63;
        *(LAS v4u*)(U + n * S5_USTR + (j * 16 + 8 * hf) * 2) = src[ch]; }
}
__device__ __forceinline__ void s5_s1_unit(Frame& F, int l, int unit) {
    const int g = unit & 63, b = unit >> 6, lg = l * 64 + g, lane = F.lane, w = F.wave, fr = lane & 15, fq = lane >> 4;
    LAS unsigned char* U = F.lds;
    s5_stage_u(F, g, b, U);
    LDS_WAIT(); __syncthreads();
    const GAS bf16* TW = (const GAS bf16*)(F.ws + WS_TW) + (size_t)lg * 128 * 1024 + (size_t)(16 * w + fr) * 1024 + 8 * fq;
    f32x4 acc[2] = {(f32x4){0.f, 0.f, 0.f, 0.f}, (f32x4){0.f, 0.f, 0.f, 0.f}};
#pragma unroll 16
    for (int ks = 0; ks < 32; ++ks) {
        const bf16x8_t bfr = *(const GAS bf16x8_t*)(TW + 32 * ks);
        const bf16x8_t a0 = *(const LAS bf16x8_t*)(U + fr * S5_USTR + (32 * ks + 8 * fq) * 2), a1 = *(const LAS bf16x8_t*)(U + (16 + fr) * S5_USTR + (32 * ks + 8 * fq) * 2);
        acc[0] = mma16(a0, bfr, acc[0]); acc[1] = mma16(a1, bfr, acc[1]); }
    GAS float* SL = (GAS float*)(F.ws + WS_SL);
#pragma unroll
    for (int mt = 0; mt < 2; ++mt)
#pragma unroll
        for (int r = 0; r < 4; ++r) { const int n = 16 * mt + 4 * fq + r; SL[((size_t)(b * 32 + n) * 64 + g) * 128 + 16 * w + fr] = acc[mt][r]; }
    __syncthreads();
}
__device__ __forceinline__ void s5_s3_unit(Frame& F, int l, int unit) {
    const int g = unit & 63, b = unit >> 6, lg = l * 64 + g, lane = F.lane, w = F.wave, fr = lane & 15, fq = lane >> 4;
    LAS unsigned char* U = F.lds; LAS unsigned char* TKL = F.lds + 32 * S5_USTR; LAS unsigned char* XP = TKL + 32768;
    float sr[32], si[32]; float a64r = 0.f, a64i = 0.f;
    if (w == 0) { const GAS float* SL = (const GAS float*)(F.ws + WS_SL) + ((size_t)(b * 32) * 64 + g) * 128; const GAS float* A64 = (const GAS float*)(F.ws + WS_A64) + (size_t)lg * 128;
        a64r = A64[lane]; a64i = A64[64 + lane];
#pragma unroll
        for (int e = 0; e < 32; ++e) { sr[e] = SL[(size_t)e * 64 * 128 + lane]; si[e] = SL[(size_t)e * 64 * 128 + 64 + lane]; } }
    s5_stage_u(F, g, b, U);
    { const GAS v4u* src = (const GAS v4u*)((const GAS bf16*)(F.ws + WS_TK) + (size_t)lg * 64 * 256);
#pragma unroll
      for (int it = 0; it < 4; ++it) *(LAS v4u*)(TKL + (F.tid + 512 * it) * 16) = src[F.tid + 512 * it]; }
    const GAS bf16* TC = (const GAS bf16*)(F.ws + WS_TC) + (size_t)lg * 1024 * 128 + (size_t)fr * 128 + 8 * fq;
    bf16x8_t tcf[8];
#pragma unroll
    for (int it = 0; it < 8; ++it) tcf[it] = *(const GAS bf16x8_t*)(TC + (size_t)((w + 8 * it) * 16) * 128);
    if (w == 0) {
        float xr = 0.f, xi = 0.f;
#pragma unroll
        for (int e = 0; e < 32; ++e) { *(LAS bf16*)(XP + e * S5_XSTR + lane * 2) = (bf16)f2bf(xr); *(LAS bf16*)(XP + e * S5_XSTR + (64 + lane) * 2) = (bf16)f2bf(xi);
            const float nr = a64r * xr - a64i * xi + sr[e], ni = a64r * xi + a64i * xr + si[e]; xr = nr; xi = ni; }
    }
    LDS_WAIT(); __syncthreads();
    f32x4 acc[2][8];
#pragma unroll
    for (int mt = 0; mt < 2; ++mt)
#pragma unroll
        for (int it = 0; it < 8; ++it) acc[mt][it] = (f32x4){0.f, 0.f, 0.f, 0.f};
#pragma unroll 1
    for (int c = 0; c < 4; ++c) {
        bf16x8_t bfr[8];
#pragma unroll
        for (int it = 0; it < 8; ++it) { const int lag = w + 8 * it - 2 * c - (fq >> 1); bfr[it] = *(const LAS bf16x8_t*)(TKL + ((lag < 0 ? 0 : lag) * 16 + fr) * 32 + 16 * (fq & 1)); if (lag < 0) bfr[it] = (bf16x8_t){0, 0, 0, 0, 0, 0, 0, 0}; }
        const bool first_ok = (w >= 2 * c);
#pragma unroll
        for (int sgrp = 0; sgrp < 8; ++sgrp) { const int ks = c + 4 * sgrp;
            const bf16x8_t a0 = *(const LAS bf16x8_t*)(U + fr * S5_USTR + (32 * ks + 8 * fq) * 2), a1 = *(const LAS bf16x8_t*)(U + (16 + fr) * S5_USTR + (32 * ks + 8 * fq) * 2);
#pragma unroll
            for (int it = sgrp; it < 8; ++it) { if (it > sgrp || first_ok) { acc[0][it] = mma16(a0, bfr[it - sgrp], acc[0][it]); acc[1][it] = mma16(a1, bfr[it - sgrp], acc[1][it]); } } }
    }
    bf16x8_t tcg[8];
#pragma unroll
    for (int ks = 0; ks < 4; ++ks) {
        if (ks < 3) {
#pragma unroll
            for (int it = 0; it < 8; ++it) { const bf16x8_t nx = *(const GAS bf16x8_t*)(TC + (size_t)((w + 8 * it) * 16) * 128 + 32 * (ks + 1)); if (ks & 1) tcf[it] = nx; else tcg[it] = nx; } }
        const bf16x8_t a0 = *(const LAS bf16x8_t*)(XP + fr * S5_XSTR + (32 * ks + 8 * fq) * 2), a1 = *(const LAS bf16x8_t*)(XP + (16 + fr) * S5_XSTR + (32 * ks + 8 * fq) * 2);
        __builtin_amdgcn_sched_barrier(0);
#pragma unroll
        for (int it = 0; it < 8; ++it) { const bf16x8_t tb = (ks & 1) ? tcg[it] : tcf[it]; acc[0][it] = mma16(a0, tb, acc[0][it]); acc[1][it] = mma16(a1, tb, acc[1][it]); }
        __builtin_amdgcn_sched_barrier(0); }
    unsigned zp[2][8][2];
    { const float dsk = ((const GAS float*)F.in[I_SD])[l * 1024 + 16 * g + fr];
#pragma unroll
      for (int mt = 0; mt < 2; ++mt)
#pragma unroll
          for (int it = 0; it < 8; ++it) { float z[4];
#pragma unroll
              for (int r = 0; r < 4; ++r) { const int n = 16 * mt + 4 * fq + r, i = w + 8 * it;
                  const float uv = bf1(*(const LAS bf16*)(U + n * S5_USTR + (i * 16 + fr) * 2)); z[r] = gelu_tanh(acc[mt][it][r] + dsk * uv); }
              zp[mt][it][0] = pg8::cvt_pk_bf16(z[0], z[1]); zp[mt][it][1] = pg8::cvt_pk_bf16(z[2], z[3]); } }
    LDS_WAIT(); __syncthreads();
#pragma unroll
    for (int mt = 0; mt < 2; ++mt)
#pragma unroll
        for (int it = 0; it < 8; ++it)
#pragma unroll
            for (int r = 0; r < 4; ++r) { const int tkn = 64 * (16 * mt + 4 * fq + r) + w + 8 * it; const unsigned v = zp[mt][it][r >> 1];
                *(LAS bf16*)(U + tkn * 32 + fr * 2) = (bf16)((r & 1) ? (v >> 16) : (v & 0xffffu)); }
    LDS_WAIT(); __syncthreads();
    { GAS bf16* Z = (GAS bf16*)(F.ws + WS_Z) + (size_t)b * SEQ * 1024 + 16 * g;
#pragma unroll
      for (int j = 0; j < 8; ++j) { const int c = F.tid + 512 * j; *(GAS v4u*)(Z + (size_t)(c >> 1) * 1024 + 8 * (c & 1)) = *(const LAS v4u*)(U + c * 16); } }
    __syncthreads();
}

constexpr int GL_TSTR = 144;
constexpr int GL_DSTR = 272;
__device__ __forceinline__ int trimg_off(int row, int ch) { return 256 * row + 16 * (ch ^ (((row & 3) << 2) | ((row >> 2) & 3))); }
typedef short s16x4_t __attribute__((ext_vector_type(4)));
__device__ __forceinline__ bf16x8_t tr_frag16(const LAS unsigned char* img, int lane, int c, int ks) {
    const int g = lane >> 4, q = (lane & 15) >> 2, p = lane & 3;
    const s16x4_t lo = __builtin_amdgcn_ds_read_tr16_b64_v4i16((LAS s16x4_t*)(img + trimg_off(32 * ks + 8 * g + q, 2 * c + (p >> 1)) + 8 * (p & 1)));
    const s16x4_t hi = __builtin_amdgcn_ds_read_tr16_b64_v4i16((LAS s16x4_t*)(img + trimg_off(32 * ks + 8 * g + 4 + q, 2 * c + (p >> 1)) + 8 * (p & 1)));
    return (bf16x8_t){lo[0], lo[1], lo[2], lo[3], hi[0], hi[1], hi[2], hi[3]};
}
__device__ __forceinline__ void gla_g1_unit(Frame& F, int l, int u, bool loadw) {
    const int n = u & 31, h = (u >> 5) & 3, b = u >> 7, tid = F.tid, lane = F.lane, w = F.wave, fr = lane & 15, fq = lane >> 4;
    const size_t tok0 = (size_t)b * SEQ + 64 * n;
    const GAS bf16* P = (const GAS bf16*)(F.ws + WS_P);
    LAS float* GL = (LAS float*)F.lds; LAS float* W2L = (LAS float*)(F.lds + 32768); LAS float* GLR = (LAS float*)(F.lds + 40960);
    LAS unsigned char* KDI = F.lds + 45056; LAS unsigned char* VI = F.lds + 61440;
    const int ti = tid >> 3, dq = tid & 7;
    const GAS bf16* qp = P + (tok0 + ti) * NP + PC_GQ + h * 128 + 16 * dq; const GAS bf16* kp = P + (tok0 + ti) * NP + PC_GK + h * 128 + 16 * dq;
    const v4u q0 = *(const GAS v4u*)qp, q1 = *(const GAS v4u*)(qp + 8), k0 = *(const GAS v4u*)kp, k1 = *(const GAS v4u*)(kp + 8);
    v4u vv4[4];
    { const GAS bf16* vp = P + (tok0 + ti) * NP + PC_GV + h * 256 + 32 * dq;
#pragma unroll
      for (int c = 0; c < 4; ++c) vv4[c] = *(const GAS v4u*)(vp + 8 * c); }
    { const GAS float* w2 = ((const GAS float*)F.in[I_GW2]) + (size_t)l * 16 * 512;
      if (loadw) {
#pragma unroll
      for (int it = 0; it < 4; ++it) { const int idx = tid + 512 * it, r = idx >> 7, dk = idx & 127; W2L[idx] = w2[r * 512 + h * 128 + dk]; } }
#pragma unroll
      for (int it = 0; it < 2; ++it) { const int idx = tid + 512 * it, i = idx >> 4, r = idx & 15; GLR[idx] = bf1(P[(tok0 + i) * NP + PC_GLR + r]); } }
    LDS_WAIT(); __syncthreads();
    { const GAS float* b2 = ((const GAS float*)F.in[I_GB2]) + l * 512 + h * 128 + 16 * dq; float a[16];
#pragma unroll
      for (int e = 0; e < 16; ++e) a[e] = b2[e];
#pragma unroll
      for (int r = 0; r < 16; ++r) { const float gv = GLR[ti * 16 + r];
#pragma unroll
          for (int e4 = 0; e4 < 4; ++e4) { const f32x4 wv4 = *(const LAS f32x4*)(W2L + r * 128 + 16 * dq + 4 * e4); a[4 * e4] += gv * wv4[0]; a[4 * e4 + 1] += gv * wv4[1]; a[4 * e4 + 2] += gv * wv4[2]; a[4 * e4 + 3] += gv * wv4[3]; } }
#pragma unroll
      for (int e = 0; e < 16; ++e) { const float x = a[e]; GL[ti * 128 + 16 * dq + e] = (fminf(x, 0.f) - __logf(1.0f + __expf(-fabsf(x)))) * (1.0f / 16.0f); } }
    LDS_WAIT(); __syncthreads();
    if (tid < 128) { float cv[64], run = 0.f;
#pragma unroll
        for (int i = 0; i < 64; ++i) cv[i] = GL[i * 128 + tid];
#pragma unroll
        for (int i = 0; i < 64; ++i) { run += cv[i]; GL[i * 128 + tid] = run; }
        GLR[tid] = run; ((GAS float*)(F.ws + WS_DEC))[(size_t)u * 128 + tid] = __expf(run); }
    LDS_WAIT(); __syncthreads();
    {
      const unsigned qw[8] = {q0.x, q0.y, q0.z, q0.w, q1.x, q1.y, q1.z, q1.w}, kw[8] = {k0.x, k0.y, k0.z, k0.w, k1.x, k1.y, k1.z, k1.w};
      float qd[16], ki[16], kd[16];
#pragma unroll
      for (int e = 0; e < 16; ++e) { const int dk = 16 * dq + e; const float bc = GL[ti * 128 + dk], bl = GLR[dk];
          const float qv = (e & 1) ? bfhi(qw[e >> 1]) : bflo(qw[e >> 1]), kv = (e & 1) ? bfhi(kw[e >> 1]) : bflo(kw[e >> 1]);
          qd[e] = qv * 0.08838834764831845f * __expf(bc); ki[e] = kv * __expf(-bc); kd[e] = kv * __expf(bl - bc); }
      GAS bf16* QD = (GAS bf16*)(F.ws + WS_QD) + ((size_t)u * 64 + ti) * 128 + 16 * dq; GAS bf16* KI = (GAS bf16*)(F.ws + WS_KI) + ((size_t)u * 64 + ti) * 128 + 16 * dq;
      v4u o; o.x = pk2(qd[0], qd[1]); o.y = pk2(qd[2], qd[3]); o.z = pk2(qd[4], qd[5]); o.w = pk2(qd[6], qd[7]); *(GAS v4u*)QD = o;
      o.x = pk2(qd[8], qd[9]); o.y = pk2(qd[10], qd[11]); o.z = pk2(qd[12], qd[13]); o.w = pk2(qd[14], qd[15]); *(GAS v4u*)(QD + 8) = o;
      o.x = pk2(ki[0], ki[1]); o.y = pk2(ki[2], ki[3]); o.z = pk2(ki[4], ki[5]); o.w = pk2(ki[6], ki[7]); *(GAS v4u*)KI = o;
      o.x = pk2(ki[8], ki[9]); o.y = pk2(ki[10], ki[11]); o.z = pk2(ki[12], ki[13]); o.w = pk2(ki[14], ki[15]); *(GAS v4u*)(KI + 8) = o;
      o.x = pk2(kd[0], kd[1]); o.y = pk2(kd[2], kd[3]); o.z = pk2(kd[4], kd[5]); o.w = pk2(kd[6], kd[7]); *(LAS v4u*)(KDI + trimg_off(ti, 2 * dq)) = o;
      o.x = pk2(kd[8], kd[9]); o.y = pk2(kd[10], kd[11]); o.z = pk2(kd[12], kd[13]); o.w = pk2(kd[14], kd[15]); *(LAS v4u*)(KDI + trimg_off(ti, 2 * dq + 1)) = o;
#pragma unroll
      for (int c = 0; c < 4; ++c) *(LAS v4u*)(VI + (dq >> 2) * 16384 + trimg_off(ti, 4 * (dq & 3) + c)) = vv4[c]; }
    LDS_WAIT(); __syncthreads();
    {
      f32x4 acc[8][2];
#pragma unroll
      for (int mt = 0; mt < 8; ++mt) { acc[mt][0] = (f32x4){0.f, 0.f, 0.f, 0.f}; acc[mt][1] = (f32x4){0.f, 0.f, 0.f, 0.f}; }
      GAS bf16* GVT = (GAS bf16*)(F.ws + WS_GVT) + (size_t)u * 256 * 64;
#pragma unroll
      for (int ks = 0; ks < 2; ++ks) { bf16x8_t bb[2], aa[8];
#pragma unroll
          for (int nt = 0; nt < 2; ++nt) { const int cb = 2 * w + nt; bb[nt] = tr_frag16(VI + (cb >> 3) * 16384, lane, cb & 7, ks); }
#pragma unroll
          for (int mt = 0; mt < 8; ++mt) aa[mt] = tr_frag16(KDI, lane, mt, ks);
#pragma unroll
          for (int nt = 0; nt < 2; ++nt) *(GAS bf16x8_t*)(GVT + (size_t)(16 * (2 * w + nt) + fr) * 64 + 32 * ks + 8 * fq) = bb[nt];
#pragma unroll
          for (int mt = 0; mt < 8; ++mt) { acc[mt][0] = mma16(aa[mt], bb[0], acc[mt][0]); acc[mt][1] = mma16(aa[mt], bb[1], acc[mt][1]); } }
      GAS bf16* KV = (GAS bf16*)(F.ws + WS_KV) + (size_t)u * 256 * 128;
#pragma unroll
      for (int nt = 0; nt < 2; ++nt)
#pragma unroll
          for (int mt = 0; mt < 8; ++mt) { v2u o; o.x = pg8::cvt_pk_bf16(acc[mt][nt][0], acc[mt][nt][1]); o.y = pg8::cvt_pk_bf16(acc[mt][nt][2], acc[mt][nt][3]);
              *(GAS v2u*)(KV + (size_t)(16 * (2 * w + nt) + fr) * 128 + 16 * mt + 4 * fq) = o; } }
    __syncthreads();
}
__device__ __forceinline__ void gla_g2_scan(Frame& F) {
    const GAS bf16* KV = (const GAS bf16*)(F.ws + WS_KV); const GAS float* DEC = (const GAS float*)(F.ws + WS_DEC); GAS bf16* ST = (GAS bf16*)(F.ws + WS_ST);
    for (int e8 = blockIdx.x * 512 + F.tid; e8 < 16 * 256 * 16; e8 += F.G * 512) { const int bh = e8 >> 12, dv = (e8 >> 4) & 255, d8 = e8 & 15;
        float s[8];
#pragma unroll
        for (int j = 0; j < 8; ++j) s[j] = 0.f;
        for (int n0 = 0; n0 < 32; n0 += 8) { v4u kv[8]; f32x4 dc[8][2];
#pragma unroll
            for (int e = 0; e < 8; ++e) { const size_t u = (size_t)bh * 32 + n0 + e; kv[e] = *(const GAS v4u*)(KV + (u * 256 + dv) * 128 + 8 * d8); dc[e][0] = *(const GAS f32x4*)(DEC + u * 128 + 8 * d8); dc[e][1] = *(const GAS f32x4*)(DEC + u * 128 + 8 * d8 + 4); }
#pragma unroll
            for (int e = 0; e < 8; ++e) { const size_t u = (size_t)bh * 32 + n0 + e; v4u o; o.x = pk2(s[0], s[1]); o.y = pk2(s[2], s[3]); o.z = pk2(s[4], s[5]); o.w = pk2(s[6], s[7]); *(GAS v4u*)(ST + (u * 256 + dv) * 128 + 8 * d8) = o;
                const unsigned kw[4] = {kv[e].x, kv[e].y, kv[e].z, kv[e].w};
#pragma unroll
                for (int j = 0; j < 4; ++j) { s[2 * j] = dc[e][j >> 1][(2 * j) & 3] * s[2 * j] + bflo(kw[j]); s[2 * j + 1] = dc[e][j >> 1][(2 * j + 1) & 3] * s[2 * j + 1] + bfhi(kw[j]); } } } }
}
__device__ __forceinline__ void gla_g3_unit(Frame& F, int l, int u) {
    const int n = u & 31, h = (u >> 5) & 3, b = u >> 7, tid = F.tid, lane = F.lane, w = F.wave, fr = lane & 15, fq = lane >> 4;
    const size_t tok0 = (size_t)b * SEQ + 64 * n;
    LAS unsigned char* QDL = F.lds; LAS unsigned char* KIL = F.lds + 17408; LAS unsigned char* ATL = F.lds + 34816; LAS float* SSQL = (LAS float*)(F.lds + 44032); LAS float* RSL = (LAS float*)(F.lds + 46080);
    bf16x8_t gvtf[2][2], stf[2][4]; v2u rr[2][4];
    { const GAS bf16* Pg = (const GAS bf16*)(F.ws + WS_P);
#pragma unroll
      for (int mt = 0; mt < 2; ++mt)
#pragma unroll
          for (int nt = 0; nt < 4; ++nt) rr[mt][nt] = *(const GAS v2u*)(Pg + (tok0 + 16 * nt + fr) * NP + PC_GR + h * 256 + 16 * (2 * w + mt) + 4 * fq); }
    { const GAS bf16* GVT = (const GAS bf16*)(F.ws + WS_GVT) + (size_t)u * 256 * 64; const GAS bf16* ST = (const GAS bf16*)(F.ws + WS_ST) + (size_t)u * 256 * 128;
#pragma unroll
      for (int mt = 0; mt < 2; ++mt) {
#pragma unroll
          for (int ks = 0; ks < 2; ++ks) gvtf[mt][ks] = *(const GAS bf16x8_t*)(GVT + (size_t)(16 * (2 * w + mt) + fr) * 64 + 32 * ks + 8 * fq);
#pragma unroll
          for (int ks = 0; ks < 4; ++ks) stf[mt][ks] = *(const GAS bf16x8_t*)(ST + (size_t)(16 * (2 * w + mt) + fr) * 128 + 32 * ks + 8 * fq); } }
    { const GAS v4u* qs = (const GAS v4u*)((const GAS bf16*)(F.ws + WS_QD) + (size_t)u * 64 * 128); const GAS v4u* ks_ = (const GAS v4u*)((const GAS bf16*)(F.ws + WS_KI) + (size_t)u * 64 * 128);
#pragma unroll
      for (int it = 0; it < 2; ++it) { const int c = tid + 512 * it, row = c >> 4, c16 = c & 15; *(LAS v4u*)(QDL + row * GL_DSTR + c16 * 16) = qs[c]; *(LAS v4u*)(KIL + row * GL_DSTR + c16 * 16) = ks_[c]; } }
    LDS_WAIT(); __syncthreads();
#pragma unroll
    for (int tt = 0; tt < 2; ++tt) { const int tile = 2 * w + tt, mi = tile >> 2, nj = tile & 3; f32x4 acc = (f32x4){0.f, 0.f, 0.f, 0.f};
        if (nj <= mi) { bf16x8_t fa[4], fb[4];
#pragma unroll
            for (int ks = 0; ks < 4; ++ks) { fa[ks] = *(const LAS bf16x8_t*)(QDL + (16 * mi + fr) * GL_DSTR + (32 * ks + 8 * fq) * 2); fb[ks] = *(const LAS bf16x8_t*)(KIL + (16 * nj + fr) * GL_DSTR + (32 * ks + 8 * fq) * 2); }
#pragma unroll
            for (int ks = 0; ks < 4; ++ks) acc = mma16(fa[ks], fb[ks], acc); }
#pragma unroll
        for (int r = 0; r < 4; ++r) { const int i = 16 * mi + 4 * fq + r, j = 16 * nj + fr; *(LAS bf16*)(ATL + i * GL_TSTR + j * 2) = (bf16)f2bf(j <= i ? acc[r] : 0.f); } }
    LDS_WAIT(); __syncthreads();
    f32x4 acc[2][4];
#pragma unroll
    for (int mt = 0; mt < 2; ++mt)
#pragma unroll
        for (int nt = 0; nt < 4; ++nt) acc[mt][nt] = (f32x4){0.f, 0.f, 0.f, 0.f};
#pragma unroll
    for (int ks = 0; ks < 2; ++ks) { bf16x8_t fb[4];
#pragma unroll
        for (int nt = 0; nt < 4; ++nt) fb[nt] = *(const LAS bf16x8_t*)(ATL + (16 * nt + fr) * GL_TSTR + (32 * ks + 8 * fq) * 2);
#pragma unroll
        for (int nt = 0; nt < 4; ++nt) { acc[0][nt] = mma16(gvtf[0][ks], fb[nt], acc[0][nt]); acc[1][nt] = mma16(gvtf[1][ks], fb[nt], acc[1][nt]); } }
#pragma unroll
    for (int ks = 0; ks < 4; ++ks) { bf16x8_t fb[4];
#pragma unroll
        for (int nt = 0; nt < 4; ++nt) fb[nt] = *(const LAS bf16x8_t*)(QDL + (16 * nt + fr) * GL_DSTR + (32 * ks + 8 * fq) * 2);
#pragma unroll
        for (int nt = 0; nt < 4; ++nt) { acc[0][nt] = mma16(stf[0][ks], fb[nt], acc[0][nt]); acc[1][nt] = mma16(stf[1][ks], fb[nt], acc[1][nt]); } }
#pragma unroll
    for (int nt = 0; nt < 4; ++nt) { float v = 0.f;
#pragma unroll
        for (int mt = 0; mt < 2; ++mt)
#pragma unroll
            for (int r = 0; r < 4; ++r) v += acc[mt][nt][r] * acc[mt][nt][r];
        v += __shfl_xor(v, 16); v += __shfl_xor(v, 32);
        if (fq == 0) SSQL[w * 64 + 16 * nt + fr] = v; }
    LDS_WAIT(); __syncthreads();
    if (tid < 64) { float s = 0.f;
#pragma unroll
        for (int ww = 0; ww < 8; ++ww) s += SSQL[ww * 64 + tid];
        RSL[tid] = __builtin_amdgcn_rsqf(s * (1.0f / 256.0f) + RMS_EPS); }
    LDS_WAIT(); __syncthreads();
    { GAS bf16* Y = (GAS bf16*)(F.ws + WS_Y); const GAS float* gn = (const GAS float*)F.in[I_GNG] + l * 256;
#pragma unroll
      for (int mt = 0; mt < 2; ++mt) { const int dv0 = 16 * (2 * w + mt) + 4 * fq; const f32x4 gv = *(const GAS f32x4*)(gn + dv0);
#pragma unroll
          for (int nt = 0; nt < 4; ++nt) { const int i = 16 * nt + fr; const float rs = RSL[i]; const v2u rw = rr[mt][nt];
              const float r0 = bflo(rw.x), r1 = bfhi(rw.x), r2 = bflo(rw.y), r3 = bfhi(rw.y);
              v2u o; o.x = pg8::cvt_pk_bf16(acc[mt][nt][0] * rs * gv[0] * r0 * sigmoidf_(r0), acc[mt][nt][1] * rs * gv[1] * r1 * sigmoidf_(r1));
              o.y = pg8::cvt_pk_bf16(acc[mt][nt][2] * rs * gv[2] * r2 * sigmoidf_(r2), acc[mt][nt][3] * rs * gv[3] * r3 * sigmoidf_(r3));
              *(GAS v2u*)(Y + (tok0 + i) * YW + 1024 + h * 256 + dv0) = o; } } }
    __syncthreads();
}
constexpr int MB_KSTR = 272, MB_VSTR = 144, MB_KBYTES = 64 * MB_KSTR, MB_BUF = MB_KBYTES + 128 * MB_VSTR;
__device__ __forceinline__ void moba_prep_unit(Frame& F, int l, int unit) {
    const int kb = unit & 7, h = (unit >> 3) & 7, b = unit >> 6, tid = F.tid;
    const size_t tok0 = (size_t)b * SEQ + 256 * kb;
    const GAS bf16* P = (const GAS bf16*)(F.ws + WS_P);
    LAS unsigned char* TL = F.lds; LAS float* PART = (LAS float*)(F.lds + 69632);
    const int c16 = tid & 15, tg = tid >> 4;
    v4u xv[8];
    { const GAS bf16* src = P + (tok0 + tg) * NP + h * 128 + 8 * c16;
#pragma unroll
      for (int j = 0; j < 8; ++j) xv[j] = *(const GAS v4u*)(src + (size_t)(32 * j) * NP + PC_MV); }
#pragma unroll
    for (int j = 0; j < 8; ++j) *(LAS v4u*)(TL + trimg_off(tg + 32 * j, c16)) = xv[j];
    LDS_WAIT(); __syncthreads();
    { const int lane = tid & 63, w = tid >> 6, g = lane >> 4, i = lane & 15, q = i >> 2, p = i & 3;
      GAS bf16* dst = (GAS bf16*)(F.ws + WS_VT) + ((size_t)(b * 8 + h) * 128 + 16 * w + i) * SEQ + 256 * kb;
#pragma unroll
      for (int half = 0; half < 2; ++half)
#pragma unroll
          for (int f = 0; f < 4; ++f) { const int G = 4 * half + g, r0 = 32 * G + 4 * f;
              const s16x4_t lo = __builtin_amdgcn_ds_read_tr16_b64_v4i16((LAS s16x4_t*)(TL + trimg_off(r0 + q, 2 * w + (p >> 1)) + 8 * (p & 1)));
              const s16x4_t hi = __builtin_amdgcn_ds_read_tr16_b64_v4i16((LAS s16x4_t*)(TL + trimg_off(r0 + 16 + q, 2 * w + (p >> 1)) + 8 * (p & 1)));
              *(GAS bf16x8_t*)(dst + 32 * G + 8 * f) = (bf16x8_t){lo[0], lo[1], lo[2], lo[3], hi[0], hi[1], hi[2], hi[3]}; } }
    __syncthreads();
}
constexpr int MB3_TILE = 128 * 256, MB3_BUF = 2 * MB3_TILE;
__device__ __forceinline__ void moba_attn_unit3(Frame& F, int bh, int qt) {
    const int b = bh >> 3, h = bh & 7, tid = F.tid, lane = F.lane, w = F.wave, fr = lane & 15, fq = lane >> 4;
    const int qb = qt >> 1, np = qt + 1, qpos = 128 * qt + 16 * w + fr;
    const GAS bf16* KN = (const GAS bf16*)(F.ws + WS_KN) + (size_t)b * SEQ * 1024 + h * 128; const GAS bf16* VT = (const GAS bf16*)(F.ws + WS_VT) + (size_t)bh * 128 * SEQ;
    LAS float* KML = (LAS float*)(F.lds + 2 * MB3_BUF);
    { const GAS float* km = (const GAS float*)(F.ws + WS_KM) + (size_t)bh * 1024; KML[tid] = km[tid]; KML[512 + tid] = km[512 + tid]; }
    bf16x8_t bq[4];
    { const GAS bf16* qp = (const GAS bf16*)(F.ws + WS_QN) + ((size_t)b * SEQ + qpos) * 1024 + h * 128 + 8 * fq;
#pragma unroll
      for (int ks = 0; ks < 4; ++ks) bq[ks] = *(const GAS bf16x8_t*)(qp + 32 * ks); }
    const int drow = lane >> 4, dslot = lane & 15;
#define MB3_DMA(buf_, p_) do { _Pragma("unroll") for (int j_ = 0; j_ < 4; ++j_) { const int row_ = 4 * (8 * j_ + w) + drow, c_ = dslot ^ (row_ & 15); \
        __builtin_amdgcn_global_load_lds((const GAS unsigned*)(KN + (size_t)(128 * (p_) + row_) * 1024 + 8 * c_), (LAS unsigned*)((buf_) + (8 * j_ + w) * 1024), 16, 0, 0); \
        __builtin_amdgcn_global_load_lds((const GAS unsigned*)(VT + (size_t)row_ * SEQ + 128 * (p_) + 8 * c_), (LAS unsigned*)((buf_) + MB3_TILE + (8 * j_ + w) * 1024), 16, 0, 0); } } while (0)
    MB3_DMA(F.lds, 0);
    VM_WAIT(); LDS_WAIT(); __syncthreads();
    unsigned selmask = 0u;
    { float sc[8];
#pragma unroll
      for (int kb = 0; kb < 8; ++kb) { float a = 0.f;
#pragma unroll
          for (int ks = 0; ks < 4; ++ks) { const LAS float* kp = KML + kb * 128 + 32 * ks + 8 * fq; const f32x4 k0 = *(const LAS f32x4*)kp, k1 = *(const LAS f32x4*)(kp + 4);
              const v4u qv = __builtin_bit_cast(v4u, bq[ks]);
              a += bflo(qv.x) * k0[0] + bfhi(qv.x) * k0[1] + bflo(qv.y) * k0[2] + bfhi(qv.y) * k0[3] + bflo(qv.z) * k1[0] + bfhi(qv.z) * k1[1] + bflo(qv.w) * k1[2] + bfhi(qv.w) * k1[3]; }
          a += __shfl_xor(a, 16); a += __shfl_xor(a, 32); sc[kb] = (kb < qb) ? a : -__builtin_inff(); }
#pragma unroll
      for (int kb = 0; kb < 8; ++kb) { int rank = 0;
#pragma unroll
          for (int j = 0; j < 8; ++j) if (j != kb) rank += ((j < qb) && (sc[j] > sc[kb] || (sc[j] == sc[kb] && j < kb))) ? 1 : 0;
          if (kb < qb && rank < 3) selmask |= 1u << kb; } }
    f32x4 ao[8];
#pragma unroll
    for (int dt = 0; dt < 8; ++dt) ao[dt] = (f32x4){0.f, 0.f, 0.f, 0.f};
    float m = -__builtin_inff(), lsum = 0.f;
#pragma unroll 1
    for (int p = 0; p < np; ++p) {
        LAS unsigned char* KB = F.lds + (p & 1) * MB3_BUF; LAS unsigned char* VB = KB + MB3_TILE;
        if (p + 1 < np) MB3_DMA(F.lds + ((p + 1) & 1) * MB3_BUF, p + 1);
        const int kb = p >> 1; const bool past = kb < qb; const bool mine = past ? (((selmask >> kb) & 1u) != 0u) : true;
        if (__any(mine)) {
            const int lim = (past ? (mine ? 0x7fffffff : -1) : qpos - 128 * p) - 4 * fq;
            f32x4 as[8];
#pragma unroll
            for (int mh = 0; mh < 4; ++mh) { bf16x8_t fragA[2][4];
#pragma unroll
                for (int mt = 0; mt < 2; ++mt)
#pragma unroll
                    for (int ks = 0; ks < 4; ++ks) fragA[mt][ks] = *(const LAS bf16x8_t*)(KB + (16 * (2 * mh + mt) + fr) * 256 + 16 * ((4 * ks + fq) ^ fr));
                __builtin_amdgcn_sched_barrier(0);
#pragma unroll
                for (int mt = 0; mt < 2; ++mt) { as[2 * mh + mt] = (f32x4){0.f, 0.f, 0.f, 0.f};
#pragma unroll
                    for (int ks = 0; ks < 4; ++ks) as[2 * mh + mt] = mma16(fragA[mt][ks], bq[ks], as[2 * mh + mt]); }
                __builtin_amdgcn_sched_barrier(0); }
            float mx = -__builtin_inff();
            if (__all(lim >= 127)) {
#pragma unroll
                for (int mt = 0; mt < 8; ++mt)
#pragma unroll
                    for (int r = 0; r < 4; ++r) mx = fmaxf(mx, as[mt][r]);
            } else {
#pragma unroll
                for (int mt = 0; mt < 8; ++mt)
#pragma unroll
                    for (int r = 0; r < 4; ++r) { const float sv_ = (16 * mt + r <= lim) ? as[mt][r] : -__builtin_inff(); as[mt][r] = sv_; mx = fmaxf(mx, sv_); }
            }
            mx = fmaxf(mx, __shfl_xor(mx, 16)); mx = fmaxf(mx, __shfl_xor(mx, 32));
            const float mnew = fmaxf(m, mx), msafe = (mnew == -__builtin_inff()) ? 0.f : mnew;
            const bool grow = __any(mnew != m);
            const float corr = grow ? __builtin_amdgcn_exp2f(m - msafe) : 1.0f;
            float ps = 0.f;
#pragma unroll
            for (int mt = 0; mt < 8; ++mt)
#pragma unroll
                for (int r = 0; r < 4; ++r) { const float pv = __builtin_amdgcn_exp2f(as[mt][r] - msafe); as[mt][r] = pv; ps += pv; }
            lsum = lsum * corr + ps; m = mnew;
            bf16x8_t pf[4];
#pragma unroll
            for (int k2 = 0; k2 < 4; ++k2) { v4u t; t.x = pg8::cvt_pk_bf16(as[2 * k2][0], as[2 * k2][1]); t.y = pg8::cvt_pk_bf16(as[2 * k2][2], as[2 * k2][3]); t.z = pg8::cvt_pk_bf16(as[2 * k2 + 1][0], as[2 * k2 + 1][1]); t.w = pg8::cvt_pk_bf16(as[2 * k2 + 1][2], as[2 * k2 + 1][3]);
                pf[k2] = __builtin_bit_cast(bf16x8_t, t); }
            if (grow) {
#pragma unroll
                for (int dt = 0; dt < 8; ++dt) ao[dt] = ao[dt] * corr; }
            __builtin_amdgcn_sched_barrier(0);
#pragma unroll
            for (int dh = 0; dh < 4; ++dh) { v2u vlo[2][4], vhi[2][4];
#pragma unroll
                for (int dt = 0; dt < 2; ++dt)
#pragma unroll
                    for (int k2 = 0; k2 < 4; ++k2) { const LAS unsigned char* vr = VB + (16 * (2 * dh + dt) + fr) * 256 + 8 * (fq & 1); const int c0 = 4 * k2 + (fq >> 1);
                        vlo[dt][k2] = *(const LAS v2u*)(vr + 16 * (c0 ^ fr)); vhi[dt][k2] = *(const LAS v2u*)(vr + 16 * ((c0 + 2) ^ fr)); }
                __builtin_amdgcn_sched_barrier(0);
#pragma unroll
                for (int dt = 0; dt < 2; ++dt)
#pragma unroll
                    for (int k2 = 0; k2 < 4; ++k2) { v4u t; t.x = vlo[dt][k2].x; t.y = vlo[dt][k2].y; t.z = vhi[dt][k2].x; t.w = vhi[dt][k2].y; ao[2 * dh + dt] = mma16(__builtin_bit_cast(bf16x8_t, t), pf[k2], ao[2 * dh + dt]); }
                __builtin_amdgcn_sched_barrier(0); }
        }
        VM_WAIT(); LDS_WAIT(); __syncthreads();
    }
#undef MB3_DMA
    lsum += __shfl_xor(lsum, 16); lsum += __shfl_xor(lsum, 32);
    const float inv = 1.0f / lsum;
    GAS bf16* yp = (GAS bf16*)(F.ws + WS_Y) + ((size_t)b * SEQ + qpos) * YW + 2048 + h * 128 + 4 * fq;
#pragma unroll
    for (int dt = 0; dt < 8; ++dt) { v2u o; o.x = pg8::cvt_pk_bf16(ao[dt][0] * inv, ao[dt][1] * inv); o.y = pg8::cvt_pk_bf16(ao[dt][2] * inv, ao[dt][3] * inv); *(GAS v2u*)(yp + 16 * dt) = o; }
}
__device__ __forceinline__ void moba_attn_unit5(Frame& F, int bh, int qt) {
    const int b = bh >> 3, h = bh & 7, tid = F.tid, lane = F.lane, w = F.wave, fr = lane & 15, fq = lane >> 4;
    const int qb = qt >> 1, np = qt + 1, qpos = 128 * qt + 16 * w + fr;
    const bool hb = w >= 4;
    const GAS bf16* KN = (const GAS bf16*)(F.ws + WS_KN) + (size_t)b * SEQ * 1024 + h * 128; const GAS bf16* VT = (const GAS bf16*)(F.ws + WS_VT) + (size_t)bh * 128 * SEQ;
    LAS float* KML = (LAS float*)(F.lds + 2 * MB3_BUF);
    { const GAS float* km = (const GAS float*)(F.ws + WS_KM) + (size_t)bh * 1024; KML[tid] = km[tid]; KML[512 + tid] = km[512 + tid]; }
    bf16x8_t bq[4];
    { const GAS bf16* qp = (const GAS bf16*)(F.ws + WS_QN) + ((size_t)b * SEQ + qpos) * 1024 + h * 128 + 8 * fq;
#pragma unroll
      for (int ks = 0; ks < 4; ++ks) bq[ks] = *(const GAS bf16x8_t*)(qp + 32 * ks); }
    const int drow = 4 * w + (lane >> 4), dc = (lane & 15) ^ (drow & 15);
    const unsigned kvoff = (unsigned)(drow * 1024 + 8 * dc) * 2u, vvoff = (unsigned)(drow * SEQ + 8 * dc) * 2u;
#define MB5_DMAK(p_) do { LAS unsigned char* buf_ = F.lds + ((p_) & 1) * MB3_BUF; _Pragma("unroll") for (int j_ = 0; j_ < 4; ++j_) { const GAS char* kb_ = (const GAS char*)KN + (size_t)(128 * (p_) + 32 * j_) * 2048; \
        __builtin_amdgcn_global_load_lds((const GAS unsigned*)(kb_ + kvoff), (LAS unsigned*)(buf_ + (8 * j_ + w) * 1024), 16, 0, 0); } } while (0)
#define MB5_DMAV(p_) do { LAS unsigned char* buf_ = F.lds + ((p_) & 1) * MB3_BUF + MB3_TILE; _Pragma("unroll") for (int j_ = 0; j_ < 4; ++j_) { const GAS char* vb_ = (const GAS char*)VT + ((size_t)(32 * j_) * SEQ + 128 * (p_)) * 2; \
        __builtin_amdgcn_global_load_lds((const GAS unsigned*)(vb_ + vvoff), (LAS unsigned*)(buf_ + (8 * j_ + w) * 1024), 16, 0, 0); } } while (0)
#define MB5_DMAK2(p_) do { LAS unsigned char* buf_ = F.lds + ((p_) & 1) * MB3_BUF; _Pragma("unroll") for (int j_ = 0; j_ < 4; ++j_) _Pragma("unroll") for (int h_ = 0; h_ < 2; ++h_) { \
        const GAS char* kb_ = (const GAS char*)KN + (size_t)(128 * (p_) + 32 * j_) * 2048 - h_ * 32768; \
        __builtin_amdgcn_global_load_lds((const GAS unsigned*)(kb_ + kvoff), (LAS unsigned*)(buf_ + (8 * j_ + w - 4 * h_) * 1024), 16, 0, 0); } } while (0)
#define MB5_DMAV2(p_) do { LAS unsigned char* buf_ = F.lds + ((p_) & 1) * MB3_BUF + MB3_TILE; _Pragma("unroll") for (int j_ = 0; j_ < 4; ++j_) _Pragma("unroll") for (int h_ = 0; h_ < 2; ++h_) { \
        const GAS char* vb_ = (const GAS char*)VT + ((size_t)(32 * j_) * SEQ + 128 * (p_)) * 2 - h_ * (16 * SEQ * 2); \
        __builtin_amdgcn_global_load_lds((const GAS unsigned*)(vb_ + vvoff), (LAS unsigned*)(buf_ + (8 * j_ + w - 4 * h_) * 1024), 16, 0, 0); } } while (0)
#define MB5_DUTY(p_) do { if ((p_) + 1 < np) { if ((p_) + 2 < np) MB5_DMAK2((p_) + 2); MB5_DMAV2((p_) + 1); } } while (0)
#define MB5_QKL(INIT_) do { _Pragma("unroll") for (int mh = 0; mh < 4; ++mh) { bf16x8_t fragA[2][4]; \
        _Pragma("unroll") for (int mt = 0; mt < 2; ++mt) _Pragma("unroll") for (int ks = 0; ks < 4; ++ks) fragA[mt][ks] = *(const LAS bf16x8_t*)(KB + (16 * (2 * mh + mt) + fr) * 256 + 16 * ((4 * ks + fq) ^ fr)); \
        __builtin_amdgcn_sched_barrier(0); \
        _Pragma("unroll") for (int mt = 0; mt < 2; ++mt) { const int i_ = 2 * mh + mt; f32x4 c_ = INIT_; _Pragma("unroll") for (int ks = 0; ks < 4; ++ks) c_ = mma16(fragA[mt][ks], bq[ks], c_); as[i_] = c_; } \
        __builtin_amdgcn_sched_barrier(0); } } while (0)
#define MB5_ZERO ((f32x4){0.f, 0.f, 0.f, 0.f})
#define MB5_MASK ((f32x4){(16 * i_ + 0 <= ld_) ? 0.f : -__builtin_inff(), (16 * i_ + 1 <= ld_) ? 0.f : -__builtin_inff(), (16 * i_ + 2 <= ld_) ? 0.f : -__builtin_inff(), (16 * i_ + 3 <= ld_) ? 0.f : -__builtin_inff()})
#define MB5_QK(p_) do { const LAS unsigned char* KB = F.lds + ((p_) & 1) * MB3_BUF; \
        if ((p_) == qt) { int ld_ = limd; asm volatile("" : "+v"(ld_)); MB5_QKL(MB5_MASK); } else { MB5_QKL(MB5_ZERO); } } while (0)
    MB5_DMAK(0); MB5_DMAV(0); if (np > 1) MB5_DMAK(1);
    VM_WAIT(); LDS_WAIT(); __syncthreads();
    unsigned selmask = 0u;
    { float sc[8];
#pragma unroll
      for (int kb = 0; kb < 8; ++kb) { float a = 0.f;
#pragma unroll
          for (int ks = 0; ks < 4; ++ks) { const LAS float* kp = KML + kb * 128 + 32 * ks + 8 * fq; const f32x4 k0 = *(const LAS f32x4*)kp, k1 = *(const LAS f32x4*)(kp + 4);
              const v4u qv = __builtin_bit_cast(v4u, bq[ks]);
              a += bflo(qv.x) * k0[0] + bfhi(qv.x) * k0[1] + bflo(qv.y) * k0[2] + bfhi(qv.y) * k0[3] + bflo(qv.z) * k1[0] + bfhi(qv.z) * k1[1] + bflo(qv.w) * k1[2] + bfhi(qv.w) * k1[3]; }
          a += __shfl_xor(a, 16); a += __shfl_xor(a, 32); sc[kb] = (kb < qb) ? a : -__builtin_inff(); }
#pragma unroll
      for (int kb = 0; kb < 8; ++kb) { int rank = 0;
#pragma unroll
          for (int j = 0; j < 8; ++j) if (j != kb) rank += ((j < qb) && (sc[j] > sc[kb] || (sc[j] == sc[kb] && j < kb))) ? 1 : 0;
          if (kb < qb && rank < 3) selmask |= 1u << kb; } }
    f32x4 ao[8];
#pragma unroll
    for (int dt = 0; dt < 8; ++dt) ao[dt] = (f32x4){0.f, 0.f, 0.f, 0.f};
    float m = -__builtin_inff();
    f32x4 al = (f32x4){0.f, 0.f, 0.f, 0.f};
    const bf16x8_t ones = (bf16x8_t){0x3F80, 0x3F80, 0x3F80, 0x3F80, 0x3F80, 0x3F80, 0x3F80, 0x3F80};
    const int limd = 16 * w + fr - 4 * fq;
    f32x4 as[8]; bf16x8_t pf[4];
#define MB5_MINE(p_) ((((p_) >> 1) < qb) ? (((selmask >> ((p_) >> 1)) & 1u) != 0u) : true)
    bool act = __any(MB5_MINE(0));
    if (act) MB5_QK(0);
    LDS_WAIT();
    if (hb) __builtin_amdgcn_s_barrier();
#pragma unroll 1
    for (int p = 0; p < np; ++p) {
        if (hb) MB5_DUTY(p);
        if (act) {
            const bool skip = ((p >> 1) < qb) && !MB5_MINE(p);
            float mx = -__builtin_inff();
#pragma unroll
            for (int mt = 0; mt < 8; ++mt)
#pragma unroll
                for (int r = 0; r < 4; ++r) mx = fmaxf(mx, as[mt][r]);
            mx = skip ? -__builtin_inff() : mx;
            mx = fmaxf(mx, __shfl_xor(mx, 16)); mx = fmaxf(mx, __shfl_xor(mx, 32));
            const float mnew = fmaxf(m, mx), msafe = (mnew == -__builtin_inff()) ? 0.f : mnew;
            const bool grow = __any(mnew != m);
            const float corr = grow ? __builtin_amdgcn_exp2f(m - msafe) : 1.0f;
            const float sub = skip ? 3.0e38f : msafe;
#pragma unroll
            for (int mt = 0; mt < 8; ++mt)
#pragma unroll
                for (int r = 0; r < 4; ++r) as[mt][r] = __builtin_amdgcn_exp2f(as[mt][r] - sub);
            m = mnew;
#pragma unroll
            for (int k2 = 0; k2 < 4; ++k2) { v4u t; t.x = pg8::cvt_pk_bf16(as[2 * k2][0], as[2 * k2][1]); t.y = pg8::cvt_pk_bf16(as[2 * k2][2], as[2 * k2][3]); t.z = pg8::cvt_pk_bf16(as[2 * k2 + 1][0], as[2 * k2 + 1][1]); t.w = pg8::cvt_pk_bf16(as[2 * k2 + 1][2], as[2 * k2 + 1][3]);
                pf[k2] = __builtin_bit_cast(bf16x8_t, t); }
            if (grow) {
#pragma unroll
                for (int dt = 0; dt < 8; ++dt) ao[dt] = ao[dt] * corr;
                al = al * corr; }
        }
        LDS_WAIT(); __builtin_amdgcn_s_barrier(); asm volatile("" ::: "memory");
        __builtin_amdgcn_s_setprio(1);
        if (act) {
            const LAS unsigned char* VB = F.lds + (p & 1) * MB3_BUF + MB3_TILE;
#pragma unroll
            for (int k2 = 0; k2 < 4; ++k2) al = mma16(ones, pf[k2], al);
#pragma unroll
            for (int dh = 0; dh < 4; ++dh) { bf16x8_t fragV[2][4];
#pragma unroll
                for (int dt = 0; dt < 2; ++dt)
#pragma unroll
                    for (int k2 = 0; k2 < 4; ++k2) fragV[dt][k2] = *(const LAS bf16x8_t*)(VB + (16 * (2 * dh + dt) + fr) * 256 + 16 * ((4 * k2 + fq) ^ fr));
                __builtin_amdgcn_sched_barrier(0);
#pragma unroll
                for (int dt = 0; dt < 2; ++dt)
#pragma unroll
                    for (int k2 = 0; k2 < 4; ++k2) ao[2 * dh + dt] = mma16(fragV[dt][k2], pf[k2], ao[2 * dh + dt]);
                __builtin_amdgcn_sched_barrier(0); }
        }
        act = (p + 1 < np) ? __any(MB5_MINE(p + 1)) : false;
        if (act) MB5_QK(p + 1);
        __builtin_amdgcn_s_setprio(0);
        if (hb) VM_WAIT();
        LDS_WAIT(); __builtin_amdgcn_s_barrier(); asm volatile("" ::: "memory");
    }
    if (!hb) __builtin_amdgcn_s_barrier();
#undef MB5_DMAK
#undef MB5_DMAV
#undef MB5_DUTY
#undef MB5_DMAK2
#undef MB5_DMAV2
#undef MB5_QK
#undef MB5_QKL
#undef MB5_ZERO
#undef MB5_MASK
#undef MB5_MINE
    const float inv = 1.0f / al[0];
    GAS bf16* yp = (GAS bf16*)(F.ws + WS_Y) + ((size_t)b * SEQ + qpos) * YW + 2048 + h * 128 + 4 * fq;
#pragma unroll
    for (int dt = 0; dt < 8; ++dt) { v2u o; o.x = pg8::cvt_pk_bf16(ao[dt][0] * inv, ao[dt][1] * inv); o.y = pg8::cvt_pk_bf16(ao[dt][2] * inv, ao[dt][3] * inv); *(GAS v2u*)(yp + 16 * dt) = o; }
}
constexpr int NPH = 9;
__global__ void __launch_bounds__(NWAVES * 64, 2) fwd_kernel(Args args) {
    extern __shared__ __attribute__((aligned(16))) unsigned char lds[];
    Frame F;
    F.lds = (LAS unsigned char*)lds;
    F.MISC = (volatile LAS unsigned*)(F.lds + MISC_OFF);
    F.tid = threadIdx.x; F.lane = F.tid & 63; F.wave = __builtin_amdgcn_readfirstlane(F.tid >> 6); F.wv = F.wave;
    F.G = gridDim.x; F.in = args.in; F.ws = (GAS unsigned char*)args.ws; F.ws0 = args.ws; F.ctl = (unsigned*)(args.ws + WS_CTL);
    for (int u = F.tid; u < (LDS_BYTES - LDSCTL_OFF) / 4; u += NWAVES * 64) ((LAS unsigned*)(F.lds + LDSCTL_OFF))[u] = 0u;
    __syncthreads();
    XcdBarrier bar; bar.bar = F.ctl + CW_BAR; bar.x = 0; bar.st = nullptr;
    if (args.fused) bar = xcd_barrier_post(F.ctl + CW_BAR, F.MISC + 8);
#define GRID_BAR() do { if (args.fused) xcd_barrier(bar, opaque_tid(F.wv)); } while (0)
    const int lo = args.ph_lo, hi = args.ph_hi;
#ifndef PH_MASK
#define PH_MASK 0x1ff
#endif
#define IN(k) (((PH_MASK >> (k)) & 1) && lo <= (k) && (k) < hi)
#define WSP(T, off) ((GAS T*)(ws + (off)))

    if (args.l_lo == 0 && IN(0)) for (int rep = 0; rep < NREP(0); ++rep) { F.refresh(); p0_prologue(F); GRID_BAR(); }

    for (int l = args.l_lo; l < args.l_hi; ++l) {
        if (IN(1)) for (int rep = 0; rep < NREP(1); ++rep) {
            GAS unsigned char* ws = (GAS unsigned char*)opaque_ptr(args.ws); const GAS unsigned char* wl = ws + WS_W + (size_t)l * SZ_WLAYER;
            pg8::Gemm g{WSP(pg8::bf16_t, WS_XB), DM, (const GAS pg8::bf16_t*)(wl + OFF_WIN), DM, DM, 0, 0}; pg8::TileOrder S; S.init(MTOK, NP, F.G, (int)blockIdx.x, 1);
            pg8::EpiInProj E{WSP(pg8::bf16_t, WS_P), WSP(float, WS_SSQ), WSP(pg8::bf16_t, WS_US), WSP(pg8::bf16_t, WS_QN), WSP(pg8::bf16_t, WS_KN), WSP(float, WS_KM), ((const GAS float*)args.in[I_MQG]) + l * 128, ((const GAS float*)args.in[I_MKG]) + l * 128};
            pg8::gemm_phase(F.lds, g, S, E, F.wv);
            if (rep == 0) { F.refresh(); cv_tail(F, l, 0); }
            GRID_BAR();
        }
        if (IN(2)) for (int rep = 0; rep < NREP(2); ++rep) {
            int rot = ((int)blockIdx.x >> 3) & 1, nstep = 2; asm volatile("" : "+s"(rot), "+s"(nstep));
#pragma unroll 1
            for (int step = 0; step < nstep; ++step) { const int kind = step ^ rot;
                VM_WAIT(); __syncthreads(); F.refresh();
                if (kind == 0) { for (int rp = 0; rp < NREP(13); ++rp) { int hprev = -1; for (int u = blockIdx.x; u < 512; u += F.G) { const int hh = (u >> 5) & 3; gla_g1_unit(F, l, u, hh != hprev); hprev = hh; } } }
                else { for (int rp = 0; rp < NREP(14); ++rp) for (int u = blockIdx.x; u < 256; u += F.G) moba_prep_unit(F, l, u); } }
            GRID_BAR(); }
        if (IN(3)) for (int rep = 0; rep < NREP(3); ++rep) {
            int rot3 = ((int)blockIdx.x >> 6) & 1, nstep3 = 2; asm volatile("" : "+s"(rot3), "+s"(nstep3));
#pragma unroll 1
            for (int step = 0; step < nstep3; ++step) {
                VM_WAIT(); __syncthreads(); F.refresh();
                if ((step ^ rot3) == 0) {
                    for (int rp = 0; rp < NREP(12); ++rp) for (int u = blockIdx.x; u < 256; u += F.G) s5_s1_unit(F, l, u);
                    VM_WAIT(); __syncthreads(); F.refresh();
                    for (int rp = 0; rp < NREP(9); ++rp) for (int u = blockIdx.x; u < 256; u += F.G) s5_s3_unit(F, l, u);
                    VM_WAIT(); __syncthreads();
                    F.refresh(); for (int rp = 0; rp < NREP(10); ++rp) gla_g2_scan(F);
                } else {
                    for (int rp = 0; rp < NREP(11) * ATT_REP; ++rp) for (int pi2 = 2 * blockIdx.x; pi2 < 512; pi2 += 2 * F.G) {
#pragma unroll 1
                        for (int hh = 0; hh < 2; ++hh) { const int pi = pi2 >> 1;
                            const int bh = (pi & 7) + 8 * ((pi >> 6) & 3), xp = (pi >> 3) & 7; moba_attn_unit5(F, bh, hh ? xp : 15 - xp); } }
                } }
            GRID_BAR(); }
        if (IN(4)) for (int rep = 0; rep < NREP(4); ++rep) {
            const int gh = F.G >= 2 ? F.G / 2 : 1;
            if ((int)blockIdx.x < gh) {
                GAS unsigned char* ws = (GAS unsigned char*)opaque_ptr(args.ws); const GAS unsigned char* wl = ws + WS_W + (size_t)l * SZ_WLAYER;
                pg8::Gemm g{WSP(pg8::bf16_t, WS_Z), 1024, (const GAS pg8::bf16_t*)(wl + OFF_WGLU), 1024, 1024, 0, 0}; pg8::TileOrder S; S.init(MTOK, 1024, gh, (int)blockIdx.x, 1);
                pg8::EpiGLU E{WSP(pg8::bf16_t, WS_Z), WSP(pg8::bf16_t, WS_Y), ((const GAS float*)args.in[I_BGLU]) + l * 1024};
                pg8::gemm_phase(F.lds, g, S, E, F.wv);
            }
            { F.refresh();
              GAS unsigned* head = (GAS unsigned*)(F.ctl + CW_QUEUE + 64 * l);
              for (;;) { if (F.tid == 0) F.MISC[16] = __hip_atomic_fetch_add(head, 1u, __ATOMIC_RELAXED, __HIP_MEMORY_SCOPE_AGENT);
                  LDS_WAIT(); __syncthreads(); const unsigned uq = F.MISC[16]; __syncthreads();
                  if (uq >= 512u) break; gla_g3_unit(F, l, (int)uq); } }
            GRID_BAR();
        }
        if (IN(5)) for (int rep = 0; rep < NREP(5); ++rep) {
            GAS unsigned char* ws = (GAS unsigned char*)opaque_ptr(args.ws); const GAS unsigned char* wl = ws + WS_W + (size_t)l * SZ_WLAYER;
            pg8::Gemm g{WSP(pg8::bf16_t, WS_Y), YW, (const GAS pg8::bf16_t*)(wl + OFF_WBR), 3072, 1024, 1024, 1024}; pg8::TileOrder S; S.init(MTOK, DM, F.G, (int)blockIdx.x, 3);
            pg8::EpiBranch E{WSP(pg8::bf16_t, WS_P), WSP(pg8::bf16_t, WS_MB)};
            pg8::gemm_phase(F.lds, g, S, E, F.wv);
            GRID_BAR();
        }
        if (IN(6)) {
            GAS unsigned char* ws = (GAS unsigned char*)opaque_ptr(args.ws); const GAS unsigned char* wl = ws + WS_W + (size_t)l * SZ_WLAYER;
            pg8::Gemm g{WSP(pg8::bf16_t, WS_MB), DM, (const GAS pg8::bf16_t*)(wl + OFF_WOUT), DM, DM, 0, 0}; pg8::TileOrder S; S.init(MTOK, DM, F.G, (int)blockIdx.x, 1);
            if (l == 0) { pg8::EpiResid<true, false> E{((const GAS float*)args.in[I_X]), nullptr, WSP(pg8::bf16_t, WS_XB), WSP(float, WS_SSQ)}; pg8::gemm_phase(F.lds, g, S, E, F.wv); }
            else { pg8::EpiResid<false, false> E{nullptr, nullptr, WSP(pg8::bf16_t, WS_XB), WSP(float, WS_SSQ)}; pg8::gemm_phase(F.lds, g, S, E, F.wv); }
            GRID_BAR();
        }
        if (IN(7)) for (int rep = 0; rep < NREP(7); ++rep) {
            GAS unsigned char* ws = (GAS unsigned char*)opaque_ptr(args.ws); const GAS unsigned char* wl = ws + WS_W + (size_t)l * SZ_WLAYER;
            pg8::Gemm g{WSP(pg8::bf16_t, WS_XB), DM, (const GAS pg8::bf16_t*)(wl + OFF_WGU), DM, DM, 0, 0}; pg8::TileOrder S; S.init(MTOK, NGU, F.G, (int)blockIdx.x, 1);
            pg8::EpiFFNUp E{WSP(pg8::bf16_t, WS_H), WSP(float, WS_SSQ)};
            pg8::gemm_phase(F.lds, g, S, E, F.wv);
            if (rep == 0) { F.refresh(); cv_tail(F, l, 1); }
            GRID_BAR();
        }
        if (IN(8)) {
            GAS unsigned char* ws = (GAS unsigned char*)opaque_ptr(args.ws); const GAS unsigned char* wl = ws + WS_W + (size_t)l * SZ_WLAYER;
            pg8::Gemm g{WSP(pg8::bf16_t, WS_H), FFN, (const GAS pg8::bf16_t*)(wl + OFF_WDN), FFN, FFN, 0, 0}; pg8::TileOrder S; S.init(MTOK, DM, F.G, (int)blockIdx.x, 1);
            if (l == DEPTH - 1) { pg8::EpiResid<false, true> E{nullptr, (GAS float*)args.out, WSP(pg8::bf16_t, WS_XB), WSP(float, WS_SSQ)}; pg8::gemm_phase(F.lds, g, S, E, F.wv); }
            else { pg8::EpiResid<false, false> E{nullptr, nullptr, WSP(pg8::bf16_t, WS_XB), WSP(float, WS_SSQ)}; pg8::gemm_phase(F.lds, g, S, E, F.wv); }
            if (l + 1 < DEPTH) GRID_BAR();
        }
    }
#undef IN
#undef GRID_BAR
}

extern "C" void kernel_launch(void* const* d_in, const int* in_sizes, int n_in, void* d_out, int out_size, void* d_ws, size_t ws_size, hipStream_t stream) {
    static int grid = 0;
    if (grid == 0) {
        if (n_in != 26 || out_size != MTOK * DM || ws_size < WS_END) { fprintf(stderr, "kernel_launch: unexpected problem (n_in %d out %d ws %zu need %zu)\n", n_in, out_size, ws_size, (size_t)WS_END); grid = -1; return; }
        int dev = 0, cus = 0, per_cu = 0;
        if (hipGetDevice(&dev) != hipSuccess || hipDeviceGetAttribute(&cus, hipDeviceAttributeMultiprocessorCount, dev) != hipSuccess) { grid = -1; return; }
        if (hipFuncSetAttribute((const void*)fwd_kernel, hipFuncAttributeMaxDynamicSharedMemorySize, LDS_BYTES) != hipSuccess) { fprintf(stderr, "kernel_launch: hipFuncSetAttribute failed\n"); grid = -1; return; }
        if (hipOccupancyMaxActiveBlocksPerMultiprocessor(&per_cu, (const void*)fwd_kernel, NWAVES * 64, LDS_BYTES) != hipSuccess || per_cu < 1) { fprintf(stderr, "kernel_launch: occupancy query says %d\n", per_cu); }
        (void)hipGetLastError();
        grid = cus;
    }
    if (grid < 0) return;
    if (hipMemsetAsync((char*)d_ws + WS_CTL, 0, CTL_ZERO_BYTES, stream) != hipSuccess) return;
    Args a{};
    for (int i = 0; i < 26; ++i) a.in[i] = (const float*)d_in[i];
    a.out = (float*)d_out; a.ws = (unsigned char*)d_ws; a.pad = 0;
#if MK_FUSED
    a.l_lo = 0; a.l_hi = DEPTH; a.ph_lo = 0; a.ph_hi = NPH; a.fused = 1;
    hipLaunchKernelGGL(fwd_kernel, dim3(grid), dim3(NWAVES * 64), LDS_BYTES, stream, a);
#else
    a.fused = 0;
    for (int l = 0; l < DEPTH; ++l)
        for (int ph = (l == 0 ? 0 : 1); ph < NPH; ++ph) { a.l_lo = l; a.l_hi = l + 1; a.ph_lo = ph; a.ph_hi = ph + 1; hipLaunchKernelGGL(fwd_kernel, dim3(grid), dim3(NWAVES * 64), LDS_BYTES, stream, a); }
#endif
}
```

```cpp
#include <hip/hip_runtime.h>
#include <cstdio>
#include <cstdint>

#ifndef REPEAT_MASK
#define REPEAT_MASK 0
#endif
#ifndef REPF
#define REPF 1
#endif
#define NREP(k) (1 + REPF * ((REPEAT_MASK >> (k)) & 1))
#ifndef ATT_REP
#define ATT_REP 1
#endif
#ifndef MK_FUSED
#define MK_FUSED 1
#endif

__device__ __forceinline__ unsigned char* opaque_ptr(unsigned char* p) { asm volatile("" : "+s"(p)); return p; }
__device__ __forceinline__ int opaque_tid(int wv) { int ln; asm volatile("v_mbcnt_lo_u32_b32 %0, -1, 0\n\tv_mbcnt_hi_u32_b32 %0, -1, %0" : "=v"(ln)); return (wv << 6) | ln; }

namespace pg8 {
#define PG8_LAS __attribute__((address_space(3)))
typedef unsigned short bf16_t;
typedef short bf16x8 __attribute__((ext_vector_type(8)));
typedef float f32x4 __attribute__((ext_vector_type(4)));
typedef unsigned u32x4 __attribute__((ext_vector_type(4)));
typedef unsigned u32x2 __attribute__((ext_vector_type(2)));
constexpr int BM = 256, BK = 64, HALF = 128, HTB = HALF * BK * 2, STAGE_BYTES = 8 * HTB, NXCD = 8, WGM = 8;

__host__ __device__ __forceinline__ int lds_byte(int r, int c) { const int st = (r >> 4) * 2 + (c >> 5), rr = r & 15, cc = c & 31, ob = rr * 64 + cc * 2; return st * 1024 + (ob ^ (((ob >> 9) & 1) << 5)); }
__host__ __device__ __forceinline__ void stage_rc(int b, int& R, int& C) { const int st = b / 1024, sb = b % 1024, swz = sb ^ (((sb >> 9) & 1) << 5); R = (st >> 1) * 16 + swz / 64; C = (st & 1) * 32 + (swz % 64) / 2; }
__host__ __device__ __forceinline__ int perm32(int rho) { const int n = rho >> 4, i = rho & 15; return 8 * (i >> 2) + 4 * n + (i & 3); }

struct Unit { int pm, pn, br; };
struct Gemm { const __attribute__((address_space(1))) bf16_t* A; int lda; const __attribute__((address_space(1))) bf16_t* Bt; int ldb; int K; int abr, bbr; };

struct TileOrder {
    int nM, nN, nwg, G, c, nbr;
    __device__ __forceinline__ void init(int M, int N, int G_, int c_, int nbr_) { asm volatile("" : "+s"(G_), "+s"(c_)); nM = M / BM; nN = N / BM; nwg = nM * nN; G = G_; c = c_; nbr = nbr_; }
    __device__ __forceinline__ bool next(int i, Unit& u) const {
        const int it = i / nbr; u.br = i - it * nbr;
        const long L = (long)it * G + c; if (L >= nwg) return false;
        int wgid = (int)L; { const int q = nwg / NXCD, r = nwg % NXCD, xcd = wgid % NXCD, off = wgid / NXCD; wgid = (xcd < r ? xcd * (q + 1) : r * (q + 1) + (xcd - r) * q) + off; }
        const int nig = WGM * nN, gid = wgid / nig, fm = gid * WGM, gsz = (nM - fm) < WGM ? (nM - fm) : WGM;
        u.pm = __builtin_amdgcn_readfirstlane(fm + ((wgid % nig) % gsz)); u.pn = __builtin_amdgcn_readfirstlane((wgid % nig) / gsz); return true;
    }
};

__device__ __forceinline__ unsigned cvt_pk_bf16(float lo, float hi) { unsigned r; asm volatile("v_cvt_pk_bf16_f32 %0, %1, %2" : "=v"(r) : "v"(lo), "v"(hi)); return r; }

template <class Epi, class Sched>
__device__ __forceinline__ void gemm_phase(PG8_LAS unsigned char* lds, const Gemm g, const Sched& S, const Epi& E, int wv) {
    const int tid = opaque_tid(wv), wid = __builtin_amdgcn_readfirstlane(tid >> 6), lane = tid & 63, wr = wid >> 2, wc = wid & 3, fr = lane & 15, fq = lane >> 4;
    const int K = g.K, nt = K / BK;
    unsigned voffA[2], voffB[2];
#pragma unroll
    for (int i = 0; i < 2; ++i) { int R, C; stage_rc(tid * 16 + i * 8192, R, C); const int Rb = (R & ~31) + perm32(R & 31);
        voffA[i] = (unsigned)(R * g.lda + C) * 2u; voffB[i] = (unsigned)(Rb * g.ldb + C) * 2u; }
    const size_t kstep = (size_t)(BK * 2);
    const size_t hstepA = (size_t)HALF * g.lda * 2, hstepB = (size_t)HALF * g.ldb * 2;
    const size_t tstepA = 2 * hstepA, tstepB = 2 * hstepB;
    const unsigned ldsw = (unsigned)wid * 1024u;
    const int aoff = lds_byte(wr * 64 + fr, fq * 8), boff = lds_byte(wc * 32 + fr, fq * 8);
#define PG8_SA(b, h) (((b) * 2 + (h)) * HTB)
#define PG8_SB(b, h) ((4 + (b) * 2 + (h)) * HTB)
#define PG8_STAGE(bufoff, gbase, voff) do { _Pragma("unroll") for (int _i = 0; _i < 2; ++_i) \
        __builtin_amdgcn_global_load_lds((const unsigned*)((const char*)(gbase) + (voff)[_i]), (PG8_LAS unsigned*)(lds + (bufoff) + ldsw + _i * 8192), 16, 0, 0); } while (0)
#define PG8_LDA(dst, b, h) do { _Pragma("unroll") for (int m = 0; m < 4; ++m) _Pragma("unroll") for (int k = 0; k < 2; ++k) dst[m][k] = *(const PG8_LAS bf16x8*)(lds + PG8_SA(b, h) + aoff + m * 2048 + k * 1024); } while (0)
#define PG8_LDB(dst, b, h) do { _Pragma("unroll") for (int n = 0; n < 2; ++n) _Pragma("unroll") for (int k = 0; k < 2; ++k) dst[n][k] = *(const PG8_LAS bf16x8*)(lds + PG8_SB(b, h) + boff + n * 2048 + k * 1024); } while (0)
#define PG8_MMA(ai, bj, At, Bt) do { __builtin_amdgcn_s_setprio(1); _Pragma("unroll") for (int m = 0; m < 4; ++m) _Pragma("unroll") for (int n = 0; n < 2; ++n) _Pragma("unroll") for (int k = 0; k < 2; ++k) \
        acc[ai][bj][m][n] = __builtin_amdgcn_mfma_f32_16x16x32_bf16(Bt[n][k], At[m][k], acc[ai][bj][m][n], 0, 0, 0); __builtin_amdgcn_s_setprio(0); } while (0)
#define PG8_WAIT_V(n) asm volatile("s_waitcnt vmcnt(" #n ")" ::: "memory")
#define PG8_WAIT_L(n) asm volatile("s_waitcnt lgkmcnt(" #n ")" ::: "memory")
#define PG8_BAR __builtin_amdgcn_s_barrier()
#define PG8_SCHED __builtin_amdgcn_sched_barrier(0)
    Unit cur, nxt; int ui = 0;
    if (!S.next(0, cur)) return;
    f32x4 acc[2][2][4][2];
#pragma unroll
    for (int a = 0; a < 2; ++a)
#pragma unroll
        for (int b = 0; b < 2; ++b)
#pragma unroll
            for (int m = 0; m < 4; ++m)
#pragma unroll
                for (int n = 0; n < 2; ++n) acc[a][b][m][n] = (f32x4){0.f, 0.f, 0.f, 0.f};
    bf16x8 At[4][2], B0[2][2], B1[2][2];
    const char* cA = (const char*)g.A + (size_t)cur.pm * tstepA + (size_t)cur.br * g.abr * 2; const char* cB = (const char*)g.Bt + (size_t)cur.pn * tstepB + (size_t)cur.br * g.bbr * 2;
    PG8_STAGE(PG8_SB(0, 0), cB, voffB); PG8_STAGE(PG8_SB(0, 1), cB + hstepB, voffB); PG8_STAGE(PG8_SA(0, 0), cA, voffA); PG8_STAGE(PG8_SA(0, 1), cA + hstepA, voffA);
    if (wr == 1) PG8_BAR;
    PG8_WAIT_V(2); PG8_BAR;
    PG8_STAGE(PG8_SB(1, 0), cB + kstep, voffB); PG8_STAGE(PG8_SA(1, 0), cA + kstep, voffA); PG8_STAGE(PG8_SB(1, 1), cB + hstepB + kstep, voffB);
    PG8_WAIT_V(6); PG8_BAR;
    for (;;) {
        const bool has_next = S.next(ui + 1, nxt);
        const char* nA = has_next ? (const char*)g.A + (size_t)nxt.pm * tstepA + (size_t)nxt.br * g.abr * 2 : cA; const char* nB = has_next ? (const char*)g.Bt + (size_t)nxt.pn * tstepB + (size_t)nxt.br * g.bbr * 2 : cB;
        for (int t = 0; t < nt; t += 2) {
            const bool last = (t == nt - 2);
            const char* a1 = cA + (size_t)(t + 1) * kstep;
            const char* a2 = last ? nA : cA + (size_t)(t + 2) * kstep; const char* b2 = last ? nB : cB + (size_t)(t + 2) * kstep;
            const char* a3 = a2 + kstep; const char* b3 = b2 + kstep;
            PG8_LDB(B0, 0, 0); PG8_LDB(B1, 0, 1); PG8_SCHED; PG8_LDA(At, 0, 0); PG8_STAGE(PG8_SA(1, 1), a1 + hstepA, voffA);
            PG8_WAIT_V(8); PG8_WAIT_L(0); PG8_BAR; PG8_MMA(0, 0, At, B0); PG8_MMA(0, 1, At, B1); PG8_BAR; PG8_SCHED;
            PG8_LDA(At, 0, 1); PG8_STAGE(PG8_SB(0, 0), b2, voffB); PG8_STAGE(PG8_SB(0, 1), b2 + hstepB, voffB); PG8_STAGE(PG8_SA(0, 0), a2, voffA);
            PG8_WAIT_V(8); PG8_WAIT_L(0); PG8_BAR; PG8_MMA(1, 0, At, B0); PG8_MMA(1, 1, At, B1); PG8_BAR; PG8_SCHED;
            PG8_LDB(B0, 1, 0); PG8_LDB(B1, 1, 1); PG8_SCHED; PG8_LDA(At, 1, 0); PG8_STAGE(PG8_SA(0, 1), a2 + hstepA, voffA);
            PG8_WAIT_V(8); PG8_WAIT_L(0); PG8_BAR; PG8_MMA(0, 0, At, B0); PG8_MMA(0, 1, At, B1); PG8_BAR; PG8_SCHED;
            PG8_LDA(At, 1, 1); PG8_STAGE(PG8_SB(1, 0), b3, voffB); PG8_STAGE(PG8_SB(1, 1), b3 + hstepB, voffB); PG8_STAGE(PG8_SA(1, 0), a3, voffA);
            PG8_WAIT_V(8); PG8_WAIT_L(0); PG8_BAR; PG8_MMA(1, 0, At, B0); PG8_MMA(1, 1, At, B1); PG8_BAR; PG8_SCHED;
        }
        if (wr == 0) PG8_BAR;
        E(acc, cur, wr, wc, fr, fq, lds);
        if (!has_next) break;
        if (!Epi::CHAIN || cur.br == S.nbr - 1) {
#pragma unroll
        for (int a = 0; a < 2; ++a)
#pragma unroll
            for (int b = 0; b < 2; ++b)
#pragma unroll
                for (int m = 0; m < 4; ++m)
#pragma unroll
                    for (int n = 0; n < 2; ++n) acc[a][b][m][n] = (f32x4){0.f, 0.f, 0.f, 0.f};
        }
        cur = nxt; cA = nA; cB = nB; ++ui;
        if (wr == 1) PG8_BAR;
    }
    PG8_WAIT_V(0);
    PG8_BAR;
#undef PG8_SA
#undef PG8_SB
#undef PG8_STAGE
#undef PG8_LDA
#undef PG8_LDB
#undef PG8_MMA
#undef PG8_WAIT_V
#undef PG8_WAIT_L
#undef PG8_BAR
#undef PG8_SCHED
}
}

constexpr int NWAVES = 8;
constexpr int DM = 2048, NBATCH = 4, SEQ = 2048, DEPTH = 4, MTOK = NBATCH * SEQ;
constexpr int INW = 13328;
constexpr int NP = 13568;
constexpr int PC_SSM = 0, PC_GQ = 1024, PC_GK = 1536, PC_GV = 2048, PC_GR = 3072, PC_MQ = 4096, PC_MK = 5120, PC_MV = 6144, PC_GS = 7168, PC_GLR = 13312;
constexpr int FFN = 5632, NGU = 2 * FFN;
constexpr int YW = 3072;
constexpr float RMS_EPS = 1e-6f;

constexpr size_t MiB = 1u << 20;
constexpr size_t WS_CTL = 0, CTL_ZERO_BYTES = 1 * MiB;
constexpr size_t SZ_WIN = (size_t)NP * DM * 2, SZ_WGLU = (size_t)1024 * 1024 * 2, SZ_WBR = (size_t)DM * 3072 * 2, SZ_WOUT = (size_t)DM * DM * 2, SZ_WGU = (size_t)NGU * DM * 2, SZ_WDN = (size_t)DM * FFN * 2;
constexpr size_t OFF_WIN = 0, OFF_WGLU = OFF_WIN + SZ_WIN, OFF_WBR = OFF_WGLU + SZ_WGLU, OFF_WOUT = OFF_WBR + SZ_WBR, OFF_WGU = OFF_WOUT + SZ_WOUT, OFF_WDN = OFF_WGU + SZ_WGU, SZ_WLAYER = OFF_WDN + SZ_WDN;
constexpr size_t WS_W = 2 * MiB;
constexpr size_t WS_P = WS_W + ((DEPTH * SZ_WLAYER + MiB - 1) / MiB) * MiB;
constexpr size_t WS_Z = WS_P + (size_t)MTOK * NP * 2;
constexpr size_t WS_Y = WS_Z + (size_t)MTOK * 1024 * 2;
constexpr size_t WS_MB = WS_Y + (size_t)MTOK * YW * 2;
constexpr size_t WS_XB = WS_MB + (size_t)MTOK * DM * 2;
constexpr size_t WS_H = WS_XB + (size_t)MTOK * DM * 2;
constexpr size_t WS_SSQ = WS_H + (size_t)MTOK * FFN * 2;
constexpr size_t WS_QN = WS_SSQ + (size_t)MTOK * 8 * 4;
constexpr size_t WS_KN = WS_QN + (size_t)MTOK * 1024 * 2;
constexpr size_t WS_KM = WS_KN + (size_t)MTOK * 1024 * 2;
constexpr size_t WS_TK = WS_KM + (size_t)4 * 8 * 8 * 128 * 4;
constexpr size_t WS_TW = WS_TK + (size_t)DEPTH * 64 * 64 * 256 * 2;
constexpr size_t WS_TC = WS_TW + (size_t)DEPTH * 64 * 128 * 1024 * 2;
constexpr size_t WS_A64 = WS_TC + (size_t)DEPTH * 64 * 1024 * 128 * 2;
constexpr size_t WS_SL = WS_A64 + (size_t)DEPTH * 64 * 128 * 4;
constexpr size_t WS_QD = WS_SL + (size_t)NBATCH * 32 * 64 * 128 * 4;
constexpr size_t WS_KI = WS_QD + (size_t)512 * 64 * 128 * 2;
constexpr size_t WS_GVT = WS_KI + (size_t)512 * 64 * 128 * 2;
constexpr size_t WS_KV = WS_GVT + (size_t)512 * 256 * 64 * 2;
constexpr size_t WS_DEC = WS_KV + (size_t)512 * 256 * 128 * 2;
constexpr size_t WS_ST = WS_DEC + (size_t)512 * 128 * 4;
constexpr size_t WS_VT = WS_ST + (size_t)512 * 256 * 128 * 2;
constexpr size_t WS_US = WS_VT + (size_t)NBATCH * 8 * 128 * SEQ * 2;
constexpr size_t WS_END = WS_US + (size_t)MTOK * 1024 * 2;
constexpr int CW_BAR = 4096;
constexpr int CW_QUEUE = 16384;

constexpr int RING_BYTES = 135168;
constexpr int LDSCTL_OFF = RING_BYTES, MISC_OFF = LDSCTL_OFF + 320;
constexpr int TAB_OFF = RING_BYTES + 1024;
constexpr int LDS_BYTES = 147456;

#define GAS __attribute__((address_space(1)))
#define LAS __attribute__((address_space(3)))
typedef unsigned short bf16;
typedef unsigned v4u __attribute__((ext_vector_type(4)));
typedef unsigned v2u __attribute__((ext_vector_type(2)));
typedef float f32x4 __attribute__((ext_vector_type(4)));
typedef float f32x2 __attribute__((ext_vector_type(2)));
#define LDS_WAIT() asm volatile("s_waitcnt lgkmcnt(0)" ::: "memory")
#define VM_WAIT() asm volatile("s_waitcnt vmcnt(0)" ::: "memory")
__device__ __forceinline__ unsigned f2bf(float f) { unsigned u = __builtin_bit_cast(unsigned, f); return (u + 0x7fffu + ((u >> 16) & 1u)) >> 16; }
__device__ __forceinline__ unsigned pk2(float lo, float hi) { return f2bf(lo) | (f2bf(hi) << 16); }
__device__ __forceinline__ float bflo(unsigned u) { return __builtin_bit_cast(float, u << 16); }
__device__ __forceinline__ float bfhi(unsigned u) { return __builtin_bit_cast(float, u & 0xffff0000u); }
__device__ __forceinline__ float bf1(bf16 b) { return __builtin_bit_cast(float, ((unsigned)b) << 16); }
__device__ __forceinline__ float sigmoidf_(float x) { return __builtin_amdgcn_rcpf(1.0f + __expf(-x)); }
__device__ __forceinline__ float gelu_tanh(float x) { const float u = 0.7978845608028654f * (x + 0.044715f * x * x * x); return x * sigmoidf_(2.0f * u); }
__device__ __forceinline__ float wave_sum(float v) {
#pragma unroll
    for (int o = 1; o < 64; o <<= 1) v += __shfl_xor(v, o);
    return v;
}
__device__ __forceinline__ float wave_max(float v) {
#pragma unroll
    for (int o = 1; o < 64; o <<= 1) v = fmaxf(v, __shfl_xor(v, o));
    return v;
}

#define XB_TMO      128
#define XB_XCNT(j)  (256  + 64 * (j))
#define XB_XSUB(j)  (1280 + 64 * (j))
#define XB_XGEN(j)  (2304 + 64 * (j))
#define XB_TOP      3328
#define XB_TOPGEN   3392
#define XCD_BAR_WORDS 3456
#define XB_SPIN_CAP (1u << 18)
__device__ __forceinline__ unsigned xb_ld(unsigned* p)              { return __hip_atomic_load(p, __ATOMIC_RELAXED, __HIP_MEMORY_SCOPE_AGENT); }
__device__ __forceinline__ unsigned xb_add(unsigned* p, unsigned v) { return __hip_atomic_fetch_add(p, v, __ATOMIC_RELAXED, __HIP_MEMORY_SCOPE_AGENT); }
__device__ __forceinline__ unsigned xb_xcc_id() { return (unsigned)__builtin_amdgcn_s_getreg((3 << 11) | 20) & 0xFu; }
#define XB_SPIN(cond, bar) do { unsigned _sp = 0; while (cond) { __builtin_amdgcn_s_sleep(1); \
    if ((++_sp & 255u) == 0u) { if (xb_ld(&(bar)[XB_TMO])) break; if (_sp > XB_SPIN_CAP) { atomicAdd(&(bar)[XB_TMO], 1u); break; } } } } while (0)
struct XcdBarrier { unsigned* bar; unsigned x; volatile LAS unsigned* st; };
__device__ __forceinline__ XcdBarrier xcd_barrier_post(unsigned* bar, volatile LAS unsigned* st) {
    XcdBarrier b; b.bar = bar; b.x = xb_xcc_id(); b.st = st;
    if (threadIdx.x == 0) (void)xb_add(&bar[XB_XCNT(b.x)], 1u);
    return b;
}
__device__ __forceinline__ void xcd_barrier_complete(unsigned* bar, unsigned x, unsigned& nloc, unsigned& nx) {
    const unsigned G = gridDim.x * gridDim.y * gridDim.z;
    unsigned sum, cnt, mine, sp = 0u;
    for (;;) {
        sum = 0u; cnt = 0u; mine = 0u;
#pragma unroll
        for (unsigned j = 0; j < 16; ++j) { const unsigned c = xb_ld(&bar[XB_XCNT(j)]); sum += c; cnt += (c > 0u) ? 1u : 0u; mine = (j == x) ? c : mine; }
        if (sum == G) break;
        __builtin_amdgcn_s_sleep(1);
        if ((++sp & 255u) == 0u) { if (xb_ld(&bar[XB_TMO])) break; if (sp > XB_SPIN_CAP) { atomicAdd(&bar[XB_TMO], 1u); break; } }
    }
    nloc = mine > 0u ? mine : 1u; nx = cnt > 0u ? cnt : 1u;
}
__device__ __forceinline__ void xcd_barrier(const XcdBarrier& b, int tid) {
    asm volatile("s_waitcnt vmcnt(0)" ::: "memory");
    __syncthreads();
    if (tid == 0) {
        unsigned* bar = b.bar;
        __builtin_amdgcn_s_waitcnt(0);
        unsigned nloc = b.st[0], nx = b.st[1];
        if (nloc == 0u) { xcd_barrier_complete(bar, b.x, nloc, nx); b.st[0] = nloc; b.st[1] = nx; }
        const unsigned old = xb_add(&bar[XB_XSUB(b.x)], 1u);
        const unsigned gen = old / nloc;
        if (old + 1u == (gen + 1u) * nloc) {
            __builtin_amdgcn_fence(__ATOMIC_RELEASE, "agent");
            asm volatile("s_waitcnt vmcnt(0)" ::: "memory");
            const unsigned og = xb_add(&bar[XB_TOP], 1u);
            const unsigned tg = og / nx;
            if (og + 1u == (tg + 1u) * nx) xb_add(&bar[XB_TOPGEN], 1u);
            else XB_SPIN(xb_ld(&bar[XB_TOPGEN]) == tg, bar);
            __builtin_amdgcn_fence(__ATOMIC_ACQUIRE, "agent");
            xb_add(&bar[XB_XGEN(b.x)], 1u);
            asm volatile("s_waitcnt vmcnt(0)" ::: "memory");
        } else {
            XB_SPIN(xb_ld(&bar[XB_XGEN(b.x)]) == gen, bar);
            __builtin_amdgcn_fence(__ATOMIC_ACQUIRE, "agent");
            asm volatile("s_waitcnt vmcnt(0)" ::: "memory");
        }
    }
    __syncthreads();
}

struct Args {
    const float* in[26];
    float* out; unsigned char* ws;
    int l_lo, l_hi, ph_lo, ph_hi;
    int fused, pad;
};
enum { I_X = 0, I_N1G, I_WIN, I_LRE, I_LIM, I_LDT, I_BRE, I_BIM, I_CRE, I_CIM, I_SD, I_WGLU, I_BGLU, I_GW2, I_GB2, I_GNG, I_MQG, I_MKG, I_WBS, I_WBG, I_WBM, I_WOUT, I_N2G, I_FWG, I_FWU, I_FWD };

namespace pg8 {
#define EPI_FENCE() asm volatile("" ::: "memory")
__device__ __forceinline__ void load_rstd(const GAS float* ssq, int pm, int wr, int fr, int fq, float (&rs)[2][4]) {
    f32x2 p[2][4];
#pragma unroll
    for (int ai = 0; ai < 2; ++ai)
#pragma unroll
        for (int m = 0; m < 4; ++m) { const int row = pm * BM + ai * HALF + wr * 64 + m * 16 + fr; p[ai][m] = *(const GAS f32x2*)(ssq + (size_t)row * 8 + 2 * fq); }
#pragma unroll
    for (int ai = 0; ai < 2; ++ai)
#pragma unroll
        for (int m = 0; m < 4; ++m) { float s = p[ai][m][0] + p[ai][m][1]; s += __shfl_xor(s, 16); s += __shfl_xor(s, 32); rs[ai][m] = __builtin_amdgcn_rsqf(s * (1.0f / DM) + RMS_EPS); }
    EPI_FENCE();
}
struct EpiInProj {
    static constexpr bool CHAIN = false;
    GAS bf16_t* P; const GAS float* ssq; GAS bf16_t* US; GAS bf16_t* QN; GAS bf16_t* KN; GAS float* KM; const GAS float* qg; const GAS float* kg;
    __device__ __forceinline__ void operator()(const f32x4 (&acc)[2][2][4][2], const Unit& u, int wr, int wc, int fr, int fq, PG8_LAS unsigned char* lds) const {
        float rs[2][4]; load_rstd(ssq, u.pm, wr, fr, fq, rs);
        const int row0 = u.pm * BM + wr * 64 + fr, col0 = u.pn * BM + wc * 32 + 8 * fq;
        if (u.pn >= 16 && u.pn < 24) {
            const bool isk = u.pn >= 20;
            PG8_LAS float* T0 = (PG8_LAS float*)(lds + TAB_OFF); PG8_LAS float* CS = T0 + 2048;
#pragma unroll
            for (int ai = 0; ai < 2; ++ai)
#pragma unroll
                for (int m = 0; m < 4; ++m) { const float r = rs[ai][m];
#pragma unroll
                    for (int bj = 0; bj < 2; ++bj) { const f32x4 v0 = acc[ai][bj][m][0] * r, v1 = acc[ai][bj][m][1] * r;
                        float s = (v0[0] * v0[0] + v0[1] * v0[1]) + (v0[2] * v0[2] + v0[3] * v0[3]) + (v1[0] * v1[0] + v1[1] * v1[1]) + (v1[2] * v1[2] + v1[3] * v1[3]);
                        s += __shfl_xor(s, 16); s += __shfl_xor(s, 32);
                        if (fq == 0) T0[bj * 1024 + (ai * HALF + wr * 64 + m * 16 + fr) * 4 + wc] = s; } }
            asm volatile("s_waitcnt lgkmcnt(0)" ::: "memory"); __builtin_amdgcn_s_barrier(); asm volatile("" ::: "memory");
            const GAS float* gp = (isk ? kg : qg) + wc * 32 + 8 * fq; const f32x4 g0 = *(const GAS f32x4*)gp, g1 = *(const GAS f32x4*)(gp + 4);
            const float hs = isk ? 1.0f : 0.08838834764831845f * 1.4426950408889634f;
            GAS bf16_t* dst = (isk ? KN : QN) + (size_t)row0 * 1024 + (u.pn & 3) * 256 + wc * 32 + 8 * fq;
            float cs[2][8];
#pragma unroll
            for (int bj = 0; bj < 2; ++bj)
#pragma unroll
                for (int e = 0; e < 8; ++e) cs[bj][e] = 0.f;
#pragma unroll
            for (int ai = 0; ai < 2; ++ai)
#pragma unroll
                for (int m = 0; m < 4; ++m) { const float r = rs[ai][m];
#pragma unroll
                    for (int bj = 0; bj < 2; ++bj) { const f32x4 p4 = *(const PG8_LAS f32x4*)(T0 + bj * 1024 + (ai * HALF + wr * 64 + m * 16 + fr) * 4);
                        const float sc = r * hs * __builtin_amdgcn_rsqf(((p4[0] + p4[1]) + (p4[2] + p4[3])) * (1.0f / 128.0f) + RMS_EPS);
                        const f32x4 v0 = acc[ai][bj][m][0] * sc * g0, v1 = acc[ai][bj][m][1] * sc * g1;
                        u32x4 w; w.x = cvt_pk_bf16(v0[0], v0[1]); w.y = cvt_pk_bf16(v0[2], v0[3]); w.z = cvt_pk_bf16(v1[0], v1[1]); w.w = cvt_pk_bf16(v1[2], v1[3]);
                        *(GAS u32x4*)(dst + (size_t)(ai * HALF + m * 16) * 1024 + bj * HALF) = w;
                        if (isk) { cs[bj][0] += bflo(w.x); cs[bj][1] += bfhi(w.x); cs[bj][2] += bflo(w.y); cs[bj][3] += bfhi(w.y); cs[bj][4] += bflo(w.z); cs[bj][5] += bfhi(w.z); cs[bj][6] += bflo(w.w); cs[bj][7] += bfhi(w.w); } } }
            if (isk) {
#pragma unroll
                for (int bj = 0; bj < 2; ++bj)
#pragma unroll
                    for (int e = 0; e < 8; ++e) { float c = cs[bj][e]; c += __shfl_xor(c, 1); c += __shfl_xor(c, 2); c += __shfl_xor(c, 4); c += __shfl_xor(c, 8); cs[bj][e] = c; }
                if (fr == 0) {
#pragma unroll
                    for (int bj = 0; bj < 2; ++bj) { PG8_LAS float* cp = CS + wr * 256 + bj * HALF + wc * 32 + 8 * fq;
                        *(PG8_LAS f32x4*)cp = (f32x4){cs[bj][0], cs[bj][1], cs[bj][2], cs[bj][3]}; *(PG8_LAS f32x4*)(cp + 4) = (f32x4){cs[bj][4], cs[bj][5], cs[bj][6], cs[bj][7]}; } }
                asm volatile("s_waitcnt lgkmcnt(0)" ::: "memory"); __builtin_amdgcn_s_barrier(); asm volatile("" ::: "memory");
                const int t = (wr * 4 + wc) * 64 + fq * 16 + fr;
                if (t < 256) { const int hd = 2 * (u.pn & 3) + (t >> 7);
                    KM[((size_t)((u.pm >> 3) * 8 + hd) * 8 + (u.pm & 7)) * 128 + (t & 127)] = (CS[t] + CS[256 + t]) * (1.0f / 256.0f); }
            }
            return;
        }
        const bool ssm = u.pn < 4;
#pragma unroll
        for (int ai = 0; ai < 2; ++ai)
#pragma unroll
            for (int m = 0; m < 4; ++m) { const int row = row0 + ai * HALF + m * 16; GAS bf16_t* rowp = P + (size_t)row * NP + col0; const float r = rs[ai][m];
#pragma unroll
                for (int bj = 0; bj < 2; ++bj) { const f32x4 v0 = acc[ai][bj][m][0] * r, v1 = acc[ai][bj][m][1] * r;
                    u32x4 w; w.x = cvt_pk_bf16(v0[0], v0[1]); w.y = cvt_pk_bf16(v0[2], v0[3]); w.z = cvt_pk_bf16(v1[0], v1[1]); w.w = cvt_pk_bf16(v1[2], v1[3]);
                    if (ssm) { const int col = col0 + bj * HALF; *(GAS u32x4*)(US + ((size_t)((row >> 11) * 64 + (col >> 4)) * SEQ + (row & (SEQ - 1))) * 16 + (col & 8)) = w; }
                    else *(GAS u32x4*)(rowp + bj * HALF) = w; } }
    }
};
struct EpiGLU {
    static constexpr bool CHAIN = false;
    const GAS bf16_t* Z; GAS bf16_t* Y; const GAS float* bias;
    __device__ __forceinline__ void operator()(const f32x4 (&acc)[2][2][4][2], const Unit& u, int wr, int wc, int fr, int fq, PG8_LAS unsigned char*) const {
        const int row0 = u.pm * BM + wr * 64 + fr, col0 = u.pn * BM + wc * 32 + 8 * fq;
        f32x4 bv[2][2];
#pragma unroll
        for (int bj = 0; bj < 2; ++bj)
#pragma unroll
            for (int n = 0; n < 2; ++n) bv[bj][n] = *(const GAS f32x4*)(bias + col0 + bj * HALF + 4 * n);
        u32x4 zb[4][2];
#pragma unroll
        for (int bt = 0; bt < 2; ++bt) {
#pragma unroll
            for (int i4 = 0; i4 < 4; ++i4) { const int idx = 4 * bt + i4; const size_t row = (size_t)(row0 + (idx >> 2) * HALF + (idx & 3) * 16);
#pragma unroll
                for (int bj = 0; bj < 2; ++bj) zb[i4][bj] = *(const GAS u32x4*)(Z + row * 1024 + col0 + bj * HALF); }
#pragma unroll
            for (int i4 = 0; i4 < 4; ++i4) { const int idx = 4 * bt + i4, ai = idx >> 2, m = idx & 3; const size_t row = (size_t)(row0 + ai * HALF + m * 16);
#pragma unroll
                for (int bj = 0; bj < 2; ++bj) { const u32x4 zz = zb[i4][bj];
                    const f32x4 g0 = acc[ai][bj][m][0] + bv[bj][0], g1 = acc[ai][bj][m][1] + bv[bj][1];
                    u32x4 w;
                    w.x = cvt_pk_bf16(bflo(zz.x) * sigmoidf_(g0[0]), bfhi(zz.x) * sigmoidf_(g0[1])); w.y = cvt_pk_bf16(bflo(zz.y) * sigmoidf_(g0[2]), bfhi(zz.y) * sigmoidf_(g0[3]));
                    w.z = cvt_pk_bf16(bflo(zz.z) * sigmoidf_(g1[0]), bfhi(zz.z) * sigmoidf_(g1[1])); w.w = cvt_pk_bf16(bflo(zz.w) * sigmoidf_(g1[2]), bfhi(zz.w) * sigmoidf_(g1[3]));
                    *(GAS u32x4*)(Y + row * YW + col0 + bj * HALF) = w; } }
            EPI_FENCE();
        }
    }
};
struct EpiBranch {
    static constexpr bool CHAIN = true;
    const GAS bf16_t* P; GAS bf16_t* MB;
    __device__ __forceinline__ void operator()(f32x4 (&acc)[2][2][4][2], const Unit& u, int wr, int wc, int fr, int fq, PG8_LAS unsigned char*) const {
        const int row0 = u.pm * BM + wr * 64 + fr, col0 = u.pn * BM + wc * 32 + 8 * fq;
        const int br = u.br;
        u32x4 ga[2][2], gb[2][2];
#pragma unroll
        for (int bt = 0; bt < 4; ++bt) {
#pragma unroll
            for (int i4 = 0; i4 < 2; ++i4) { const int idx = 2 * bt + i4; const size_t row = (size_t)(row0 + (idx >> 2) * HALF + (idx & 3) * 16);
#pragma unroll
                for (int bj = 0; bj < 2; ++bj) { const GAS bf16_t* gp = P + row * NP + PC_GS + br * DM + col0 + bj * HALF; ga[i4][bj] = *(const GAS u32x4*)gp; if (br != 2) gb[i4][bj] = *(const GAS u32x4*)(gp + DM); } }
#pragma unroll
            for (int i4 = 0; i4 < 2; ++i4) { const int idx = 2 * bt + i4, ai = idx >> 2, m = idx & 3; const size_t row = (size_t)(row0 + ai * HALF + m * 16);
#pragma unroll
                for (int bj = 0; bj < 2; ++bj) { const u32x4 g0 = ga[i4][bj]; const unsigned g0w[4] = {g0.x, g0.y, g0.z, g0.w}; float f[8];
                    if (br != 2) { const u32x4 g1 = gb[i4][bj]; const unsigned g1w[4] = {g1.x, g1.y, g1.z, g1.w};
#pragma unroll
                        for (int e = 0; e < 4; ++e) {
                            const float a0 = __builtin_amdgcn_fmed3f(bflo(g0w[e]), -30.f, 30.f), a1 = __builtin_amdgcn_fmed3f(bfhi(g0w[e]), -30.f, 30.f), b0 = __builtin_amdgcn_fmed3f(bflo(g1w[e]), -30.f, 30.f), b1 = __builtin_amdgcn_fmed3f(bfhi(g1w[e]), -30.f, 30.f);
                            f[2 * e] = (1.0f + __expf(-b0)) * __builtin_amdgcn_rcpf(1.0f + __expf(-a0)); f[2 * e + 1] = (1.0f + __expf(-b1)) * __builtin_amdgcn_rcpf(1.0f + __expf(-a1)); } }
                    else {
#pragma unroll
                        for (int e = 0; e < 4; ++e) { f[2 * e] = sigmoidf_(__builtin_amdgcn_fmed3f(bflo(g0w[e]), -30.f, 30.f)); f[2 * e + 1] = sigmoidf_(__builtin_amdgcn_fmed3f(bfhi(g0w[e]), -30.f, 30.f)); } }
                    f32x4 v0 = acc[ai][bj][m][0], v1 = acc[ai][bj][m][1];
                    v0[0] *= f[0]; v0[1] *= f[1]; v0[2] *= f[2]; v0[3] *= f[3]; v1[0] *= f[4]; v1[1] *= f[5]; v1[2] *= f[6]; v1[3] *= f[7];
                    if (br != 2) { acc[ai][bj][m][0] = v0; acc[ai][bj][m][1] = v1; }
                    else { u32x4 w; w.x = cvt_pk_bf16(v0[0], v0[1]); w.y = cvt_pk_bf16(v0[2], v0[3]); w.z = cvt_pk_bf16(v1[0], v1[1]); w.w = cvt_pk_bf16(v1[2], v1[3]); *(GAS u32x4*)(MB + row * DM + col0 + bj * HALF) = w; } } }
            EPI_FENCE();
        }
    }
};
template <bool FIRST, bool LAST> struct EpiResid {
    static constexpr bool CHAIN = false;
    const GAS float* xin; GAS float* xout; GAS bf16_t* XB; GAS float* ssq;
    __device__ __forceinline__ void operator()(const f32x4 (&acc)[2][2][4][2], const Unit& u, int wr, int wc, int fr, int fq, PG8_LAS unsigned char* lds) const {
        const int row0 = u.pm * BM + wr * 64 + fr, col0 = u.pn * BM + wc * 32 + 8 * fq;
        PG8_LAS float* T = (PG8_LAS float*)(lds + TAB_OFF);
        f32x4 xf[FIRST ? 4 : 1][2][2]; u32x4 xh[FIRST ? 1 : 8][2];
#pragma unroll
        for (int bt = 0; bt < (FIRST ? 2 : 1); ++bt) {
#pragma unroll
            for (int i4 = 0; i4 < (FIRST ? 4 : 8); ++i4) { const int idx = (FIRST ? 4 * bt : 0) + i4; const size_t row = (size_t)(row0 + (idx >> 2) * HALF + (idx & 3) * 16);
#pragma unroll
                for (int bj = 0; bj < 2; ++bj) { const size_t o = row * DM + col0 + bj * HALF;
                    if (FIRST) { xf[i4 & 3][bj][0] = *(const GAS f32x4*)(xin + o); xf[i4 & 3][bj][1] = *(const GAS f32x4*)(xin + o + 4); } else xh[FIRST ? 0 : i4][bj] = *(const GAS u32x4*)(XB + o); } }
#pragma unroll
            for (int i4 = 0; i4 < (FIRST ? 4 : 8); ++i4) { const int idx = (FIRST ? 4 * bt : 0) + i4, ai = idx >> 2, m = idx & 3; const size_t row = (size_t)(row0 + ai * HALF + m * 16); float s = 0.f;
#pragma unroll
                for (int bj = 0; bj < 2; ++bj) { const size_t o = row * DM + col0 + bj * HALF; f32x4 v0, v1;
                    if (FIRST) { v0 = acc[ai][bj][m][0] + xf[i4 & 3][bj][0]; v1 = acc[ai][bj][m][1] + xf[i4 & 3][bj][1]; }
                    else { const u32x4 h = xh[FIRST ? 0 : i4][bj]; v0 = acc[ai][bj][m][0] + (f32x4){bflo(h.x), bfhi(h.x), bflo(h.y), bfhi(h.y)}; v1 = acc[ai][bj][m][1] + (f32x4){bflo(h.z), bfhi(h.z), bflo(h.w), bfhi(h.w)}; }
                    if (LAST) { *(GAS f32x4*)(xout + o) = v0; *(GAS f32x4*)(xout + o + 4) = v1; }
                    else { u32x4 w; w.x = cvt_pk_bf16(v0[0], v0[1]); w.y = cvt_pk_bf16(v0[2], v0[3]); w.z = cvt_pk_bf16(v1[0], v1[1]); w.w = cvt_pk_bf16(v1[2], v1[3]); *(GAS u32x4*)(XB + o) = w;
                        v0 = (f32x4){bflo(w.x), bfhi(w.x), bflo(w.y), bfhi(w.y)}; v1 = (f32x4){bflo(w.z), bfhi(w.z), bflo(w.w), bfhi(w.w)}; }
                    s += (v0[0] * v0[0] + v0[1] * v0[1]) + (v0[2] * v0[2] + v0[3] * v0[3]) + (v1[0] * v1[0] + v1[1] * v1[1]) + (v1[2] * v1[2] + v1[3] * v1[3]); }
                if (!LAST) { s += __shfl_xor(s, 16); s += __shfl_xor(s, 32);
                    if (fq == 0) T[(ai * HALF + wr * 64 + m * 16 + fr) * 4 + wc] = s; } }
            EPI_FENCE();
        }
        if (!LAST) {
            asm volatile("s_waitcnt lgkmcnt(0)" ::: "memory"); __builtin_amdgcn_s_barrier(); asm volatile("" ::: "memory");
            const int t = (wr * 4 + wc) * 64 + fq * 16 + fr;
            if (t < 256) { const f32x4 p = *(const PG8_LAS f32x4*)(T + t * 4); ssq[(size_t)(u.pm * BM + t) * 8 + u.pn] = (p[0] + p[1]) + (p[2] + p[3]); }
        }
    }
};
struct EpiFFNUp {
    static constexpr bool CHAIN = false;
    GAS bf16_t* H; const GAS float* ssq;
    __device__ __forceinline__ void operator()(const f32x4 (&acc)[2][2][4][2], const Unit& u, int wr, int wc, int fr, int fq, PG8_LAS unsigned char*) const {
        float rs[2][4]; load_rstd(ssq, u.pm, wr, fr, fq, rs);
        const int row0 = u.pm * BM + wr * 64 + fr, col0 = u.pn * HALF + wc * 32 + 8 * fq;
#pragma unroll
        for (int ai = 0; ai < 2; ++ai)
#pragma unroll
            for (int m = 0; m < 4; ++m) { const float r = rs[ai][m]; float h[8];
#pragma unroll
                for (int n = 0; n < 2; ++n)
#pragma unroll
                    for (int e = 0; e < 4; ++e) { const float gv = acc[ai][0][m][n][e] * r, uv = acc[ai][1][m][n][e] * r; h[n * 4 + e] = gv * sigmoidf_(gv) * uv; }
                u32x4 w; w.x = cvt_pk_bf16(h[0], h[1]); w.y = cvt_pk_bf16(h[2], h[3]); w.z = cvt_pk_bf16(h[4], h[5]); w.w = cvt_pk_bf16(h[6], h[7]);
                *(GAS u32x4*)(H + (size_t)(row0 + ai * HALF + m * 16) * FFN + col0) = w; }
    }
};
}

struct Frame {
    __device__ __forceinline__ void refresh() { ws = (GAS unsigned char*)opaque_ptr(ws0); tid = opaque_tid(wv); lane = tid & 63; wave = __builtin_amdgcn_readfirstlane(tid >> 6); }
    LAS unsigned char* lds;
    volatile LAS unsigned* MISC;
    unsigned* ctl;
    int tid, lane, wave, G, wv;
    const float* const* in;
    GAS unsigned char* ws; unsigned char* ws0;
};

struct ConvDesc { const GAS float* W; const GAS float* gk; GAS bf16* WT; int ldw, k0, src_c0, nvalid, ldt, dst_r0, dst_k; };
struct ConvRegs { f32x4 v[16]; f32x4 g0, g1; };
__device__ __forceinline__ void conv_load(const ConvDesc& d, ConvRegs& R, int lane) {
    const int c4 = 4 * (lane & 15), rq = lane >> 4, c8 = lane & 7;
#pragma unroll
    for (int i = 0; i < 16; ++i) { const int kk = 4 * i + rq; R.v[i] = (c4 < d.nvalid) ? __builtin_nontemporal_load((const GAS f32x4*)(d.W + (size_t)(d.k0 + kk) * d.ldw + d.src_c0 + c4)) : (f32x4){0.f, 0.f, 0.f, 0.f}; }
    if (d.gk) { R.g0 = *(const GAS f32x4*)(d.gk + d.k0 + 8 * c8); R.g1 = *(const GAS f32x4*)(d.gk + d.k0 + 8 * c8 + 4); }
}
__device__ __forceinline__ void conv_finish(const ConvDesc& d, const ConvRegs& R, LAS float* scr, int lane) {
    const int c4 = 4 * (lane & 15), rq = lane >> 4, c8 = lane & 7;
#pragma unroll
    for (int i = 0; i < 16; ++i) { LAS float* p = scr + (4 * i + rq) * 65 + c4; p[0] = R.v[i][0]; p[1] = R.v[i][1]; p[2] = R.v[i][2]; p[3] = R.v[i][3]; }
    LDS_WAIT(); asm volatile("" ::: "memory");
#pragma unroll
    for (int j = 0; j < 8; ++j) { const int n = (lane >> 3) + 8 * j; const LAS float* sp = scr + (8 * c8) * 65 + n;
        v4u o;
        if (d.gk) { o.x = pk2(sp[0 * 65] * R.g0[0], sp[1 * 65] * R.g0[1]); o.y = pk2(sp[2 * 65] * R.g0[2], sp[3 * 65] * R.g0[3]); o.z = pk2(sp[4 * 65] * R.g1[0], sp[5 * 65] * R.g1[1]); o.w = pk2(sp[6 * 65] * R.g1[2], sp[7 * 65] * R.g1[3]); }
        else { o.x = pk2(sp[0 * 65], sp[1 * 65]); o.y = pk2(sp[2 * 65], sp[3 * 65]); o.z = pk2(sp[4 * 65], sp[5 * 65]); o.w = pk2(sp[6 * 65], sp[7 * 65]); }
        *(GAS v4u*)(d.WT + (size_t)(d.dst_r0 + n) * d.ldt + d.dst_k + 8 * c8) = o; }
    LDS_WAIT(); asm volatile("" ::: "memory");
}
constexpr int CV_NB_IN = NP / 64, CV_NB_FF = FFN / 64;
constexpr int CV_I_IN = 32 * CV_NB_IN, CV_I_GLU = 16 * 16, CV_I_BR = 3 * 16 * 32, CV_I_OUT = 32 * 32, CV_I_GU = 2 * 32 * CV_NB_FF, CV_I_DN = CV_NB_FF * 32;
constexpr int CV_I_LAYER = CV_I_IN + CV_I_GLU + CV_I_BR + CV_I_OUT + CV_I_GU + CV_I_DN;
#ifndef CVQ1
#define CVQ1 6
#endif
#ifndef CVQ7
#define CVQ7 7
#endif
constexpr int CV_Q1 = CVQ1, CV_Q7 = CVQ7;
__device__ __forceinline__ ConvDesc conv_layer_desc(Frame& F, int l, int r) {
    GAS unsigned char* wl = F.ws + WS_W + (size_t)l * SZ_WLAYER; ConvDesc d;
    if (r < CV_I_IN) { const int nb = r % CV_NB_IN, kb = r / CV_NB_IN, n0 = 64 * nb; int src, nv;
        if (n0 < 4096) { src = n0; nv = 64; } else if (n0 < PC_GLR) { src = n0 + 16; nv = 64; } else if (n0 == PC_GLR) { src = 4096; nv = 16; } else { src = 0; nv = 0; }
        d.W = ((const GAS float*)F.in[I_WIN]) + (size_t)l * DM * INW; d.ldw = INW; d.k0 = 64 * kb; d.src_c0 = src; d.nvalid = nv; d.gk = ((const GAS float*)F.in[I_N1G]) + l * DM; d.WT = (GAS bf16*)(wl + OFF_WIN); d.ldt = DM; d.dst_r0 = n0; d.dst_k = 64 * kb; return d; } r -= CV_I_IN;
    if (r < CV_I_GLU) { const int nb = r % 16, kb = r / 16;
        d.W = ((const GAS float*)F.in[I_WGLU]) + (size_t)l * 1024 * 1024; d.ldw = 1024; d.k0 = 64 * kb; d.src_c0 = 64 * nb; d.nvalid = 64; d.gk = nullptr; d.WT = (GAS bf16*)(wl + OFF_WGLU); d.ldt = 1024; d.dst_r0 = 64 * nb; d.dst_k = 64 * kb; return d; } r -= CV_I_GLU;
    if (r < CV_I_BR) { const int br = r / (16 * 32), rr = r % (16 * 32), nb = rr % 32, kb = rr / 32;
        d.W = ((const GAS float*)F.in[I_WBS + br]) + (size_t)l * 1024 * DM; d.ldw = DM; d.k0 = 64 * kb; d.src_c0 = 64 * nb; d.nvalid = 64; d.gk = nullptr; d.WT = (GAS bf16*)(wl + OFF_WBR); d.ldt = 3072; d.dst_r0 = 64 * nb; d.dst_k = br * 1024 + 64 * kb; return d; } r -= CV_I_BR;
    if (r < CV_I_OUT) { const int nb = r % 32, kb = r / 32;
        d.W = ((const GAS float*)F.in[I_WOUT]) + (size_t)l * DM * DM; d.ldw = DM; d.k0 = 64 * kb; d.src_c0 = 64 * nb; d.nvalid = 64; d.gk = nullptr; d.WT = (GAS bf16*)(wl + OFF_WOUT); d.ldt = DM; d.dst_r0 = 64 * nb; d.dst_k = 64 * kb; return d; } r -= CV_I_OUT;
    if (r < CV_I_GU) { const int sel = r / (32 * CV_NB_FF), rr = r % (32 * CV_NB_FF), nb = rr % CV_NB_FF, kb = rr / CV_NB_FF, j0 = 64 * nb;
        d.W = ((const GAS float*)F.in[I_FWG + sel]) + (size_t)l * DM * FFN; d.ldw = FFN; d.k0 = 64 * kb; d.src_c0 = j0; d.nvalid = 64; d.gk = ((const GAS float*)F.in[I_N2G]) + l * DM; d.WT = (GAS bf16*)(wl + OFF_WGU); d.ldt = DM; d.dst_r0 = (j0 / 128) * 256 + sel * 128 + (j0 % 128); d.dst_k = 64 * kb; return d; } r -= CV_I_GU;
    { const int nb = r % 32, kb = r / 32;
        d.W = ((const GAS float*)F.in[I_FWD]) + (size_t)l * FFN * DM; d.ldw = DM; d.k0 = 64 * kb; d.src_c0 = 64 * nb; d.nvalid = 64; d.gk = nullptr; d.WT = (GAS bf16*)(wl + OFF_WDN); d.ldt = FFN; d.dst_r0 = 64 * nb; d.dst_k = 64 * kb; return d; }
}
template <class Dec> __device__ __forceinline__ void conv_stream(int first, int limit, int stride, LAS float* scr, int lane, const Dec& dec) {
    int it = first; if (it >= limit) return;
    ConvDesc dA, dB; ConvRegs rA, rB;
    dA = dec(it); conv_load(dA, rA, lane);
    for (;;) {
        it += stride; const bool hb = it < limit;
        if (hb) { dB = dec(it); conv_load(dB, rB, lane); }
        conv_finish(dA, rA, scr, lane);
        if (!hb) break;
        it += stride; const bool ha = it < limit;
        if (ha) { dA = dec(it); conv_load(dA, rA, lane); }
        conv_finish(dB, rB, scr, lane);
        if (!ha) break;
    }
}
__device__ __forceinline__ int cv_ntail(int nwg, int G) { const int nr = (nwg + G - 1) / G; return nr * G - nwg; }
__device__ __forceinline__ void cv_slot(int G, int s, int& lo, int& hi) {
    const int cap1 = cv_ntail((MTOK / 256) * (NP / 256), G) * NWAVES * CV_Q1, cap7 = cv_ntail((MTOK / 256) * (NGU / 256), G) * NWAVES * CV_Q7;
    int Bn = DEPTH * CV_I_LAYER, B = Bn;
    for (int t = 2 * DEPTH; t >= 1; --t) { const int l = (t - 1) >> 1, odd = t & 1, D = l * CV_I_LAYER + (odd ? CV_I_IN : CV_I_LAYER - CV_I_DN), cap = odd ? cap1 : cap7;
        Bn = B; B = (Bn - cap > D) ? Bn - cap : D; if (t == s) { lo = B; hi = Bn; return; } if (t == 1 && s == 0) { lo = 0; hi = B; return; } }
    lo = 0; hi = 0;
}
__device__ __forceinline__ void cv_tail(Frame& F, int l, int which) {
    const int nwg = (MTOK / 256) * ((which ? NGU : NP) / 256), ntail = cv_ntail(nwg, F.G), first = F.G - ntail;
    if ((int)blockIdx.x < first) return;
    int lo, hi; cv_slot(F.G, 2 * l + 1 + which, lo, hi);
    LAS float* scr = (LAS float*)(F.lds + F.wave * 16896);
    conv_stream(lo + ((int)blockIdx.x - first) * NWAVES + F.wave, hi, ntail * NWAVES, scr, F.lane, [&](int g) { const int ll = g / CV_I_LAYER; return conv_layer_desc(F, ll, g - ll * CV_I_LAYER); });
}
__device__ __forceinline__ void s5_tables_unit(Frame& F, int lg);
__device__ __forceinline__ void p0_prologue(Frame& F) {
    int npass = 2, tf = (((int)blockIdx.x >> 3) & 1); asm volatile("" : "+s"(npass), "+s"(tf));
#pragma unroll 1
    for (int pass = 0; pass < npass; ++pass) {
        if (pass == tf) { F.refresh(); __syncthreads(); for (int lg = blockIdx.x; lg < DEPTH * 64; lg += F.G) s5_tables_unit(F, lg); }
        if (pass == 0) { F.refresh(); int lo0, hi0; cv_slot(F.G, 0, lo0, hi0);
            conv_stream((int)blockIdx.x * NWAVES + F.wave, hi0, F.G * NWAVES, (LAS float*)(F.lds + F.wave * 16896), F.lane, [&](int g) { const int ll = g / CV_I_LAYER; return conv_layer_desc(F, ll, g - ll * CV_I_LAYER); }); }
    }
    F.refresh();
    const int gw = blockIdx.x * NWAVES + F.wave, NGW = F.G * NWAVES, lane = F.lane;
    const GAS float* x = ((const GAS float*)F.in[I_X]); GAS bf16* XB = (GAS bf16*)(F.ws + WS_XB); GAS float* ssq = (GAS float*)(F.ws + WS_SSQ);
    for (int m = gw; m < MTOK; m += NGW) {
        const GAS f32x4* xr = (const GAS f32x4*)(x + (size_t)m * DM) + lane; float s = 0.f;
        GAS v2u* o8 = (GAS v2u*)(XB + (size_t)m * DM) + lane;
#pragma unroll
        for (int j = 0; j < 8; ++j) { const f32x4 v = xr[64 * j]; s += (v[0] * v[0] + v[1] * v[1]) + (v[2] * v[2] + v[3] * v[3]); v2u w; w.x = pk2(v[0], v[1]); w.y = pk2(v[2], v[3]); o8[64 * j] = w; }
        s = wave_sum(s);
        if (lane < 8) ssq[(size_t)m * 8 + lane] = (lane == 0) ? s : 0.f;
    }
}

typedef short bf16x8_t __attribute__((ext_vector_type(8)));
__device__ __forceinline__ f32x4 mma16(bf16x8_t a, bf16x8_t b, f32x4 c) { return __builtin_amdgcn_mfma_f32_16x16x32_bf16(a, b, c, 0, 0, 0); }
constexpr int S5_USTR = 2064;
constexpr int S5_XSTR = 272;
__device__ __forceinline__ void s5_tables_unit(Frame& F, int lg) {
    LAS float* APr = (LAS float*)F.lds; LAS float* APi = APr + 65 * 64; LAS float* BBr = APi + 65 * 64; LAS float* BBi = BBr + 1024; LAS float* CCr = BBi + 1024; LAS float* CCi = CCr + 1024;
    const int tid = F.tid;
    const GAS float* lre_ = ((const GAS float*)F.in[I_LRE]) + lg * 64; const GAS float* lim_ = ((const GAS float*)F.in[I_LIM]) + lg * 64; const double dt = exp((double)((const GAS float*)F.in[I_LDT])[lg]);
    for (int idx = tid; idx < 65 * 64; idx += 512) { const int t = idx >> 6, p = idx & 63;
        const double lr = (double)lre_[p], li = (double)lim_[p]; const double mag = exp(lr * dt * (double)t); double ang = li * dt * (double)t;
        ang -= 6.283185307179586476925 * rint(ang * 0.15915494309189533577);
        APr[idx] = (float)(mag * (double)cosf((float)ang)); APi[idx] = (float)(mag * (double)sinf((float)ang)); }
    for (int idx = tid; idx < 1024; idx += 512) { const int p = idx >> 4, c = idx & 15;
        const double lr = (double)lre_[p], li = (double)lim_[p]; const double mag = exp(lr * dt); double ang = li * dt; ang -= 6.283185307179586476925 * rint(ang * 0.15915494309189533577);
        const double ar = mag * (double)cosf((float)ang), ai = mag * (double)sinf((float)ang), den = lr * lr + li * li, nr = ar - 1.0, ni = ai;
        const double zr = (nr * lr + ni * li) / den, zi = (ni * lr - nr * li) / den;
        const double br = (double)((const GAS float*)F.in[I_BRE])[(size_t)(lg * 64 + p) * 16 + c], bi = (double)((const GAS float*)F.in[I_BIM])[(size_t)(lg * 64 + p) * 16 + c];
        BBr[idx] = (float)(zr * br - zi * bi); BBi[idx] = (float)(zr * bi + zi * br);
        CCr[idx] = ((const GAS float*)F.in[I_CRE])[(size_t)lg * 1024 + idx]; CCi[idx] = ((const GAS float*)F.in[I_CIM])[(size_t)lg * 1024 + idx]; }
    LDS_WAIT(); __syncthreads();
    { const int t = tid >> 3, co0 = 2 * (tid & 7); float acc0[16], acc1[16];
#pragma unroll
      for (int i = 0; i < 16; ++i) { acc0[i] = 0.f; acc1[i] = 0.f; }
      for (int p = 0; p < 64; ++p) { const float ar = APr[t * 64 + p], ai = APi[t * 64 + p];
          const float c0r = CCr[co0 * 64 + p], c0i = CCi[co0 * 64 + p], c1r = CCr[(co0 + 1) * 64 + p], c1i = CCi[(co0 + 1) * 64 + p];
          const float w0r = c0r * ar - c0i * ai, w0i = c0r * ai + c0i * ar, w1r = c1r * ar - c1i * ai, w1i = c1r * ai + c1i * ar;
#pragma unroll
          for (int ci = 0; ci < 16; ++ci) { const float br = BBr[p * 16 + ci], bi = BBi[p * 16 + ci]; acc0[ci] += w0r * br - w0i * bi; acc1[ci] += w1r * br - w1i * bi; } }
      GAS bf16* TK = (GAS bf16*)(F.ws + WS_TK) + (size_t)lg * 64 * 256 + (size_t)(t * 16 + co0) * 16;
      v4u o0, o1, o2, o3; o0.x = pk2(acc0[0], acc0[1]); o0.y = pk2(acc0[2], acc0[3]); o0.z = pk2(acc0[4], acc0[5]); o0.w = pk2(acc0[6], acc0[7]);
      o1.x = pk2(acc0[8], acc0[9]); o1.y = pk2(acc0[10], acc0[11]); o1.z = pk2(acc0[12], acc0[13]); o1.w = pk2(acc0[14], acc0[15]);
      o2.x = pk2(acc1[0], acc1[1]); o2.y = pk2(acc1[2], acc1[3]); o2.z = pk2(acc1[4], acc1[5]); o2.w = pk2(acc1[6], acc1[7]);
      o3.x = pk2(acc1[8], acc1[9]); o3.y = pk2(acc1[10], acc1[11]); o3.z = pk2(acc1[12], acc1[13]); o3.w = pk2(acc1[14], acc1[15]);
      *(GAS v4u*)(TK) = o0; *(GAS v4u*)(TK + 8) = o1; *(GAS v4u*)(TK + 16) = o2; *(GAS v4u*)(TK + 24) = o3; }
    { GAS bf16* TW = (GAS bf16*)(F.ws + WS_TW) + (size_t)lg * 128 * 1024;
      for (int ch = tid; ch < 16384; ch += 512) { const int col = ch >> 7, kc = ch & 127, ri = col >> 6, p = col & 63, j = kc >> 1, c0 = 8 * (kc & 1);
          const float ar = APr[(63 - j) * 64 + p], ai = APi[(63 - j) * 64 + p]; float v[8];
#pragma unroll
          for (int e = 0; e < 8; ++e) { const float br = BBr[p * 16 + c0 + e], bi = BBi[p * 16 + c0 + e]; v[e] = ri ? (ar * bi + ai * br) : (ar * br - ai * bi); }
          v4u o; o.x = pk2(v[0], v[1]); o.y = pk2(v[2], v[3]); o.z = pk2(v[4], v[5]); o.w = pk2(v[6], v[7]);
          *(GAS v4u*)(TW + (size_t)col * 1024 + kc * 8) = o; } }
    { GAS bf16* TC = (GAS bf16*)(F.ws + WS_TC) + (size_t)lg * 1024 * 128;
      for (int ch = tid; ch < 16384; ch += 512) { const int row = ch >> 4, kc = ch & 15, i = row >> 4, co = row & 15, ri = kc >> 3, p0 = 8 * (kc & 7); float v[8];
#pragma unroll
          for (int e = 0; e < 8; ++e) { const int p = p0 + e; const float ar = APr[(i + 1) * 64 + p], ai = APi[(i + 1) * 64 + p], cr = CCr[co * 64 + p], ci = CCi[co * 64 + p];
              v[e] = ri ? -(cr * ai + ci * ar) : (cr * ar - ci * ai); }
          v4u o; o.x = pk2(v[0], v[1]); o.y = pk2(v[2], v[3]); o.z = pk2(v[4], v[5]); o.w = pk2(v[6], v[7]);
          *(GAS v4u*)(TC + (size_t)row * 128 + kc * 8) = o; } }
    if (tid < 128) ((GAS float*)(F.ws + WS_A64))[(size_t)lg * 128 + tid] = (tid < 64) ? APr[64 * 64 + tid] : APi[64 * 64 + tid - 64];
    LDS_WAIT(); __syncthreads();
}
__device__ __forceinline__ void s5_stage_u(Frame& F, int g, int b, LAS unsigned char* U) {
    const GAS v4u* src = (const GAS v4u*)((const GAS bf16*)(F.ws + WS_US) + (size_t)(b * 64 + g) * SEQ * 16);
#pragma unroll
    for (int it = 0; it < 8; ++it) { const int ch = F.tid + 512 * it, t = ch >> 1, hf = ch & 1, n = t >> 6, j = t & 63;
        *(LAS v4u*)(U + n * S5_USTR + (j * 16 + 8 * hf) * 2) = src[ch]; }
}
__device__ __forceinline__ void s5_s1_unit(Frame& F, int l, int unit) {
    const int g = unit & 63, b = unit >> 6, lg = l * 64 + g, lane = F.lane, w = F.wave, fr = lane & 15, fq = lane >> 4;
    LAS unsigned char* U = F.lds;
    s5_stage_u(F, g, b, U);
    LDS_WAIT(); __syncthreads();
    const GAS bf16* TW = (const GAS bf16*)(F.ws + WS_TW) + (size_t)lg * 128 * 1024 + (size_t)(16 * w + fr) * 1024 + 8 * fq;
    f32x4 acc[2] = {(f32x4){0.f, 0.f, 0.f, 0.f}, (f32x4){0.f, 0.f, 0.f, 0.f}};
#pragma unroll 16
    for (int ks = 0; ks < 32; ++ks) {
        const bf16x8_t bfr = *(const GAS bf16x8_t*)(TW + 32 * ks);
        const bf16x8_t a0 = *(const LAS bf16x8_t*)(U + fr * S5_USTR + (32 * ks + 8 * fq) * 2), a1 = *(const LAS bf16x8_t*)(U + (16 + fr) * S5_USTR + (32 * ks + 8 * fq) * 2);
        acc[0] = mma16(a0, bfr, acc[0]); acc[1] = mma16(a1, bfr, acc[1]); }
    GAS float* SL = (GAS float*)(F.ws + WS_SL);
#pragma unroll
    for (int mt = 0; mt < 2; ++mt)
#pragma unroll
        for (int r = 0; r < 4; ++r) { const int n = 16 * mt + 4 * fq + r; SL[((size_t)(b * 32 + n) * 64 + g) * 128 + 16 * w + fr] = acc[mt][r]; }
    __syncthreads();
}
__device__ __forceinline__ void s5_s3_unit(Frame& F, int l, int unit) {
    const int g = unit & 63, b = unit >> 6, lg = l * 64 + g, lane = F.lane, w = F.wave, fr = lane & 15, fq = lane >> 4;
    LAS unsigned char* U = F.lds; LAS unsigned char* TKL = F.lds + 32 * S5_USTR; LAS unsigned char* XP = TKL + 32768;
    float sr[32], si[32]; float a64r = 0.f, a64i = 0.f;
    if (w == 0) { const GAS float* SL = (const GAS float*)(F.ws + WS_SL) + ((size_t)(b * 32) * 64 + g) * 128; const GAS float* A64 = (const GAS float*)(F.ws + WS_A64) + (size_t)lg * 128;
        a64r = A64[lane]; a64i = A64[64 + lane];
#pragma unroll
        for (int e = 0; e < 32; ++e) { sr[e] = SL[(size_t)e * 64 * 128 + lane]; si[e] = SL[(size_t)e * 64 * 128 + 64 + lane]; } }
    s5_stage_u(F, g, b, U);
    { const GAS v4u* src = (const GAS v4u*)((const GAS bf16*)(F.ws + WS_TK) + (size_t)lg * 64 * 256);
#pragma unroll
      for (int it = 0; it < 4; ++it) *(LAS v4u*)(TKL + (F.tid + 512 * it) * 16) = src[F.tid + 512 * it]; }
    const GAS bf16* TC = (const GAS bf16*)(F.ws + WS_TC) + (size_t)lg * 1024 * 128 + (size_t)fr * 128 + 8 * fq;
    bf16x8_t tcf[8];
#pragma unroll
    for (int it = 0; it < 8; ++it) tcf[it] = *(const GAS bf16x8_t*)(TC + (size_t)((w + 8 * it) * 16) * 128);
    if (w == 0) {
        float xr = 0.f, xi = 0.f;
#pragma unroll
        for (int e = 0; e < 32; ++e) { *(LAS bf16*)(XP + e * S5_XSTR + lane * 2) = (bf16)f2bf(xr); *(LAS bf16*)(XP + e * S5_XSTR + (64 + lane) * 2) = (bf16)f2bf(xi);
            const float nr = a64r * xr - a64i * xi + sr[e], ni = a64r * xi + a64i * xr + si[e]; xr = nr; xi = ni; }
    }
    LDS_WAIT(); __syncthreads();
    f32x4 acc[2][8];
#pragma unroll
    for (int mt = 0; mt < 2; ++mt)
#pragma unroll
        for (int it = 0; it < 8; ++it) acc[mt][it] = (f32x4){0.f, 0.f, 0.f, 0.f};
#pragma unroll 1
    for (int c = 0; c < 4; ++c) {
        bf16x8_t bfr[8];
#pragma unroll
        for (int it = 0; it < 8; ++it) { const int lag = w + 8 * it - 2 * c - (fq >> 1); bfr[it] = *(const LAS bf16x8_t*)(TKL + ((lag < 0 ? 0 : lag) * 16 + fr) * 32 + 16 * (fq & 1)); if (lag < 0) bfr[it] = (bf16x8_t){0, 0, 0, 0, 0, 0, 0, 0}; }
        const bool first_ok = (w >= 2 * c);
#pragma unroll
        for (int sgrp = 0; sgrp < 8; ++sgrp) { const int ks = c + 4 * sgrp;
            const bf16x8_t a0 = *(const LAS bf16x8_t*)(U + fr * S5_USTR + (32 * ks + 8 * fq) * 2), a1 = *(const LAS bf16x8_t*)(U + (16 + fr) * S5_USTR + (32 * ks + 8 * fq) * 2);
#pragma unroll
            for (int it = sgrp; it < 8; ++it) { if (it > sgrp || first_ok) { acc[0][it] = mma16(a0, bfr[it - sgrp], acc[0][it]); acc[1][it] = mma16(a1, bfr[it - sgrp], acc[1][it]); } } }
    }
    bf16x8_t tcg[8];
#pragma unroll
    for (int ks = 0; ks < 4; ++ks) {
        if (ks < 3) {
#pragma unroll
            for (int it = 0; it < 8; ++it) { const bf16x8_t nx = *(const GAS bf16x8_t*)(TC + (size_t)((w + 8 * it) * 16) * 128 + 32 * (ks + 1)); if (ks & 1) tcf[it] = nx; else tcg[it] = nx; } }
        const bf16x8_t a0 = *(const LAS bf16x8_t*)(XP + fr * S5_XSTR + (32 * ks + 8 * fq) * 2), a1 = *(const LAS bf16x8_t*)(XP + (16 + fr) * S5_XSTR + (32 * ks + 8 * fq) * 2);
        __builtin_amdgcn_sched_barrier(0);
#pragma unroll
        for (int it = 0; it < 8; ++it) { const bf16x8_t tb = (ks & 1) ? tcg[it] : tcf[it]; acc[0][it] = mma16(a0, tb, acc[0][it]); acc[1][it] = mma16(a1, tb, acc[1][it]); }
        __builtin_amdgcn_sched_barrier(0); }
    unsigned zp[2][8][2];
    { const float dsk = ((const GAS float*)F.in[I_SD])[l * 1024 + 16 * g + fr];
#pragma unroll
      for (int mt = 0; mt < 2; ++mt)
#pragma unroll
          for (int it = 0; it < 8; ++it) { float z[4];
#pragma unroll
              for (int r = 0; r < 4; ++r) { const int n = 16 * mt + 4 * fq + r, i = w + 8 * it;
                  const float uv = bf1(*(const LAS bf16*)(U + n * S5_USTR + (i * 16 + fr) * 2)); z[r] = gelu_tanh(acc[mt][it][r] + dsk * uv); }
              zp[mt][it][0] = pg8::cvt_pk_bf16(z[0], z[1]); zp[mt][it][1] = pg8::cvt_pk_bf16(z[2], z[3]); } }
    LDS_WAIT(); __syncthreads();
#pragma unroll
    for (int mt = 0; mt < 2; ++mt)
#pragma unroll
        for (int it = 0; it < 8; ++it)
#pragma unroll
            for (int r = 0; r < 4; ++r) { const int tkn = 64 * (16 * mt + 4 * fq + r) + w + 8 * it; const unsigned v = zp[mt][it][r >> 1];
                *(LAS bf16*)(U + tkn * 32 + fr * 2) = (bf16)((r & 1) ? (v >> 16) : (v & 0xffffu)); }
    LDS_WAIT(); __syncthreads();
    { GAS bf16* Z = (GAS bf16*)(F.ws + WS_Z) + (size_t)b * SEQ * 1024 + 16 * g;
#pragma unroll
      for (int j = 0; j < 8; ++j) { const int c = F.tid + 512 * j; *(GAS v4u*)(Z + (size_t)(c >> 1) * 1024 + 8 * (c & 1)) = *(const LAS v4u*)(U + c * 16); } }
    __syncthreads();
}

__device__ __forceinline__ void s5_s13_unit(Frame& F, int l, int unit) {
    const int g = unit & 63, b = unit >> 6, lg = l * 64 + g;
    float a64r = 0.f, a64i = 0.f;
    { const int lane = F.lane, w = F.wave, fr = lane & 15, fq = lane >> 4;
      LAS unsigned char* U = F.lds; LAS unsigned char* TKL = F.lds + 32 * S5_USTR; LAS float* SLL = (LAS float*)(TKL + 32768 + 32 * S5_XSTR + 64);
      s5_stage_u(F, g, b, U);
      { const GAS v4u* src = (const GAS v4u*)((const GAS bf16*)(F.ws + WS_TK) + (size_t)lg * 64 * 256);
#pragma unroll
        for (int it = 0; it < 4; ++it) *(LAS v4u*)(TKL + (F.tid + 512 * it) * 16) = src[F.tid + 512 * it]; }
      LDS_WAIT(); __syncthreads();
      const GAS bf16* TW = (const GAS bf16*)(F.ws + WS_TW) + (size_t)lg * 128 * 1024 + (size_t)(16 * w + fr) * 1024 + 8 * fq;
      f32x4 sacc[2] = {(f32x4){0.f, 0.f, 0.f, 0.f}, (f32x4){0.f, 0.f, 0.f, 0.f}};
#pragma unroll 16
      for (int ks = 0; ks < 32; ++ks) {
          const bf16x8_t bfr = *(const GAS bf16x8_t*)(TW + 32 * ks);
          const bf16x8_t a0 = *(const LAS bf16x8_t*)(U + fr * S5_USTR + (32 * ks + 8 * fq) * 2), a1 = *(const LAS bf16x8_t*)(U + (16 + fr) * S5_USTR + (32 * ks + 8 * fq) * 2);
          sacc[0] = mma16(a0, bfr, sacc[0]); sacc[1] = mma16(a1, bfr, sacc[1]); }
#pragma unroll
      for (int mt = 0; mt < 2; ++mt)
#pragma unroll
          for (int r = 0; r < 4; ++r) SLL[(16 * mt + 4 * fq + r) * 128 + 16 * w + fr] = sacc[mt][r]; }
    F.refresh();
    const int lane = F.lane, w = F.wave, fr = lane & 15, fq = lane >> 4;
    LAS unsigned char* U = F.lds; LAS unsigned char* TKL = F.lds + 32 * S5_USTR; LAS unsigned char* XP = TKL + 32768; LAS float* SLL = (LAS float*)(XP + 32 * S5_XSTR + 64);
    if (w == 0) { const GAS float* A64 = (const GAS float*)(F.ws + WS_A64) + (size_t)lg * 128; a64r = A64[lane]; a64i = A64[64 + lane]; }
    const GAS bf16* TC = (const GAS bf16*)(F.ws + WS_TC) + (size_t)lg * 1024 * 128 + (size_t)fr * 128 + 8 * fq;
    bf16x8_t tcf[8];
#pragma unroll
    for (int it = 0; it < 8; ++it) tcf[it] = *(const GAS bf16x8_t*)(TC + (size_t)((w + 8 * it) * 16) * 128);
    LDS_WAIT(); __syncthreads();
    if (w == 0) {
        float xr = 0.f, xi = 0.f;
#pragma unroll
        for (int e = 0; e < 32; ++e) { *(LAS bf16*)(XP + e * S5_XSTR + lane * 2) = (bf16)f2bf(xr); *(LAS bf16*)(XP + e * S5_XSTR + (64 + lane) * 2) = (bf16)f2bf(xi);
            const float sr = SLL[e * 128 + lane], si = SLL[e * 128 + 64 + lane];
            const float nr = a64r * xr - a64i * xi + sr, ni = a64r * xi + a64i * xr + si; xr = nr; xi = ni; }
    }
    LDS_WAIT(); __syncthreads();
    f32x4 acc[2][8];
#pragma unroll
    for (int mt = 0; mt < 2; ++mt)
#pragma unroll
        for (int it = 0; it < 8; ++it) acc[mt][it] = (f32x4){0.f, 0.f, 0.f, 0.f};
#pragma unroll 1
    for (int c = 0; c < 4; ++c) {
        bf16x8_t bfr[8];
#pragma unroll
        for (int it = 0; it < 8; ++it) { const int lag = w + 8 * it - 2 * c - (fq >> 1); bfr[it] = *(const LAS bf16x8_t*)(TKL + ((lag < 0 ? 0 : lag) * 16 + fr) * 32 + 16 * (fq & 1)); if (lag < 0) bfr[it] = (bf16x8_t){0, 0, 0, 0, 0, 0, 0, 0}; }
        const bool first_ok = (w >= 2 * c);
#pragma unroll
        for (int sgrp = 0; sgrp < 8; ++sgrp) { const int ks = c + 4 * sgrp;
            const bf16x8_t a0 = *(const LAS bf16x8_t*)(U + fr * S5_USTR + (32 * ks + 8 * fq) * 2), a1 = *(const LAS bf16x8_t*)(U + (16 + fr) * S5_USTR + (32 * ks + 8 * fq) * 2);
#pragma unroll
            for (int it = sgrp; it < 8; ++it) { if (it > sgrp || first_ok) { acc[0][it] = mma16(a0, bfr[it - sgrp], acc[0][it]); acc[1][it] = mma16(a1, bfr[it - sgrp], acc[1][it]); } } }
    }
    bf16x8_t tcg[8];
#pragma unroll
    for (int ks = 0; ks < 4; ++ks) {
        if (ks < 3) {
#pragma unroll
            for (int it = 0; it < 8; ++it) { const bf16x8_t nx = *(const GAS bf16x8_t*)(TC + (size_t)((w + 8 * it) * 16) * 128 + 32 * (ks + 1)); if (ks & 1) tcf[it] = nx; else tcg[it] = nx; } }
        const bf16x8_t a0 = *(const LAS bf16x8_t*)(XP + fr * S5_XSTR + (32 * ks + 8 * fq) * 2), a1 = *(const LAS bf16x8_t*)(XP + (16 + fr) * S5_XSTR + (32 * ks + 8 * fq) * 2);
        __builtin_amdgcn_sched_barrier(0);
#pragma unroll
        for (int it = 0; it < 8; ++it) { const bf16x8_t tb = (ks & 1) ? tcg[it] : tcf[it]; acc[0][it] = mma16(a0, tb, acc[0][it]); acc[1][it] = mma16(a1, tb, acc[1][it]); }
        __builtin_amdgcn_sched_barrier(0); }
    unsigned zp[2][8][2];
    { const float dsk = ((const GAS float*)F.in[I_SD])[l * 1024 + 16 * g + fr];
#pragma unroll
      for (int mt = 0; mt < 2; ++mt)
#pragma unroll
          for (int it = 0; it < 8; ++it) { float z[4];
#pragma unroll
              for (int r = 0; r < 4; ++r) { const int n = 16 * mt + 4 * fq + r, i = w + 8 * it;
                  const float uv = bf1(*(const LAS bf16*)(U + n * S5_USTR + (i * 16 + fr) * 2)); z[r] = gelu_tanh(acc[mt][it][r] + dsk * uv); }
              zp[mt][it][0] = pg8::cvt_pk_bf16(z[0], z[1]); zp[mt][it][1] = pg8::cvt_pk_bf16(z[2], z[3]); } }
    LDS_WAIT(); __syncthreads();
#pragma unroll
    for (int mt = 0; mt < 2; ++mt)
#pragma unroll
        for (int it = 0; it < 8; ++it)
#pragma unroll
            for (int r = 0; r < 4; ++r) { const int tkn = 64 * (16 * mt + 4 * fq + r) + w + 8 * it; const unsigned v = zp[mt][it][r >> 1];
                *(LAS bf16*)(U + tkn * 32 + fr * 2) = (bf16)((r & 1) ? (v >> 16) : (v & 0xffffu)); }
    LDS_WAIT(); __syncthreads();
    { GAS bf16* Z = (GAS bf16*)(F.ws + WS_Z) + (size_t)b * SEQ * 1024 + 16 * g;
#pragma unroll
      for (int j = 0; j < 8; ++j) { const int c = F.tid + 512 * j; *(GAS v4u*)(Z + (size_t)(c >> 1) * 1024 + 8 * (c & 1)) = *(const LAS v4u*)(U + c * 16); } }
    __syncthreads();
}

constexpr int GL_TSTR = 144;
constexpr int GL_DSTR = 272;
__device__ __forceinline__ int trimg_off(int row, int ch) { return 256 * row + 16 * (ch ^ (((row & 3) << 2) | ((row >> 2) & 3))); }
typedef short s16x4_t __attribute__((ext_vector_type(4)));
__device__ __forceinline__ bf16x8_t tr_frag16(const LAS unsigned char* img, int lane, int c, int ks) {
    const int g = lane >> 4, q = (lane & 15) >> 2, p = lane & 3;
    const s16x4_t lo = __builtin_amdgcn_ds_read_tr16_b64_v4i16((LAS s16x4_t*)(img + trimg_off(32 * ks + 8 * g + q, 2 * c + (p >> 1)) + 8 * (p & 1)));
    const s16x4_t hi = __builtin_amdgcn_ds_read_tr16_b64_v4i16((LAS s16x4_t*)(img + trimg_off(32 * ks + 8 * g + 4 + q, 2 * c + (p >> 1)) + 8 * (p & 1)));
    return (bf16x8_t){lo[0], lo[1], lo[2], lo[3], hi[0], hi[1], hi[2], hi[3]};
}
__device__ __forceinline__ void gla_g1_unit(Frame& F, int l, int u, bool loadw) {
    const int n = u & 31, h = (u >> 5) & 3, b = u >> 7, tid = F.tid, lane = F.lane, w = F.wave, fr = lane & 15, fq = lane >> 4;
    const size_t tok0 = (size_t)b * SEQ + 64 * n;
    const GAS bf16* P = (const GAS bf16*)(F.ws + WS_P);
    LAS float* GL = (LAS float*)F.lds; LAS float* W2L = (LAS float*)(F.lds + 32768); LAS float* GLR = (LAS float*)(F.lds + 40960);
    LAS unsigned char* KDI = F.lds + 45056; LAS unsigned char* VI = F.lds + 61440;
    const int ti = tid >> 3, dq = tid & 7;
    const GAS bf16* qp = P + (tok0 + ti) * NP + PC_GQ + h * 128 + 16 * dq; const GAS bf16* kp = P + (tok0 + ti) * NP + PC_GK + h * 128 + 16 * dq;
    const v4u q0 = *(const GAS v4u*)qp, q1 = *(const GAS v4u*)(qp + 8), k0 = *(const GAS v4u*)kp, k1 = *(const GAS v4u*)(kp + 8);
    v4u vv4[4];
    { const GAS bf16* vp = P + (tok0 + ti) * NP + PC_GV + h * 256 + 32 * dq;
#pragma unroll
      for (int c = 0; c < 4; ++c) vv4[c] = *(const GAS v4u*)(vp + 8 * c); }
    { const GAS float* w2 = ((const GAS float*)F.in[I_GW2]) + (size_t)l * 16 * 512;
      if (loadw) {
#pragma unroll
      for (int it = 0; it < 4; ++it) { const int idx = tid + 512 * it, r = idx >> 7, dk = idx & 127; W2L[idx] = w2[r * 512 + h * 128 + dk]; } }
#pragma unroll
      for (int it = 0; it < 2; ++it) { const int idx = tid + 512 * it, i = idx >> 4, r = idx & 15; GLR[idx] = bf1(P[(tok0 + i) * NP + PC_GLR + r]); } }
    LDS_WAIT(); __syncthreads();
    { const GAS float* b2 = ((const GAS float*)F.in[I_GB2]) + l * 512 + h * 128 + 16 * dq; float a[16];
#pragma unroll
      for (int e = 0; e < 16; ++e) a[e] = b2[e];
#pragma unroll
      for (int r = 0; r < 16; ++r) { const float gv = GLR[ti * 16 + r];
#pragma unroll
          for (int e4 = 0; e4 < 4; ++e4) { const f32x4 wv4 = *(const LAS f32x4*)(W2L + r * 128 + 16 * dq + 4 * e4); a[4 * e4] += gv * wv4[0]; a[4 * e4 + 1] += gv * wv4[1]; a[4 * e4 + 2] += gv * wv4[2]; a[4 * e4 + 3] += gv * wv4[3]; } }
#pragma unroll
      for (int e = 0; e < 16; ++e) { const float x = a[e]; GL[ti * 128 + 16 * dq + e] = (fminf(x, 0.f) - __logf(1.0f + __expf(-fabsf(x)))) * (1.0f / 16.0f); } }
    LDS_WAIT(); __syncthreads();
    if (tid < 128) { float cv[64], run = 0.f;
#pragma unroll
        for (int i = 0; i < 64; ++i) cv[i] = GL[i * 128 + tid];
#pragma unroll
        for (int i = 0; i < 64; ++i) { run += cv[i]; GL[i * 128 + tid] = run; }
        GLR[tid] = run; ((GAS float*)(F.ws + WS_DEC))[(size_t)u * 128 + tid] = __expf(run); }
    LDS_WAIT(); __syncthreads();
    {
      const unsigned qw[8] = {q0.x, q0.y, q0.z, q0.w, q1.x, q1.y, q1.z, q1.w}, kw[8] = {k0.x, k0.y, k0.z, k0.w, k1.x, k1.y, k1.z, k1.w};
      float qd[16], ki[16], kd[16];
#pragma unroll
      for (int e = 0; e < 16; ++e) { const int dk = 16 * dq + e; const float bc = GL[ti * 128 + dk], bl = GLR[dk];
          const float qv = (e & 1) ? bfhi(qw[e >> 1]) : bflo(qw[e >> 1]), kv = (e & 1) ? bfhi(kw[e >> 1]) : bflo(kw[e >> 1]);
          qd[e] = qv * 0.08838834764831845f * __expf(bc); ki[e] = kv * __expf(-bc); kd[e] = kv * __expf(bl - bc); }
      GAS bf16* QD = (GAS bf16*)(F.ws + WS_QD) + ((size_t)u * 64 + ti) * 128 + 16 * dq; GAS bf16* KI = (GAS bf16*)(F.ws + WS_KI) + ((size_t)u * 64 + ti) * 128 + 16 * dq;
      v4u o; o.x = pk2(qd[0], qd[1]); o.y = pk2(qd[2], qd[3]); o.z = pk2(qd[4], qd[5]); o.w = pk2(qd[6], qd[7]); *(GAS v4u*)QD = o;
      o.x = pk2(qd[8], qd[9]); o.y = pk2(qd[10], qd[11]); o.z = pk2(qd[12], qd[13]); o.w = pk2(qd[14], qd[15]); *(GAS v4u*)(QD + 8) = o;
      o.x = pk2(ki[0], ki[1]); o.y = pk2(ki[2], ki[3]); o.z = pk2(ki[4], ki[5]); o.w = pk2(ki[6], ki[7]); *(GAS v4u*)KI = o;
      o.x = pk2(ki[8], ki[9]); o.y = pk2(ki[10], ki[11]); o.z = pk2(ki[12], ki[13]); o.w = pk2(ki[14], ki[15]); *(GAS v4u*)(KI + 8) = o;
      o.x = pk2(kd[0], kd[1]); o.y = pk2(kd[2], kd[3]); o.z = pk2(kd[4], kd[5]); o.w = pk2(kd[6], kd[7]); *(LAS v4u*)(KDI + trimg_off(ti, 2 * dq)) = o;
      o.x = pk2(kd[8], kd[9]); o.y = pk2(kd[10], kd[11]); o.z = pk2(kd[12], kd[13]); o.w = pk2(kd[14], kd[15]); *(LAS v4u*)(KDI + trimg_off(ti, 2 * dq + 1)) = o;
#pragma unroll
      for (int c = 0; c < 4; ++c) *(LAS v4u*)(VI + (dq >> 2) * 16384 + trimg_off(ti, 4 * (dq & 3) + c)) = vv4[c]; }
    LDS_WAIT(); __syncthreads();
    {
      f32x4 acc[8][2];
#pragma unroll
      for (int mt = 0; mt < 8; ++mt) { acc[mt][0] = (f32x4){0.f, 0.f, 0.f, 0.f}; acc[mt][1] = (f32x4){0.f, 0.f, 0.f, 0.f}; }
      GAS bf16* GVT = (GAS bf16*)(F.ws + WS_GVT) + (size_t)u * 256 * 64;
#pragma unroll
      for (int ks = 0; ks < 2; ++ks) { bf16x8_t bb[2], aa[8];
#pragma unroll
          for (int nt = 0; nt < 2; ++nt) { const int cb = 2 * w + nt; bb[nt] = tr_frag16(VI + (cb >> 3) * 16384, lane, cb & 7, ks); }
#pragma unroll
          for (int mt = 0; mt < 8; ++mt) aa[mt] = tr_frag16(KDI, lane, mt, ks);
#pragma unroll
          for (int nt = 0; nt < 2; ++nt) *(GAS bf16x8_t*)(GVT + (size_t)(16 * (2 * w + nt) + fr) * 64 + 32 * ks + 8 * fq) = bb[nt];
#pragma unroll
          for (int mt = 0; mt < 8; ++mt) { acc[mt][0] = mma16(aa[mt], bb[0], acc[mt][0]); acc[mt][1] = mma16(aa[mt], bb[1], acc[mt][1]); } }
      GAS bf16* KV = (GAS bf16*)(F.ws + WS_KV) + (size_t)u * 256 * 128;
#pragma unroll
      for (int nt = 0; nt < 2; ++nt)
#pragma unroll
          for (int mt = 0; mt < 8; ++mt) { v2u o; o.x = pg8::cvt_pk_bf16(acc[mt][nt][0], acc[mt][nt][1]); o.y = pg8::cvt_pk_bf16(acc[mt][nt][2], acc[mt][nt][3]);
              *(GAS v2u*)(KV + (size_t)(16 * (2 * w + nt) + fr) * 128 + 16 * mt + 4 * fq) = o; } }
    __syncthreads();
}
__device__ __forceinline__ void gla_g2_scan(Frame& F) {
    const GAS bf16* KV = (const GAS bf16*)(F.ws + WS_KV); const GAS float* DEC = (const GAS float*)(F.ws + WS_DEC); GAS bf16* ST = (GAS bf16*)(F.ws + WS_ST);
    for (int e8 = blockIdx.x * 512 + F.tid; e8 < 16 * 256 * 16; e8 += F.G * 512) { const int bh = e8 >> 12, dv = (e8 >> 4) & 255, d8 = e8 & 15;
        float s[8];
#pragma unroll
        for (int j = 0; j < 8; ++j) s[j] = 0.f;
        for (int n0 = 0; n0 < 32; n0 += 8) { v4u kv[8]; f32x4 dc[8][2];
#pragma unroll
            for (int e = 0; e < 8; ++e) { const size_t u = (size_t)bh * 32 + n0 + e; kv[e] = *(const GAS v4u*)(KV + (u * 256 + dv) * 128 + 8 * d8); dc[e][0] = *(const GAS f32x4*)(DEC + u * 128 + 8 * d8); dc[e][1] = *(const GAS f32x4*)(DEC + u * 128 + 8 * d8 + 4); }
#pragma unroll
            for (int e = 0; e < 8; ++e) { const size_t u = (size_t)bh * 32 + n0 + e; v4u o; o.x = pk2(s[0], s[1]); o.y = pk2(s[2], s[3]); o.z = pk2(s[4], s[5]); o.w = pk2(s[6], s[7]); *(GAS v4u*)(ST + (u * 256 + dv) * 128 + 8 * d8) = o;
                const unsigned kw[4] = {kv[e].x, kv[e].y, kv[e].z, kv[e].w};
#pragma unroll
                for (int j = 0; j < 4; ++j) { s[2 * j] = dc[e][j >> 1][(2 * j) & 3] * s[2 * j] + bflo(kw[j]); s[2 * j + 1] = dc[e][j >> 1][(2 * j + 1) & 3] * s[2 * j + 1] + bfhi(kw[j]); } } } }
}
__device__ __forceinline__ void gla_g3_unit(Frame& F, int l, int u) {
    const int n = u & 31, h = (u >> 5) & 3, b = u >> 7, tid = F.tid, lane = F.lane, w = F.wave, fr = lane & 15, fq = lane >> 4;
    const size_t tok0 = (size_t)b * SEQ + 64 * n;
    LAS unsigned char* QDL = F.lds; LAS unsigned char* KIL = F.lds + 17408; LAS unsigned char* ATL = F.lds + 34816; LAS float* SSQL = (LAS float*)(F.lds + 44032); LAS float* RSL = (LAS float*)(F.lds + 46080);
    bf16x8_t gvtf[2][2], stf[2][4]; v2u rr[2][4];
    { const GAS bf16* Pg = (const GAS bf16*)(F.ws + WS_P);
#pragma unroll
      for (int mt = 0; mt < 2; ++mt)
#pragma unroll
          for (int nt = 0; nt < 4; ++nt) rr[mt][nt] = *(const GAS v2u*)(Pg + (tok0 + 16 * nt + fr) * NP + PC_GR + h * 256 + 16 * (2 * w + mt) + 4 * fq); }
    { const GAS bf16* GVT = (const GAS bf16*)(F.ws + WS_GVT) + (size_t)u * 256 * 64; const GAS bf16* ST = (const GAS bf16*)(F.ws + WS_ST) + (size_t)u * 256 * 128;
#pragma unroll
      for (int mt = 0; mt < 2; ++mt) {
#pragma unroll
          for (int ks = 0; ks < 2; ++ks) gvtf[mt][ks] = *(const GAS bf16x8_t*)(GVT + (size_t)(16 * (2 * w + mt) + fr) * 64 + 32 * ks + 8 * fq);
#pragma unroll
          for (int ks = 0; ks < 4; ++ks) stf[mt][ks] = *(const GAS bf16x8_t*)(ST + (size_t)(16 * (2 * w + mt) + fr) * 128 + 32 * ks + 8 * fq); } }
    { const GAS v4u* qs = (const GAS v4u*)((const GAS bf16*)(F.ws + WS_QD) + (size_t)u * 64 * 128); const GAS v4u* ks_ = (const GAS v4u*)((const GAS bf16*)(F.ws + WS_KI) + (size_t)u * 64 * 128);
#pragma unroll
      for (int it = 0; it < 2; ++it) { const int c = tid + 512 * it, row = c >> 4, c16 = c & 15; *(LAS v4u*)(QDL + row * GL_DSTR + c16 * 16) = qs[c]; *(LAS v4u*)(KIL + row * GL_DSTR + c16 * 16) = ks_[c]; } }
    LDS_WAIT(); __syncthreads();
#pragma unroll
    for (int tt = 0; tt < 2; ++tt) { const int tile = 2 * w + tt, mi = tile >> 2, nj = tile & 3; f32x4 acc = (f32x4){0.f, 0.f, 0.f, 0.f};
        if (nj <= mi) { bf16x8_t fa[4], fb[4];
#pragma unroll
            for (int ks = 0; ks < 4; ++ks) { fa[ks] = *(const LAS bf16x8_t*)(QDL + (16 * mi + fr) * GL_DSTR + (32 * ks + 8 * fq) * 2); fb[ks] = *(const LAS bf16x8_t*)(KIL + (16 * nj + fr) * GL_DSTR + (32 * ks + 8 * fq) * 2); }
#pragma unroll
            for (int ks = 0; ks < 4; ++ks) acc = mma16(fa[ks], fb[ks], acc); }
#pragma unroll
        for (int r = 0; r < 4; ++r) { const int i = 16 * mi + 4 * fq + r, j = 16 * nj + fr; *(LAS bf16*)(ATL + i * GL_TSTR + j * 2) = (bf16)f2bf(j <= i ? acc[r] : 0.f); } }
    LDS_WAIT(); __syncthreads();
    f32x4 acc[2][4];
#pragma unroll
    for (int mt = 0; mt < 2; ++mt)
#pragma unroll
        for (int nt = 0; nt < 4; ++nt) acc[mt][nt] = (f32x4){0.f, 0.f, 0.f, 0.f};
#pragma unroll
    for (int ks = 0; ks < 2; ++ks) { bf16x8_t fb[4];
#pragma unroll
        for (int nt = 0; nt < 4; ++nt) fb[nt] = *(const LAS bf16x8_t*)(ATL + (16 * nt + fr) * GL_TSTR + (32 * ks + 8 * fq) * 2);
#pragma unroll
        for (int nt = 0; nt < 4; ++nt) { acc[0][nt] = mma16(gvtf[0][ks], fb[nt], acc[0][nt]); acc[1][nt] = mma16(gvtf[1][ks], fb[nt], acc[1][nt]); } }
#pragma unroll
    for (int ks = 0; ks < 4; ++ks) { bf16x8_t fb[4];
#pragma unroll
        for (int nt = 0; nt < 4; ++nt) fb[nt] = *(const LAS bf16x8_t*)(QDL + (16 * nt + fr) * GL_DSTR + (32 * ks + 8 * fq) * 2);
#pragma unroll
        for (int nt = 0; nt < 4; ++nt) { acc[0][nt] = mma16(stf[0][ks], fb[nt], acc[0][nt]); acc[1][nt] = mma16(stf[1][ks], fb[nt], acc[1][nt]); } }
#pragma unroll
    for (int nt = 0; nt < 4; ++nt) { float v = 0.f;
#pragma unroll
        for (int mt = 0; mt < 2; ++mt)
#pragma unroll
            for (int r = 0; r < 4; ++r) v += acc[mt][nt][r] * acc[mt][nt][r];
        v += __shfl_xor(v, 16); v += __shfl_xor(v, 32);
        if (fq == 0) SSQL[w * 64 + 16 * nt + fr] = v; }
    LDS_WAIT(); __syncthreads();
    if (tid < 64) { float s = 0.f;
#pragma unroll
        for (int ww = 0; ww < 8; ++ww) s += SSQL[ww * 64 + tid];
        RSL[tid] = __builtin_amdgcn_rsqf(s * (1.0f / 256.0f) + RMS_EPS); }
    LDS_WAIT(); __syncthreads();
    { GAS bf16* Y = (GAS bf16*)(F.ws + WS_Y); const GAS float* gn = (const GAS float*)F.in[I_GNG] + l * 256;
#pragma unroll
      for (int mt = 0; mt < 2; ++mt) { const int dv0 = 16 * (2 * w + mt) + 4 * fq; const f32x4 gv = *(const GAS f32x4*)(gn + dv0);
#pragma unroll
          for (int nt = 0; nt < 4; ++nt) { const int i = 16 * nt + fr; const float rs = RSL[i]; const v2u rw = rr[mt][nt];
              const float r0 = bflo(rw.x), r1 = bfhi(rw.x), r2 = bflo(rw.y), r3 = bfhi(rw.y);
              v2u o; o.x = pg8::cvt_pk_bf16(acc[mt][nt][0] * rs * gv[0] * r0 * sigmoidf_(r0), acc[mt][nt][1] * rs * gv[1] * r1 * sigmoidf_(r1));
              o.y = pg8::cvt_pk_bf16(acc[mt][nt][2] * rs * gv[2] * r2 * sigmoidf_(r2), acc[mt][nt][3] * rs * gv[3] * r3 * sigmoidf_(r3));
              *(GAS v2u*)(Y + (tok0 + i) * YW + 1024 + h * 256 + dv0) = o; } } }
    __syncthreads();
}
constexpr int MB_KSTR = 272, MB_VSTR = 144, MB_KBYTES = 64 * MB_KSTR, MB_BUF = MB_KBYTES + 128 * MB_VSTR;
__device__ __forceinline__ void moba_prep_unit(Frame& F, int l, int unit) {
    const int kb = unit & 7, h = (unit >> 3) & 7, b = unit >> 6, tid = F.tid;
    const size_t tok0 = (size_t)b * SEQ + 256 * kb;
    const GAS bf16* P = (const GAS bf16*)(F.ws + WS_P);
    LAS unsigned char* TL = F.lds; LAS float* PART = (LAS float*)(F.lds + 69632);
    const int c16 = tid & 15, tg = tid >> 4;
    v4u xv[8];
    { const GAS bf16* src = P + (tok0 + tg) * NP + h * 128 + 8 * c16;
#pragma unroll
      for (int j = 0; j < 8; ++j) xv[j] = *(const GAS v4u*)(src + (size_t)(32 * j) * NP + PC_MV); }
#pragma unroll
    for (int j = 0; j < 8; ++j) *(LAS v4u*)(TL + trimg_off(tg + 32 * j, c16)) = xv[j];
    LDS_WAIT(); __syncthreads();
    { const int lane = tid & 63, w = tid >> 6, g = lane >> 4, i = lane & 15, q = i >> 2, p = i & 3;
      GAS bf16* dst = (GAS bf16*)(F.ws + WS_VT) + ((size_t)(b * 8 + h) * 128 + 16 * w + i) * SEQ + 256 * kb;
#pragma unroll
      for (int half = 0; half < 2; ++half)
#pragma unroll
          for (int f = 0; f < 4; ++f) { const int G = 4 * half + g, r0 = 32 * G + 4 * f;
              const s16x4_t lo = __builtin_amdgcn_ds_read_tr16_b64_v4i16((LAS s16x4_t*)(TL + trimg_off(r0 + q, 2 * w + (p >> 1)) + 8 * (p & 1)));
              const s16x4_t hi = __builtin_amdgcn_ds_read_tr16_b64_v4i16((LAS s16x4_t*)(TL + trimg_off(r0 + 16 + q, 2 * w + (p >> 1)) + 8 * (p & 1)));
              *(GAS bf16x8_t*)(dst + 32 * G + 8 * f) = (bf16x8_t){lo[0], lo[1], lo[2], lo[3], hi[0], hi[1], hi[2], hi[3]}; } }
    __syncthreads();
}
constexpr int MB3_TILE = 128 * 256, MB3_BUF = 2 * MB3_TILE;
__device__ __forceinline__ void moba_attn_unit3(Frame& F, int bh, int qt) {
    const int b = bh >> 3, h = bh & 7, tid = F.tid, lane = F.lane, w = F.wave, fr = lane & 15, fq = lane >> 4;
    const int qb = qt >> 1, np = qt + 1, qpos = 128 * qt + 16 * w + fr;
    const GAS bf16* KN = (const GAS bf16*)(F.ws + WS_KN) + (size_t)b * SEQ * 1024 + h * 128; const GAS bf16* VT = (const GAS bf16*)(F.ws + WS_VT) + (size_t)bh * 128 * SEQ;
    LAS float* KML = (LAS float*)(F.lds + 2 * MB3_BUF);
    { const GAS float* km = (const GAS float*)(F.ws + WS_KM) + (size_t)bh * 1024; KML[tid] = km[tid]; KML[512 + tid] = km[512 + tid]; }
    bf16x8_t bq[4];
    { const GAS bf16* qp = (const GAS bf16*)(F.ws + WS_QN) + ((size_t)b * SEQ + qpos) * 1024 + h * 128 + 8 * fq;
#pragma unroll
      for (int ks = 0; ks < 4; ++ks) bq[ks] = *(const GAS bf16x8_t*)(qp + 32 * ks); }
    const int drow = lane >> 4, dslot = lane & 15;
#define MB3_DMA(buf_, p_) do { _Pragma("unroll") for (int j_ = 0; j_ < 4; ++j_) { const int row_ = 4 * (8 * j_ + w) + drow, c_ = dslot ^ (row_ & 15); \
        __builtin_amdgcn_global_load_lds((const GAS unsigned*)(KN + (size_t)(128 * (p_) + row_) * 1024 + 8 * c_), (LAS unsigned*)((buf_) + (8 * j_ + w) * 1024), 16, 0, 0); \
        __builtin_amdgcn_global_load_lds((const GAS unsigned*)(VT + (size_t)row_ * SEQ + 128 * (p_) + 8 * c_), (LAS unsigned*)((buf_) + MB3_TILE + (8 * j_ + w) * 1024), 16, 0, 0); } } while (0)
    MB3_DMA(F.lds, 0);
    VM_WAIT(); LDS_WAIT(); __syncthreads();
    unsigned selmask = 0u;
    { float sc[8];
#pragma unroll
      for (int kb = 0; kb < 8; ++kb) { float a = 0.f;
#pragma unroll
          for (int ks = 0; ks < 4; ++ks) { const LAS float* kp = KML + kb * 128 + 32 * ks + 8 * fq; const f32x4 k0 = *(const LAS f32x4*)kp, k1 = *(const LAS f32x4*)(kp + 4);
              const v4u qv = __builtin_bit_cast(v4u, bq[ks]);
              a += bflo(qv.x) * k0[0] + bfhi(qv.x) * k0[1] + bflo(qv.y) * k0[2] + bfhi(qv.y) * k0[3] + bflo(qv.z) * k1[0] + bfhi(qv.z) * k1[1] + bflo(qv.w) * k1[2] + bfhi(qv.w) * k1[3]; }
          a += __shfl_xor(a, 16); a += __shfl_xor(a, 32); sc[kb] = (kb < qb) ? a : -__builtin_inff(); }
#pragma unroll
      for (int kb = 0; kb < 8; ++kb) { int rank = 0;
#pragma unroll
          for (int j = 0; j < 8; ++j) if (j != kb) rank += ((j < qb) && (sc[j] > sc[kb] || (sc[j] == sc[kb] && j < kb))) ? 1 : 0;
          if (kb < qb && rank < 3) selmask |= 1u << kb; } }
    f32x4 ao[8];
#pragma unroll
    for (int dt = 0; dt < 8; ++dt) ao[dt] = (f32x4){0.f, 0.f, 0.f, 0.f};
    float m = -__builtin_inff(), lsum = 0.f;
#pragma unroll 1
    for (int p = 0; p < np; ++p) {
        LAS unsigned char* KB = F.lds + (p & 1) * MB3_BUF; LAS unsigned char* VB = KB + MB3_TILE;
        if (p + 1 < np) MB3_DMA(F.lds + ((p + 1) & 1) * MB3_BUF, p + 1);
        const int kb = p >> 1; const bool past = kb < qb; const bool mine = past ? (((selmask >> kb) & 1u) != 0u) : true;
        if (__any(mine)) {
            const int lim = (past ? (mine ? 0x7fffffff : -1) : qpos - 128 * p) - 4 * fq;
            f32x4 as[8];
#pragma unroll
            for (int mh = 0; mh < 4; ++mh) { bf16x8_t fragA[2][4];
#pragma unroll
                for (int mt = 0; mt < 2; ++mt)
#pragma unroll
                    for (int ks = 0; ks < 4; ++ks) fragA[mt][ks] = *(const LAS bf16x8_t*)(KB + (16 * (2 * mh + mt) + fr) * 256 + 16 * ((4 * ks + fq) ^ fr));
                __builtin_amdgcn_sched_barrier(0);
#pragma unroll
                for (int mt = 0; mt < 2; ++mt) { as[2 * mh + mt] = (f32x4){0.f, 0.f, 0.f, 0.f};
#pragma unroll
                    for (int ks = 0; ks < 4; ++ks) as[2 * mh + mt] = mma16(fragA[mt][ks], bq[ks], as[2 * mh + mt]); }
                __builtin_amdgcn_sched_barrier(0); }
            float mx = -__builtin_inff();
            if (__all(lim >= 127)) {
#pragma unroll
                for (int mt = 0; mt < 8; ++mt)
#pragma unroll
                    for (int r = 0; r < 4; ++r) mx = fmaxf(mx, as[mt][r]);
            } else {
#pragma unroll
                for (int mt = 0; mt < 8; ++mt)
#pragma unroll
                    for (int r = 0; r < 4; ++r) { const float sv_ = (16 * mt + r <= lim) ? as[mt][r] : -__builtin_inff(); as[mt][r] = sv_; mx = fmaxf(mx, sv_); }
            }
            mx = fmaxf(mx, __shfl_xor(mx, 16)); mx = fmaxf(mx, __shfl_xor(mx, 32));
            const float mnew = fmaxf(m, mx), msafe = (mnew == -__builtin_inff()) ? 0.f : mnew;
            const bool grow = __any(mnew != m);
            const float corr = grow ? __builtin_amdgcn_exp2f(m - msafe) : 1.0f;
            float ps = 0.f;
#pragma unroll
            for (int mt = 0; mt < 8; ++mt)
#pragma unroll
                for (int r = 0; r < 4; ++r) { const float pv = __builtin_amdgcn_exp2f(as[mt][r] - msafe); as[mt][r] = pv; ps += pv; }
            lsum = lsum * corr + ps; m = mnew;
            bf16x8_t pf[4];
#pragma unroll
            for (int k2 = 0; k2 < 4; ++k2) { v4u t; t.x = pg8::cvt_pk_bf16(as[2 * k2][0], as[2 * k2][1]); t.y = pg8::cvt_pk_bf16(as[2 * k2][2], as[2 * k2][3]); t.z = pg8::cvt_pk_bf16(as[2 * k2 + 1][0], as[2 * k2 + 1][1]); t.w = pg8::cvt_pk_bf16(as[2 * k2 + 1][2], as[2 * k2 + 1][3]);
                pf[k2] = __builtin_bit_cast(bf16x8_t, t); }
            if (grow) {
#pragma unroll
                for (int dt = 0; dt < 8; ++dt) ao[dt] = ao[dt] * corr; }
            __builtin_amdgcn_sched_barrier(0);
#pragma unroll
            for (int dh = 0; dh < 4; ++dh) { v2u vlo[2][4], vhi[2][4];
#pragma unroll
                for (int dt = 0; dt < 2; ++dt)
#pragma unroll
                    for (int k2 = 0; k2 < 4; ++k2) { const LAS unsigned char* vr = VB + (16 * (2 * dh + dt) + fr) * 256 + 8 * (fq & 1); const int c0 = 4 * k2 + (fq >> 1);
                        vlo[dt][k2] = *(const LAS v2u*)(vr + 16 * (c0 ^ fr)); vhi[dt][k2] = *(const LAS v2u*)(vr + 16 * ((c0 + 2) ^ fr)); }
                __builtin_amdgcn_sched_barrier(0);
#pragma unroll
                for (int dt = 0; dt < 2; ++dt)
#pragma unroll
                    for (int k2 = 0; k2 < 4; ++k2) { v4u t; t.x = vlo[dt][k2].x; t.y = vlo[dt][k2].y; t.z = vhi[dt][k2].x; t.w = vhi[dt][k2].y; ao[2 * dh + dt] = mma16(__builtin_bit_cast(bf16x8_t, t), pf[k2], ao[2 * dh + dt]); }
                __builtin_amdgcn_sched_barrier(0); }
        }
        VM_WAIT(); LDS_WAIT(); __syncthreads();
    }
#undef MB3_DMA
    lsum += __shfl_xor(lsum, 16); lsum += __shfl_xor(lsum, 32);
    const float inv = 1.0f / lsum;
    GAS bf16* yp = (GAS bf16*)(F.ws + WS_Y) + ((size_t)b * SEQ + qpos) * YW + 2048 + h * 128 + 4 * fq;
#pragma unroll
    for (int dt = 0; dt < 8; ++dt) { v2u o; o.x = pg8::cvt_pk_bf16(ao[dt][0] * inv, ao[dt][1] * inv); o.y = pg8::cvt_pk_bf16(ao[dt][2] * inv, ao[dt][3] * inv); *(GAS v2u*)(yp + 16 * dt) = o; }
}
__device__ __forceinline__ void moba_attn_unit5(Frame& F, int bh, int qt) {
    const int b = bh >> 3, h = bh & 7, tid = F.tid, lane = F.lane, w = F.wave, fr = lane & 15, fq = lane >> 4;
    const int qb = qt >> 1, np = qt + 1, qpos = 128 * qt + 16 * w + fr;
    const bool hb = w >= 4;
    const GAS bf16* KN = (const GAS bf16*)(F.ws + WS_KN) + (size_t)b * SEQ * 1024 + h * 128; const GAS bf16* VT = (const GAS bf16*)(F.ws + WS_VT) + (size_t)bh * 128 * SEQ;
    LAS float* KML = (LAS float*)(F.lds + 2 * MB3_BUF);
    { const GAS float* km = (const GAS float*)(F.ws + WS_KM) + (size_t)bh * 1024; KML[tid] = km[tid]; KML[512 + tid] = km[512 + tid]; }
    bf16x8_t bq[4];
    { const GAS bf16* qp = (const GAS bf16*)(F.ws + WS_QN) + ((size_t)b * SEQ + qpos) * 1024 + h * 128 + 8 * fq;
#pragma unroll
      for (int ks = 0; ks < 4; ++ks) bq[ks] = *(const GAS bf16x8_t*)(qp + 32 * ks); }
    const int drow = 4 * w + (lane >> 4), dc = (lane & 15) ^ (drow & 15);
    const unsigned kvoff = (unsigned)(drow * 1024 + 8 * dc) * 2u, vvoff = (unsigned)(drow * SEQ + 8 * dc) * 2u;
#define MB5_DMAK(p_) do { LAS unsigned char* buf_ = F.lds + ((p_) & 1) * MB3_BUF; _Pragma("unroll") for (int j_ = 0; j_ < 4; ++j_) { const GAS char* kb_ = (const GAS char*)KN + (size_t)(128 * (p_) + 32 * j_) * 2048; \
        __builtin_amdgcn_global_load_lds((const GAS unsigned*)(kb_ + kvoff), (LAS unsigned*)(buf_ + (8 * j_ + w) * 1024), 16, 0, 0); } } while (0)
#define MB5_DMAV(p_) do { LAS unsigned char* buf_ = F.lds + ((p_) & 1) * MB3_BUF + MB3_TILE; _Pragma("unroll") for (int j_ = 0; j_ < 4; ++j_) { const GAS char* vb_ = (const GAS char*)VT + ((size_t)(32 * j_) * SEQ + 128 * (p_)) * 2; \
        __builtin_amdgcn_global_load_lds((const GAS unsigned*)(vb_ + vvoff), (LAS unsigned*)(buf_ + (8 * j_ + w) * 1024), 16, 0, 0); } } while (0)
#define MB5_DMAK2(p_) do { LAS unsigned char* buf_ = F.lds + ((p_) & 1) * MB3_BUF; _Pragma("unroll") for (int j_ = 0; j_ < 4; ++j_) _Pragma("unroll") for (int h_ = 0; h_ < 2; ++h_) { \
        const GAS char* kb_ = (const GAS char*)KN + (size_t)(128 * (p_) + 32 * j_) * 2048 - h_ * 32768; \
        __builtin_amdgcn_global_load_lds((const GAS unsigned*)(kb_ + kvoff), (LAS unsigned*)(buf_ + (8 * j_ + w - 4 * h_) * 1024), 16, 0, 0); } } while (0)
#define MB5_DMAV2(p_) do { LAS unsigned char* buf_ = F.lds + ((p_) & 1) * MB3_BUF + MB3_TILE; _Pragma("unroll") for (int j_ = 0; j_ < 4; ++j_) _Pragma("unroll") for (int h_ = 0; h_ < 2; ++h_) { \
        const GAS char* vb_ = (const GAS char*)VT + ((size_t)(32 * j_) * SEQ + 128 * (p_)) * 2 - h_ * (16 * SEQ * 2); \
        __builtin_amdgcn_global_load_lds((const GAS unsigned*)(vb_ + vvoff), (LAS unsigned*)(buf_ + (8 * j_ + w - 4 * h_) * 1024), 16, 0, 0); } } while (0)
#define MB5_DUTY(p_) do { if ((p_) + 1 < np) { if ((p_) + 2 < np) MB5_DMAK2((p_) + 2); MB5_DMAV2((p_) + 1); } } while (0)
#define MB5_QKL(INIT_) do { _Pragma("unroll") for (int mh = 0; mh < 4; ++mh) { bf16x8_t fragA[2][4]; \
        _Pragma("unroll") for (int mt = 0; mt < 2; ++mt) _Pragma("unroll") for (int ks = 0; ks < 4; ++ks) fragA[mt][ks] = *(const LAS bf16x8_t*)(KB + (16 * (2 * mh + mt) + fr) * 256 + 16 * ((4 * ks + fq) ^ fr)); \
        __builtin_amdgcn_sched_barrier(0); \
        _Pragma("unroll") for (int mt = 0; mt < 2; ++mt) { const int i_ = 2 * mh + mt; f32x4 c_ = INIT_; _Pragma("unroll") for (int ks = 0; ks < 4; ++ks) c_ = mma16(fragA[mt][ks], bq[ks], c_); as[i_] = c_; } \
        __builtin_amdgcn_sched_barrier(0); } } while (0)
#define MB5_ZERO ((f32x4){0.f, 0.f, 0.f, 0.f})
#define MB5_MASK ((f32x4){(16 * i_ + 0 <= ld_) ? 0.f : -__builtin_inff(), (16 * i_ + 1 <= ld_) ? 0.f : -__builtin_inff(), (16 * i_ + 2 <= ld_) ? 0.f : -__builtin_inff(), (16 * i_ + 3 <= ld_) ? 0.f : -__builtin_inff()})
#define MB5_QK(p_) do { const LAS unsigned char* KB = F.lds + ((p_) & 1) * MB3_BUF; \
        if ((p_) == qt) { int ld_ = limd; asm volatile("" : "+v"(ld_)); MB5_QKL(MB5_MASK); } else { MB5_QKL(MB5_ZERO); } } while (0)
    MB5_DMAK(0); MB5_DMAV(0); if (np > 1) MB5_DMAK(1);
    VM_WAIT(); LDS_WAIT(); __syncthreads();
    unsigned selmask = 0u;
    { float sc[8];
#pragma unroll
      for (int kb = 0; kb < 8; ++kb) { float a = 0.f;
#pragma unroll
          for (int ks = 0; ks < 4; ++ks) { const LAS float* kp = KML + kb * 128 + 32 * ks + 8 * fq; const f32x4 k0 = *(const LAS f32x4*)kp, k1 = *(const LAS f32x4*)(kp + 4);
              const v4u qv = __builtin_bit_cast(v4u, bq[ks]);
              a += bflo(qv.x) * k0[0] + bfhi(qv.x) * k0[1] + bflo(qv.y) * k0[2] + bfhi(qv.y) * k0[3] + bflo(qv.z) * k1[0] + bfhi(qv.z) * k1[1] + bflo(qv.w) * k1[2] + bfhi(qv.w) * k1[3]; }
          a += __shfl_xor(a, 16); a += __shfl_xor(a, 32); sc[kb] = (kb < qb) ? a : -__builtin_inff(); }
#pragma unroll
      for (int kb = 0; kb < 8; ++kb) { int rank = 0;
#pragma unroll
          for (int j = 0; j < 8; ++j) if (j != kb) rank += ((j < qb) && (sc[j] > sc[kb] || (sc[j] == sc[kb] && j < kb))) ? 1 : 0;
          if (kb < qb && rank < 3) selmask |= 1u << kb; } }
    f32x4 ao[8];
#pragma unroll
    for (int dt = 0; dt < 8; ++dt) ao[dt] = (f32x4){0.f, 0.f, 0.f, 0.f};
    float m = -__builtin_inff();
    f32x4 al = (f32x4){0.f, 0.f, 0.f, 0.f};
    const bf16x8_t ones = (bf16x8_t){0x3F80, 0x3F80, 0x3F80, 0x3F80, 0x3F80, 0x3F80, 0x3F80, 0x3F80};
    const int limd = 16 * w + fr - 4 * fq;
    f32x4 as[8]; bf16x8_t pf[4];
#define MB5_MINE(p_) ((((p_) >> 1) < qb) ? (((selmask >> ((p_) >> 1)) & 1u) != 0u) : true)
    bool act = __any(MB5_MINE(0));
    if (act) MB5_QK(0);
    LDS_WAIT();
    if (hb) __builtin_amdgcn_s_barrier();
#pragma unroll 1
    for (int p = 0; p < np; ++p) {
        if (hb) MB5_DUTY(p);
        if (act) {
            const bool skip = ((p >> 1) < qb) && !MB5_MINE(p);
            float mx = -__builtin_inff();
#pragma unroll
            for (int mt = 0; mt < 8; ++mt)
#pragma unroll
                for (int r = 0; r < 4; ++r) mx = fmaxf(mx, as[mt][r]);
            mx = skip ? -__builtin_inff() : mx;
            mx = fmaxf(mx, __shfl_xor(mx, 16)); mx = fmaxf(mx, __shfl_xor(mx, 32));
            const float mnew = fmaxf(m, mx), msafe = (mnew == -__builtin_inff()) ? 0.f : mnew;
            const bool grow = __any(mnew != m);
            const float corr = grow ? __builtin_amdgcn_exp2f(m - msafe) : 1.0f;
            const float sub = skip ? 3.0e38f : msafe;
#pragma unroll
            for (int mt = 0; mt < 8; ++mt)
#pragma unroll
                for (int r = 0; r < 4; ++r) as[mt][r] = __builtin_amdgcn_exp2f(as[mt][r] - sub);
            m = mnew;
#pragma unroll
            for (int k2 = 0; k2 < 4; ++k2) { v4u t; t.x = pg8::cvt_pk_bf16(as[2 * k2][0], as[2 * k2][1]); t.y = pg8::cvt_pk_bf16(as[2 * k2][2], as[2 * k2][3]); t.z = pg8::cvt_pk_bf16(as[2 * k2 + 1][0], as[2 * k2 + 1][1]); t.w = pg8::cvt_pk_bf16(as[2 * k2 + 1][2], as[2 * k2 + 1][3]);
                pf[k2] = __builtin_bit_cast(bf16x8_t, t); }
            if (grow) {
#pragma unroll
                for (int dt = 0; dt < 8; ++dt) ao[dt] = ao[dt] * corr;
                al = al * corr; }
        }
        LDS_WAIT(); __builtin_amdgcn_s_barrier(); asm volatile("" ::: "memory");
        __builtin_amdgcn_s_setprio(1);
        if (act) {
            const LAS unsigned char* VB = F.lds + (p & 1) * MB3_BUF + MB3_TILE;
#pragma unroll
            for (int k2 = 0; k2 < 4; ++k2) al = mma16(ones, pf[k2], al);
#pragma unroll
            for (int dh = 0; dh < 4; ++dh) { bf16x8_t fragV[2][4];
#pragma unroll
                for (int dt = 0; dt < 2; ++dt)
#pragma unroll
                    for (int k2 = 0; k2 < 4; ++k2) fragV[dt][k2] = *(const LAS bf16x8_t*)(VB + (16 * (2 * dh + dt) + fr) * 256 + 16 * ((4 * k2 + fq) ^ fr));
                __builtin_amdgcn_sched_barrier(0);
#pragma unroll
                for (int dt = 0; dt < 2; ++dt)
#pragma unroll
                    for (int k2 = 0; k2 < 4; ++k2) ao[2 * dh + dt] = mma16(fragV[dt][k2], pf[k2], ao[2 * dh + dt]);
                __builtin_amdgcn_sched_barrier(0); }
        }
        act = (p + 1 < np) ? __any(MB5_MINE(p + 1)) : false;
        if (act) MB5_QK(p + 1);
        __builtin_amdgcn_s_setprio(0);
        if (hb) VM_WAIT();
        LDS_WAIT(); __builtin_amdgcn_s_barrier(); asm volatile("" ::: "memory");
    }
    if (!hb) __builtin_amdgcn_s_barrier();
#undef MB5_DMAK
#undef MB5_DMAV
#undef MB5_DUTY
#undef MB5_DMAK2
#undef MB5_DMAV2
#undef MB5_QK
#undef MB5_QKL
#undef MB5_ZERO
#undef MB5_MASK
#undef MB5_MINE
    const float inv = 1.0f / al[0];
    GAS bf16* yp = (GAS bf16*)(F.ws + WS_Y) + ((size_t)b * SEQ + qpos) * YW + 2048 + h * 128 + 4 * fq;
#pragma unroll
    for (int dt = 0; dt < 8; ++dt) { v2u o; o.x = pg8::cvt_pk_bf16(ao[dt][0] * inv, ao[dt][1] * inv); o.y = pg8::cvt_pk_bf16(ao[dt][2] * inv, ao[dt][3] * inv); *(GAS v2u*)(yp + 16 * dt) = o; }
}
constexpr int NPH = 9;
__global__ void __launch_bounds__(NWAVES * 64, 2) fwd_kernel(Args args) {
    extern __shared__ __attribute__((aligned(16))) unsigned char lds[];
    Frame F;
    F.lds = (LAS unsigned char*)lds;
    F.MISC = (volatile LAS unsigned*)(F.lds + MISC_OFF);
    F.tid = threadIdx.x; F.lane = F.tid & 63; F.wave = __builtin_amdgcn_readfirstlane(F.tid >> 6); F.wv = F.wave;
    F.G = gridDim.x; F.in = args.in; F.ws = (GAS unsigned char*)args.ws; F.ws0 = args.ws; F.ctl = (unsigned*)(args.ws + WS_CTL);
    for (int u = F.tid; u < (LDS_BYTES - LDSCTL_OFF) / 4; u += NWAVES * 64) ((LAS unsigned*)(F.lds + LDSCTL_OFF))[u] = 0u;
    __syncthreads();
    XcdBarrier bar; bar.bar = F.ctl + CW_BAR; bar.x = 0; bar.st = nullptr;
    if (args.fused) bar = xcd_barrier_post(F.ctl + CW_BAR, F.MISC + 8);
#define GRID_BAR() do { if (args.fused) xcd_barrier(bar, opaque_tid(F.wv)); } while (0)
    const int lo = args.ph_lo, hi = args.ph_hi;
#ifndef PH_MASK
#define PH_MASK 0x1ff
#endif
#define IN(k) (((PH_MASK >> (k)) & 1) && lo <= (k) && (k) < hi)
#define WSP(T, off) ((GAS T*)(ws + (off)))

    if (args.l_lo == 0 && IN(0)) for (int rep = 0; rep < NREP(0); ++rep) { F.refresh(); p0_prologue(F); GRID_BAR(); }

    for (int l = args.l_lo; l < args.l_hi; ++l) {
        if (IN(1)) for (int rep = 0; rep < NREP(1); ++rep) {
            GAS unsigned char* ws = (GAS unsigned char*)opaque_ptr(args.ws); const GAS unsigned char* wl = ws + WS_W + (size_t)l * SZ_WLAYER;
            pg8::Gemm g{WSP(pg8::bf16_t, WS_XB), DM, (const GAS pg8::bf16_t*)(wl + OFF_WIN), DM, DM, 0, 0}; pg8::TileOrder S; S.init(MTOK, NP, F.G, (int)blockIdx.x, 1);
            pg8::EpiInProj E{WSP(pg8::bf16_t, WS_P), WSP(float, WS_SSQ), WSP(pg8::bf16_t, WS_US), WSP(pg8::bf16_t, WS_QN), WSP(pg8::bf16_t, WS_KN), WSP(float, WS_KM), ((const GAS float*)args.in[I_MQG]) + l * 128, ((const GAS float*)args.in[I_MKG]) + l * 128};
            pg8::gemm_phase(F.lds, g, S, E, F.wv);
            if (rep == 0) { F.refresh(); cv_tail(F, l, 0); }
            GRID_BAR();
        }
        if (IN(2)) for (int rep = 0; rep < NREP(2); ++rep) {
            int rot = ((int)blockIdx.x >> 3) & 1, nstep = 2; asm volatile("" : "+s"(rot), "+s"(nstep));
#pragma unroll 1
            for (int step = 0; step < nstep; ++step) { const int kind = step ^ rot;
                VM_WAIT(); __syncthreads(); F.refresh();
                if (kind == 0) { for (int rp = 0; rp < NREP(13); ++rp) { int hprev = -1; for (int u = blockIdx.x; u < 512; u += F.G) { const int hh = (u >> 5) & 3; gla_g1_unit(F, l, u, hh != hprev); hprev = hh; } } }
                else { for (int rp = 0; rp < NREP(14); ++rp) for (int u = blockIdx.x; u < 256; u += F.G) moba_prep_unit(F, l, u); } }
            GRID_BAR(); }
        if (IN(3)) for (int rep = 0; rep < NREP(3); ++rep) {
            int rot3 = ((int)blockIdx.x >> 6) & 1, nstep3 = 2; asm volatile("" : "+s"(rot3), "+s"(nstep3));
#pragma unroll 1
            for (int step = 0; step < nstep3; ++step) {
                VM_WAIT(); __syncthreads(); F.refresh();
                if ((step ^ rot3) == 0) {
                    for (int rp = 0; rp < NREP(9); ++rp) for (int u = blockIdx.x; u < 256; u += F.G) s5_s13_unit(F, l, u);
                    VM_WAIT(); __syncthreads();
                    F.refresh(); for (int rp = 0; rp < NREP(10); ++rp) gla_g2_scan(F);
                } else {
                    for (int rp = 0; rp < NREP(11) * ATT_REP; ++rp) for (int pi2 = 2 * blockIdx.x; pi2 < 512; pi2 += 2 * F.G) {
#pragma unroll 1
                        for (int hh = 0; hh < 2; ++hh) { const int pi = pi2 >> 1;
                            const int bh = (pi & 7) + 8 * ((pi >> 6) & 3), xp = (pi >> 3) & 7; moba_attn_unit5(F, bh, hh ? xp : 15 - xp); } }
                } }
            GRID_BAR(); }
        if (IN(4)) for (int rep = 0; rep < NREP(4); ++rep) {
            const int gh = F.G >= 2 ? F.G / 2 : 1;
            if ((int)blockIdx.x < gh) {
                GAS unsigned char* ws = (GAS unsigned char*)opaque_ptr(args.ws); const GAS unsigned char* wl = ws + WS_W + (size_t)l * SZ_WLAYER;
                pg8::Gemm g{WSP(pg8::bf16_t, WS_Z), 1024, (const GAS pg8::bf16_t*)(wl + OFF_WGLU), 1024, 1024, 0, 0}; pg8::TileOrder S; S.init(MTOK, 1024, gh, (int)blockIdx.x, 1);
                pg8::EpiGLU E{WSP(pg8::bf16_t, WS_Z), WSP(pg8::bf16_t, WS_Y), ((const GAS float*)args.in[I_BGLU]) + l * 1024};
                pg8::gemm_phase(F.lds, g, S, E, F.wv);
            }
            { F.refresh();
              GAS unsigned* head = (GAS unsigned*)(F.ctl + CW_QUEUE + 64 * l);
              for (;;) { if (F.tid == 0) F.MISC[16] = __hip_atomic_fetch_add(head, 1u, __ATOMIC_RELAXED, __HIP_MEMORY_SCOPE_AGENT);
                  LDS_WAIT(); __syncthreads(); const unsigned uq = F.MISC[16]; __syncthreads();
                  if (uq >= 512u) break; gla_g3_unit(F, l, (int)uq); } }
            GRID_BAR();
        }
        if (IN(5)) for (int rep = 0; rep < NREP(5); ++rep) {
            GAS unsigned char* ws = (GAS unsigned char*)opaque_ptr(args.ws); const GAS unsigned char* wl = ws + WS_W + (size_t)l * SZ_WLAYER;
            pg8::Gemm g{WSP(pg8::bf16_t, WS_Y), YW, (const GAS pg8::bf16_t*)(wl + OFF_WBR), 3072, 1024, 1024, 1024}; pg8::TileOrder S; S.init(MTOK, DM, F.G, (int)blockIdx.x, 3);
            pg8::EpiBranch E{WSP(pg8::bf16_t, WS_P), WSP(pg8::bf16_t, WS_MB)};
            pg8::gemm_phase(F.lds, g, S, E, F.wv);
            GRID_BAR();
        }
        if (IN(6)) {
            GAS unsigned char* ws = (GAS unsigned char*)opaque_ptr(args.ws); const GAS unsigned char* wl = ws + WS_W + (size_t)l * SZ_WLAYER;
            pg8::Gemm g{WSP(pg8::bf16_t, WS_MB), DM, (const GAS pg8::bf16_t*)(wl + OFF_WOUT), DM, DM, 0, 0}; pg8::TileOrder S; S.init(MTOK, DM, F.G, (int)blockIdx.x, 1);
            if (l == 0) { pg8::EpiResid<true, false> E{((const GAS float*)args.in[I_X]), nullptr, WSP(pg8::bf16_t, WS_XB), WSP(float, WS_SSQ)}; pg8::gemm_phase(F.lds, g, S, E, F.wv); }
            else { pg8::EpiResid<false, false> E{nullptr, nullptr, WSP(pg8::bf16_t, WS_XB), WSP(float, WS_SSQ)}; pg8::gemm_phase(F.lds, g, S, E, F.wv); }
            GRID_BAR();
        }
        if (IN(7)) for (int rep = 0; rep < NREP(7); ++rep) {
            GAS unsigned char* ws = (GAS unsigned char*)opaque_ptr(args.ws); const GAS unsigned char* wl = ws + WS_W + (size_t)l * SZ_WLAYER;
            pg8::Gemm g{WSP(pg8::bf16_t, WS_XB), DM, (const GAS pg8::bf16_t*)(wl + OFF_WGU), DM, DM, 0, 0}; pg8::TileOrder S; S.init(MTOK, NGU, F.G, (int)blockIdx.x, 1);
            pg8::EpiFFNUp E{WSP(pg8::bf16_t, WS_H), WSP(float, WS_SSQ)};
            pg8::gemm_phase(F.lds, g, S, E, F.wv);
            if (rep == 0) { F.refresh(); cv_tail(F, l, 1); }
            GRID_BAR();
        }
        if (IN(8)) {
            GAS unsigned char* ws = (GAS unsigned char*)opaque_ptr(args.ws); const GAS unsigned char* wl = ws + WS_W + (size_t)l * SZ_WLAYER;
            pg8::Gemm g{WSP(pg8::bf16_t, WS_H), FFN, (const GAS pg8::bf16_t*)(wl + OFF_WDN), FFN, FFN, 0, 0}; pg8::TileOrder S; S.init(MTOK, DM, F.G, (int)blockIdx.x, 1);
            if (l == DEPTH - 1) { pg8::EpiResid<false, true> E{nullptr, (GAS float*)args.out, WSP(pg8::bf16_t, WS_XB), WSP(float, WS_SSQ)}; pg8::gemm_phase(F.lds, g, S, E, F.wv); }
            else { pg8::EpiResid<false, false> E{nullptr, nullptr, WSP(pg8::bf16_t, WS_XB), WSP(float, WS_SSQ)}; pg8::gemm_phase(F.lds, g, S, E, F.wv); }
            if (l + 1 < DEPTH) GRID_BAR();
        }
    }
#undef IN
#undef GRID_BAR
}

extern "C" void kernel_launch(void* const* d_in, const int* in_sizes, int n_in, void* d_out, int out_size, void* d_ws, size_t ws_size, hipStream_t stream) {
    static int grid = 0;
    if (grid == 0) {
        if (n_in != 26 || out_size != MTOK * DM || ws_size < WS_END) { fprintf(stderr, "kernel_launch: unexpected problem (n_in %d out %d ws %zu need %zu)\n", n_in, out_size, ws_size, (size_t)WS_END); grid = -1; return; }
        int dev = 0, cus = 0, per_cu = 0;
        if (hipGetDevice(&dev) != hipSuccess || hipDeviceGetAttribute(&cus, hipDeviceAttributeMultiprocessorCount, dev) != hipSuccess) { grid = -1; return; }
        if (hipFuncSetAttribute((const void*)fwd_kernel, hipFuncAttributeMaxDynamicSharedMemorySize, LDS_BYTES) != hipSuccess) { fprintf(stderr, "kernel_launch: hipFuncSetAttribute failed\n"); grid = -1; return; }
        if (hipOccupancyMaxActiveBlocksPerMultiprocessor(&per_cu, (const void*)fwd_kernel, NWAVES * 64, LDS_BYTES) != hipSuccess || per_cu < 1) { fprintf(stderr, "kernel_launch: occupancy query says %d\n", per_cu); }
        (void)hipGetLastError();
        grid = cus;
    }
    if (grid < 0) return;
    if (hipMemsetAsync((char*)d_ws + WS_CTL, 0, CTL_ZERO_BYTES, stream) != hipSuccess) return;
    Args a{};
    for (int i = 0; i < 26; ++i) a.in[i] = (const float*)d_in[i];
    a.out = (float*)d_out; a.ws = (unsigned char*)d_ws; a.pad = 0;
#if MK_FUSED
    a.l_lo = 0; a.l_hi = DEPTH; a.ph_lo = 0; a.ph_hi = NPH; a.fused = 1;
    hipLaunchKernelGGL(fwd_kernel, dim3(grid), dim3(NWAVES * 64), LDS_BYTES, stream, a);
#else
    a.fused = 0;
    for (int l = 0; l < DEPTH; ++l)
        for (int ph = (l == 0 ? 0 : 1); ph < NPH; ++ph) { a.l_lo = l; a.l_hi = l + 1; a.ph_lo = ph; a.ph_hi = ph + 1; hipLaunchKernelGGL(fwd_kernel, dim3(grid), dim3(NWAVES * 64), LDS_BYTES, stream, a); }
#endif
}
```
